# Optimizing an MI355X kernel written in HIP

```python
import jax, jax.numpy as jnp
from jax import lax
import numpy as np


D_MODEL = 1024
BATCH = 4
SEQ = 8192
DEPTH = 4

GRID_W = 64
CTX_LEN = 256
FOURIER_GROUPS = 4
FOURIER_GROUP_DIM = D_MODEL // 8
FOURIER_DIM = FOURIER_GROUPS * FOURIER_GROUP_DIM
HEAD_DIM = 64
N_Q_HEADS = D_MODEL // 128
N_KV_HEADS = N_Q_HEADS // 4
Q_PER_KV = N_Q_HEADS // N_KV_HEADS
ATTN_DIM = N_Q_HEADS * HEAD_DIM
KV_DIM = N_KV_HEADS * HEAD_DIM
WINDOW = 128
BLOCK = 128
ROPE_THETA = 10000.0
ROPE_FREQS = HEAD_DIM // 4
IN_DIM = FOURIER_DIM + ATTN_DIM + 2 * KV_DIM + 2 * D_MODEL
SPLITS = (FOURIER_DIM, FOURIER_DIM + ATTN_DIM, FOURIER_DIM + ATTN_DIM + KV_DIM,
          FOURIER_DIM + ATTN_DIM + 2 * KV_DIM, FOURIER_DIM + ATTN_DIM + 2 * KV_DIM + D_MODEL)
KV_LO = FOURIER_DIM + ATTN_DIM
KV_HI = FOURIER_DIM + ATTN_DIM + 2 * KV_DIM
N_EXPERTS = 32
TOP_K = 4
D_EXPERT = D_MODEL
SWIGLU_LIMIT = 7.0
SWIGLU_ALPHA = 1.702
MOE_BLOCK = 128
N_MOD = 6
EPS = 1e-5
NEG_INF = -1e30

kernel_name = 'hybrid_fourier_window_moe_dit_block'


def rmsnorm(x, g):
    xf = x.astype(jnp.float32)
    y = xf * lax.rsqrt(jnp.mean(xf * xf, axis=-1, keepdims=True) + EPS)
    return (y * g.astype(jnp.float32)).astype(x.dtype)


def modulate(h, shift, scale):
    return h * (1 + scale) + shift


def axial_rope_tables(n):
    rows = n // GRID_W
    row = jnp.broadcast_to(jnp.arange(rows)[:, None], (rows, GRID_W)).reshape(-1)
    col = jnp.broadcast_to(jnp.arange(GRID_W)[None, :], (rows, GRID_W)).reshape(-1)
    inv_freq = ROPE_THETA ** (-jnp.arange(ROPE_FREQS, dtype=jnp.float32) / ROPE_FREQS)
    ang = jnp.stack([row.astype(jnp.float32)[:, None] * inv_freq,
                     col.astype(jnp.float32)[:, None] * inv_freq], axis=1)
    return jnp.cos(ang), jnp.sin(ang)


def apply_axial_rope(x, cos, sin):
    b, n, h, _ = x.shape
    xs = x.reshape(b, n, h, 2, 2, ROPE_FREQS)
    c = cos.reshape(1, n, 1, 2, ROPE_FREQS).astype(x.dtype)
    s = sin.reshape(1, n, 1, 2, ROPE_FREQS).astype(x.dtype)
    x1, x2 = xs[..., 0, :], xs[..., 1, :]
    out = jnp.stack([x1 * c - x2 * s, x2 * c + x1 * s], axis=-2)
    return out.reshape(x.shape)


def split_projection(p):
    b, n = p.shape[:2]
    f, q, k, v, gf, ga = jnp.split(p, SPLITS, axis=-1)
    return (f, q.reshape(b, n, N_Q_HEADS, HEAD_DIM), k.reshape(b, n, N_KV_HEADS, HEAD_DIM),
            v.reshape(b, n, N_KV_HEADS, HEAD_DIM), gf, ga)


def fourier_mix(f):
    b, n, _ = f.shape
    fg = f.astype(jnp.float32).reshape(b, n, FOURIER_GROUPS, FOURIER_GROUP_DIM)
    out = jnp.fft.fft2(fg, axes=(1, 3), norm='ortho').real
    return out.reshape(b, n, FOURIER_DIM).astype(f.dtype)


def sink_column(sink, shape):
    return jnp.broadcast_to(sink.astype(jnp.float32).reshape((1,) * (len(shape) - 4) + (N_KV_HEADS, Q_PER_KV, 1, 1)), shape)


def latent_attention(q, k, v, kc, vc, sink):
    b, n = q.shape[:2]
    L = kc.shape[1]
    nb = n // BLOCK
    qb = (q * HEAD_DIM ** -0.5).reshape(b, nb, BLOCK, N_KV_HEADS, Q_PER_KV, HEAD_DIM)

    def windows(t):
        tp = jnp.pad(t, ((0, 0), (BLOCK, BLOCK), (0, 0), (0, 0))).reshape(b, nb + 2, BLOCK, N_KV_HEADS, HEAD_DIM)
        return jnp.concatenate([tp[:, :-2], tp[:, 1:-1], tp[:, 2:]], axis=2)

    kw, vw = windows(k), windows(v)
    s_loc = jnp.einsum('bnqhgd,bnkhd->bnhgqk', qb, kw).astype(jnp.float32)
    r = jnp.arange(BLOCK)[:, None]
    s = jnp.arange(3 * BLOCK)[None, :]
    rel = s - BLOCK - r
    key_pos = (jnp.arange(nb)[:, None, None] - 1) * BLOCK + s[None]
    mask = (jnp.abs(rel) <= WINDOW)[None] & (key_pos >= 0) & (key_pos < n)
    s_loc = jnp.where(mask[None, :, None, None], s_loc, NEG_INF)
    s_ctx = jnp.einsum('bnqhgd,bkhd->bnhgqk', qb, kc).astype(jnp.float32)
    sk = sink_column(sink, s_ctx.shape[:-1] + (1,))
    p = jax.nn.softmax(jnp.concatenate([s_loc, s_ctx, sk], axis=-1), axis=-1)
    p_loc = p[..., :3 * BLOCK].astype(v.dtype)
    p_ctx = p[..., 3 * BLOCK:3 * BLOCK + L].astype(v.dtype)
    o = (jnp.einsum('bnhgqk,bnkhd->bnqhgd', p_loc, vw)
         + jnp.einsum('bnhgqk,bkhd->bnqhgd', p_ctx, vc))
    return o.reshape(b, n, ATTN_DIM)


def context_attention(qc, kc, vc, sink):
    b, L = qc.shape[:2]
    qg = (qc * HEAD_DIM ** -0.5).reshape(b, L, N_KV_HEADS, Q_PER_KV, HEAD_DIM)
    s = jnp.einsum('bqhgd,bkhd->bhgqk', qg, kc).astype(jnp.float32)
    sk = sink_column(sink, s.shape[:-1] + (1,))
    p = jax.nn.softmax(jnp.concatenate([s, sk], axis=-1), axis=-1)[..., :L].astype(vc.dtype)
    o = jnp.einsum('bhgqk,bkhd->bqhgd', p, vc)
    return o.reshape(b, L, ATTN_DIM)


def merge_branches(f_mixed, attn, gf, ga, w_fo, w_ao, w_out):
    y = jax.nn.sigmoid(gf) * (f_mixed @ w_fo) + jax.nn.sigmoid(ga) * (attn @ w_ao)
    return y @ w_out


def token_mixer(hx, hc, w_in, w_fo, w_ao, w_out, sink, cos, sin, with_ctx_out):
    fx, qx, kx, vx, gfx, gax = split_projection(hx @ w_in)
    qx, kx = apply_axial_rope(qx, cos, sin), apply_axial_rope(kx, cos, sin)
    if with_ctx_out:
        fc, qc, kc, vc, gfc, gac = split_projection(hc @ w_in)
    else:
        b, L = hc.shape[:2]
        kc, vc = jnp.split(hc @ w_in[:, KV_LO:KV_HI], 2, axis=-1)
        kc, vc = kc.reshape(b, L, N_KV_HEADS, HEAD_DIM), vc.reshape(b, L, N_KV_HEADS, HEAD_DIM)
    ax = latent_attention(qx, kx, vx, kc, vc, sink)
    out_x = merge_branches(fourier_mix(fx), ax, gfx, gax, w_fo, w_ao, w_out)
    if not with_ctx_out:
        return out_x, None
    ac = context_attention(qc, kc, vc, sink)
    out_c = merge_branches(fourier_mix(fc), ac, gfc, gac, w_fo, w_ao, w_out)
    return out_x, out_c


def moe_ffn(h, router_w, router_b, w_gu, b_gu, w_down, b_down):
    t, d = h.shape
    logits = (h @ router_w + router_b).astype(jnp.float32)
    top_v, top_i = lax.top_k(logits, TOP_K)
    gates = jax.nn.softmax(top_v, axis=-1).astype(h.dtype)
    tk = t * TOP_K
    flat_e = top_i.reshape(tk)
    flat_tok = jnp.arange(tk) // TOP_K
    order = jnp.argsort(flat_e)
    e_sorted = flat_e[order]
    tok_sorted = flat_tok[order]
    gate_sorted = gates.reshape(tk)[order]
    counts = jnp.zeros((N_EXPERTS,), jnp.int32).at[flat_e].add(1)
    padded = (counts + MOE_BLOCK - 1) // MOE_BLOCK * MOE_BLOCK
    pad_end = jnp.cumsum(padded)
    pad_start = pad_end - padded
    start = jnp.cumsum(counts) - counts
    dest = pad_start[e_sorted] + jnp.arange(tk) - start[e_sorted]
    n_blocks = -(-(tk + N_EXPERTS * (MOE_BLOCK - 1)) // MOE_BLOCK)
    rows = n_blocks * MOE_BLOCK
    slot_tok = jnp.full((rows,), t, jnp.int32).at[dest].set(tok_sorted)
    h_pad = jnp.concatenate([h, jnp.zeros((1, d), h.dtype)], axis=0)
    xb = h_pad[slot_tok].reshape(n_blocks, MOE_BLOCK, d)
    block_e = jnp.minimum(jnp.searchsorted(pad_end, jnp.arange(n_blocks) * MOE_BLOCK, side='right'), N_EXPERTS - 1)

    def expert_block(args):
        xe, e = args
        gu = xe @ w_gu[e] + b_gu[e]
        a, u = jnp.split(gu, 2, axis=-1)
        a = jnp.minimum(a, SWIGLU_LIMIT)
        u = jnp.clip(u, -SWIGLU_LIMIT, SWIGLU_LIMIT)
        y = a * jax.nn.sigmoid(SWIGLU_ALPHA * a) * (u + 1)
        return y @ w_down[e] + b_down[e]

    yb = lax.map(expert_block, (xb, block_e)).reshape(rows, d)
    contrib = yb[dest] * gate_sorted[:, None]
    return jax.ops.segment_sum(contrib, tok_sorted, num_segments=t)


def setup_inputs(seed: int = 0) -> dict:
    key = jax.random.key(seed)
    ks = jax.random.split(key, 20)

    def nrm(k, shape, scale):
        return jax.random.normal(k, shape, jnp.float32) * scale

    return {
        'x': nrm(ks[0], (BATCH, SEQ, D_MODEL), 1.0),
        'c': nrm(ks[1], (BATCH, D_MODEL), 1.0),
        'ctx': nrm(ks[2], (BATCH, CTX_LEN, D_MODEL), 1.0),
        'c_ctx': nrm(ks[3], (D_MODEL,), 1.0),
        'ada_w': nrm(ks[4], (DEPTH, D_MODEL, N_MOD * D_MODEL), 0.5 * D_MODEL ** -0.5),
        'ada_b': nrm(ks[5], (DEPTH, N_MOD * D_MODEL), 0.02),
        'norm1_g': 1.0 + nrm(ks[6], (DEPTH, D_MODEL), 0.02),
        'norm2_g': 1.0 + nrm(ks[7], (DEPTH, D_MODEL), 0.02),
        'w_in': nrm(ks[8], (DEPTH, D_MODEL, IN_DIM), D_MODEL ** -0.5),
        'attn_sink': nrm(ks[9], (DEPTH, N_Q_HEADS), 0.5),
        'w_fourier_out': nrm(ks[10], (DEPTH, FOURIER_DIM, D_MODEL), FOURIER_DIM ** -0.5),
        'w_attn_out': nrm(ks[11], (DEPTH, ATTN_DIM, D_MODEL), ATTN_DIM ** -0.5),
        'w_out': nrm(ks[12], (DEPTH, D_MODEL, D_MODEL), D_MODEL ** -0.5),
        'router_w': nrm(ks[13], (DEPTH, D_MODEL, N_EXPERTS), D_MODEL ** -0.5),
        'router_b': nrm(ks[14], (DEPTH, N_EXPERTS), 0.01),
        'expert_w_gu': nrm(ks[15], (DEPTH, N_EXPERTS, D_MODEL, 2 * D_EXPERT), D_MODEL ** -0.5),
        'expert_b_gu': nrm(ks[16], (DEPTH, N_EXPERTS, 2 * D_EXPERT), 0.02),
        'expert_w_down': nrm(ks[17], (DEPTH, N_EXPERTS, D_EXPERT, D_MODEL), D_EXPERT ** -0.5),
        'expert_b_down': nrm(ks[18], (DEPTH, N_EXPERTS, D_MODEL), 0.02),
        'final_norm_g': 1.0 + nrm(ks[19], (D_MODEL,), 0.02),
    }


def reference(x, c, ctx, c_ctx, ada_w, ada_b, norm1_g, norm2_g, w_in, attn_sink, w_fourier_out,
              w_attn_out, w_out, router_w, router_b, expert_w_gu, expert_b_gu, expert_w_down,
              expert_b_down, final_norm_g):
    b, n, d = x.shape
    L = ctx.shape[1]
    cos, sin = axial_rope_tables(n)
    silu_c = jax.nn.silu(c)
    silu_cc = jax.nn.silu(c_ctx)
    for l in range(DEPTH):
        last = l == DEPTH - 1
        mod_x = (silu_c @ ada_w[l] + ada_b[l])[:, None, :]
        mod_c = silu_cc @ ada_w[l] + ada_b[l]
        sh1x, sc1x, g1x, sh2x, sc2x, g2x = jnp.split(mod_x, N_MOD, axis=-1)
        sh1c, sc1c, g1c, sh2c, sc2c, g2c = jnp.split(mod_c, N_MOD, axis=-1)
        hx = modulate(rmsnorm(x, norm1_g[l]), sh1x, sc1x)
        hc = modulate(rmsnorm(ctx, norm1_g[l]), sh1c, sc1c)
        out_x, out_c = token_mixer(hx, hc, w_in[l], w_fourier_out[l], w_attn_out[l], w_out[l],
                                   attn_sink[l], cos, sin, not last)
        x = x + g1x * out_x
        hx2 = modulate(rmsnorm(x, norm2_g[l]), sh2x, sc2x).reshape(b * n, d)
        if last:
            m = moe_ffn(hx2, router_w[l], router_b[l], expert_w_gu[l], expert_b_gu[l],
                        expert_w_down[l], expert_b_down[l])
            x = x + g2x * m.reshape(b, n, d)
        else:
            ctx = ctx + g1c * out_c
            hc2 = modulate(rmsnorm(ctx, norm2_g[l]), sh2c, sc2c).reshape(b * L, d)
            m = moe_ffn(jnp.concatenate([hx2, hc2], axis=0), router_w[l], router_b[l], expert_w_gu[l],
                        expert_b_gu[l], expert_w_down[l], expert_b_down[l])
            x = x + g2x * m[:b * n].reshape(b, n, d)
            ctx = ctx + g2c * m[b * n:].reshape(b, L, d)
    return rmsnorm(x, final_norm_g)
```

```cpp
#include <hip/hip_runtime.h>
#include <cstdio>
#include <cstdint>

#define LAS __attribute__((address_space(3)))
typedef unsigned short bf16_t;
typedef short bf16x8 __attribute__((ext_vector_type(8)));
typedef short s16x4 __attribute__((ext_vector_type(4)));
typedef float f32x4 __attribute__((ext_vector_type(4)));
typedef float f32x16 __attribute__((ext_vector_type(16)));
typedef unsigned u32x4 __attribute__((ext_vector_type(4)));
typedef unsigned u32x2 __attribute__((ext_vector_type(2)));

#ifndef N_LAUNCH_MODE
#define N_LAUNCH_MODE 1
#endif
#ifndef DBG_CHECK
#define DBG_CHECK 0
#endif
#ifndef NLAYERS_RUN
#define NLAYERS_RUN 4
#endif

constexpr int D = 1024, NB = 4, SEQ = 8192, TX = NB * SEQ, LC = 256, TC = NB * LC, TT = TX + TC, DEPTH = 4;
constexpr int IN_DIM = 3328, NEXP = 32;
constexpr int ROWS_MAX = TT * 4 + NEXP * 256;
constexpr float LOG2E = 1.4426950408889634f;
constexpr float QSCALE = 0.125f * LOG2E;
constexpr float EPS = 1e-5f;

constexpr size_t al256(size_t x) { return (x + 255) & ~(size_t)255; }
constexpr size_t WS_CTL = 0;
constexpr size_t CTL_BYTES = 65536;
constexpr size_t CTL_CNT = 16384;
constexpr size_t WS_MOD = WS_CTL + CTL_BYTES;
constexpr size_t WS_ROPE = WS_MOD + al256((size_t)DEPTH * 5 * 6144 * 4);
constexpr size_t WS_W1 = WS_ROPE + 16384;
constexpr size_t WS_MT = WS_W1 + 256 * 128 * 2;
constexpr size_t WS_WC = WS_MT + (size_t)64 * 256 * 128 * 2;
constexpr size_t WS_RWT = WS_WC + 512 * 256 * 2;
constexpr size_t WS_WIN = WS_RWT + (size_t)DEPTH * 32 * 1024 * 2;
constexpr size_t WS_WFO = WS_WIN + (size_t)DEPTH * IN_DIM * 1024 * 2;
constexpr size_t WS_WAO = WS_WFO + (size_t)DEPTH * 1024 * 1024 * 2;
constexpr size_t WS_WOUT = WS_WAO + (size_t)DEPTH * 1024 * 512 * 2;
constexpr size_t WS_WGU = WS_WOUT + (size_t)DEPTH * 1024 * 1024 * 2;
constexpr size_t WS_WDN = WS_WGU + (size_t)DEPTH * 32 * 2048 * 1024 * 2;
constexpr size_t WS_H = WS_WDN + (size_t)DEPTH * 32 * 1024 * 1024 * 2;
constexpr size_t WS_FT = WS_H + (size_t)(TT + 256) * 1024 * 2;
constexpr size_t WS_FCT = WS_FT + (size_t)131072 * 128 * 2;
constexpr size_t WS_Q = WS_FCT + (size_t)2048 * 256 * 2;
constexpr size_t WS_K = WS_Q + (size_t)TT * 512 * 2;
constexpr size_t WS_V = WS_K + (size_t)TT * 128 * 2;
constexpr size_t WS_GF = WS_V + (size_t)TT * 128 * 2;
constexpr size_t WS_GA = WS_GF + (size_t)TT * 1024 * 2;
constexpr size_t WS_T1 = WS_GA + (size_t)TT * 1024 * 2;
constexpr size_t WS_XS = WS_T1 + (size_t)64 * 2048 * 128 * 2;
constexpr size_t WS_AO = WS_XS + (size_t)TT * 1024 * 2;
constexpr size_t WS_YB = WS_AO + (size_t)TT * 512 * 2;
constexpr size_t WS_XW = WS_YB + (size_t)TT * 1024 * 2;
constexpr size_t WS_CW = WS_XW + (size_t)TX * 1024 * 4;
constexpr size_t WS_ACT = WS_CW + (size_t)TC * 1024 * 4;
constexpr size_t WS_YE = WS_ACT + (size_t)ROWS_MAX * 1024 * 2;
constexpr size_t WS_LIST = WS_YE + (size_t)ROWS_MAX * 1024 * 2;
constexpr size_t WS_SLOT = WS_LIST + (size_t)32 * TT * 4;
constexpr size_t WS_GATE = WS_SLOT + (size_t)TT * 4 * 4;
constexpr size_t WS_END = WS_GATE + (size_t)TT * 4 * 4;

constexpr int LDS_STAGE = 131072;
constexpr int LDS_MISC = LDS_STAGE;
constexpr int LDS_BYTES = 147456;

typedef __bf16 bf16v2_t __attribute__((ext_vector_type(2)));
typedef float f32x2_t __attribute__((ext_vector_type(2)));
__device__ __forceinline__ unsigned cvt_pk_bf16(float lo, float hi) { const f32x2_t v = {lo, hi}; const bf16v2_t b = __builtin_convertvector(v, bf16v2_t); return __builtin_bit_cast(unsigned, b); }
__device__ __forceinline__ bf16_t f2bf(float f) { return (bf16_t)(cvt_pk_bf16(f, 0.f) & 0xffffu); }
__device__ __forceinline__ float bf_lo(unsigned u) { return __uint_as_float(u << 16); }
__device__ __forceinline__ float bf_hi(unsigned u) { return __uint_as_float(u & 0xffff0000u); }
__device__ __forceinline__ float bf2f(bf16_t b) { return __uint_as_float(((unsigned)b) << 16); }
__device__ __forceinline__ float sigmoidf_(float x) { return __builtin_amdgcn_rcpf(1.0f + __builtin_amdgcn_exp2f(-x * LOG2E)); }
__device__ __forceinline__ float wave_sum(float v) {
#pragma unroll
    for (int o = 32; o >= 1; o >>= 1) v += __shfl_xor(v, o);
    return v;
}

#define XB_TMO      128
#define XB_XCNT(j)  (256  + 64 * (j))
#define XB_XSUB(j)  (1280 + 64 * (j))
#define XB_XGEN(j)  (2304 + 64 * (j))
#define XB_TOP      3328
#define XB_TOPGEN   3392
#define XCD_BAR_WORDS 3456
#define XB_SPIN_CAP (1u << 22)

__device__ __forceinline__ unsigned xb_ld(unsigned* p)              { return __hip_atomic_load(p, __ATOMIC_RELAXED, __HIP_MEMORY_SCOPE_AGENT); }
__device__ __forceinline__ unsigned xb_add(unsigned* p, unsigned v) { return __hip_atomic_fetch_add(p, v, __ATOMIC_RELAXED, __HIP_MEMORY_SCOPE_AGENT); }
__device__ __forceinline__ unsigned xb_xcc_id() { return (unsigned)__builtin_amdgcn_s_getreg((3 << 11) | 20) & 0xFu; }
#define XB_SPIN(cond, bar) do { unsigned _sp = 0; while (cond) { __builtin_amdgcn_s_sleep(1); \
    if ((++_sp & 255u) == 0u) { if (xb_ld(&(bar)[XB_TMO])) break; if (_sp > XB_SPIN_CAP) { atomicAdd(&(bar)[XB_TMO], 1u); break; } } } } while (0)

struct XcdBarrier { unsigned* bar; unsigned x; volatile LAS unsigned* st; };

__device__ __forceinline__ XcdBarrier xcd_barrier_post(unsigned* bar, volatile LAS unsigned* st) {
    XcdBarrier b; b.bar = bar; b.x = xb_xcc_id(); b.st = st;
    if (threadIdx.x == 0) (void)xb_add(&bar[XB_XCNT(b.x)], 1u);
    return b;
}
__device__ __forceinline__ void xcd_barrier_complete(unsigned* bar, unsigned x, unsigned& nloc, unsigned& nx) {
    const unsigned G = gridDim.x * gridDim.y * gridDim.z;
    unsigned sum, cnt, mine, sp = 0u;
    for (;;) {
        sum = 0u; cnt = 0u; mine = 0u;
#pragma unroll
        for (unsigned j = 0; j < 16; ++j) { const unsigned c = xb_ld(&bar[XB_XCNT(j)]); sum += c; cnt += (c > 0u) ? 1u : 0u; mine = (j == x) ? c : mine; }
        if (sum == G) break;
        __builtin_amdgcn_s_sleep(1);
        if ((++sp & 255u) == 0u) { if (xb_ld(&bar[XB_TMO])) break; if (sp > XB_SPIN_CAP) { atomicAdd(&bar[XB_TMO], 1u); break; } }
    }
    nloc = mine > 0u ? mine : 1u; nx = cnt > 0u ? cnt : 1u;
}
__device__ __forceinline__ void xcd_barrier(const XcdBarrier& b) {
    asm volatile("s_waitcnt vmcnt(0)" ::: "memory");
    __syncthreads();
    if (threadIdx.x == 0) {
        unsigned* bar = b.bar;
        __builtin_amdgcn_s_waitcnt(0);
        unsigned nloc = b.st[0], nx = b.st[1];
        if (nloc == 0u) { xcd_barrier_complete(bar, b.x, nloc, nx); b.st[0] = nloc; b.st[1] = nx; }
        const unsigned old = xb_add(&bar[XB_XSUB(b.x)], 1u);
        const unsigned gen = old / nloc;
        if (old + 1u == (gen + 1u) * nloc) {
            __builtin_amdgcn_fence(__ATOMIC_RELEASE, "agent");
            asm volatile("s_waitcnt vmcnt(0)" ::: "memory");
            const unsigned og = xb_add(&bar[XB_TOP], 1u);
            const unsigned tg = og / nx;
            if (og + 1u == (tg + 1u) * nx) xb_add(&bar[XB_TOPGEN], 1u);
            else XB_SPIN(xb_ld(&bar[XB_TOPGEN]) == tg, bar);
            __builtin_amdgcn_fence(__ATOMIC_ACQUIRE, "agent");
            xb_add(&bar[XB_XGEN(b.x)], 1u);
            asm volatile("s_waitcnt vmcnt(0)" ::: "memory");
        } else {
            XB_SPIN(xb_ld(&bar[XB_XGEN(b.x)]) == gen, bar);
            __builtin_amdgcn_fence(__ATOMIC_ACQUIRE, "agent");
            asm volatile("s_waitcnt vmcnt(0)" ::: "memory");
        }
    }
    __syncthreads();
}

struct Fr {
    LAS unsigned char* lds;
    unsigned char* ws;
    float* out;
    int tid, lane, wave, G, bid;
};
__device__ __forceinline__ const float* in_ptr(const Fr& F, int i) {
    volatile LAS unsigned* p = (volatile LAS unsigned*)(F.lds + 131072 + 512) + 2 * i;
    const unsigned lo = __builtin_amdgcn_readfirstlane(p[0]), hi = __builtin_amdgcn_readfirstlane(p[1]);
    return (const float*)(((unsigned long long)hi << 32) | lo);
}
#define INP(i) in_ptr(F, (i))
#define LAUNDER(F) do { unsigned char* _w = (F).ws; asm volatile("" : "+s"(_w)); (F).ws = _w; int _t = threadIdx.x; asm volatile("" : "+v"(_t)); (F).tid = _t; (F).lane = _t & 63; (F).wave = __builtin_amdgcn_readfirstlane(_t >> 6); } while (0)
#define WSP(T, off) ((T*)(F.ws + (off)))

namespace g8 {
constexpr int BM = 256, BK = 64, HALF = 128, HTB = HALF * BK * 2, NXCD = 8, WGM = 8;
__device__ __forceinline__ int lds_byte(int r, int c) { const int st = (r >> 4) * 2 + (c >> 5), rr = r & 15, cc = c & 31, ob = rr * 64 + cc * 2; return st * 1024 + (ob ^ (((ob >> 9) & 1) << 5)); }
__device__ __forceinline__ void stage_rc(int b, int& R, int& C) { const int st = b / 1024, sb = b % 1024, swz = sb ^ (((sb >> 9) & 1) << 5); R = (st >> 1) * 16 + swz / 64; C = (st & 1) * 32 + (swz % 64) / 2; }
__device__ __forceinline__ int perm32(int rho) { const int n = rho >> 4, i = rho & 15; return 8 * (i >> 2) + 4 * n + (i & 3); }
__device__ __forceinline__ void order2d(int L, int nM, int nN, int& pm, int& pn) {
    const int nwg = nM * nN;
    int wgid = L; { const int q = nwg / NXCD, r = nwg % NXCD, xcd = wgid % NXCD, off = wgid / NXCD; wgid = (xcd < r ? xcd * (q + 1) : r * (q + 1) + (xcd - r) * q) + off; }
    const int nig = WGM * nN, gid = wgid / nig, fm = gid * WGM, gsz = (nM - fm) < WGM ? (nM - fm) : WGM;
    pm = fm + ((wgid % nig) % gsz); pn = (wgid % nig) / gsz;
}
__device__ __forceinline__ void lane_geom(int tid, int& R0, int& Rb0, int& C0) { asm volatile("" : "+v"(tid)); stage_rc(tid * 16, R0, C0); Rb0 = (R0 & ~31) + perm32(R0 & 31); }

#define G8_ROWS(ai, m) (128 * (ai) + 64 * wr + 16 * (m) + fr)
#define G8_COL0(bj) (128 * (bj) + 32 * wc + 8 * fq)

template <class P>
__device__ __forceinline__ void gemm_run(LAS unsigned char* lds, P& prob) {
    int tid = threadIdx.x; asm volatile("" : "+v"(tid));
    const int wid = __builtin_amdgcn_readfirstlane(tid >> 6), lane = tid & 63, wr = wid >> 2, wc = wid & 3, fr = lane & 15, fq = lane >> 4;
    const size_t kstep = (size_t)(BK * 2);
    const unsigned ldsw = (unsigned)wid * 1024u;
    const int aoff = lds_byte(wr * 64 + fr, fq * 8), boff = lds_byte(wc * 32 + fr, fq * 8);
#define G8_SA(b, h) (((b) * 2 + (h)) * HTB)
#define G8_SB(b, h) ((4 + (b) * 2 + (h)) * HTB)
#define G8_STAGE_(bufoff, g0, o0, g1, o1) do { \
        __builtin_amdgcn_global_load_lds((const unsigned*)((const char*)(g0) + (o0)), (LAS unsigned*)(lds + (bufoff) + ldsw), 16, 0, 0); \
        __builtin_amdgcn_global_load_lds((const unsigned*)((const char*)(g1) + (o1)), (LAS unsigned*)(lds + (bufoff) + ldsw + 8192), 16, 0, 0); } while (0)
#define G8_OA(j) (P::GATHER_A ? oa[j] : oa[0])
#define G8_STA(bufoff, gbase, h) G8_STAGE_(bufoff, (gbase) + dA[2 * (h)], G8_OA(2 * (h)), (gbase) + dA[2 * (h) + 1], G8_OA(2 * (h) + 1))
#define G8_STB(bufoff, gbase, h) G8_STAGE_(bufoff, (gbase) + dB[2 * (h)], ob, (gbase) + dB[2 * (h) + 1], ob)
#define G8_LDA(dst, b, h) do { _Pragma("unroll") for (int m = 0; m < 4; ++m) _Pragma("unroll") for (int k = 0; k < 2; ++k) dst[m][k] = *(const LAS bf16x8*)(lds + G8_SA(b, h) + aoff + m * 2048 + k * 1024); } while (0)
#define G8_LDB(dst, b, h) do { _Pragma("unroll") for (int n = 0; n < 2; ++n) _Pragma("unroll") for (int k = 0; k < 2; ++k) dst[n][k] = *(const LAS bf16x8*)(lds + G8_SB(b, h) + boff + n * 2048 + k * 1024); } while (0)
#define G8_MMA(ai, bj, At, Bt) do { __builtin_amdgcn_s_setprio(1); _Pragma("unroll") for (int m = 0; m < 4; ++m) _Pragma("unroll") for (int n = 0; n < 2; ++n) _Pragma("unroll") for (int k = 0; k < 2; ++k) \
        acc[ai][bj][m][n] = __builtin_amdgcn_mfma_f32_16x16x32_bf16(Bt[n][k], At[m][k], acc[ai][bj][m][n], 0, 0, 0); __builtin_amdgcn_s_setprio(0); } while (0)
#define G8_WAIT_V(n) asm volatile("s_waitcnt vmcnt(" #n ")" ::: "memory")
#define G8_WAIT_L(n) asm volatile("s_waitcnt lgkmcnt(" #n ")" ::: "memory")
#define G8_BAR __builtin_amdgcn_s_barrier()
#define G8_SCHED __builtin_amdgcn_sched_barrier(0)
    typename P::U cur, nxt; int ui = 0;
    if (!prob.get(0, cur)) return;
    f32x4 acc[2][2][4][2];
#pragma unroll
    for (int a = 0; a < 2; ++a)
#pragma unroll
        for (int b = 0; b < 2; ++b)
#pragma unroll
            for (int m = 0; m < 4; ++m)
#pragma unroll
                for (int n = 0; n < 2; ++n) acc[a][b][m][n] = (f32x4){0.f, 0.f, 0.f, 0.f};
    bf16x8 At[4][2], B0[2][2], B1[2][2];
    unsigned oa[4], ob, dA[4], dB[4]; const char* cA; const char* cB; int nt;
    prob.setup(cur, oa, ob, dA, dB, cA, cB, nt);
    G8_STB(G8_SB(0, 0), cB, 0); G8_STA(G8_SA(0, 0), cA, 0); G8_STB(G8_SB(0, 1), cB, 1); G8_STA(G8_SA(0, 1), cA, 1);
    if (wr == 1) G8_BAR;
    G8_WAIT_V(4); G8_BAR;
    G8_STB(G8_SB(1, 0), cB + kstep, 0); G8_STA(G8_SA(1, 0), cA + kstep, 0); G8_STB(G8_SB(1, 1), cB + kstep, 1);
    G8_WAIT_V(6); G8_BAR;
    for (;;) {
        const bool has_next = prob.get(ui + 1, nxt);
        int nnt = nt;
        for (int t = 0; t < nt; t += 2) {
            const bool last = (t == nt - 2);
            G8_LDB(B0, 0, 0); G8_SCHED; G8_LDA(At, 0, 0); G8_STA(G8_SA(1, 1), cA + (size_t)(t + 1) * kstep, 1);
            G8_WAIT_L(8); G8_BAR; G8_WAIT_L(0); G8_MMA(0, 0, At, B0); G8_BAR; G8_SCHED;
            const char* a2; const char* b2;
            if (last) { if (has_next) { prob.setup(nxt, oa, ob, dA, dB, cA, cB, nnt); } a2 = cA; b2 = cB; }
            else { a2 = cA + (size_t)(t + 2) * kstep; b2 = cB + (size_t)(t + 2) * kstep; }
            const char* a3 = a2 + kstep; const char* b3 = b2 + kstep;
            G8_LDB(B1, 0, 1); G8_STB(G8_SB(0, 0), b2, 0);
            G8_BAR; G8_WAIT_L(0); G8_MMA(0, 1, At, B1); G8_BAR;
            G8_LDA(At, 0, 1); G8_STA(G8_SA(0, 0), a2, 0);
            G8_BAR; G8_WAIT_L(0); G8_MMA(1, 0, At, B0); G8_BAR; G8_SCHED;
            G8_STB(G8_SB(0, 1), b2, 1);
            G8_WAIT_V(6); G8_BAR; G8_MMA(1, 1, At, B1); G8_BAR;
            G8_LDB(B0, 1, 0); G8_SCHED; G8_LDA(At, 1, 0); G8_STA(G8_SA(0, 1), a2, 1);
            G8_WAIT_L(8); G8_BAR; G8_WAIT_L(0); G8_MMA(0, 0, At, B0); G8_BAR; G8_SCHED;
            G8_LDB(B1, 1, 1); G8_STB(G8_SB(1, 0), b3, 0);
            G8_BAR; G8_WAIT_L(0); G8_MMA(0, 1, At, B1); G8_BAR;
            G8_LDA(At, 1, 1); G8_STA(G8_SA(1, 0), a3, 0);
            G8_BAR; G8_WAIT_L(0); G8_MMA(1, 0, At, B0); G8_BAR; G8_SCHED;
            G8_STB(G8_SB(1, 1), b3, 1);
            G8_WAIT_V(6); G8_BAR; G8_MMA(1, 1, At, B1); G8_BAR;
            if (last) break;
        }
        { int t2 = threadIdx.x; asm volatile("" : "+v"(t2)); const int l2 = t2 & 63; prob.epi(acc, cur, wr, wc, l2 & 15, l2 >> 4); }
        if (!has_next) break;
#pragma unroll
        for (int a = 0; a < 2; ++a)
#pragma unroll
            for (int b = 0; b < 2; ++b)
#pragma unroll
                for (int m = 0; m < 4; ++m)
#pragma unroll
                    for (int n = 0; n < 2; ++n) acc[a][b][m][n] = (f32x4){0.f, 0.f, 0.f, 0.f};
        cur = nxt; nt = nnt; ++ui;
    }
    G8_WAIT_V(0);
    if (wr == 0) G8_BAR;
    G8_BAR;
}
}

__device__ __forceinline__ u32x4 pack8(const f32x4& v0, const f32x4& v1) {
    u32x4 w; w.x = cvt_pk_bf16(v0[0], v0[1]); w.y = cvt_pk_bf16(v0[2], v0[3]); w.z = cvt_pk_bf16(v1[0], v1[1]); w.w = cvt_pk_bf16(v1[2], v1[3]); return w;
}
__device__ __forceinline__ void unpack8(const u32x4& w, f32x4& v0, f32x4& v1) {
    v0 = (f32x4){bf_lo(w.x), bf_hi(w.x), bf_lo(w.y), bf_hi(w.y)}; v1 = (f32x4){bf_lo(w.z), bf_hi(w.z), bf_lo(w.w), bf_hi(w.w)};
}

template <int WHICH> struct InProjProb {
    static constexpr bool PERM = true, GATHER_A = false;
    struct U { int kind, pm, pn, b, j; };
    const bf16_t* H; const bf16_t* W;
    bf16_t *FT, *FCT, *Q, *Kb, *Vb, *GF, *GA; const float* rope;
    int nM, n_nat, n_fx, n_fc, n_extra, G, c;
    __device__ __forceinline__ bool get(int i, U& u) const {
        const int L = i * G + c;
        if (WHICH == 0) {
            if (L >= n_nat + n_extra) return false;
            const bool nat = L < n_nat;
            int pm, pn; g8::order2d(nat ? L : 0, nM, 11, pm, pn);
            u.kind = 2; u.pm = __builtin_amdgcn_readfirstlane(nat ? pm : (128 + L - n_nat)); u.pn = __builtin_amdgcn_readfirstlane(nat ? (pn + 2) : 4); u.b = 0; u.j = 0;
            return true;
        } else {
            if (L >= n_fx + n_fc) return false;
            const bool fx = L < n_fx; const int L2 = L - n_fx;
            u.kind = __builtin_amdgcn_readfirstlane(fx ? 0 : 1); u.b = __builtin_amdgcn_readfirstlane(fx ? (L >> 6) : (L2 >> 1)); u.j = __builtin_amdgcn_readfirstlane(fx ? ((L & 63) >> 1) : 0); u.pn = __builtin_amdgcn_readfirstlane(fx ? (L & 1) : (L2 & 1)); u.pm = 0;
            return true;
        }
    }
    __device__ __forceinline__ void setup(const U& u, unsigned (&oa)[4], unsigned& ob, unsigned (&dA)[4], unsigned (&dB)[4], const char*& pA, const char*& pB, int& nt) const {
        int R0, Rb0, C0; g8::lane_geom(threadIdx.x, R0, Rb0, C0);
        nt = 16;
#pragma unroll
        for (int j = 0; j < 4; ++j) { dA[j] = (unsigned)(64 * j * 1024) * 2u; dB[j] = dA[j]; }
        if (WHICH == 0) {
            pA = (const char*)H; pB = (const char*)W;
            oa[0] = (unsigned)((256 * u.pm + R0) * 1024 + C0) * 2u; ob = (unsigned)((256 * u.pn + Rb0) * 1024 + C0) * 2u;
        } else {
            pA = (const char*)W; pB = (const char*)H;
            oa[0] = (unsigned)((256 * u.pn + R0) * 1024 + C0) * 2u;
            if (u.kind == 0) { ob = (unsigned)((u.b * SEQ + 64 * Rb0 + 2 * u.j) * 1024 + C0) * 2u;
                dB[1] = (unsigned)(64 * 64 * 1024) * 2u; dB[2] = 2048u; dB[3] = dB[1] + 2048u; }
            else ob = (unsigned)((TX + u.b * LC + Rb0) * 1024 + C0) * 2u;
        }
    }
    __device__ __forceinline__ void epi(const f32x4 (&acc)[2][2][4][2], const U& u, int wr, int wc, int fr, int fq) const {
        if (WHICH == 0) {
            if (u.pn >= 5) {
                bf16_t* dst = (u.pn >= 9) ? GA : GF; const int cb = 256 * ((u.pn >= 9) ? u.pn - 9 : u.pn - 5);
#pragma unroll
                for (int ai = 0; ai < 2; ++ai)
#pragma unroll
                    for (int m = 0; m < 4; ++m) { const size_t tok = (size_t)256 * u.pm + G8_ROWS(ai, m);
#pragma unroll
                        for (int bj = 0; bj < 2; ++bj) { f32x4 v0 = acc[ai][bj][m][0], v1 = acc[ai][bj][m][1];
#pragma unroll
                            for (int e = 0; e < 4; ++e) { v0[e] = sigmoidf_(v0[e]); v1[e] = sigmoidf_(v1[e]); }
                            *(u32x4*)(dst + tok * 1024 + cb + G8_COL0(bj)) = pack8(v0, v1); } }
            } else {
#pragma unroll
                for (int ai = 0; ai < 2; ++ai)
#pragma unroll
                    for (int m = 0; m < 4; ++m) { const int tok = 256 * u.pm + G8_ROWS(ai, m);
                        const bool isx = tok < TX; const int n = tok & (SEQ - 1); const int prow = n >> 6, pcol = n & 63;
#pragma unroll
                        for (int bj = 0; bj < 2; ++bj) { f32x4 v0 = acc[ai][bj][m][0], v1 = acc[ai][bj][m][1];
                            const int c0 = G8_COL0(bj);
                            const bool isv = (u.pn == 4) && (bj == 1);
                            if (!isv) {
                                const int dp = c0 & 63; const int axis = dp >> 5, f0 = (dp & 31) >> 1;
                                if (isx) {
                                    const int pos = axis ? pcol : prow;
                                    const f32x4 cs = *(const f32x4*)(rope + pos * 16 + f0), sn = *(const f32x4*)(rope + 2048 + pos * 16 + f0);
                                    f32x4 r0, r1;
                                    r0[0] = v0[0] * cs[0] - v0[1] * sn[0]; r0[1] = v0[1] * cs[0] + v0[0] * sn[0];
                                    r0[2] = v0[2] * cs[1] - v0[3] * sn[1]; r0[3] = v0[3] * cs[1] + v0[2] * sn[1];
                                    r1[0] = v1[0] * cs[2] - v1[1] * sn[2]; r1[1] = v1[1] * cs[2] + v1[0] * sn[2];
                                    r1[2] = v1[2] * cs[3] - v1[3] * sn[3]; r1[3] = v1[3] * cs[3] + v1[2] * sn[3];
                                    v0 = r0; v1 = r1;
                                }
                            }
                            if (u.pn < 4) { v0 *= QSCALE; v1 *= QSCALE; *(u32x4*)(Q + (size_t)tok * 512 + 256 * (u.pn - 2) + c0) = pack8(v0, v1); }
                            else if (!isv) { *(u32x4*)(Kb + (size_t)tok * 128 + c0) = pack8(v0, v1); }
                            else { *(u32x4*)(Vb + (size_t)tok * 128 + (c0 - 128)) = pack8(v0, v1); }
                        } }
            }
        } else {
#pragma unroll
            for (int ai = 0; ai < 2; ++ai)
#pragma unroll
                for (int m = 0; m < 4; ++m) { const int ch = 256 * u.pn + G8_ROWS(ai, m);
#pragma unroll
                    for (int bj = 0; bj < 2; ++bj) { const int c0 = G8_COL0(bj);
                        const u32x4 w = pack8(acc[ai][bj][m][0], acc[ai][bj][m][1]);
                        if (u.kind == 0) { const int n2 = 2 * u.j + (c0 >> 7), n1 = c0 & 127; *(u32x4*)(FT + ((size_t)(u.b * 512 + ch) * 64 + n2) * 128 + n1) = w; }
                        else *(u32x4*)(FCT + (size_t)(u.b * 512 + ch) * 256 + c0) = w;
                    } }
        }
    }
};

struct Fft1Prob {
    static constexpr bool PERM = true, GATHER_A = false;
    struct U { int kind, pm, pn; };
    const bf16_t *W1, *FT, *WC, *FCT; bf16_t *T1, *XS;
    int n0, n1, G, c;
    __device__ __forceinline__ bool get(int i, U& u) const {
        const int L = i * G + c;
        if (L >= n0 + n1) return false;
        const bool k0 = L < n0; const int L2 = L - n0;
        u.kind = __builtin_amdgcn_readfirstlane(k0 ? 0 : 1); u.pm = __builtin_amdgcn_readfirstlane(k0 ? 0 : (L2 & 1)); u.pn = __builtin_amdgcn_readfirstlane(k0 ? L : (L2 >> 1));
        return true;
    }
    __device__ __forceinline__ void setup(const U& u, unsigned (&oa)[4], unsigned& ob, unsigned (&dA)[4], unsigned (&dB)[4], const char*& pA, const char*& pB, int& nt) const {
        int R0, Rb0, C0; g8::lane_geom(threadIdx.x, R0, Rb0, C0);
        if (u.kind == 0) { nt = 2; pA = (const char*)W1; pB = (const char*)FT;
#pragma unroll
            for (int j = 0; j < 4; ++j) { dA[j] = (unsigned)(64 * j * 128) * 2u; dB[j] = dA[j]; }
            oa[0] = (unsigned)(R0 * 128 + C0) * 2u; ob = (unsigned)((256 * u.pn + Rb0) * 128 + C0) * 2u;
        } else { nt = 4; pA = (const char*)WC; pB = (const char*)FCT;
#pragma unroll
            for (int j = 0; j < 4; ++j) { dA[j] = (unsigned)(64 * j * 256) * 2u; dB[j] = dA[j]; }
            oa[0] = (unsigned)((256 * u.pm + R0) * 256 + C0) * 2u; ob = (unsigned)((256 * u.pn + Rb0) * 256 + C0) * 2u;
        }
    }
    __device__ __forceinline__ void epi(const f32x4 (&acc)[2][2][4][2], const U& u, int wr, int wc, int fr, int fq) const {
        if (u.kind == 0) {
#pragma unroll
            for (int m = 0; m < 4; ++m) { const int r = G8_ROWS(0, m); const int k1p = r >> 1, part = r & 1;
#pragma unroll
                for (int bj = 0; bj < 2; ++bj) { const int col = 256 * u.pn + G8_COL0(bj); const int bc = col >> 6, n2 = col & 63;
                    *(u32x4*)(T1 + (((size_t)k1p * 2048 + bc) * 2 + part) * 64 + n2) = pack8(acc[0][bj][m][0], acc[0][bj][m][1]); } }
        } else {
#pragma unroll
            for (int ai = 0; ai < 2; ++ai)
#pragma unroll
                for (int m = 0; m < 4; ++m) { const int r = 256 * u.pm + G8_ROWS(ai, m); const int k = r >> 1, reim = r & 1;
#pragma unroll
                    for (int bj = 0; bj < 2; ++bj) { const int bc = 256 * u.pn + G8_COL0(bj); const int b = bc >> 9, ch = bc & 511, g = ch >> 7, d = ch & 127;
                        *(u32x4*)(XS + (size_t)(TX + b * LC + k) * 1024 + g * 256 + reim * 128 + d) = pack8(acc[ai][bj][m][0], acc[ai][bj][m][1]); } }
        }
    }
};

struct Fft2Prob {
    static constexpr bool PERM = true, GATHER_A = false;
    struct U { int k1p, pn; };
    const bf16_t *MT, *T1; bf16_t* XS; int G, c;
    __device__ __forceinline__ bool get(int i, U& u) const { const int L = i * G + c; if (L >= 512) return false; u.k1p = __builtin_amdgcn_readfirstlane(L >> 3); u.pn = __builtin_amdgcn_readfirstlane(L & 7); return true; }
    __device__ __forceinline__ void setup(const U& u, unsigned (&oa)[4], unsigned& ob, unsigned (&dA)[4], unsigned (&dB)[4], const char*& pA, const char*& pB, int& nt) const {
        int R0, Rb0, C0; g8::lane_geom(threadIdx.x, R0, Rb0, C0);
        nt = 2; pA = (const char*)MT; pB = (const char*)T1;
#pragma unroll
        for (int j = 0; j < 4; ++j) { dA[j] = (unsigned)(64 * j * 128) * 2u; dB[j] = dA[j]; }
        oa[0] = (unsigned)((u.k1p * 256 + R0) * 128 + C0) * 2u; ob = (unsigned)((u.k1p * 2048 + 256 * u.pn + Rb0) * 128 + C0) * 2u;
    }
    __device__ __forceinline__ void epi(const f32x4 (&acc)[2][2][4][2], const U& u, int wr, int wc, int fr, int fq) const {
#pragma unroll
        for (int ai = 0; ai < 2; ++ai)
#pragma unroll
            for (int m = 0; m < 4; ++m) { const int r = G8_ROWS(ai, m); const int s = r >> 7, k2 = (r & 127) >> 1, reim = r & 1;
                const int kb = (u.k1p == 0) ? 64 * s : (s ? 128 - u.k1p : u.k1p); const int k = kb + 128 * k2;
#pragma unroll
                for (int bj = 0; bj < 2; ++bj) { const int bc = 256 * u.pn + G8_COL0(bj); const int b = bc >> 9, ch = bc & 511, g = ch >> 7, d = ch & 127;
                    *(u32x4*)(XS + (size_t)(b * SEQ + k) * 1024 + g * 256 + reim * 128 + d) = pack8(acc[ai][bj][m][0], acc[ai][bj][m][1]); } }
    }
};

template <int MODE> struct MergeProb {
    static constexpr bool PERM = true, GATHER_A = false;
    struct U { int pm, pn; };
    const bf16_t* A; const bf16_t* W; int lda;
    const bf16_t* GATE; bf16_t* YB;
    const float* xin; const float* cin; float* XW; float* CW; const float* g1x; const float* g1c;
    int nM, G, c;
    __device__ __forceinline__ bool get(int i, U& u) const { const int L = i * G + c; if (L >= nM * 4) return false; int pm, pn; g8::order2d(L, nM, 4, pm, pn); u.pm = __builtin_amdgcn_readfirstlane(pm); u.pn = __builtin_amdgcn_readfirstlane(pn); return true; }
    __device__ __forceinline__ void setup(const U& u, unsigned (&oa)[4], unsigned& ob, unsigned (&dA)[4], unsigned (&dB)[4], const char*& pA, const char*& pB, int& nt) const {
        int R0, Rb0, C0; g8::lane_geom(threadIdx.x, R0, Rb0, C0);
        nt = lda >> 6; pA = (const char*)A; pB = (const char*)W;
#pragma unroll
        for (int j = 0; j < 4; ++j) { dA[j] = (unsigned)(64 * j * lda) * 2u; dB[j] = dA[j]; }
        oa[0] = (unsigned)((256 * u.pm + R0) * lda + C0) * 2u; ob = (unsigned)((256 * u.pn + Rb0) * lda + C0) * 2u;
    }
    __device__ __forceinline__ void epi(const f32x4 (&acc)[2][2][4][2], const U& u, int wr, int wc, int fr, int fq) const {
#pragma unroll
        for (int ai = 0; ai < 2; ++ai)
#pragma unroll
            for (int m = 0; m < 4; ++m) { const int tok = 256 * u.pm + G8_ROWS(ai, m);
#pragma unroll
                for (int bj = 0; bj < 2; ++bj) { const int col = 256 * u.pn + G8_COL0(bj);
                    f32x4 v0 = acc[ai][bj][m][0], v1 = acc[ai][bj][m][1];
                    if (MODE < 2) {
                        f32x4 g0, g1; unpack8(*(const u32x4*)(GATE + (size_t)tok * 1024 + col), g0, g1);
                        v0 *= g0; v1 *= g1;
                        if (MODE == 1) { f32x4 t0, t1; unpack8(*(const u32x4*)(YB + (size_t)tok * 1024 + col), t0, t1); v0 += t0; v1 += t1; }
                        *(u32x4*)(YB + (size_t)tok * 1024 + col) = pack8(v0, v1);
                    } else {
                        if (tok < TX) {
                            const float* gp = g1x + (tok >> 13) * 6144 + col; const f32x4 ga = *(const f32x4*)gp, gb = *(const f32x4*)(gp + 4);
                            const float* xp = xin + (size_t)tok * 1024 + col; float* op = XW + (size_t)tok * 1024 + col;
                            *(f32x4*)op = *(const f32x4*)xp + ga * v0; *(f32x4*)(op + 4) = *(const f32x4*)(xp + 4) + gb * v1;
                        } else {
                            const float* gp = g1c + col; const f32x4 ga = *(const f32x4*)gp, gb = *(const f32x4*)(gp + 4);
                            const float* xp = cin + (size_t)(tok - TX) * 1024 + col; float* op = CW + (size_t)(tok - TX) * 1024 + col;
                            *(f32x4*)op = *(const f32x4*)xp + ga * v0; *(f32x4*)(op + 4) = *(const f32x4*)(xp + 4) + gb * v1;
                        }
                    }
                } }
    }
};

struct MoeGuProb {
    static constexpr bool PERM = true, GATHER_A = true;
    struct U { int e, rt, pn, base, cnt; int tok[4]; };
    const bf16_t* H; const bf16_t* W; const float* bgu; bf16_t* ACT; const int* list; const int* cnt;
    const volatile LAS int* tstart;
    int R, G, c;
    __device__ __forceinline__ bool get(int i, U& u) const {
        const int L = i * G + c; if (L >= R * 8) return false;
        int rt, pn; g8::order2d(L, R, 8, rt, pn);
        int e = 0;
#pragma unroll 1
        for (int q = 1; q < 32; ++q) e = (tstart[q] <= rt) ? q : e;
        u.e = __builtin_amdgcn_readfirstlane(e); u.rt = __builtin_amdgcn_readfirstlane(rt); u.pn = __builtin_amdgcn_readfirstlane(pn); u.base = __builtin_amdgcn_readfirstlane((rt - tstart[e]) * 256); u.cnt = __builtin_amdgcn_readfirstlane(cnt[e]);
        int R0, Rb0, C0; g8::lane_geom(threadIdx.x, R0, Rb0, C0);
#pragma unroll
        for (int j = 0; j < 4; ++j) { const int p = u.base + R0 + 64 * j; u.tok[j] = (p < u.cnt) ? list[(size_t)e * TT + p] : TT; }
        return true;
    }
    __device__ __forceinline__ void setup(const U& u, unsigned (&oa)[4], unsigned& ob, unsigned (&dA)[4], unsigned (&dB)[4], const char*& pA, const char*& pB, int& nt) const {
        int R0, Rb0, C0; g8::lane_geom(threadIdx.x, R0, Rb0, C0);
        nt = 16; pA = (const char*)H; pB = (const char*)W;
#pragma unroll
        for (int j = 0; j < 4; ++j) { dA[j] = 0u; dB[j] = (unsigned)(64 * j * 1024) * 2u; oa[j] = (unsigned)(u.tok[j] * 1024 + C0) * 2u; }
        ob = (unsigned)((u.e * 2048 + 256 * u.pn + Rb0) * 1024 + C0) * 2u;
    }
    __device__ __forceinline__ void epi(const f32x4 (&acc)[2][2][4][2], const U& u, int wr, int wc, int fr, int fq) const {
        const int j0 = 128 * u.pn + 32 * wc + 8 * fq;
        const float* bp = bgu + (size_t)u.e * 2048 + j0;
        const f32x4 ba0 = *(const f32x4*)bp, ba1 = *(const f32x4*)(bp + 4), bu0 = *(const f32x4*)(bp + 1024), bu1 = *(const f32x4*)(bp + 1028);
#pragma unroll
        for (int ai = 0; ai < 2; ++ai)
#pragma unroll
            for (int m = 0; m < 4; ++m) { const size_t row = (size_t)256 * u.rt + G8_ROWS(ai, m);
                f32x4 a0 = acc[ai][0][m][0] + ba0, a1 = acc[ai][0][m][1] + ba1, u0 = acc[ai][1][m][0] + bu0, u1 = acc[ai][1][m][1] + bu1, y0, y1;
#pragma unroll
                for (int e = 0; e < 4; ++e) {
                    float a = fminf(a0[e], 7.0f), uu = fminf(fmaxf(u0[e], -7.0f), 7.0f); y0[e] = a * sigmoidf_(1.702f * a) * (uu + 1.0f);
                    a = fminf(a1[e], 7.0f); uu = fminf(fmaxf(u1[e], -7.0f), 7.0f); y1[e] = a * sigmoidf_(1.702f * a) * (uu + 1.0f);
                }
                *(u32x4*)(ACT + row * 1024 + j0) = pack8(y0, y1); }
    }
};
struct MoeDnProb {
    static constexpr bool PERM = true, GATHER_A = false;
    struct U { int e, rt, pn; };
    const bf16_t* ACT; const bf16_t* W; const float* bdn; bf16_t* YE;
    const volatile LAS int* tstart; int R, G, c;
    __device__ __forceinline__ bool get(int i, U& u) const {
        const int L = i * G + c; if (L >= R * 4) return false;
        int rt, pn; g8::order2d(L, R, 4, rt, pn);
        int e = 0;
#pragma unroll 1
        for (int q = 1; q < 32; ++q) e = (tstart[q] <= rt) ? q : e;
        u.e = __builtin_amdgcn_readfirstlane(e); u.rt = __builtin_amdgcn_readfirstlane(rt); u.pn = __builtin_amdgcn_readfirstlane(pn); return true;
    }
    __device__ __forceinline__ void setup(const U& u, unsigned (&oa)[4], unsigned& ob, unsigned (&dA)[4], unsigned (&dB)[4], const char*& pA, const char*& pB, int& nt) const {
        int R0, Rb0, C0; g8::lane_geom(threadIdx.x, R0, Rb0, C0);
        nt = 16; pA = (const char*)ACT; pB = (const char*)W;
#pragma unroll
        for (int j = 0; j < 4; ++j) { dA[j] = (unsigned)(64 * j * 1024) * 2u; dB[j] = dA[j]; }
        oa[0] = (unsigned)((256 * u.rt + R0) * 1024 + C0) * 2u; ob = (unsigned)((u.e * 1024 + 256 * u.pn + Rb0) * 1024 + C0) * 2u;
    }
    __device__ __forceinline__ void epi(const f32x4 (&acc)[2][2][4][2], const U& u, int wr, int wc, int fr, int fq) const {
#pragma unroll
        for (int bj = 0; bj < 2; ++bj) { const int col = 256 * u.pn + G8_COL0(bj);
            const float* bp = bdn + (size_t)u.e * 1024 + col; const f32x4 b0 = *(const f32x4*)bp, b1 = *(const f32x4*)(bp + 4);
#pragma unroll
            for (int ai = 0; ai < 2; ++ai)
#pragma unroll
                for (int m = 0; m < 4; ++m) { const size_t row = (size_t)256 * u.rt + G8_ROWS(ai, m);
                    *(u32x4*)(YE + row * 1024 + col) = pack8(acc[ai][bj][m][0] + b0, acc[ai][bj][m][1] + b1); } }
    }
};

__device__ __forceinline__ int rope_perm(int d) { return (d & 32) | ((d & 15) << 1) | ((d >> 4) & 1); }
template <class RM>
__device__ __forceinline__ void transpose_tile(const Fr& F, const float* src, int N, int k0, int n0, bf16_t* dst, int Kd, RM rm) {
    LAS unsigned char* lds = F.lds;
    const int tid = F.tid;
    { const int r = tid >> 4, c4 = (tid & 15) * 4;
#pragma unroll
      for (int j = 0; j < 2; ++j) { const int k = r + 32 * j; const f32x4 v = *(const f32x4*)(src + (size_t)(k0 + k) * N + n0 + c4);
#pragma unroll
          for (int e = 0; e < 4; ++e) *(LAS bf16_t*)(lds + (c4 + e) * 144 + k * 2) = f2bf(v[e]); } }
    __syncthreads();
    { const int n = tid >> 3, ch = tid & 7; const u32x4 w = *(const LAS u32x4*)(lds + n * 144 + ch * 16);
      *(u32x4*)(dst + (size_t)rm(n0 + n) * Kd + k0 + ch * 8) = w; }
    __syncthreads();
}
struct RmId { __device__ int operator()(int n) const { return n; } };
struct RmWin { __device__ int operator()(int n) const { return (n >= 512 && n < 1152) ? ((n & ~63) | rope_perm(n & 63)) : n; } };
struct RmGu { __device__ int operator()(int n) const { const int bj = n >> 10, j = n & 1023; return 256 * (j >> 7) + 128 * bj + (j & 127); } };

__device__ __forceinline__ void prologue_phase(const Fr& F) {
    const int tid = F.tid, G = F.G, bid = F.bid;
    const float PI2 = 6.283185307179586f;
    const size_t gtid = (size_t)bid * 512 + tid, gsz = (size_t)G * 512;
    { float* rope = WSP(float, WS_ROPE);
      for (size_t i = gtid; i < 2048; i += gsz) { const int pos = (int)(i >> 4), f = (int)(i & 15); const float inv = powf(10000.0f, -(float)f / 16.0f); const float a = (float)pos * inv; rope[i] = cosf(a); rope[2048 + i] = sinf(a); } }
    { bf16_t* W1 = WSP(bf16_t, WS_W1);
      for (size_t i = gtid; i < 256 * 128; i += gsz) { const int r = (int)(i >> 7), n1 = (int)(i & 127); float v = 0.f;
          if (r < 128) { const int k1p = r >> 1, part = r & 1;
              if (part == 0) v = cospif((float)((k1p * n1) & 127) / 64.0f);
              else if (k1p == 0) v = (n1 & 1) ? -1.0f : 1.0f;
              else v = -sinpif((float)((k1p * n1) & 127) / 64.0f); }
          W1[i] = f2bf(v); } }
    { bf16_t* MT = WSP(bf16_t, WS_MT);
      for (size_t i = gtid; i < (size_t)64 * 256 * 128; i += gsz) {
          const int kk = (int)(i & 127), r = (int)((i >> 7) & 255), k1p = (int)(i >> 15);
          const int part = kk >> 6, n2 = kk & 63, s = r >> 7, k2 = (r & 127) >> 1, reim = r & 1;
          float v;
          if (k1p == 0) { const int k = 64 * s + 128 * k2; const int mm = (n2 * k) & 8191; const float cm = cospif((float)mm / 4096.0f), sm = sinpif((float)mm / 4096.0f);
              v = (part == s) ? (reim ? -sm : cm) : 0.0f; }
          else { const int k = (s ? 128 - k1p : k1p) + 128 * k2; const int mm = (n2 * k) & 8191; const float cm = cospif((float)mm / 4096.0f), sm = sinpif((float)mm / 4096.0f);
              if (s == 0) v = reim ? (part ? cm : -sm) : (part ? sm : cm);
              else        v = reim ? (part ? -cm : -sm) : (part ? -sm : cm); }
          MT[i] = f2bf(v); } }
    { bf16_t* WC = WSP(bf16_t, WS_WC);
      const float sc = 5.656854249492381f;
      for (size_t i = gtid; i < 512 * 256; i += gsz) { const int n = (int)(i & 255), r = (int)(i >> 8), k = r >> 1, reim = r & 1; const int mm = (k * n) & 255;
          WC[i] = f2bf(sc * (reim ? -sinpif((float)mm / 128.0f) : cospif((float)mm / 128.0f))); } }
    { bf16_t* RWT = WSP(bf16_t, WS_RWT); const float* rw = INP(13);
      for (size_t i = gtid; i < (size_t)DEPTH * 32 * 1024; i += gsz) { const int k = (int)(i & 1023), e = (int)((i >> 10) & 31), l = (int)(i >> 15); RWT[i] = f2bf(rw[((size_t)l * 1024 + k) * 32 + e]); } }
    { bf16_t* H = WSP(bf16_t, WS_H); for (size_t i = gtid; i < 256 * 1024; i += gsz) H[(size_t)TT * 1024 + i] = 0; }
    (void)PI2;
    {
        LAS float* sil = (LAS float*)(F.lds + 65536);
        LAS float* red = (LAS float*)(F.lds + 65536 + 20480);
        for (int i = tid; i < 5 * 1024; i += 512) { const int v = i >> 10, k = i & 1023; const float x = (v < 4) ? INP(1)[v * 1024 + k] : INP(3)[k]; sil[i] = x * sigmoidf_(x); }
        __syncthreads();
        float* MOD = WSP(float, WS_MOD);
        for (int u = bid; u < DEPTH * 96; u += G) {
            const int l = u / 96, j0 = (u % 96) * 64;
            const float* aw = INP(4) + (size_t)l * 1024 * 6144 + j0 + F.lane;
            float a0 = 0.f, a1 = 0.f, a2 = 0.f, a3 = 0.f, a4 = 0.f;
            for (int kk = 0; kk < 128; ++kk) { const int k = F.wave * 128 + kk; const float w = aw[(size_t)k * 6144];
                a0 += sil[k] * w; a1 += sil[1024 + k] * w; a2 += sil[2048 + k] * w; a3 += sil[3072 + k] * w; a4 += sil[4096 + k] * w; }
            red[(F.wave * 5 + 0) * 64 + F.lane] = a0; red[(F.wave * 5 + 1) * 64 + F.lane] = a1; red[(F.wave * 5 + 2) * 64 + F.lane] = a2; red[(F.wave * 5 + 3) * 64 + F.lane] = a3; red[(F.wave * 5 + 4) * 64 + F.lane] = a4;
            __syncthreads();
            if (tid < 320) { const int v = tid >> 6, jl = tid & 63; float s = INP(5)[(size_t)l * 6144 + j0 + jl];
#pragma unroll
                for (int w = 0; w < 8; ++w) s += red[(w * 5 + v) * 64 + jl];
                MOD[((size_t)l * 5 + v) * 6144 + j0 + jl] = s; }
            __syncthreads();
        }
    }
    {
        LAS float* tab = (LAS float*)(F.lds + 65536);
        if (tid < 128) { tab[tid] = cospif((float)tid / 64.0f); tab[128 + tid] = sinpif((float)tid / 64.0f); }
        __syncthreads();
        bf16_t* WFO = WSP(bf16_t, WS_WFO);
        for (int u = bid; u < DEPTH * 4 * 2 * 16; u += G) {
            const int dc = u & 15, reim = (u >> 4) & 1, g = (u >> 5) & 3, l = u >> 7;
            const float* wf = INP(10) + ((size_t)l * 512 + g * 128) * 1024;
#pragma unroll 1
            for (int oh = 0; oh < 2; ++oh) { const int o = tid + 512 * oh;
                float a[8] = {0.f, 0.f, 0.f, 0.f, 0.f, 0.f, 0.f, 0.f};
                for (int j = 0; j < 128; ++j) { const float w = wf[(size_t)j * 1024 + o];
#pragma unroll
                    for (int q = 0; q < 8; ++q) a[q] += tab[reim * 128 + ((j * (dc * 8 + q)) & 127)] * w; }
                u32x4 w4; w4.x = cvt_pk_bf16(a[0] * (1.f / 1024.f), a[1] * (1.f / 1024.f)); w4.y = cvt_pk_bf16(a[2] * (1.f / 1024.f), a[3] * (1.f / 1024.f));
                w4.z = cvt_pk_bf16(a[4] * (1.f / 1024.f), a[5] * (1.f / 1024.f)); w4.w = cvt_pk_bf16(a[6] * (1.f / 1024.f), a[7] * (1.f / 1024.f));
                *(u32x4*)(WFO + ((size_t)l * 1024 + o) * 1024 + g * 256 + reim * 128 + dc * 8) = w4; }
        }
        __syncthreads();
    }
    {
        constexpr int T_WIN = DEPTH * 16 * 52, T_WAO = DEPTH * 8 * 16, T_WOUT = DEPTH * 16 * 16, T_GU = DEPTH * 32 * 16 * 32, T_DN = DEPTH * 32 * 16 * 16;
        constexpr int T_ALL = T_WIN + T_WAO + T_WOUT + T_GU + T_DN;
        for (int t = bid; t < T_ALL; t += G) {
            int q = t;
            if (q < T_WIN) { const int l = q / (16 * 52), r = q % (16 * 52), kt = r / 52, ntl = r % 52;
                transpose_tile(F, INP(8) + (size_t)l * 1024 * IN_DIM, IN_DIM, kt * 64, ntl * 64, WSP(bf16_t, WS_WIN) + (size_t)l * IN_DIM * 1024, 1024, RmWin()); continue; }
            q -= T_WIN;
            if (q < T_WAO) { const int l = q / 128, r = q % 128, kt = r / 16, ntl = r % 16;
                transpose_tile(F, INP(11) + (size_t)l * 512 * 1024, 1024, kt * 64, ntl * 64, WSP(bf16_t, WS_WAO) + (size_t)l * 1024 * 512, 512, RmId()); continue; }
            q -= T_WAO;
            if (q < T_WOUT) { const int l = q / 256, r = q % 256, kt = r / 16, ntl = r % 16;
                transpose_tile(F, INP(12) + (size_t)l * 1024 * 1024, 1024, kt * 64, ntl * 64, WSP(bf16_t, WS_WOUT) + (size_t)l * 1024 * 1024, 1024, RmId()); continue; }
            q -= T_WOUT;
            if (q < T_GU) { const int le = q / 512, r = q % 512, kt = r / 32, ntl = r % 32;
                transpose_tile(F, INP(15) + (size_t)le * 1024 * 2048, 2048, kt * 64, ntl * 64, WSP(bf16_t, WS_WGU) + (size_t)le * 2048 * 1024, 1024, RmGu()); continue; }
            q -= T_GU;
            { const int le = q / 256, r = q % 256, kt = r / 16, ntl = r % 16;
                transpose_tile(F, INP(17) + (size_t)le * 1024 * 1024, 1024, kt * 64, ntl * 64, WSP(bf16_t, WS_WDN) + (size_t)le * 1024 * 1024, 1024, RmId()); }
        }
    }
}

__device__ __forceinline__ void moe_combine(const Fr& F, int tok, int lprev, const volatile LAS int* tstart, f32x4 (&m)[4]) {
    const int* slot = WSP(int, WS_SLOT); const float* gate = WSP(float, WS_GATE); const bf16_t* YE = WSP(bf16_t, WS_YE);
#pragma unroll
    for (int j = 0; j < 4; ++j) m[j] = (f32x4){0.f, 0.f, 0.f, 0.f};
#pragma unroll
    for (int k = 0; k < 4; ++k) {
        const int sl = slot[tok * 4 + k]; const float gk = gate[tok * 4 + k];
        const int e = sl >> 20, pos = sl & 0xfffff;
        const size_t row = (size_t)256 * tstart[e] + pos;
        const bf16_t* yp = YE + row * 1024 + 4 * F.lane;
#pragma unroll
        for (int j = 0; j < 4; ++j) { const u32x2 w = *(const u32x2*)(yp + 256 * j); m[j][0] += gk * bf_lo(w.x); m[j][1] += gk * bf_hi(w.x); m[j][2] += gk * bf_lo(w.y); m[j][3] += gk * bf_hi(w.y); }
    }
    (void)lprev;
}
__device__ __forceinline__ int fill_tstart(const Fr& F, int l) {
    volatile LAS int* ts = (volatile LAS int*)(F.lds + LDS_MISC + 64);
    __syncthreads();
    if (F.tid == 0) { const int* cnt = (const int*)(F.ws + WS_CTL + CTL_CNT) + l * 32; int s = 0; for (int e = 0; e < 32; ++e) { ts[e] = s; s += (cnt[e] + 255) >> 8; } ts[32] = s; }
    __syncthreads();
    return ts[32];
}

__device__ __forceinline__ void norm1_phase(const Fr& F, int l) {
    const volatile LAS int* tstart = (const volatile LAS int*)(F.lds + LDS_MISC + 64);
    if (l > 0) fill_tstart(F, l - 1);
    const float* MOD = WSP(float, WS_MOD);
    const bool fin = (l == DEPTH);
    const int ntok = fin ? TX : TT;
    const bool tmo = fin && (xb_ld((unsigned*)(F.ws + WS_CTL) + XB_TMO) != 0u);
    const float* gvec = fin ? INP(19) : INP(6) + (size_t)l * 1024;
    float* XW = WSP(float, WS_XW); float* CW = WSP(float, WS_CW); bf16_t* H = WSP(bf16_t, WS_H);
    for (int tok = F.bid * 8 + F.wave; tok < ntok; tok += F.G * 8) {
        const bool isx = tok < TX; const int v = isx ? (tok >> 13) : 4;
        const float* src = (l == 0) ? (isx ? INP(0) + (size_t)tok * 1024 : INP(2) + (size_t)(tok - TX) * 1024) : (isx ? XW + (size_t)tok * 1024 : CW + (size_t)(tok - TX) * 1024);
        f32x4 x[4];
#pragma unroll
        for (int j = 0; j < 4; ++j) x[j] = *(const f32x4*)(src + 256 * j + 4 * F.lane);
        if (l > 0) {
            f32x4 mm[4]; moe_combine(F, tok, l - 1, tstart, mm);
            const float* g2 = MOD + ((size_t)(l - 1) * 5 + v) * 6144 + 5 * 1024;
            float* dst = isx ? XW + (size_t)tok * 1024 : CW + (size_t)(tok - TX) * 1024;
#pragma unroll
            for (int j = 0; j < 4; ++j) { x[j] += *(const f32x4*)(g2 + 256 * j + 4 * F.lane) * mm[j]; if (!fin) *(f32x4*)(dst + 256 * j + 4 * F.lane) = x[j]; }
        }
        float ss = 0.f;
#pragma unroll
        for (int j = 0; j < 4; ++j) ss += x[j][0] * x[j][0] + x[j][1] * x[j][1] + x[j][2] * x[j][2] + x[j][3] * x[j][3];
        ss = wave_sum(ss);
        const float rstd = rsqrtf(ss * (1.0f / 1024.0f) + EPS);
        if (fin) {
#pragma unroll
            for (int j = 0; j < 4; ++j) { const f32x4 g = *(const f32x4*)(gvec + 256 * j + 4 * F.lane); *(f32x4*)(F.out + (size_t)tok * 1024 + 256 * j + 4 * F.lane) = tmo ? (f32x4){__builtin_nanf(""), __builtin_nanf(""), __builtin_nanf(""), __builtin_nanf("")} : x[j] * rstd * g; }
        } else {
            const float* md = MOD + ((size_t)l * 5 + v) * 6144;
#pragma unroll
            for (int j = 0; j < 4; ++j) { const int c = 256 * j + 4 * F.lane; const f32x4 g = *(const f32x4*)(gvec + c), sh = *(const f32x4*)(md + c), sc = *(const f32x4*)(md + 1024 + c);
                const f32x4 y = x[j] * rstd * g * (sc + 1.0f) + sh;
                u32x2 w; w.x = cvt_pk_bf16(y[0], y[1]); w.y = cvt_pk_bf16(y[2], y[3]); *(u32x2*)(H + (size_t)tok * 1024 + c) = w; }
        }
    }
}

__device__ __forceinline__ void norm2_router_phase(const Fr& F, int l) {
    const int ntok = (l == DEPTH - 1) ? TX : TT;
    const float* MOD = WSP(float, WS_MOD); const float* gvec = INP(7) + (size_t)l * 1024;
    const float* XW = WSP(float, WS_XW); const float* CW = WSP(float, WS_CW); bf16_t* H = WSP(bf16_t, WS_H);
    const bf16_t* RWT = WSP(bf16_t, WS_RWT) + (size_t)l * 32 * 1024; const float* rb = INP(14) + l * 32;
    int* cntg = (int*)(F.ws + WS_CTL + CTL_CNT) + l * 32; int* list = WSP(int, WS_LIST); int* slot = WSP(int, WS_SLOT); float* gate = WSP(float, WS_GATE);
    LAS unsigned char* hs = F.lds;
    LAS float* part = (LAS float*)(F.lds + 69632);
    LAS float* logit = (LAS float*)(F.lds + 69632 + 36864);
    LAS int* lcnt = (LAS int*)(F.lds + 69632 + 36864 + 4608);
    LAS int* lbase = lcnt + 32;
    const int lane = F.lane, w = F.wave, l32 = lane & 31, hh = lane >> 5;
    for (int tl = F.bid; tl < ntok / 32; tl += F.G) {
        const int t0 = tl * 32;
        if (F.tid < 32) lcnt[F.tid] = 0;
#pragma unroll 1
        for (int q = 0; q < 4; ++q) {
            const int tloc = 4 * w + q, tok = t0 + tloc; const bool isx = tok < TX; const int v = isx ? (tok >> 13) : 4;
            const float* src = isx ? XW + (size_t)tok * 1024 : CW + (size_t)(tok - TX) * 1024;
            f32x4 x[4]; float ss = 0.f;
#pragma unroll
            for (int j = 0; j < 4; ++j) { x[j] = *(const f32x4*)(src + 256 * j + 4 * lane); ss += x[j][0] * x[j][0] + x[j][1] * x[j][1] + x[j][2] * x[j][2] + x[j][3] * x[j][3]; }
            ss = wave_sum(ss); const float rstd = rsqrtf(ss * (1.0f / 1024.0f) + EPS);
            const float* md = MOD + ((size_t)l * 5 + v) * 6144;
#pragma unroll
            for (int j = 0; j < 4; ++j) { const int c = 256 * j + 4 * lane; const f32x4 g = *(const f32x4*)(gvec + c), sh = *(const f32x4*)(md + 3072 + c), sc = *(const f32x4*)(md + 4096 + c);
                const f32x4 y = x[j] * rstd * g * (sc + 1.0f) + sh;
                u32x2 wv; wv.x = cvt_pk_bf16(y[0], y[1]); wv.y = cvt_pk_bf16(y[2], y[3]);
                *(u32x2*)(H + (size_t)tok * 1024 + c) = wv; *(LAS u32x2*)(hs + tloc * 2064 + c * 2) = wv; }
        }
        __syncthreads();
        {
            f32x16 acc;
#pragma unroll
            for (int e = 0; e < 16; ++e) acc[e] = 0.f;
#pragma unroll
            for (int s = 0; s < 8; ++s) { const int k = 128 * w + 16 * s + 8 * hh;
                const bf16x8 a = *(const LAS bf16x8*)(hs + l32 * 2064 + k * 2);
                const bf16x8 b = *(const bf16x8*)(RWT + (size_t)l32 * 1024 + k);
                acc = __builtin_amdgcn_mfma_f32_32x32x16_bf16(a, b, acc, 0, 0, 0); }
#pragma unroll
            for (int e = 0; e < 16; ++e) { const int trow = 8 * (e >> 2) + 4 * hh + (e & 3); part[(w * 32 + trow) * 33 + l32] = acc[e]; }
        }
        __syncthreads();
        { const int tr = F.tid >> 4, e0 = (F.tid & 15) * 2;
#pragma unroll
          for (int q = 0; q < 2; ++q) { float s = rb[e0 + q];
#pragma unroll
              for (int ww = 0; ww < 8; ++ww) s += part[(ww * 32 + tr) * 33 + e0 + q];
              logit[tr * 33 + e0 + q] = s; } }
        __syncthreads();
        int es[4], rk[4]; float gs[4];
        if (F.tid < 32) {
            float lv[4]; unsigned used = 0u;
#pragma unroll
            for (int k = 0; k < 4; ++k) { float best = -3.0e38f; int bi = 0;
#pragma unroll 1
                for (int e = 0; e < 32; ++e) { const float vv = logit[F.tid * 33 + e]; if (!((used >> e) & 1u) && vv > best) { best = vv; bi = e; } }
                used |= 1u << bi; es[k] = bi; lv[k] = best; }
            const float mx = lv[0]; float sum = 0.f;
#pragma unroll
            for (int k = 0; k < 4; ++k) { gs[k] = __expf(lv[k] - mx); sum += gs[k]; }
#pragma unroll
            for (int k = 0; k < 4; ++k) { gs[k] /= sum; rk[k] = __hip_atomic_fetch_add(&lcnt[es[k]], 1, __ATOMIC_RELAXED, __HIP_MEMORY_SCOPE_WORKGROUP); }
        }
        __syncthreads();
        if (F.tid < 32) { const int n = lcnt[F.tid]; lbase[F.tid] = n ? atomicAdd(&cntg[F.tid], n) : 0; }
        __syncthreads();
        if (F.tid < 32) { const int tok = t0 + F.tid;
#pragma unroll
            for (int k = 0; k < 4; ++k) { const int pos = lbase[es[k]] + rk[k]; list[(size_t)es[k] * TT + pos] = tok; slot[tok * 4 + k] = (es[k] << 20) | pos; gate[tok * 4 + k] = gs[k]; } }
        __syncthreads();
    }
}

template <int OFF> __device__ __forceinline__ s16x4 tr_read(unsigned vb) { s16x4 r; asm volatile("ds_read_b64_tr_b16 %0, %1 offset:%2" : "=&v"(r) : "v"(vb), "i"(OFF) : "memory"); return r; }

__device__ __forceinline__ void attn_phase(const Fr& F, int l, bool with_ctx) {
    LAS unsigned char* lds = F.lds;
    const unsigned ldsb = (unsigned)(uintptr_t)lds;
    const bf16_t* Q = WSP(bf16_t, WS_Q); const bf16_t* Kb = WSP(bf16_t, WS_K); const bf16_t* Vb = WSP(bf16_t, WS_V); bf16_t* AO = WSP(bf16_t, WS_AO);
    const int tid = F.tid, lane = F.lane, w = F.wave, l32 = lane & 31, hh = lane >> 5;
    const int g = w >> 1, rhalf = w & 1;
    const int nunits = 512 + (with_ctx ? 16 : 0);
    const int skey = tid >> 3, sch = tid & 7;
    const unsigned k_st = (unsigned)(skey * 128 + ((sch ^ ((skey >> 1) & 7)) * 16));
    const unsigned v_st = (unsigned)(8192 + skey * 128 + ((((sch >> 1) ^ (((skey >> 1) & 1) << 1)) * 32) + (sch & 1) * 16));
    unsigned vbase[2];
    { const int li = lane & 15, q = li >> 2, p = li & 3, g16 = l32 >> 4; const int key = 4 * hh + q;
#pragma unroll
      for (int db = 0; db < 2; ++db) { const int c32 = 2 * db + g16; vbase[db] = ldsb + 8192u + (unsigned)(key * 128 + ((c32 ^ (((key >> 1) & 1) << 1)) * 32) + 8 * p); } }
    for (int u = F.bid; u < nunits; u += F.G) {
        int b, qb, kvh; bool isctx;
        if (u < 512) { b = u >> 7; qb = (u >> 1) & 63; kvh = u & 1; isctx = false; }
        else { const int uu = u - 512; b = uu >> 2; qb = (uu >> 1) & 1; kvh = uu & 1; isctx = true; }
        const int head = kvh * 4 + g;
        const int qtok0 = isctx ? (TX + b * LC + qb * 128) : (b * SEQ + qb * 128);
        bf16x8 qf[2][4];
#pragma unroll
        for (int qk = 0; qk < 2; ++qk)
#pragma unroll
            for (int s = 0; s < 4; ++s) qf[qk][s] = *(const bf16x8*)(Q + (size_t)(qtok0 + rhalf * 64 + qk * 32 + l32) * 512 + head * 64 + 16 * s + 8 * hh);
        const float sink2 = INP(9)[l * 8 + head] * LOG2E;
        float m_run[2] = {sink2, sink2}, l_run[2] = {hh ? 0.f : 1.f, hh ? 0.f : 1.f};
        f32x16 O[2][2];
#pragma unroll
        for (int a = 0; a < 2; ++a)
#pragma unroll
            for (int c = 0; c < 2; ++c)
#pragma unroll
                for (int e = 0; e < 16; ++e) O[a][c][e] = 0.f;
        int t = isctx ? 6 : (qb == 0 ? 2 : 0);
        u32x4 kreg, vreg;
        { const int tok0 = (t < 6) ? (b * SEQ + (qb - 1) * 128 + 64 * t) : (TX + b * LC + 64 * (t - 6));
          kreg = *(const u32x4*)(Kb + (size_t)(tok0 + skey) * 128 + kvh * 64 + sch * 8); vreg = *(const u32x4*)(Vb + (size_t)(tok0 + skey) * 128 + kvh * 64 + sch * 8); }
        for (;;) {
            __syncthreads();
            *(LAS u32x4*)(lds + k_st) = kreg; *(LAS u32x4*)(lds + v_st) = vreg;
            int tn = t + 1; if (!isctx && qb == 63 && (tn == 4 || tn == 5)) tn = 6;
            const bool more = tn < 10;
            if (more) { const int tok0 = (tn < 6) ? (b * SEQ + (qb - 1) * 128 + 64 * tn) : (TX + b * LC + 64 * (tn - 6));
                kreg = *(const u32x4*)(Kb + (size_t)(tok0 + skey) * 128 + kvh * 64 + sch * 8); vreg = *(const u32x4*)(Vb + (size_t)(tok0 + skey) * 128 + kvh * 64 + sch * 8); }
            __syncthreads();
            const bool local = (!isctx) && (t < 6);
            const bool skip = local && ((rhalf == 0 && t == 5) || (rhalf == 1 && t == 0));
            if (!skip) {
                f32x16 S[2][2];
#pragma unroll
                for (int kb = 0; kb < 2; ++kb)
#pragma unroll
                    for (int qk = 0; qk < 2; ++qk)
#pragma unroll
                        for (int e = 0; e < 16; ++e) S[kb][qk][e] = 0.f;
#pragma unroll
                for (int kb = 0; kb < 2; ++kb)
#pragma unroll
                    for (int s = 0; s < 4; ++s) { const int key = 32 * kb + l32, ch = 2 * s + hh;
                        const bf16x8 kf = *(const LAS bf16x8*)(lds + key * 128 + ((ch ^ ((key >> 1) & 7)) * 16));
#pragma unroll
                        for (int qk = 0; qk < 2; ++qk) S[kb][qk] = __builtin_amdgcn_mfma_f32_32x32x16_bf16(kf, qf[qk][s], S[kb][qk], 0, 0, 0); }
                bf16x8 pf[2][2][2];
#pragma unroll
                for (int qk = 0; qk < 2; ++qk) {
                    if (local) { const int rq = rhalf * 64 + qk * 32 + l32;
#pragma unroll
                        for (int kb = 0; kb < 2; ++kb)
#pragma unroll
                            for (int e = 0; e < 16; ++e) { const int kk = 64 * t + 32 * kb + 8 * (e >> 2) + 4 * hh + (e & 3); const int rel = kk - 128 - rq; if (rel < -128 || rel > 128) S[kb][qk][e] = -__builtin_inff(); } }
                    float mx = -__builtin_inff();
#pragma unroll
                    for (int kb = 0; kb < 2; ++kb)
#pragma unroll
                        for (int e = 0; e < 16; ++e) mx = fmaxf(mx, S[kb][qk][e]);
                    mx = fmaxf(mx, __shfl_xor(mx, 32));
                    const float mn = fmaxf(m_run[qk], mx); const float alpha = __builtin_amdgcn_exp2f(m_run[qk] - mn); m_run[qk] = mn;
                    float rs = 0.f;
#pragma unroll
                    for (int kb = 0; kb < 2; ++kb)
#pragma unroll
                        for (int e = 0; e < 16; ++e) { const float p = __builtin_amdgcn_exp2f(S[kb][qk][e] - mn); S[kb][qk][e] = p; rs += p; }
                    l_run[qk] = l_run[qk] * alpha + rs;
#pragma unroll
                    for (int db = 0; db < 2; ++db)
#pragma unroll
                        for (int e = 0; e < 16; ++e) O[db][qk][e] *= alpha;
#pragma unroll
                    for (int kb = 0; kb < 2; ++kb)
#pragma unroll
                        for (int sp = 0; sp < 2; ++sp) { u32x4 pw;
                            pw.x = cvt_pk_bf16(S[kb][qk][8 * sp + 0], S[kb][qk][8 * sp + 1]); pw.y = cvt_pk_bf16(S[kb][qk][8 * sp + 2], S[kb][qk][8 * sp + 3]);
                            pw.z = cvt_pk_bf16(S[kb][qk][8 * sp + 4], S[kb][qk][8 * sp + 5]); pw.w = cvt_pk_bf16(S[kb][qk][8 * sp + 6], S[kb][qk][8 * sp + 7]);
                            pf[kb][sp][qk] = __builtin_bit_cast(bf16x8, pw); }
                }
#define PV_STEP(KB, SP) do { \
                    const s16x4 a0 = tr_read<((32 * (KB) + 16 * (SP)) * 128)>(vbase[0]), a1 = tr_read<((32 * (KB) + 16 * (SP) + 8) * 128)>(vbase[0]); \
                    const s16x4 c0 = tr_read<((32 * (KB) + 16 * (SP)) * 128)>(vbase[1]), c1 = tr_read<((32 * (KB) + 16 * (SP) + 8) * 128)>(vbase[1]); \
                    asm volatile("s_waitcnt lgkmcnt(0)" ::: "memory"); __builtin_amdgcn_sched_barrier(0); \
                    const bf16x8 vf0 = (bf16x8){a0[0], a0[1], a0[2], a0[3], a1[0], a1[1], a1[2], a1[3]}, vf1 = (bf16x8){c0[0], c0[1], c0[2], c0[3], c1[0], c1[1], c1[2], c1[3]}; \
                    O[0][0] = __builtin_amdgcn_mfma_f32_32x32x16_bf16(vf0, pf[KB][SP][0], O[0][0], 0, 0, 0); O[0][1] = __builtin_amdgcn_mfma_f32_32x32x16_bf16(vf0, pf[KB][SP][1], O[0][1], 0, 0, 0); \
                    O[1][0] = __builtin_amdgcn_mfma_f32_32x32x16_bf16(vf1, pf[KB][SP][0], O[1][0], 0, 0, 0); O[1][1] = __builtin_amdgcn_mfma_f32_32x32x16_bf16(vf1, pf[KB][SP][1], O[1][1], 0, 0, 0); } while (0)
                PV_STEP(0, 0); PV_STEP(0, 1); PV_STEP(1, 0); PV_STEP(1, 1);
#undef PV_STEP
            }
            if (!more) break;
            t = tn;
        }
#pragma unroll
        for (int qk = 0; qk < 2; ++qk) {
            const float lt = l_run[qk] + __shfl_xor(l_run[qk], 32); const float inv = 1.0f / lt;
            const size_t tok = (size_t)(qtok0 + rhalf * 64 + qk * 32 + l32);
#pragma unroll
            for (int db = 0; db < 2; ++db)
#pragma unroll
                for (int vq = 0; vq < 4; ++vq) { u32x2 wv; wv.x = cvt_pk_bf16(O[db][qk][4 * vq] * inv, O[db][qk][4 * vq + 1] * inv); wv.y = cvt_pk_bf16(O[db][qk][4 * vq + 2] * inv, O[db][qk][4 * vq + 3] * inv);
                    *(u32x2*)(AO + tok * 512 + head * 64 + 32 * db + 8 * vq + 4 * hh) = wv; }
        }
    }
    __syncthreads();
}

struct Args { const float* in[20]; float* out; unsigned char* ws; int ph_lo, ph_hi; };

constexpr int PH_PER_LAYER = 9;
constexpr int PH_FINAL = 1 + DEPTH * PH_PER_LAYER;
constexpr int PH_COUNT = PH_FINAL + 1;

__global__ void __launch_bounds__(512, 2) fwd_kernel(Args args) {
    extern __shared__ __attribute__((aligned(16))) unsigned char lds_raw[];
    Fr F;
    F.lds = (LAS unsigned char*)lds_raw; F.ws = args.ws; F.out = args.out;
    F.tid = threadIdx.x; F.lane = F.tid & 63; F.wave = __builtin_amdgcn_readfirstlane(F.tid >> 6); F.G = gridDim.x; F.bid = blockIdx.x;
    volatile LAS unsigned* misc = (volatile LAS unsigned*)(F.lds + LDS_MISC);
    if (F.tid < 64) misc[F.tid] = 0u;
    if (F.tid < 20) { const unsigned long long pv = (unsigned long long)args.in[F.tid]; misc[128 + 2 * F.tid] = (unsigned)pv; misc[128 + 2 * F.tid + 1] = (unsigned)(pv >> 32); }
    __syncthreads();
    XcdBarrier bar; bar.bar = (unsigned*)(F.ws + WS_CTL); bar.x = 0; bar.st = misc;
    const bool one = (args.ph_hi - args.ph_lo) > 1;
    if (one) bar = xcd_barrier_post((unsigned*)(F.ws + WS_CTL), misc);
    const int lo = args.ph_lo, hi = args.ph_hi;
#ifdef STOP_PH
#define IN(k) (lo <= (k) && (k) < hi && ((k) < STOP_PH || (k) == PH_FINAL))
#else
#define IN(k) (lo <= (k) && (k) < hi)
#endif
#define SEAM(k) do { if (lo <= (k) + 1 && (k) + 1 < hi) xcd_barrier(bar); } while (0)

#ifndef PHM
#define PHM 0xFFFF
#endif
#define PHON(b) ((PHM >> (b)) & 1)
    if (PHON(0) && IN(0)) { LAUNDER(F); prologue_phase(F); SEAM(0); }

#pragma unroll 1
    for (int l = 0; l < NLAYERS_RUN; ++l) {
        const int pb = 1 + l * PH_PER_LAYER;
        const bool lastl = (l == DEPTH - 1);
        if (PHON(1) && IN(pb + 0)) { LAUNDER(F); norm1_phase(F, l); SEAM(pb + 0); }
        if (PHON(2) && IN(pb + 1)) { LAUNDER(F);
            { InProjProb<0> P; P.H = WSP(bf16_t, WS_H); P.W = WSP(bf16_t, WS_WIN) + (size_t)l * IN_DIM * 1024;
              P.FT = WSP(bf16_t, WS_FT); P.FCT = WSP(bf16_t, WS_FCT); P.Q = WSP(bf16_t, WS_Q); P.Kb = WSP(bf16_t, WS_K); P.Vb = WSP(bf16_t, WS_V); P.GF = WSP(bf16_t, WS_GF); P.GA = WSP(bf16_t, WS_GA);
              P.rope = WSP(float, WS_ROPE);
              P.nM = lastl ? 128 : 132; P.n_nat = P.nM * 11; P.n_fx = 256; P.n_fc = lastl ? 0 : 8; P.n_extra = lastl ? 4 : 0; P.G = F.G; P.c = F.bid;
              g8::gemm_run(F.lds, P); }
            { InProjProb<1> P; P.H = WSP(bf16_t, WS_H); P.W = WSP(bf16_t, WS_WIN) + (size_t)l * IN_DIM * 1024;
              P.FT = WSP(bf16_t, WS_FT); P.FCT = WSP(bf16_t, WS_FCT); P.Q = nullptr; P.Kb = nullptr; P.Vb = nullptr; P.GF = nullptr; P.GA = nullptr; P.rope = nullptr;
              P.nM = 0; P.n_nat = 0; P.n_fx = 256; P.n_fc = lastl ? 0 : 8; P.n_extra = 0; P.G = F.G; P.c = (F.bid + 180) % F.G;
              g8::gemm_run(F.lds, P); }
            SEAM(pb + 1);
        }
        if (PHON(3) && IN(pb + 2)) { LAUNDER(F);
#ifndef NO_ATTN
            attn_phase(F, l, !lastl);
#endif
#ifndef NO_FFT1
            Fft1Prob P; P.W1 = WSP(bf16_t, WS_W1); P.FT = WSP(bf16_t, WS_FT); P.WC = WSP(bf16_t, WS_WC); P.FCT = WSP(bf16_t, WS_FCT); P.T1 = WSP(bf16_t, WS_T1); P.XS = WSP(bf16_t, WS_XS);
            P.n0 = 512; P.n1 = lastl ? 0 : 16; P.G = F.G; P.c = F.bid;
            g8::gemm_run(F.lds, P);
#endif
            SEAM(pb + 2);
        }
        if (PHON(4) && IN(pb + 3)) { LAUNDER(F);
            Fft2Prob P; P.MT = WSP(bf16_t, WS_MT); P.T1 = WSP(bf16_t, WS_T1); P.XS = WSP(bf16_t, WS_XS); P.G = F.G; P.c = F.bid;
            g8::gemm_run(F.lds, P); SEAM(pb + 3);
        }
        if (PHON(5) && IN(pb + 4)) { LAUNDER(F);
            { MergeProb<0> P; P.A = WSP(bf16_t, WS_XS); P.W = WSP(bf16_t, WS_WFO) + (size_t)l * 1024 * 1024; P.lda = 1024; P.GATE = WSP(bf16_t, WS_GF); P.YB = WSP(bf16_t, WS_YB);
              P.xin = nullptr; P.cin = nullptr; P.XW = nullptr; P.CW = nullptr; P.g1x = nullptr; P.g1c = nullptr; P.nM = lastl ? 128 : 132; P.G = F.G; P.c = F.bid;
              g8::gemm_run(F.lds, P); }
            { MergeProb<1> P; P.A = WSP(bf16_t, WS_AO); P.W = WSP(bf16_t, WS_WAO) + (size_t)l * 1024 * 512; P.lda = 512; P.GATE = WSP(bf16_t, WS_GA); P.YB = WSP(bf16_t, WS_YB);
              P.xin = nullptr; P.cin = nullptr; P.XW = nullptr; P.CW = nullptr; P.g1x = nullptr; P.g1c = nullptr; P.nM = lastl ? 128 : 132; P.G = F.G; P.c = F.bid;
              g8::gemm_run(F.lds, P); }
            SEAM(pb + 4);
        }
        if (PHON(6) && IN(pb + 5)) { LAUNDER(F);
            MergeProb<2> P; P.A = WSP(bf16_t, WS_YB); P.W = WSP(bf16_t, WS_WOUT) + (size_t)l * 1024 * 1024; P.lda = 1024; P.GATE = nullptr; P.YB = nullptr;
            P.xin = (l == 0) ? INP(0) : WSP(float, WS_XW); P.cin = (l == 0) ? INP(2) : WSP(float, WS_CW); P.XW = WSP(float, WS_XW); P.CW = WSP(float, WS_CW);
            P.g1x = WSP(float, WS_MOD) + (size_t)l * 5 * 6144 + 2 * 1024; P.g1c = WSP(float, WS_MOD) + ((size_t)l * 5 + 4) * 6144 + 2 * 1024; P.nM = lastl ? 128 : 132; P.G = F.G; P.c = F.bid;
            g8::gemm_run(F.lds, P); SEAM(pb + 5);
        }
        if (PHON(7) && IN(pb + 6)) { LAUNDER(F); norm2_router_phase(F, l); SEAM(pb + 6); }
        if (PHON(8) && IN(pb + 7)) { LAUNDER(F);
            MoeGuProb P; P.R = fill_tstart(F, l);
            P.H = WSP(bf16_t, WS_H); P.W = WSP(bf16_t, WS_WGU) + (size_t)l * 32 * 2048 * 1024; P.bgu = INP(16) + (size_t)l * 32 * 2048; P.ACT = WSP(bf16_t, WS_ACT);
            P.list = WSP(int, WS_LIST); P.cnt = (const int*)(F.ws + WS_CTL + CTL_CNT) + l * 32; P.tstart = (const volatile LAS int*)(F.lds + LDS_MISC + 64); P.G = F.G; P.c = F.bid;
            g8::gemm_run(F.lds, P); SEAM(pb + 7);
        }
        if (PHON(9) && IN(pb + 8)) { LAUNDER(F);
            MoeDnProb P; P.R = fill_tstart(F, l);
            P.ACT = WSP(bf16_t, WS_ACT); P.W = WSP(bf16_t, WS_WDN) + (size_t)l * 32 * 1024 * 1024; P.bdn = INP(18) + (size_t)l * 32 * 1024; P.YE = WSP(bf16_t, WS_YE);
            P.tstart = (const volatile LAS int*)(F.lds + LDS_MISC + 64); P.G = F.G; P.c = F.bid;
            g8::gemm_run(F.lds, P); SEAM(pb + 8);
        }
    }
#ifdef STOP_PH
    if (IN(PH_FINAL)) { LAUNDER(F);
        const size_t n = (size_t)TX * 1024;
        for (size_t i = (size_t)F.bid * 512 + F.tid; i < n; i += (size_t)F.G * 512) {
            F.out[i] = DUMP_EXPR(i);
        } }
#else
    if (PHON(10) && IN(PH_FINAL)) { LAUNDER(F); norm1_phase(F, DEPTH); }
#endif
#undef IN
#undef SEAM
}

extern "C" void kernel_launch(void* const* d_in, const int* in_sizes, int n_in, void* d_out, int out_size, void* d_ws, size_t ws_size, hipStream_t stream) {
    static int grid = 0;
    if (grid == 0) {
        if (n_in != 20 || ws_size < WS_END) { fprintf(stderr, "kernel_launch: bad arguments (n_in %d, ws %zu < %zu)\n", n_in, ws_size, (size_t)WS_END); grid = -1; return; }
        int dev = 0, cus = 0, per_cu = 0;
        if (hipGetDevice(&dev) != hipSuccess || hipDeviceGetAttribute(&cus, hipDeviceAttributeMultiprocessorCount, dev) != hipSuccess) { grid = -1; return; }
        if (hipFuncSetAttribute((const void*)fwd_kernel, hipFuncAttributeMaxDynamicSharedMemorySize, LDS_BYTES) != hipSuccess) { fprintf(stderr, "kernel_launch: hipFuncSetAttribute failed\n"); grid = -1; return; }
        if (hipOccupancyMaxActiveBlocksPerMultiprocessor(&per_cu, (const void*)fwd_kernel, 512, LDS_BYTES) != hipSuccess || per_cu < 1) { fprintf(stderr, "kernel_launch: occupancy query says %d\n", per_cu); }
        (void)hipGetLastError();
        grid = cus;
    }
    if (grid < 0) return;
    (void)hipMemsetAsync((char*)d_ws + WS_CTL, 0, CTL_BYTES, stream);
    Args a{};
    for (int i = 0; i < 20; ++i) a.in[i] = (const float*)d_in[i];
    a.out = (float*)d_out; a.ws = (unsigned char*)d_ws;
#if N_LAUNCH_MODE == 1
    a.ph_lo = 0; a.ph_hi = PH_COUNT;
    hipLaunchKernelGGL(fwd_kernel, dim3(grid), dim3(512), LDS_BYTES, stream, a);
#else
    for (int p = 0; p < PH_COUNT; ++p) { a.ph_lo = p; a.ph_hi = p + 1; hipLaunchKernelGGL(fwd_kernel, dim3(grid), dim3(512), LDS_BYTES, stream, a); }
#endif
    (void)in_sizes; (void)out_size;
}
```

```cpp
#include <hip/hip_runtime.h>
#include <cstdio>
#include <cstdint>

#define LAS __attribute__((address_space(3)))
typedef unsigned short bf16_t;
typedef short bf16x8 __attribute__((ext_vector_type(8)));
typedef short s16x4 __attribute__((ext_vector_type(4)));
typedef float f32x4 __attribute__((ext_vector_type(4)));
typedef float f32x16 __attribute__((ext_vector_type(16)));
typedef unsigned u32x4 __attribute__((ext_vector_type(4)));
typedef unsigned u32x2 __attribute__((ext_vector_type(2)));
typedef int i32x4 __attribute__((ext_vector_type(4)));

#ifndef N_LAUNCH_MODE
#define N_LAUNCH_MODE 1
#endif
#ifndef DBG_CHECK
#define DBG_CHECK 0
#endif
#ifndef EMU8
#define EMU8 false
#endif
#ifndef NLAYERS_RUN
#define NLAYERS_RUN 4
#endif

constexpr int D = 1024, NB = 4, SEQ = 8192, TX = NB * SEQ, LC = 256, TC = NB * LC, TT = TX + TC, DEPTH = 4;
constexpr int IN_DIM = 3328, NEXP = 32;
constexpr int ROWS_MAX = TT * 4 + NEXP * 256;
constexpr float LOG2E = 1.4426950408889634f;
constexpr float QSCALE = 0.125f * LOG2E;
constexpr float EPS = 1e-5f;

constexpr size_t al256(size_t x) { return (x + 255) & ~(size_t)255; }
constexpr size_t WS_CTL = 0;
constexpr size_t CTL_BYTES = 65536;
constexpr size_t CTL_CNT = 16384;
constexpr size_t WS_MOD = WS_CTL + CTL_BYTES;
constexpr size_t WS_ROPE = WS_MOD + al256((size_t)DEPTH * 5 * 6144 * 4);
constexpr size_t WS_W1 = WS_ROPE + 16384;
constexpr size_t WS_MT = WS_W1 + 256 * 128 * 2;
constexpr size_t WS_WC = WS_MT + (size_t)64 * 256 * 128 * 2;
constexpr size_t WS_RWT = WS_WC + 512 * 256 * 2;
constexpr size_t WS_WIN = WS_RWT + (size_t)DEPTH * 32 * 1024 * 2;
constexpr size_t WS_WFO = WS_WIN + (size_t)DEPTH * IN_DIM * 1024 * 2;
constexpr size_t WS_WAO = WS_WFO + (size_t)DEPTH * 1024 * 1024 * 2;
constexpr size_t WS_WOUT = WS_WAO + (size_t)DEPTH * 1024 * 512 * 2;
constexpr size_t WS_WGU = WS_WOUT + (size_t)DEPTH * 1024 * 1024 * 2;
constexpr size_t WS_SWGU = WS_WGU + (size_t)DEPTH * 32 * 2048 * 1024;
constexpr size_t WS_WDN = WS_SWGU + (size_t)DEPTH * 32 * 2048 * 4;
constexpr size_t WS_H = WS_WDN + (size_t)DEPTH * 32 * 1024 * 1024 * 2;
constexpr size_t WS_FT = WS_H + (size_t)(TT + 256) * 1024 * 2;
constexpr size_t WS_FCT = WS_FT + (size_t)131072 * 128 * 2;
constexpr size_t WS_Q = WS_FCT + (size_t)2048 * 256 * 2;
constexpr size_t WS_K = WS_Q + (size_t)TT * 512 * 2;
constexpr size_t WS_V = WS_K + (size_t)TT * 128 * 2;
constexpr size_t WS_GF = WS_V + (size_t)TT * 128 * 2;
constexpr size_t WS_GA = WS_GF + (size_t)TT * 1024 * 2;
constexpr size_t WS_T1 = WS_GA + (size_t)TT * 1024 * 2;
constexpr size_t WS_XS = WS_T1 + (size_t)64 * 2048 * 128 * 2;
constexpr size_t WS_AO = WS_XS + (size_t)TT * 1024 * 2;
constexpr size_t WS_YB = WS_AO + (size_t)TT * 512 * 2;
constexpr size_t WS_XW = WS_YB + (size_t)TT * 1024 * 2;
constexpr size_t WS_CW = WS_XW + (size_t)TX * 1024 * 4;
constexpr size_t WS_ACT = WS_CW + (size_t)TC * 1024 * 4;
constexpr size_t WS_YE = WS_ACT + (size_t)ROWS_MAX * 1024 * 2;
constexpr size_t WS_LIST = WS_YE + (size_t)ROWS_MAX * 1024 * 2;
constexpr size_t WS_SLOT = WS_LIST + (size_t)32 * TT * 4;
constexpr size_t WS_GATE = WS_SLOT + (size_t)TT * 4 * 4;
constexpr size_t WS_H8 = WS_GATE + (size_t)TT * 4 * 4;
constexpr size_t WS_LSC = WS_H8 + (size_t)(TT + 256) * 1024;
constexpr size_t WS_END = WS_LSC + (size_t)32 * TT * 4;

constexpr int LDS_STAGE = 131072;
constexpr int LDS_MISC = LDS_STAGE;
constexpr int LDS_BYTES = 147456;

typedef __bf16 bf16v2_t __attribute__((ext_vector_type(2)));
typedef float f32x2_t __attribute__((ext_vector_type(2)));
__device__ __forceinline__ unsigned cvt_pk_bf16(float lo, float hi) { const f32x2_t v = {lo, hi}; const bf16v2_t b = __builtin_convertvector(v, bf16v2_t); return __builtin_bit_cast(unsigned, b); }
__device__ __forceinline__ float q8(float x) { const int p = __builtin_amdgcn_cvt_pk_fp8_f32(x, 0.f, 0, false); return __builtin_amdgcn_cvt_f32_fp8(p, 0); }
__device__ __forceinline__ bf16_t f2bf(float f) { return (bf16_t)(cvt_pk_bf16(f, 0.f) & 0xffffu); }
__device__ __forceinline__ float bf_lo(unsigned u) { return __uint_as_float(u << 16); }
__device__ __forceinline__ float bf_hi(unsigned u) { return __uint_as_float(u & 0xffff0000u); }
__device__ __forceinline__ float bf2f(bf16_t b) { return __uint_as_float(((unsigned)b) << 16); }
__device__ __forceinline__ float sigmoidf_(float x) { return __builtin_amdgcn_rcpf(1.0f + __builtin_amdgcn_exp2f(-x * LOG2E)); }
__device__ __forceinline__ float wave_sum(float v) {
#pragma unroll
    for (int o = 32; o >= 1; o >>= 1) v += __shfl_xor(v, o);
    return v;
}

#define XB_TMO      128
#define XB_XCNT(j)  (256  + 64 * (j))
#define XB_XSUB(j)  (1280 + 64 * (j))
#define XB_XGEN(j)  (2304 + 64 * (j))
#define XB_TOP      3328
#define XB_TOPGEN   3392
#define XCD_BAR_WORDS 3456
#define XB_SPIN_CAP (1u << 22)

__device__ __forceinline__ unsigned xb_ld(unsigned* p)              { return __hip_atomic_load(p, __ATOMIC_RELAXED, __HIP_MEMORY_SCOPE_AGENT); }
__device__ __forceinline__ unsigned xb_add(unsigned* p, unsigned v) { return __hip_atomic_fetch_add(p, v, __ATOMIC_RELAXED, __HIP_MEMORY_SCOPE_AGENT); }
__device__ __forceinline__ unsigned xb_xcc_id() { return (unsigned)__builtin_amdgcn_s_getreg((3 << 11) | 20) & 0xFu; }
#define XB_SPIN(cond, bar) do { unsigned _sp = 0; while (cond) { __builtin_amdgcn_s_sleep(1); \
    if ((++_sp & 255u) == 0u) { if (xb_ld(&(bar)[XB_TMO])) break; if (_sp > XB_SPIN_CAP) { atomicAdd(&(bar)[XB_TMO], 1u); break; } } } } while (0)

struct XcdBarrier { unsigned* bar; unsigned x; volatile LAS unsigned* st; };

__device__ __forceinline__ XcdBarrier xcd_barrier_post(unsigned* bar, volatile LAS unsigned* st) {
    XcdBarrier b; b.bar = bar; b.x = xb_xcc_id(); b.st = st;
    if (threadIdx.x == 0) (void)xb_add(&bar[XB_XCNT(b.x)], 1u);
    return b;
}
__device__ __forceinline__ void xcd_barrier_complete(unsigned* bar, unsigned x, unsigned& nloc, unsigned& nx) {
    const unsigned G = gridDim.x * gridDim.y * gridDim.z;
    unsigned sum, cnt, mine, sp = 0u;
    for (;;) {
        sum = 0u; cnt = 0u; mine = 0u;
#pragma unroll
        for (unsigned j = 0; j < 16; ++j) { const unsigned c = xb_ld(&bar[XB_XCNT(j)]); sum += c; cnt += (c > 0u) ? 1u : 0u; mine = (j == x) ? c : mine; }
        if (sum == G) break;
        __builtin_amdgcn_s_sleep(1);
        if ((++sp & 255u) == 0u) { if (xb_ld(&bar[XB_TMO])) break; if (sp > XB_SPIN_CAP) { atomicAdd(&bar[XB_TMO], 1u); break; } }
    }
    nloc = mine > 0u ? mine : 1u; nx = cnt > 0u ? cnt : 1u;
}
__device__ __forceinline__ void xcd_barrier(const XcdBarrier& b) {
    asm volatile("s_waitcnt vmcnt(0)" ::: "memory");
    __syncthreads();
    if (threadIdx.x == 0) {
        unsigned* bar = b.bar;
        __builtin_amdgcn_s_waitcnt(0);
        unsigned nloc = b.st[0], nx = b.st[1];
        if (nloc == 0u) { xcd_barrier_complete(bar, b.x, nloc, nx); b.st[0] = nloc; b.st[1] = nx; }
        const unsigned old = xb_add(&bar[XB_XSUB(b.x)], 1u);
        const unsigned gen = old / nloc;
        if (old + 1u == (gen + 1u) * nloc) {
            __builtin_amdgcn_fence(__ATOMIC_RELEASE, "agent");
            asm volatile("s_waitcnt vmcnt(0)" ::: "memory");
            const unsigned og = xb_add(&bar[XB_TOP], 1u);
            const unsigned tg = og / nx;
            if (og + 1u == (tg + 1u) * nx) xb_add(&bar[XB_TOPGEN], 1u);
            else XB_SPIN(xb_ld(&bar[XB_TOPGEN]) == tg, bar);
            __builtin_amdgcn_fence(__ATOMIC_ACQUIRE, "agent");
            xb_add(&bar[XB_XGEN(b.x)], 1u);
            asm volatile("s_waitcnt vmcnt(0)" ::: "memory");
        } else {
            XB_SPIN(xb_ld(&bar[XB_XGEN(b.x)]) == gen, bar);
            __builtin_amdgcn_fence(__ATOMIC_ACQUIRE, "agent");
            asm volatile("s_waitcnt vmcnt(0)" ::: "memory");
        }
    }
    __syncthreads();
}

struct Fr {
    LAS unsigned char* lds;
    unsigned char* ws;
    float* out;
    int tid, lane, wave, G, bid;
};
__device__ __forceinline__ const float* in_ptr(const Fr& F, int i) {
    volatile LAS unsigned* p = (volatile LAS unsigned*)(F.lds + 131072 + 512) + 2 * i;
    const unsigned lo = __builtin_amdgcn_readfirstlane(p[0]), hi = __builtin_amdgcn_readfirstlane(p[1]);
    return (const float*)(((unsigned long long)hi << 32) | lo);
}
#define INP(i) in_ptr(F, (i))
#define LAUNDER(F) do { unsigned char* _w = (F).ws; asm volatile("" : "+s"(_w)); (F).ws = _w; int _t = threadIdx.x; asm volatile("" : "+v"(_t)); (F).tid = _t; (F).lane = _t & 63; (F).wave = __builtin_amdgcn_readfirstlane(_t >> 6); } while (0)
#define WSP(T, off) ((T*)(F.ws + (off)))

namespace g8 {
constexpr int BM = 256, BK = 64, HALF = 128, HTB = HALF * BK * 2, NXCD = 8, WGM = 8;
__device__ __forceinline__ int lds_byte(int r, int c) { const int st = (r >> 4) * 2 + (c >> 5), rr = r & 15, cc = c & 31, ob = rr * 64 + cc * 2; return st * 1024 + (ob ^ (((ob >> 9) & 1) << 5)); }
__device__ __forceinline__ void stage_rc(int b, int& R, int& C) { const int st = b / 1024, sb = b % 1024, swz = sb ^ (((sb >> 9) & 1) << 5); R = (st >> 1) * 16 + swz / 64; C = (st & 1) * 32 + (swz % 64) / 2; }
__device__ __forceinline__ int perm32(int rho) { const int n = rho >> 4, i = rho & 15; return 8 * (i >> 2) + 4 * n + (i & 3); }
__device__ __forceinline__ void order2d(int L, int nM, int nN, int& pm, int& pn) {
    const int nwg = nM * nN;
    int wgid = L; { const int q = nwg / NXCD, r = nwg % NXCD, xcd = wgid % NXCD, off = wgid / NXCD; wgid = (xcd < r ? xcd * (q + 1) : r * (q + 1) + (xcd - r) * q) + off; }
    const int nig = WGM * nN, gid = wgid / nig, fm = gid * WGM, gsz = (nM - fm) < WGM ? (nM - fm) : WGM;
    pm = fm + ((wgid % nig) % gsz); pn = (wgid % nig) / gsz;
}
__device__ __forceinline__ void lane_geom(int tid, int& R0, int& Rb0, int& C0) { asm volatile("" : "+v"(tid)); stage_rc(tid * 16, R0, C0); Rb0 = (R0 & ~31) + perm32(R0 & 31); }

#define G8_ROWS(ai, m) (128 * (ai) + 64 * wr + 16 * (m) + fr)
#define G8_COL0(bj) (128 * (bj) + 32 * wc + 8 * fq)

template <bool I8> __device__ __forceinline__ f32x4 mma1(const bf16x8& b, const bf16x8& a, const f32x4& c) { return __builtin_amdgcn_mfma_f32_16x16x32_bf16(b, a, c, 0, 0, 0); }
template <bool I8> __device__ __forceinline__ i32x4 mma1(const bf16x8& b, const bf16x8& a, const i32x4& c) { return __builtin_amdgcn_mfma_i32_16x16x64_i8(__builtin_bit_cast(i32x4, b), __builtin_bit_cast(i32x4, a), c, 0, 0, 0); }
template <class P>
__device__ __forceinline__ void gemm_run(LAS unsigned char* lds, P& prob) {
    int tid = threadIdx.x; asm volatile("" : "+v"(tid));
    const int wid = __builtin_amdgcn_readfirstlane(tid >> 6), lane = tid & 63, wr = wid >> 2, wc = wid & 3, fr = lane & 15, fq = lane >> 4;
    const size_t kstep = (size_t)(BK * 2);
    const unsigned ldsw = (unsigned)wid * 1024u;
    const int aoff = lds_byte(wr * 64 + fr, fq * 8), boff = lds_byte(wc * 32 + fr, fq * 8);
#define G8_SA(b, h) (((b) * 2 + (h)) * HTB)
#define G8_SB(b, h) ((4 + (b) * 2 + (h)) * HTB)
#define G8_STAGE_(bufoff, g0, o0, g1, o1) do { \
        __builtin_amdgcn_global_load_lds((const unsigned*)((const char*)(g0) + (o0)), (LAS unsigned*)(lds + (bufoff) + ldsw), 16, 0, 0); \
        __builtin_amdgcn_global_load_lds((const unsigned*)((const char*)(g1) + (o1)), (LAS unsigned*)(lds + (bufoff) + ldsw + 8192), 16, 0, 0); } while (0)
#define G8_OA(j) (P::GATHER_A ? oa[j] : oa[0])
#define G8_STA(bufoff, gbase, h) G8_STAGE_(bufoff, (gbase) + dA[2 * (h)], G8_OA(2 * (h)), (gbase) + dA[2 * (h) + 1], G8_OA(2 * (h) + 1))
#define G8_STB(bufoff, gbase, h) G8_STAGE_(bufoff, (gbase) + dB[2 * (h)], ob, (gbase) + dB[2 * (h) + 1], ob)
#define G8_LDA(dst, b, h) do { _Pragma("unroll") for (int m = 0; m < 4; ++m) _Pragma("unroll") for (int k = 0; k < 2; ++k) dst[m][k] = *(const LAS bf16x8*)(lds + G8_SA(b, h) + aoff + m * 2048 + k * 1024); } while (0)
#define G8_LDB(dst, b, h) do { _Pragma("unroll") for (int n = 0; n < 2; ++n) _Pragma("unroll") for (int k = 0; k < 2; ++k) dst[n][k] = *(const LAS bf16x8*)(lds + G8_SB(b, h) + boff + n * 2048 + k * 1024); } while (0)
#define G8_MMA(ai, bj, At, Bt) do { __builtin_amdgcn_s_setprio(1); _Pragma("unroll") for (int m = 0; m < 4; ++m) _Pragma("unroll") for (int n = 0; n < 2; ++n) _Pragma("unroll") for (int k = 0; k < 2; ++k) \
        acc[ai][bj][m][n] = mma1<P::I8>(Bt[n][k], At[m][k], acc[ai][bj][m][n]); __builtin_amdgcn_s_setprio(0); } while (0)
#define G8_WAIT_V(n) asm volatile("s_waitcnt vmcnt(" #n ")" ::: "memory")
#define G8_WAIT_L(n) asm volatile("s_waitcnt lgkmcnt(" #n ")" ::: "memory")
#define G8_BAR __builtin_amdgcn_s_barrier()
#define G8_SCHED __builtin_amdgcn_sched_barrier(0)
    typename P::U cur, nxt; int ui = 0;
    if (!prob.get(0, cur)) return;
    typedef typename P::Acc Acc;
    Acc acc[2][2][4][2];
#pragma unroll
    for (int a = 0; a < 2; ++a)
#pragma unroll
        for (int b = 0; b < 2; ++b)
#pragma unroll
            for (int m = 0; m < 4; ++m)
#pragma unroll
                for (int n = 0; n < 2; ++n) acc[a][b][m][n] = (Acc){0, 0, 0, 0};
    bf16x8 At[4][2], B0[2][2], B1[2][2];
    unsigned oa[4], ob, dA[4], dB[4]; const char* cA; const char* cB; int nt;
    prob.setup(cur, oa, ob, dA, dB, cA, cB, nt);
    G8_STB(G8_SB(0, 0), cB, 0); G8_STA(G8_SA(0, 0), cA, 0); G8_STB(G8_SB(0, 1), cB, 1); G8_STA(G8_SA(0, 1), cA, 1);
    if (wr == 1) G8_BAR;
    G8_WAIT_V(4); G8_BAR;
    G8_STB(G8_SB(1, 0), cB + kstep, 0); G8_STA(G8_SA(1, 0), cA + kstep, 0); G8_STB(G8_SB(1, 1), cB + kstep, 1);
    G8_WAIT_V(6); G8_BAR;
    for (;;) {
        const bool has_next = prob.get(ui + 1, nxt);
        int nnt = nt;
        for (int t = 0; t < nt; t += 2) {
            const bool last = (t == nt - 2);
            G8_LDB(B0, 0, 0); G8_SCHED; G8_LDA(At, 0, 0); G8_STA(G8_SA(1, 1), cA + (size_t)(t + 1) * kstep, 1);
            G8_WAIT_L(8); G8_BAR; G8_WAIT_L(0); G8_MMA(0, 0, At, B0); G8_BAR; G8_SCHED;
            const char* a2; const char* b2;
            if (last) { if (has_next) { prob.setup(nxt, oa, ob, dA, dB, cA, cB, nnt); } a2 = cA; b2 = cB; }
            else { a2 = cA + (size_t)(t + 2) * kstep; b2 = cB + (size_t)(t + 2) * kstep; }
            const char* a3 = a2 + kstep; const char* b3 = b2 + kstep;
            G8_LDB(B1, 0, 1); G8_STB(G8_SB(0, 0), b2, 0);
            G8_BAR; G8_WAIT_L(0); G8_MMA(0, 1, At, B1); G8_BAR;
            G8_LDA(At, 0, 1); G8_STA(G8_SA(0, 0), a2, 0);
            G8_BAR; G8_WAIT_L(0); G8_MMA(1, 0, At, B0); G8_BAR; G8_SCHED;
            G8_STB(G8_SB(0, 1), b2, 1);
            G8_WAIT_V(6); G8_BAR; G8_MMA(1, 1, At, B1); G8_BAR;
            G8_LDB(B0, 1, 0); G8_SCHED; G8_LDA(At, 1, 0); G8_STA(G8_SA(0, 1), a2, 1);
            G8_WAIT_L(8); G8_BAR; G8_WAIT_L(0); G8_MMA(0, 0, At, B0); G8_BAR; G8_SCHED;
            G8_LDB(B1, 1, 1); G8_STB(G8_SB(1, 0), b3, 0);
            G8_BAR; G8_WAIT_L(0); G8_MMA(0, 1, At, B1); G8_BAR;
            G8_LDA(At, 1, 1); G8_STA(G8_SA(1, 0), a3, 0);
            G8_BAR; G8_WAIT_L(0); G8_MMA(1, 0, At, B0); G8_BAR; G8_SCHED;
            G8_STB(G8_SB(1, 1), b3, 1);
            G8_WAIT_V(6); G8_BAR; G8_MMA(1, 1, At, B1); G8_BAR;
            if (last) break;
        }
        { int t2 = threadIdx.x; asm volatile("" : "+v"(t2)); const int l2 = t2 & 63; prob.epi(acc, cur, wr, wc, l2 & 15, l2 >> 4); }
        if (!has_next) break;
#pragma unroll
        for (int a = 0; a < 2; ++a)
#pragma unroll
            for (int b = 0; b < 2; ++b)
#pragma unroll
                for (int m = 0; m < 4; ++m)
#pragma unroll
                    for (int n = 0; n < 2; ++n) acc[a][b][m][n] = (Acc){0, 0, 0, 0};
        cur = nxt; nt = nnt; ++ui;
    }
    G8_WAIT_V(0);
    if (wr == 0) G8_BAR;
    G8_BAR;
}
}

__device__ __forceinline__ u32x4 pack8(const f32x4& v0, const f32x4& v1) {
    u32x4 w; w.x = cvt_pk_bf16(v0[0], v0[1]); w.y = cvt_pk_bf16(v0[2], v0[3]); w.z = cvt_pk_bf16(v1[0], v1[1]); w.w = cvt_pk_bf16(v1[2], v1[3]); return w;
}
__device__ __forceinline__ void unpack8(const u32x4& w, f32x4& v0, f32x4& v1) {
    v0 = (f32x4){bf_lo(w.x), bf_hi(w.x), bf_lo(w.y), bf_hi(w.y)}; v1 = (f32x4){bf_lo(w.z), bf_hi(w.z), bf_lo(w.w), bf_hi(w.w)};
}

template <int WHICH> struct InProjProb {
    static constexpr bool PERM = true, GATHER_A = false, I8 = false; typedef f32x4 Acc;
    struct U { int kind, pm, pn, b, j; };
    const bf16_t* H; const bf16_t* W;
    bf16_t *FT, *FCT, *Q, *Kb, *Vb, *GF, *GA; const float* rope;
    int nM, n_nat, n_fx, n_fc, n_extra, G, c;
    __device__ __forceinline__ bool get(int i, U& u) const {
        const int L = i * G + c;
        if (WHICH == 0) {
            if (L >= n_nat + n_extra) return false;
            const bool nat = L < n_nat;
            int pm, pn; g8::order2d(nat ? L : 0, nM, 11, pm, pn);
            u.kind = 2; u.pm = __builtin_amdgcn_readfirstlane(nat ? pm : (128 + L - n_nat)); u.pn = __builtin_amdgcn_readfirstlane(nat ? (pn + 2) : 4); u.b = 0; u.j = 0;
            return true;
        } else {
            if (L >= n_fx + n_fc) return false;
            const bool fx = L < n_fx; const int L2 = L - n_fx;
            u.kind = __builtin_amdgcn_readfirstlane(fx ? 0 : 1); u.b = __builtin_amdgcn_readfirstlane(fx ? (L >> 6) : (L2 >> 1)); u.j = __builtin_amdgcn_readfirstlane(fx ? ((L & 63) >> 1) : 0); u.pn = __builtin_amdgcn_readfirstlane(fx ? (L & 1) : (L2 & 1)); u.pm = 0;
            return true;
        }
    }
    __device__ __forceinline__ void setup(const U& u, unsigned (&oa)[4], unsigned& ob, unsigned (&dA)[4], unsigned (&dB)[4], const char*& pA, const char*& pB, int& nt) const {
        int R0, Rb0, C0; g8::lane_geom(threadIdx.x, R0, Rb0, C0);
        nt = 16;
#pragma unroll
        for (int j = 0; j < 4; ++j) { dA[j] = (unsigned)(64 * j * 1024) * 2u; dB[j] = dA[j]; }
        if (WHICH == 0) {
            pA = (const char*)H; pB = (const char*)W;
            oa[0] = (unsigned)((256 * u.pm + R0) * 1024 + C0) * 2u; ob = (unsigned)((256 * u.pn + Rb0) * 1024 + C0) * 2u;
        } else {
            pA = (const char*)W; pB = (const char*)H;
            oa[0] = (unsigned)((256 * u.pn + R0) * 1024 + C0) * 2u;
            if (u.kind == 0) { ob = (unsigned)((u.b * SEQ + 64 * Rb0 + 2 * u.j) * 1024 + C0) * 2u;
                dB[1] = (unsigned)(64 * 64 * 1024) * 2u; dB[2] = 2048u; dB[3] = dB[1] + 2048u; }
            else ob = (unsigned)((TX + u.b * LC + Rb0) * 1024 + C0) * 2u;
        }
    }
    __device__ __forceinline__ void epi(const f32x4 (&acc)[2][2][4][2], const U& u, int wr, int wc, int fr, int fq) const {
        if (WHICH == 0) {
            if (u.pn >= 5) {
                bf16_t* dst = (u.pn >= 9) ? GA : GF; const int cb = 256 * ((u.pn >= 9) ? u.pn - 9 : u.pn - 5);
#pragma unroll
                for (int ai = 0; ai < 2; ++ai)
#pragma unroll
                    for (int m = 0; m < 4; ++m) { const size_t tok = (size_t)256 * u.pm + G8_ROWS(ai, m);
#pragma unroll
                        for (int bj = 0; bj < 2; ++bj) { f32x4 v0 = acc[ai][bj][m][0], v1 = acc[ai][bj][m][1];
#pragma unroll
                            for (int e = 0; e < 4; ++e) { v0[e] = sigmoidf_(v0[e]); v1[e] = sigmoidf_(v1[e]); }
                            *(u32x4*)(dst + tok * 1024 + cb + G8_COL0(bj)) = pack8(v0, v1); } }
            } else {
#pragma unroll
                for (int ai = 0; ai < 2; ++ai)
#pragma unroll
                    for (int m = 0; m < 4; ++m) { const int tok = 256 * u.pm + G8_ROWS(ai, m);
                        const bool isx = tok < TX; const int n = tok & (SEQ - 1); const int prow = n >> 6, pcol = n & 63;
#pragma unroll
                        for (int bj = 0; bj < 2; ++bj) { f32x4 v0 = acc[ai][bj][m][0], v1 = acc[ai][bj][m][1];
                            const int c0 = G8_COL0(bj);
                            const bool isv = (u.pn == 4) && (bj == 1);
                            if (!isv) {
                                const int dp = c0 & 63; const int axis = dp >> 5, f0 = (dp & 31) >> 1;
                                if (isx) {
                                    const int pos = axis ? pcol : prow;
                                    const f32x4 cs = *(const f32x4*)(rope + pos * 16 + f0), sn = *(const f32x4*)(rope + 2048 + pos * 16 + f0);
                                    f32x4 r0, r1;
                                    r0[0] = v0[0] * cs[0] - v0[1] * sn[0]; r0[1] = v0[1] * cs[0] + v0[0] * sn[0];
                                    r0[2] = v0[2] * cs[1] - v0[3] * sn[1]; r0[3] = v0[3] * cs[1] + v0[2] * sn[1];
                                    r1[0] = v1[0] * cs[2] - v1[1] * sn[2]; r1[1] = v1[1] * cs[2] + v1[0] * sn[2];
                                    r1[2] = v1[2] * cs[3] - v1[3] * sn[3]; r1[3] = v1[3] * cs[3] + v1[2] * sn[3];
                                    v0 = r0; v1 = r1;
                                }
                            }
                            if (u.pn < 4) { v0 *= QSCALE; v1 *= QSCALE; *(u32x4*)(Q + (size_t)tok * 512 + 256 * (u.pn - 2) + c0) = pack8(v0, v1); }
                            else if (!isv) { *(u32x4*)(Kb + (size_t)tok * 128 + c0) = pack8(v0, v1); }
                            else { *(u32x4*)(Vb + (size_t)tok * 128 + (c0 - 128)) = pack8(v0, v1); }
                        } }
            }
        } else {
#pragma unroll
            for (int ai = 0; ai < 2; ++ai)
#pragma unroll
                for (int m = 0; m < 4; ++m) { const int ch = 256 * u.pn + G8_ROWS(ai, m);
#pragma unroll
                    for (int bj = 0; bj < 2; ++bj) { const int c0 = G8_COL0(bj);
                        const u32x4 w = pack8(acc[ai][bj][m][0], acc[ai][bj][m][1]);
                        if (u.kind == 0) { const int n2 = 2 * u.j + (c0 >> 7), n1 = c0 & 127; *(u32x4*)(FT + ((size_t)(u.b * 512 + ch) * 64 + n2) * 128 + n1) = w; }
                        else *(u32x4*)(FCT + (size_t)(u.b * 512 + ch) * 256 + c0) = w;
                    } }
        }
    }
};

struct Fft1Prob {
    static constexpr bool PERM = true, GATHER_A = false, I8 = false; typedef f32x4 Acc;
    struct U { int kind, pm, pn; };
    const bf16_t *W1, *FT, *WC, *FCT; bf16_t *T1, *XS;
    int n0, n1, G, c;
    __device__ __forceinline__ bool get(int i, U& u) const {
        const int L = i * G + c;
        if (L >= n0 + n1) return false;
        const bool k0 = L < n0; const int L2 = L - n0;
        u.kind = __builtin_amdgcn_readfirstlane(k0 ? 0 : 1); u.pm = __builtin_amdgcn_readfirstlane(k0 ? 0 : (L2 & 1)); u.pn = __builtin_amdgcn_readfirstlane(k0 ? L : (L2 >> 1));
        return true;
    }
    __device__ __forceinline__ void setup(const U& u, unsigned (&oa)[4], unsigned& ob, unsigned (&dA)[4], unsigned (&dB)[4], const char*& pA, const char*& pB, int& nt) const {
        int R0, Rb0, C0; g8::lane_geom(threadIdx.x, R0, Rb0, C0);
        if (u.kind == 0) { nt = 2; pA = (const char*)W1; pB = (const char*)FT;
#pragma unroll
            for (int j = 0; j < 4; ++j) { dA[j] = (unsigned)(64 * j * 128) * 2u; dB[j] = dA[j]; }
            oa[0] = (unsigned)(R0 * 128 + C0) * 2u; ob = (unsigned)((256 * u.pn + Rb0) * 128 + C0) * 2u;
        } else { nt = 4; pA = (const char*)WC; pB = (const char*)FCT;
#pragma unroll
            for (int j = 0; j < 4; ++j) { dA[j] = (unsigned)(64 * j * 256) * 2u; dB[j] = dA[j]; }
            oa[0] = (unsigned)((256 * u.pm + R0) * 256 + C0) * 2u; ob = (unsigned)((256 * u.pn + Rb0) * 256 + C0) * 2u;
        }
    }
    __device__ __forceinline__ void epi(const f32x4 (&acc)[2][2][4][2], const U& u, int wr, int wc, int fr, int fq) const {
        if (u.kind == 0) {
#pragma unroll
            for (int m = 0; m < 4; ++m) { const int r = G8_ROWS(0, m); const int k1p = r >> 1, part = r & 1;
#pragma unroll
                for (int bj = 0; bj < 2; ++bj) { const int col = 256 * u.pn + G8_COL0(bj); const int bc = col >> 6, n2 = col & 63;
                    *(u32x4*)(T1 + (((size_t)k1p * 2048 + bc) * 2 + part) * 64 + n2) = pack8(acc[0][bj][m][0], acc[0][bj][m][1]); } }
        } else {
#pragma unroll
            for (int ai = 0; ai < 2; ++ai)
#pragma unroll
                for (int m = 0; m < 4; ++m) { const int r = 256 * u.pm + G8_ROWS(ai, m); const int k = r >> 1, reim = r & 1;
#pragma unroll
                    for (int bj = 0; bj < 2; ++bj) { const int bc = 256 * u.pn + G8_COL0(bj); const int b = bc >> 9, ch = bc & 511, g = ch >> 7, d = ch & 127;
                        *(u32x4*)(XS + (size_t)(TX + b * LC + k) * 1024 + g * 256 + reim * 128 + d) = pack8(acc[ai][bj][m][0], acc[ai][bj][m][1]); } }
        }
    }
};

struct Fft2Prob {
    static constexpr bool PERM = true, GATHER_A = false, I8 = false; typedef f32x4 Acc;
    struct U { int k1p, pn; };
    const bf16_t *MT, *T1; bf16_t* XS; int G, c;
    __device__ __forceinline__ bool get(int i, U& u) const { const int L = i * G + c; if (L >= 512) return false; u.k1p = __builtin_amdgcn_readfirstlane(L >> 3); u.pn = __builtin_amdgcn_readfirstlane(L & 7); return true; }
    __device__ __forceinline__ void setup(const U& u, unsigned (&oa)[4], unsigned& ob, unsigned (&dA)[4], unsigned (&dB)[4], const char*& pA, const char*& pB, int& nt) const {
        int R0, Rb0, C0; g8::lane_geom(threadIdx.x, R0, Rb0, C0);
        nt = 2; pA = (const char*)MT; pB = (const char*)T1;
#pragma unroll
        for (int j = 0; j < 4; ++j) { dA[j] = (unsigned)(64 * j * 128) * 2u; dB[j] = dA[j]; }
        oa[0] = (unsigned)((u.k1p * 256 + R0) * 128 + C0) * 2u; ob = (unsigned)((u.k1p * 2048 + 256 * u.pn + Rb0) * 128 + C0) * 2u;
    }
    __device__ __forceinline__ void epi(const f32x4 (&acc)[2][2][4][2], const U& u, int wr, int wc, int fr, int fq) const {
#pragma unroll
        for (int ai = 0; ai < 2; ++ai)
#pragma unroll
            for (int m = 0; m < 4; ++m) { const int r = G8_ROWS(ai, m); const int s = r >> 7, k2 = (r & 127) >> 1, reim = r & 1;
                const int kb = (u.k1p == 0) ? 64 * s : (s ? 128 - u.k1p : u.k1p); const int k = kb + 128 * k2;
#pragma unroll
                for (int bj = 0; bj < 2; ++bj) { const int bc = 256 * u.pn + G8_COL0(bj); const int b = bc >> 9, ch = bc & 511, g = ch >> 7, d = ch & 127;
                    *(u32x4*)(XS + (size_t)(b * SEQ + k) * 1024 + g * 256 + reim * 128 + d) = pack8(acc[ai][bj][m][0], acc[ai][bj][m][1]); } }
    }
};

template <int MODE> struct MergeProb {
    static constexpr bool PERM = true, GATHER_A = false, I8 = false; typedef f32x4 Acc;
    struct U { int pm, pn; };
    const bf16_t* A; const bf16_t* W; int lda;
    const bf16_t* GATE; bf16_t* YB;
    const float* xin; const float* cin; float* XW; float* CW; const float* g1x; const float* g1c;
    int nM, G, c;
    __device__ __forceinline__ bool get(int i, U& u) const { const int L = i * G + c; if (L >= nM * 4) return false; int pm, pn; g8::order2d(L, nM, 4, pm, pn); u.pm = __builtin_amdgcn_readfirstlane(pm); u.pn = __builtin_amdgcn_readfirstlane(pn); return true; }
    __device__ __forceinline__ void setup(const U& u, unsigned (&oa)[4], unsigned& ob, unsigned (&dA)[4], unsigned (&dB)[4], const char*& pA, const char*& pB, int& nt) const {
        int R0, Rb0, C0; g8::lane_geom(threadIdx.x, R0, Rb0, C0);
        nt = lda >> 6; pA = (const char*)A; pB = (const char*)W;
#pragma unroll
        for (int j = 0; j < 4; ++j) { dA[j] = (unsigned)(64 * j * lda) * 2u; dB[j] = dA[j]; }
        oa[0] = (unsigned)((256 * u.pm + R0) * lda + C0) * 2u; ob = (unsigned)((256 * u.pn + Rb0) * lda + C0) * 2u;
    }
    __device__ __forceinline__ void epi(const f32x4 (&acc)[2][2][4][2], const U& u, int wr, int wc, int fr, int fq) const {
#pragma unroll
        for (int ai = 0; ai < 2; ++ai)
#pragma unroll
            for (int m = 0; m < 4; ++m) { const int tok = 256 * u.pm + G8_ROWS(ai, m);
#pragma unroll
                for (int bj = 0; bj < 2; ++bj) { const int col = 256 * u.pn + G8_COL0(bj);
                    f32x4 v0 = acc[ai][bj][m][0], v1 = acc[ai][bj][m][1];
                    if (MODE < 2) {
                        f32x4 g0, g1; unpack8(*(const u32x4*)(GATE + (size_t)tok * 1024 + col), g0, g1);
                        v0 *= g0; v1 *= g1;
                        if (MODE == 1) { f32x4 t0, t1; unpack8(*(const u32x4*)(YB + (size_t)tok * 1024 + col), t0, t1); v0 += t0; v1 += t1; }
                        *(u32x4*)(YB + (size_t)tok * 1024 + col) = pack8(v0, v1);
                    } else {
                        if (tok < TX) {
                            const float* gp = g1x + (tok >> 13) * 6144 + col; const f32x4 ga = *(const f32x4*)gp, gb = *(const f32x4*)(gp + 4);
                            const float* xp = xin + (size_t)tok * 1024 + col; float* op = XW + (size_t)tok * 1024 + col;
                            *(f32x4*)op = *(const f32x4*)xp + ga * v0; *(f32x4*)(op + 4) = *(const f32x4*)(xp + 4) + gb * v1;
                        } else {
                            const float* gp = g1c + col; const f32x4 ga = *(const f32x4*)gp, gb = *(const f32x4*)(gp + 4);
                            const float* xp = cin + (size_t)(tok - TX) * 1024 + col; float* op = CW + (size_t)(tok - TX) * 1024 + col;
                            *(f32x4*)op = *(const f32x4*)xp + ga * v0; *(f32x4*)(op + 4) = *(const f32x4*)(xp + 4) + gb * v1;
                        }
                    }
                } }
    }
};

struct MoeGuProb {
    static constexpr bool PERM = true, GATHER_A = true, I8 = true; typedef i32x4 Acc;
    struct U { int e, rt, pn, base, cnt; int tok[4]; };
    const signed char* H8; const signed char* W8; const float* sW; const float* lsc; const float* bgu; bf16_t* ACT; const int* list; const int* cnt;
    const volatile LAS int* tstart;
    int R, G, c;
    __device__ __forceinline__ bool get(int i, U& u) const {
        const int L = i * G + c; if (L >= R * 8) return false;
        int rt, pn; g8::order2d(L, R, 8, rt, pn);
        int e = 0;
#pragma unroll 1
        for (int q = 1; q < 32; ++q) e = (tstart[q] <= rt) ? q : e;
        u.e = __builtin_amdgcn_readfirstlane(e); u.rt = __builtin_amdgcn_readfirstlane(rt); u.pn = __builtin_amdgcn_readfirstlane(pn); u.base = __builtin_amdgcn_readfirstlane((rt - tstart[e]) * 256); u.cnt = __builtin_amdgcn_readfirstlane(cnt[e]);
        int R0, Rb0, C0; g8::lane_geom(threadIdx.x, R0, Rb0, C0);
#pragma unroll
        for (int j = 0; j < 4; ++j) { const int p = u.base + R0 + 64 * j; u.tok[j] = (p < u.cnt) ? list[(size_t)e * TT + p] : TT; }
        return true;
    }
    __device__ __forceinline__ void setup(const U& u, unsigned (&oa)[4], unsigned& ob, unsigned (&dA)[4], unsigned (&dB)[4], const char*& pA, const char*& pB, int& nt) const {
        int R0, Rb0, C0; g8::lane_geom(threadIdx.x, R0, Rb0, C0);
        nt = 8; pA = (const char*)H8; pB = (const char*)W8;
#pragma unroll
        for (int j = 0; j < 4; ++j) { dA[j] = 0u; dB[j] = (unsigned)(64 * j * 1024); oa[j] = (unsigned)(u.tok[j] * 1024 + C0 * 2); }
        ob = (unsigned)((u.e * 2048 + 256 * u.pn + Rb0) * 1024 + C0 * 2);
    }
    __device__ __forceinline__ void epi(const i32x4 (&acc)[2][2][4][2], const U& u, int wr, int wc, int fr, int fq) const {
        const int j0 = 128 * u.pn + 32 * wc + 8 * fq;
        const float* bp = bgu + (size_t)u.e * 2048 + j0;
        const f32x4 ba0 = *(const f32x4*)bp, ba1 = *(const f32x4*)(bp + 4), bu0 = *(const f32x4*)(bp + 1024), bu1 = *(const f32x4*)(bp + 1028);
        const float* sp = sW + (size_t)u.e * 2048 + 256 * u.pn + 32 * wc + 8 * fq;
        const f32x4 sa0 = *(const f32x4*)sp, sa1 = *(const f32x4*)(sp + 4), su0 = *(const f32x4*)(sp + 128), su1 = *(const f32x4*)(sp + 132);
#pragma unroll
        for (int ai = 0; ai < 2; ++ai)
#pragma unroll
            for (int m = 0; m < 4; ++m) { const int rr = G8_ROWS(ai, m); const size_t row = (size_t)256 * u.rt + rr;
                const int p = u.base + rr; const float rs = (p < u.cnt) ? lsc[(size_t)u.e * TT + p] : 0.0f;
                f32x4 a0, a1, u0, u1, y0, y1;
#pragma unroll
                for (int e = 0; e < 4; ++e) { a0[e] = (float)acc[ai][0][m][0][e] * rs * sa0[e] + ba0[e]; a1[e] = (float)acc[ai][0][m][1][e] * rs * sa1[e] + ba1[e];
                    u0[e] = (float)acc[ai][1][m][0][e] * rs * su0[e] + bu0[e]; u1[e] = (float)acc[ai][1][m][1][e] * rs * su1[e] + bu1[e]; }
#pragma unroll
                for (int e = 0; e < 4; ++e) {
                    float a = fminf(a0[e], 7.0f), uu = fminf(fmaxf(u0[e], -7.0f), 7.0f); y0[e] = a * sigmoidf_(1.702f * a) * (uu + 1.0f);
                    a = fminf(a1[e], 7.0f); uu = fminf(fmaxf(u1[e], -7.0f), 7.0f); y1[e] = a * sigmoidf_(1.702f * a) * (uu + 1.0f);
                }
                *(u32x4*)(ACT + row * 1024 + j0) = pack8(y0, y1); }
    }
};
struct MoeDnProb {
    static constexpr bool PERM = true, GATHER_A = false, I8 = false; typedef f32x4 Acc;
    struct U { int e, rt, pn; };
    const bf16_t* ACT; const bf16_t* W; const float* bdn; bf16_t* YE;
    const volatile LAS int* tstart; int R, G, c;
    __device__ __forceinline__ bool get(int i, U& u) const {
        const int L = i * G + c; if (L >= R * 4) return false;
        int rt, pn; g8::order2d(L, R, 4, rt, pn);
        int e = 0;
#pragma unroll 1
        for (int q = 1; q < 32; ++q) e = (tstart[q] <= rt) ? q : e;
        u.e = __builtin_amdgcn_readfirstlane(e); u.rt = __builtin_amdgcn_readfirstlane(rt); u.pn = __builtin_amdgcn_readfirstlane(pn); return true;
    }
    __device__ __forceinline__ void setup(const U& u, unsigned (&oa)[4], unsigned& ob, unsigned (&dA)[4], unsigned (&dB)[4], const char*& pA, const char*& pB, int& nt) const {
        int R0, Rb0, C0; g8::lane_geom(threadIdx.x, R0, Rb0, C0);
        nt = 16; pA = (const char*)ACT; pB = (const char*)W;
#pragma unroll
        for (int j = 0; j < 4; ++j) { dA[j] = (unsigned)(64 * j * 1024) * 2u; dB[j] = dA[j]; }
        oa[0] = (unsigned)((256 * u.rt + R0) * 1024 + C0) * 2u; ob = (unsigned)((u.e * 1024 + 256 * u.pn + Rb0) * 1024 + C0) * 2u;
    }
    __device__ __forceinline__ void epi(const f32x4 (&acc)[2][2][4][2], const U& u, int wr, int wc, int fr, int fq) const {
#pragma unroll
        for (int bj = 0; bj < 2; ++bj) { const int col = 256 * u.pn + G8_COL0(bj);
            const float* bp = bdn + (size_t)u.e * 1024 + col; const f32x4 b0 = *(const f32x4*)bp, b1 = *(const f32x4*)(bp + 4);
#pragma unroll
            for (int ai = 0; ai < 2; ++ai)
#pragma unroll
                for (int m = 0; m < 4; ++m) { const size_t row = (size_t)256 * u.rt + G8_ROWS(ai, m);
                    *(u32x4*)(YE + row * 1024 + col) = pack8(acc[ai][bj][m][0] + b0, acc[ai][bj][m][1] + b1); } }
    }
};

__device__ __forceinline__ int rope_perm(int d) { return (d & 32) | ((d & 15) << 1) | ((d >> 4) & 1); }
template <class RM>
__device__ __forceinline__ void transpose_tile(const Fr& F, const float* src, int N, int k0, int n0, bf16_t* dst, int Kd, RM rm) {
    LAS unsigned char* lds = F.lds;
    const int tid = F.tid;
    { const int kq = tid >> 4, c4 = (tid & 15) * 4; f32x4 v[4];
#pragma unroll
      for (int r = 0; r < 4; ++r) v[r] = *(const f32x4*)(src + (size_t)(k0 + 4 * kq + r) * N + n0 + c4);
#pragma unroll
      for (int e = 0; e < 4; ++e) { u32x2 w; w.x = cvt_pk_bf16(v[0][e], v[1][e]); w.y = cvt_pk_bf16(v[2][e], v[3][e]); *(LAS u32x2*)(lds + (c4 + e) * 272 + kq * 8) = w; } }
    __syncthreads();
    { const int n = tid >> 3, ch = tid & 7; const u32x4 w0 = *(const LAS u32x4*)(lds + n * 272 + ch * 32), w1 = *(const LAS u32x4*)(lds + n * 272 + ch * 32 + 16);
      bf16_t* dp = dst + (size_t)rm(n0 + n) * Kd + k0 + ch * 16; *(u32x4*)dp = w0; *(u32x4*)(dp + 8) = w1; }
    __syncthreads();
}
__device__ __forceinline__ void quant_wgu_strip(const Fr& F, const float* src, int n0, signed char* dst, float* sdst) {
    LAS unsigned char* lds = F.lds;
    LAS float* red = (LAS float*)(lds + 16384);
    LAS float* inv = (LAS float*)(lds + 16384 + 8192);
    const int tid = F.tid, kq = tid >> 4, c4 = (tid & 15) * 4;
    f32x4 mx = {0.f, 0.f, 0.f, 0.f};
#pragma unroll 4
    for (int k = kq; k < 1024; k += 32) { const f32x4 v = *(const f32x4*)(src + (size_t)k * 2048 + n0 + c4);
#pragma unroll
        for (int e = 0; e < 4; ++e) mx[e] = fmaxf(mx[e], fabsf(v[e])); }
#pragma unroll
    for (int e = 0; e < 4; ++e) red[kq * 64 + c4 + e] = mx[e];
    __syncthreads();
    if (tid < 64) { float m = 0.f;
#pragma unroll
        for (int r = 0; r < 32; ++r) m = fmaxf(m, red[r * 64 + tid]);
        const int n = n0 + tid, bj = n >> 10, j = n & 1023; const int row = 256 * (j >> 7) + 128 * bj + (j & 127);
        sdst[row] = m * (1.0f / 127.0f); inv[tid] = m > 0.f ? 127.0f / m : 0.f; }
    __syncthreads();
    const f32x4 iv = *(const LAS f32x4*)(inv + c4);
#pragma unroll 1
    for (int kt = 0; kt < 8; ++kt) { f32x4 v[4];
#pragma unroll
        for (int r = 0; r < 4; ++r) v[r] = *(const f32x4*)(src + (size_t)(kt * 128 + 4 * kq + r) * 2048 + n0 + c4);
#pragma unroll
        for (int e = 0; e < 4; ++e) { const int q0 = __float2int_rn(v[0][e] * iv[e]), q1 = __float2int_rn(v[1][e] * iv[e]), q2 = __float2int_rn(v[2][e] * iv[e]), q3 = __float2int_rn(v[3][e] * iv[e]);
            *(LAS unsigned*)(lds + (c4 + e) * 144 + kq * 4) = (unsigned)(q0 & 255) | ((unsigned)(q1 & 255) << 8) | ((unsigned)(q2 & 255) << 16) | ((unsigned)(q3 & 255) << 24); }
        __syncthreads();
        { const int nl = tid >> 3, ch = tid & 7; const u32x4 w = *(const LAS u32x4*)(lds + nl * 144 + ch * 16);
          const int n = n0 + nl, bj = n >> 10, j = n & 1023; const int row = 256 * (j >> 7) + 128 * bj + (j & 127);
          *(u32x4*)(dst + (size_t)row * 1024 + kt * 128 + ch * 16) = w; }
        __syncthreads();
    }
}
struct RmId { __device__ int operator()(int n) const { return n; } };
struct RmWin { __device__ int operator()(int n) const { return (n >= 512 && n < 1152) ? ((n & ~63) | rope_perm(n & 63)) : n; } };

__device__ __forceinline__ void prologue_phase(const Fr& F) {
    const int tid = F.tid, G = F.G, bid = F.bid;
    const float PI2 = 6.283185307179586f;
    const size_t gtid = (size_t)bid * 512 + tid, gsz = (size_t)G * 512;
    { float* rope = WSP(float, WS_ROPE);
      for (size_t i = gtid; i < 2048; i += gsz) { const int pos = (int)(i >> 4), f = (int)(i & 15); const float inv = powf(10000.0f, -(float)f / 16.0f); const float a = (float)pos * inv; rope[i] = cosf(a); rope[2048 + i] = sinf(a); } }
    { bf16_t* W1 = WSP(bf16_t, WS_W1);
      for (size_t i = gtid; i < 256 * 128; i += gsz) { const int r = (int)(i >> 7), n1 = (int)(i & 127); float v = 0.f;
          if (r < 128) { const int k1p = r >> 1, part = r & 1;
              if (part == 0) v = cospif((float)((k1p * n1) & 127) / 64.0f);
              else if (k1p == 0) v = (n1 & 1) ? -1.0f : 1.0f;
              else v = -sinpif((float)((k1p * n1) & 127) / 64.0f); }
          W1[i] = f2bf(v); } }
    { bf16_t* MT = WSP(bf16_t, WS_MT);
      for (size_t i = gtid; i < (size_t)64 * 256 * 128; i += gsz) {
          const int kk = (int)(i & 127), r = (int)((i >> 7) & 255), k1p = (int)(i >> 15);
          const int part = kk >> 6, n2 = kk & 63, s = r >> 7, k2 = (r & 127) >> 1, reim = r & 1;
          float v;
          if (k1p == 0) { const int k = 64 * s + 128 * k2; const int mm = (n2 * k) & 8191; const float cm = cospif((float)mm / 4096.0f), sm = sinpif((float)mm / 4096.0f);
              v = (part == s) ? (reim ? -sm : cm) : 0.0f; }
          else { const int k = (s ? 128 - k1p : k1p) + 128 * k2; const int mm = (n2 * k) & 8191; const float cm = cospif((float)mm / 4096.0f), sm = sinpif((float)mm / 4096.0f);
              if (s == 0) v = reim ? (part ? cm : -sm) : (part ? sm : cm);
              else        v = reim ? (part ? -cm : -sm) : (part ? -sm : cm); }
          MT[i] = f2bf(v); } }
    { bf16_t* WC = WSP(bf16_t, WS_WC);
      const float sc = 5.656854249492381f;
      for (size_t i = gtid; i < 512 * 256; i += gsz) { const int n = (int)(i & 255), r = (int)(i >> 8), k = r >> 1, reim = r & 1; const int mm = (k * n) & 255;
          WC[i] = f2bf(sc * (reim ? -sinpif((float)mm / 128.0f) : cospif((float)mm / 128.0f))); } }
    { bf16_t* RWT = WSP(bf16_t, WS_RWT); const float* rw = INP(13);
      for (size_t i = gtid; i < (size_t)DEPTH * 32 * 1024; i += gsz) { const int k = (int)(i & 1023), e = (int)((i >> 10) & 31), l = (int)(i >> 15); RWT[i] = f2bf(rw[((size_t)l * 1024 + k) * 32 + e]); } }
    { bf16_t* H = WSP(bf16_t, WS_H); for (size_t i = gtid; i < 256 * 1024; i += gsz) H[(size_t)TT * 1024 + i] = 0;
      unsigned* H8z = (unsigned*)(WSP(signed char, WS_H8) + (size_t)TT * 1024); for (size_t i = gtid; i < 256 * 256; i += gsz) H8z[i] = 0u; }
    (void)PI2;
    {
        LAS float* sil = (LAS float*)(F.lds + 65536);
        LAS float* red = (LAS float*)(F.lds + 65536 + 20480);
        for (int i = tid; i < 5 * 1024; i += 512) { const int v = i >> 10, k = i & 1023; const float x = (v < 4) ? INP(1)[v * 1024 + k] : INP(3)[k]; sil[i] = x * sigmoidf_(x); }
        __syncthreads();
        float* MOD = WSP(float, WS_MOD);
        for (int u = bid; u < DEPTH * 96; u += G) {
            const int l = u / 96, j0 = (u % 96) * 64;
            const float* aw = INP(4) + (size_t)l * 1024 * 6144 + j0 + F.lane;
            float a0 = 0.f, a1 = 0.f, a2 = 0.f, a3 = 0.f, a4 = 0.f;
            for (int kk = 0; kk < 128; ++kk) { const int k = F.wave * 128 + kk; const float w = aw[(size_t)k * 6144];
                a0 += sil[k] * w; a1 += sil[1024 + k] * w; a2 += sil[2048 + k] * w; a3 += sil[3072 + k] * w; a4 += sil[4096 + k] * w; }
            red[(F.wave * 5 + 0) * 64 + F.lane] = a0; red[(F.wave * 5 + 1) * 64 + F.lane] = a1; red[(F.wave * 5 + 2) * 64 + F.lane] = a2; red[(F.wave * 5 + 3) * 64 + F.lane] = a3; red[(F.wave * 5 + 4) * 64 + F.lane] = a4;
            __syncthreads();
            if (tid < 320) { const int v = tid >> 6, jl = tid & 63; float s = INP(5)[(size_t)l * 6144 + j0 + jl];
#pragma unroll
                for (int w = 0; w < 8; ++w) s += red[(w * 5 + v) * 64 + jl];
                MOD[((size_t)l * 5 + v) * 6144 + j0 + jl] = s; }
            __syncthreads();
        }
    }
    {
        LAS float* tab = (LAS float*)(F.lds + 65536);
        if (tid < 128) { tab[tid] = cospif((float)tid / 64.0f); tab[128 + tid] = sinpif((float)tid / 64.0f); }
        __syncthreads();
        bf16_t* WFO = WSP(bf16_t, WS_WFO);
        for (int u = bid; u < DEPTH * 4 * 2 * 16; u += G) {
            const int dc = u & 15, reim = (u >> 4) & 1, g = (u >> 5) & 3, l = u >> 7;
            const float* wf = INP(10) + ((size_t)l * 512 + g * 128) * 1024;
#pragma unroll 1
            for (int oh = 0; oh < 2; ++oh) { const int o = tid + 512 * oh;
                float a[8] = {0.f, 0.f, 0.f, 0.f, 0.f, 0.f, 0.f, 0.f};
                for (int j = 0; j < 128; ++j) { const float w = wf[(size_t)j * 1024 + o];
#pragma unroll
                    for (int q = 0; q < 8; ++q) a[q] += tab[reim * 128 + ((j * (dc * 8 + q)) & 127)] * w; }
                u32x4 w4; w4.x = cvt_pk_bf16(a[0] * (1.f / 1024.f), a[1] * (1.f / 1024.f)); w4.y = cvt_pk_bf16(a[2] * (1.f / 1024.f), a[3] * (1.f / 1024.f));
                w4.z = cvt_pk_bf16(a[4] * (1.f / 1024.f), a[5] * (1.f / 1024.f)); w4.w = cvt_pk_bf16(a[6] * (1.f / 1024.f), a[7] * (1.f / 1024.f));
                *(u32x4*)(WFO + ((size_t)l * 1024 + o) * 1024 + g * 256 + reim * 128 + dc * 8) = w4; }
        }
        __syncthreads();
    }
    {
        constexpr int T_WIN = DEPTH * 8 * 52, T_WAO = DEPTH * 4 * 16, T_WOUT = DEPTH * 8 * 16, T_DN = DEPTH * 32 * 8 * 16, T_GU = DEPTH * 32 * 32;
        constexpr int T_ALL = T_GU + T_DN + T_WIN + T_WAO + T_WOUT;
        for (int t = bid; t < T_ALL; t += G) {
            int q = t;
            if (q < T_GU) { const int le = q >> 5, ns = q & 31;
                quant_wgu_strip(F, INP(15) + (size_t)le * 1024 * 2048, ns * 64, WSP(signed char, WS_WGU) + (size_t)le * 2048 * 1024, WSP(float, WS_SWGU) + (size_t)le * 2048); continue; }
            q -= T_GU;
            if (q < T_DN) { const int le = q / 128, r = q % 128, kt = r / 16, ntl = r % 16;
                transpose_tile(F, INP(17) + (size_t)le * 1024 * 1024, 1024, kt * 128, ntl * 64, WSP(bf16_t, WS_WDN) + (size_t)le * 1024 * 1024, 1024, RmId()); continue; }
            q -= T_DN;
            if (q < T_WIN) { const int l = q / (8 * 52), r = q % (8 * 52), kt = r / 52, ntl = r % 52;
                transpose_tile(F, INP(8) + (size_t)l * 1024 * IN_DIM, IN_DIM, kt * 128, ntl * 64, WSP(bf16_t, WS_WIN) + (size_t)l * IN_DIM * 1024, 1024, RmWin()); continue; }
            q -= T_WIN;
            if (q < T_WAO) { const int l = q / 64, r = q % 64, kt = r / 16, ntl = r % 16;
                transpose_tile(F, INP(11) + (size_t)l * 512 * 1024, 1024, kt * 128, ntl * 64, WSP(bf16_t, WS_WAO) + (size_t)l * 1024 * 512, 512, RmId()); continue; }
            q -= T_WAO;
            { const int l = q / 128, r = q % 128, kt = r / 16, ntl = r % 16;
                transpose_tile(F, INP(12) + (size_t)l * 1024 * 1024, 1024, kt * 128, ntl * 64, WSP(bf16_t, WS_WOUT) + (size_t)l * 1024 * 1024, 1024, RmId()); }
        }
    }
}

__device__ __forceinline__ void moe_combine(const Fr& F, int tok, int lprev, const volatile LAS int* tstart, f32x4 (&m)[4]) {
    const int* slot = WSP(int, WS_SLOT); const float* gate = WSP(float, WS_GATE); const bf16_t* YE = WSP(bf16_t, WS_YE);
#pragma unroll
    for (int j = 0; j < 4; ++j) m[j] = (f32x4){0.f, 0.f, 0.f, 0.f};
#pragma unroll
    for (int k = 0; k < 4; ++k) {
        const int sl = slot[tok * 4 + k]; const float gk = gate[tok * 4 + k];
        const int e = sl >> 20, pos = sl & 0xfffff;
        const size_t row = (size_t)256 * tstart[e] + pos;
        const bf16_t* yp = YE + row * 1024 + 4 * F.lane;
#pragma unroll
        for (int j = 0; j < 4; ++j) { const u32x2 w = *(const u32x2*)(yp + 256 * j); m[j][0] += gk * bf_lo(w.x); m[j][1] += gk * bf_hi(w.x); m[j][2] += gk * bf_lo(w.y); m[j][3] += gk * bf_hi(w.y); }
    }
    (void)lprev;
}
__device__ __forceinline__ int fill_tstart(const Fr& F, int l) {
    volatile LAS int* ts = (volatile LAS int*)(F.lds + LDS_MISC + 64);
    __syncthreads();
    if (F.tid == 0) { const int* cnt = (const int*)(F.ws + WS_CTL + CTL_CNT) + l * 32; int s = 0; for (int e = 0; e < 32; ++e) { ts[e] = s; s += (cnt[e] + 255) >> 8; } ts[32] = s; }
    __syncthreads();
    return ts[32];
}

__device__ __forceinline__ void norm1_phase(const Fr& F, int l) {
    const volatile LAS int* tstart = (const volatile LAS int*)(F.lds + LDS_MISC + 64);
    if (l > 0) fill_tstart(F, l - 1);
    const float* MOD = WSP(float, WS_MOD);
    const bool fin = (l == DEPTH);
    const int ntok = fin ? TX : TT;
    const bool tmo = fin && (xb_ld((unsigned*)(F.ws + WS_CTL) + XB_TMO) != 0u);
    const float* gvec = fin ? INP(19) : INP(6) + (size_t)l * 1024;
    float* XW = WSP(float, WS_XW); float* CW = WSP(float, WS_CW); bf16_t* H = WSP(bf16_t, WS_H);
    for (int tok = F.bid * 8 + F.wave; tok < ntok; tok += F.G * 8) {
        const bool isx = tok < TX; const int v = isx ? (tok >> 13) : 4;
        const float* src = (l == 0) ? (isx ? INP(0) + (size_t)tok * 1024 : INP(2) + (size_t)(tok - TX) * 1024) : (isx ? XW + (size_t)tok * 1024 : CW + (size_t)(tok - TX) * 1024);
        f32x4 x[4];
#pragma unroll
        for (int j = 0; j < 4; ++j) x[j] = *(const f32x4*)(src + 256 * j + 4 * F.lane);
        if (l > 0) {
            f32x4 mm[4]; moe_combine(F, tok, l - 1, tstart, mm);
            const float* g2 = MOD + ((size_t)(l - 1) * 5 + v) * 6144 + 5 * 1024;
            float* dst = isx ? XW + (size_t)tok * 1024 : CW + (size_t)(tok - TX) * 1024;
#pragma unroll
            for (int j = 0; j < 4; ++j) { x[j] += *(const f32x4*)(g2 + 256 * j + 4 * F.lane) * mm[j]; if (!fin) *(f32x4*)(dst + 256 * j + 4 * F.lane) = x[j]; }
        }
        float ss = 0.f;
#pragma unroll
        for (int j = 0; j < 4; ++j) ss += x[j][0] * x[j][0] + x[j][1] * x[j][1] + x[j][2] * x[j][2] + x[j][3] * x[j][3];
        ss = wave_sum(ss);
        const float rstd = rsqrtf(ss * (1.0f / 1024.0f) + EPS);
        if (fin) {
#pragma unroll
            for (int j = 0; j < 4; ++j) { const f32x4 g = *(const f32x4*)(gvec + 256 * j + 4 * F.lane); *(f32x4*)(F.out + (size_t)tok * 1024 + 256 * j + 4 * F.lane) = tmo ? (f32x4){__builtin_nanf(""), __builtin_nanf(""), __builtin_nanf(""), __builtin_nanf("")} : x[j] * rstd * g; }
        } else {
            const float* md = MOD + ((size_t)l * 5 + v) * 6144;
#pragma unroll
            for (int j = 0; j < 4; ++j) { const int c = 256 * j + 4 * F.lane; const f32x4 g = *(const f32x4*)(gvec + c), sh = *(const f32x4*)(md + c), sc = *(const f32x4*)(md + 1024 + c);
                const f32x4 y = x[j] * rstd * g * (sc + 1.0f) + sh;
                u32x2 w; w.x = cvt_pk_bf16(y[0], y[1]); w.y = cvt_pk_bf16(y[2], y[3]); *(u32x2*)(H + (size_t)tok * 1024 + c) = w; }
        }
    }
}

__device__ __forceinline__ void norm2_router_phase(const Fr& F, int l) {
    const int ntok = (l == DEPTH - 1) ? TX : TT;
    const float* MOD = WSP(float, WS_MOD); const float* gvec = INP(7) + (size_t)l * 1024;
    const float* XW = WSP(float, WS_XW); const float* CW = WSP(float, WS_CW); bf16_t* H = WSP(bf16_t, WS_H);
    const bf16_t* RWT = WSP(bf16_t, WS_RWT) + (size_t)l * 32 * 1024; const float* rb = INP(14) + l * 32;
    int* cntg = (int*)(F.ws + WS_CTL + CTL_CNT) + l * 32; int* list = WSP(int, WS_LIST); int* slot = WSP(int, WS_SLOT); float* gate = WSP(float, WS_GATE);
    LAS unsigned char* hs = F.lds;
    LAS float* part = (LAS float*)(F.lds + 69632);
    LAS float* logit = (LAS float*)(F.lds + 69632 + 36864);
    LAS int* lcnt = (LAS int*)(F.lds + 69632 + 36864 + 4608);
    LAS int* lbase = lcnt + 32;
    LAS float* tsc = (LAS float*)(lbase + 32);
    signed char* H8 = WSP(signed char, WS_H8); float* lscg = WSP(float, WS_LSC);
    const int lane = F.lane, w = F.wave, l32 = lane & 31, hh = lane >> 5;
    for (int tl = F.bid; tl < ntok / 32; tl += F.G) {
        const int t0 = tl * 32;
        if (F.tid < 32) lcnt[F.tid] = 0;
#pragma unroll 1
        for (int q = 0; q < 4; ++q) {
            const int tloc = 4 * w + q, tok = t0 + tloc; const bool isx = tok < TX; const int v = isx ? (tok >> 13) : 4;
            const float* src = isx ? XW + (size_t)tok * 1024 : CW + (size_t)(tok - TX) * 1024;
            f32x4 x[4]; float ss = 0.f;
#pragma unroll
            for (int j = 0; j < 4; ++j) { x[j] = *(const f32x4*)(src + 256 * j + 4 * lane); ss += x[j][0] * x[j][0] + x[j][1] * x[j][1] + x[j][2] * x[j][2] + x[j][3] * x[j][3]; }
            ss = wave_sum(ss); const float rstd = rsqrtf(ss * (1.0f / 1024.0f) + EPS);
            const float* md = MOD + ((size_t)l * 5 + v) * 6144;
            float amax = 0.f;
#pragma unroll
            for (int j = 0; j < 4; ++j) { const int c = 256 * j + 4 * lane; const f32x4 g = *(const f32x4*)(gvec + c), sh = *(const f32x4*)(md + 3072 + c), sc = *(const f32x4*)(md + 4096 + c);
                x[j] = x[j] * rstd * g * (sc + 1.0f) + sh;
                amax = fmaxf(amax, fmaxf(fmaxf(fabsf(x[j][0]), fabsf(x[j][1])), fmaxf(fabsf(x[j][2]), fabsf(x[j][3]))));
                u32x2 wv; wv.x = cvt_pk_bf16(x[j][0], x[j][1]); wv.y = cvt_pk_bf16(x[j][2], x[j][3]);
                *(LAS u32x2*)(hs + tloc * 2064 + c * 2) = wv; }
#pragma unroll
            for (int o = 32; o >= 1; o >>= 1) amax = fmaxf(amax, __shfl_xor(amax, o));
            const float inv = amax > 0.f ? 127.0f / amax : 0.f;
#pragma unroll
            for (int j = 0; j < 4; ++j) { const int c = 256 * j + 4 * lane;
                const int q0 = __float2int_rn(x[j][0] * inv), q1 = __float2int_rn(x[j][1] * inv), q2 = __float2int_rn(x[j][2] * inv), q3 = __float2int_rn(x[j][3] * inv);
                *(unsigned*)(H8 + (size_t)tok * 1024 + c) = (unsigned)(q0 & 255) | ((unsigned)(q1 & 255) << 8) | ((unsigned)(q2 & 255) << 16) | ((unsigned)(q3 & 255) << 24); }
            if (lane == 0) tsc[tloc] = amax * (1.0f / 127.0f);
        }
        __syncthreads();
        {
            f32x16 acc;
#pragma unroll
            for (int e = 0; e < 16; ++e) acc[e] = 0.f;
#pragma unroll
            for (int s = 0; s < 8; ++s) { const int k = 128 * w + 16 * s + 8 * hh;
                const bf16x8 a = *(const LAS bf16x8*)(hs + l32 * 2064 + k * 2);
                const bf16x8 b = *(const bf16x8*)(RWT + (size_t)l32 * 1024 + k);
                acc = __builtin_amdgcn_mfma_f32_32x32x16_bf16(a, b, acc, 0, 0, 0); }
#pragma unroll
            for (int e = 0; e < 16; ++e) { const int trow = 8 * (e >> 2) + 4 * hh + (e & 3); part[(w * 32 + trow) * 33 + l32] = acc[e]; }
        }
        __syncthreads();
        { const int tr = F.tid >> 4, e0 = (F.tid & 15) * 2;
#pragma unroll
          for (int q = 0; q < 2; ++q) { float s = rb[e0 + q];
#pragma unroll
              for (int ww = 0; ww < 8; ++ww) s += part[(ww * 32 + tr) * 33 + e0 + q];
              logit[tr * 33 + e0 + q] = s; } }
        __syncthreads();
        int es[4], rk[4]; float gs[4];
        if (F.tid < 32) {
            float lv[4]; unsigned used = 0u;
#pragma unroll
            for (int k = 0; k < 4; ++k) { float best = -3.0e38f; int bi = 0;
#pragma unroll 1
                for (int e = 0; e < 32; ++e) { const float vv = logit[F.tid * 33 + e]; if (!((used >> e) & 1u) && vv > best) { best = vv; bi = e; } }
                used |= 1u << bi; es[k] = bi; lv[k] = best; }
            const float mx = lv[0]; float sum = 0.f;
#pragma unroll
            for (int k = 0; k < 4; ++k) { gs[k] = __expf(lv[k] - mx); sum += gs[k]; }
#pragma unroll
            for (int k = 0; k < 4; ++k) { gs[k] /= sum; rk[k] = __hip_atomic_fetch_add(&lcnt[es[k]], 1, __ATOMIC_RELAXED, __HIP_MEMORY_SCOPE_WORKGROUP); }
        }
        __syncthreads();
        if (F.tid < 32) { const int n = lcnt[F.tid]; lbase[F.tid] = n ? atomicAdd(&cntg[F.tid], n) : 0; }
        __syncthreads();
        if (F.tid < 32) { const int tok = t0 + F.tid;
#pragma unroll
            for (int k = 0; k < 4; ++k) { const int pos = lbase[es[k]] + rk[k]; list[(size_t)es[k] * TT + pos] = tok; lscg[(size_t)es[k] * TT + pos] = tsc[F.tid]; slot[tok * 4 + k] = (es[k] << 20) | pos; gate[tok * 4 + k] = gs[k]; } }
        __syncthreads();
    }
}

template <int OFF> __device__ __forceinline__ s16x4 tr_read(unsigned vb) { s16x4 r; asm volatile("ds_read_b64_tr_b16 %0, %1 offset:%2" : "=&v"(r) : "v"(vb), "i"(OFF) : "memory"); return r; }

__device__ __forceinline__ void attn_phase(const Fr& F, int l, bool with_ctx) {
    LAS unsigned char* lds = F.lds;
    const unsigned ldsb = (unsigned)(uintptr_t)lds;
    const bf16_t* Q = WSP(bf16_t, WS_Q); const bf16_t* Kb = WSP(bf16_t, WS_K); const bf16_t* Vb = WSP(bf16_t, WS_V); bf16_t* AO = WSP(bf16_t, WS_AO);
    const int tid = F.tid, lane = F.lane, w = F.wave, l32 = lane & 31, hh = lane >> 5;
    const int g = w >> 1, rhalf = w & 1;
    const int nunits = 512 + (with_ctx ? 16 : 0);
    const int skey = tid >> 3, sch = tid & 7;
    const unsigned k_st = (unsigned)(skey * 128 + ((sch ^ ((skey >> 1) & 7)) * 16));
    const unsigned v_st = (unsigned)(8192 + skey * 128 + ((((sch >> 1) ^ (((skey >> 1) & 1) << 1)) * 32) + (sch & 1) * 16));
    unsigned vbase[2];
    { const int li = lane & 15, q = li >> 2, p = li & 3, g16 = l32 >> 4; const int key = 4 * hh + q;
#pragma unroll
      for (int db = 0; db < 2; ++db) { const int c32 = 2 * db + g16; vbase[db] = ldsb + 8192u + (unsigned)(key * 128 + ((c32 ^ (((key >> 1) & 1) << 1)) * 32) + 8 * p); } }
    for (int u = F.bid; u < nunits; u += F.G) {
        int b, qb, kvh; bool isctx;
        if (u < 512) { b = u >> 7; qb = (u >> 1) & 63; kvh = u & 1; isctx = false; }
        else { const int uu = u - 512; b = uu >> 2; qb = (uu >> 1) & 1; kvh = uu & 1; isctx = true; }
        const int head = kvh * 4 + g;
        const int qtok0 = isctx ? (TX + b * LC + qb * 128) : (b * SEQ + qb * 128);
        bf16x8 qf[2][4];
#pragma unroll
        for (int qk = 0; qk < 2; ++qk)
#pragma unroll
            for (int s = 0; s < 4; ++s) qf[qk][s] = *(const bf16x8*)(Q + (size_t)(qtok0 + rhalf * 64 + qk * 32 + l32) * 512 + head * 64 + 16 * s + 8 * hh);
        const float sink2 = INP(9)[l * 8 + head] * LOG2E;
        float m_run[2] = {sink2, sink2}, l_run[2] = {hh ? 0.f : 1.f, hh ? 0.f : 1.f};
        f32x16 O[2][2];
#pragma unroll
        for (int a = 0; a < 2; ++a)
#pragma unroll
            for (int c = 0; c < 2; ++c)
#pragma unroll
                for (int e = 0; e < 16; ++e) O[a][c][e] = 0.f;
        int t = isctx ? 6 : (qb == 0 ? 2 : 0);
        u32x4 kreg, vreg;
        { const int tok0 = (t < 6) ? (b * SEQ + (qb - 1) * 128 + 64 * t) : (TX + b * LC + 64 * (t - 6));
          kreg = *(const u32x4*)(Kb + (size_t)(tok0 + skey) * 128 + kvh * 64 + sch * 8); vreg = *(const u32x4*)(Vb + (size_t)(tok0 + skey) * 128 + kvh * 64 + sch * 8); }
        for (;;) {
            __syncthreads();
            *(LAS u32x4*)(lds + k_st) = kreg; *(LAS u32x4*)(lds + v_st) = vreg;
            int tn = t + 1; if (!isctx && qb == 63 && (tn == 4 || tn == 5)) tn = 6;
            const bool more = tn < 10;
            if (more) { const int tok0 = (tn < 6) ? (b * SEQ + (qb - 1) * 128 + 64 * tn) : (TX + b * LC + 64 * (tn - 6));
                kreg = *(const u32x4*)(Kb + (size_t)(tok0 + skey) * 128 + kvh * 64 + sch * 8); vreg = *(const u32x4*)(Vb + (size_t)(tok0 + skey) * 128 + kvh * 64 + sch * 8); }
            __syncthreads();
            const bool local = (!isctx) && (t < 6);
            const bool skip = local && ((rhalf == 0 && t == 5) || (rhalf == 1 && t == 0));
            if (!skip) {
                f32x16 S[2][2];
#pragma unroll
                for (int kb = 0; kb < 2; ++kb)
#pragma unroll
                    for (int qk = 0; qk < 2; ++qk)
#pragma unroll
                        for (int e = 0; e < 16; ++e) S[kb][qk][e] = 0.f;
#pragma unroll
                for (int kb = 0; kb < 2; ++kb)
#pragma unroll
                    for (int s = 0; s < 4; ++s) { const int key = 32 * kb + l32, ch = 2 * s + hh;
                        const bf16x8 kf = *(const LAS bf16x8*)(lds + key * 128 + ((ch ^ ((key >> 1) & 7)) * 16));
#pragma unroll
                        for (int qk = 0; qk < 2; ++qk) S[kb][qk] = __builtin_amdgcn_mfma_f32_32x32x16_bf16(kf, qf[qk][s], S[kb][qk], 0, 0, 0); }
                bf16x8 pf[2][2][2];
#pragma unroll
                for (int qk = 0; qk < 2; ++qk) {
                    if (local) { const int rq = rhalf * 64 + qk * 32 + l32;
#pragma unroll
                        for (int kb = 0; kb < 2; ++kb)
#pragma unroll
                            for (int e = 0; e < 16; ++e) { const int kk = 64 * t + 32 * kb + 8 * (e >> 2) + 4 * hh + (e & 3); const int rel = kk - 128 - rq; if (rel < -128 || rel > 128) S[kb][qk][e] = -__builtin_inff(); } }
                    float mx = -__builtin_inff();
#pragma unroll
                    for (int kb = 0; kb < 2; ++kb)
#pragma unroll
                        for (int e = 0; e < 16; ++e) mx = fmaxf(mx, S[kb][qk][e]);
                    mx = fmaxf(mx, __shfl_xor(mx, 32));
                    const float mn = fmaxf(m_run[qk], mx); const float alpha = __builtin_amdgcn_exp2f(m_run[qk] - mn); m_run[qk] = mn;
                    float rs = 0.f;
#pragma unroll
                    for (int kb = 0; kb < 2; ++kb)
#pragma unroll
                        for (int e = 0; e < 16; ++e) { const float p = __builtin_amdgcn_exp2f(S[kb][qk][e] - mn); S[kb][qk][e] = p; rs += p; }
                    l_run[qk] = l_run[qk] * alpha + rs;
#pragma unroll
                    for (int db = 0; db < 2; ++db)
#pragma unroll
                        for (int e = 0; e < 16; ++e) O[db][qk][e] *= alpha;
#pragma unroll
                    for (int kb = 0; kb < 2; ++kb)
#pragma unroll
                        for (int sp = 0; sp < 2; ++sp) { u32x4 pw;
                            pw.x = cvt_pk_bf16(S[kb][qk][8 * sp + 0], S[kb][qk][8 * sp + 1]); pw.y = cvt_pk_bf16(S[kb][qk][8 * sp + 2], S[kb][qk][8 * sp + 3]);
                            pw.z = cvt_pk_bf16(S[kb][qk][8 * sp + 4], S[kb][qk][8 * sp + 5]); pw.w = cvt_pk_bf16(S[kb][qk][8 * sp + 6], S[kb][qk][8 * sp + 7]);
                            pf[kb][sp][qk] = __builtin_bit_cast(bf16x8, pw); }
                }
#define PV_STEP(KB, SP) do { \
                    const s16x4 a0 = tr_read<((32 * (KB) + 16 * (SP)) * 128)>(vbase[0]), a1 = tr_read<((32 * (KB) + 16 * (SP) + 8) * 128)>(vbase[0]); \
                    const s16x4 c0 = tr_read<((32 * (KB) + 16 * (SP)) * 128)>(vbase[1]), c1 = tr_read<((32 * (KB) + 16 * (SP) + 8) * 128)>(vbase[1]); \
                    asm volatile("s_waitcnt lgkmcnt(0)" ::: "memory"); __builtin_amdgcn_sched_barrier(0); \
                    const bf16x8 vf0 = (bf16x8){a0[0], a0[1], a0[2], a0[3], a1[0], a1[1], a1[2], a1[3]}, vf1 = (bf16x8){c0[0], c0[1], c0[2], c0[3], c1[0], c1[1], c1[2], c1[3]}; \
                    O[0][0] = __builtin_amdgcn_mfma_f32_32x32x16_bf16(vf0, pf[KB][SP][0], O[0][0], 0, 0, 0); O[0][1] = __builtin_amdgcn_mfma_f32_32x32x16_bf16(vf0, pf[KB][SP][1], O[0][1], 0, 0, 0); \
                    O[1][0] = __builtin_amdgcn_mfma_f32_32x32x16_bf16(vf1, pf[KB][SP][0], O[1][0], 0, 0, 0); O[1][1] = __builtin_amdgcn_mfma_f32_32x32x16_bf16(vf1, pf[KB][SP][1], O[1][1], 0, 0, 0); } while (0)
                PV_STEP(0, 0); PV_STEP(0, 1); PV_STEP(1, 0); PV_STEP(1, 1);
#undef PV_STEP
            }
            if (!more) break;
            t = tn;
        }
#pragma unroll
        for (int qk = 0; qk < 2; ++qk) {
            const float lt = l_run[qk] + __shfl_xor(l_run[qk], 32); const float inv = 1.0f / lt;
            const size_t tok = (size_t)(qtok0 + rhalf * 64 + qk * 32 + l32);
#pragma unroll
            for (int db = 0; db < 2; ++db)
#pragma unroll
                for (int vq = 0; vq < 4; ++vq) { u32x2 wv; wv.x = cvt_pk_bf16(O[db][qk][4 * vq] * inv, O[db][qk][4 * vq + 1] * inv); wv.y = cvt_pk_bf16(O[db][qk][4 * vq + 2] * inv, O[db][qk][4 * vq + 3] * inv);
                    *(u32x2*)(AO + tok * 512 + head * 64 + 32 * db + 8 * vq + 4 * hh) = wv; }
        }
    }
    __syncthreads();
}

struct Args { const float* in[20]; float* out; unsigned char* ws; int ph_lo, ph_hi; };

constexpr int PH_PER_LAYER = 9;
constexpr int PH_FINAL = 1 + DEPTH * PH_PER_LAYER;
constexpr int PH_COUNT = PH_FINAL + 1;

__global__ void __launch_bounds__(512, 2) fwd_kernel(Args args) {
    extern __shared__ __attribute__((aligned(16))) unsigned char lds_raw[];
    Fr F;
    F.lds = (LAS unsigned char*)lds_raw; F.ws = args.ws; F.out = args.out;
    F.tid = threadIdx.x; F.lane = F.tid & 63; F.wave = __builtin_amdgcn_readfirstlane(F.tid >> 6); F.G = gridDim.x; F.bid = blockIdx.x;
    volatile LAS unsigned* misc = (volatile LAS unsigned*)(F.lds + LDS_MISC);
    if (F.tid < 64) misc[F.tid] = 0u;
    if (F.tid < 20) { const unsigned long long pv = (unsigned long long)args.in[F.tid]; misc[128 + 2 * F.tid] = (unsigned)pv; misc[128 + 2 * F.tid + 1] = (unsigned)(pv >> 32); }
    __syncthreads();
    XcdBarrier bar; bar.bar = (unsigned*)(F.ws + WS_CTL); bar.x = 0; bar.st = misc;
    const bool one = (args.ph_hi - args.ph_lo) > 1;
    if (one) bar = xcd_barrier_post((unsigned*)(F.ws + WS_CTL), misc);
    const int lo = args.ph_lo, hi = args.ph_hi;
#ifdef STOP_PH
#define IN(k) (lo <= (k) && (k) < hi && ((k) < STOP_PH || (k) == PH_FINAL))
#else
#define IN(k) (lo <= (k) && (k) < hi)
#endif
#ifndef DUP_PH
#define DUP_PH -1
#endif
#define NREP(b) ((DUP_PH == (b)) ? 2 : 1)
#define SEAM(k) do { if (lo <= (k) + 1 && (k) + 1 < hi) xcd_barrier(bar); } while (0)

#ifndef PHM
#define PHM 0xFFFF
#endif
#define PHON(b) ((PHM >> (b)) & 1)
    if (PHON(0) && IN(0)) { for (int rep = 0; rep < NREP(0); ++rep) { LAUNDER(F); prologue_phase(F); SEAM(0); } }

#pragma unroll 1
    for (int l = 0; l < NLAYERS_RUN; ++l) {
        const int pb = 1 + l * PH_PER_LAYER;
        const bool lastl = (l == DEPTH - 1);
        if (PHON(1) && IN(pb + 0)) { LAUNDER(F); norm1_phase(F, l); SEAM(pb + 0); }
        if (PHON(2) && IN(pb + 1)) for (int rep = 0; rep < NREP(2); ++rep) { LAUNDER(F);
            { InProjProb<0> P; P.H = WSP(bf16_t, WS_H); P.W = WSP(bf16_t, WS_WIN) + (size_t)l * IN_DIM * 1024;
              P.FT = WSP(bf16_t, WS_FT); P.FCT = WSP(bf16_t, WS_FCT); P.Q = WSP(bf16_t, WS_Q); P.Kb = WSP(bf16_t, WS_K); P.Vb = WSP(bf16_t, WS_V); P.GF = WSP(bf16_t, WS_GF); P.GA = WSP(bf16_t, WS_GA);
              P.rope = WSP(float, WS_ROPE);
              P.nM = lastl ? 128 : 132; P.n_nat = P.nM * 11; P.n_fx = 256; P.n_fc = lastl ? 0 : 8; P.n_extra = lastl ? 4 : 0; P.G = F.G; P.c = F.bid;
              g8::gemm_run(F.lds, P); }
            { InProjProb<1> P; P.H = WSP(bf16_t, WS_H); P.W = WSP(bf16_t, WS_WIN) + (size_t)l * IN_DIM * 1024;
              P.FT = WSP(bf16_t, WS_FT); P.FCT = WSP(bf16_t, WS_FCT); P.Q = nullptr; P.Kb = nullptr; P.Vb = nullptr; P.GF = nullptr; P.GA = nullptr; P.rope = nullptr;
              P.nM = 0; P.n_nat = 0; P.n_fx = 256; P.n_fc = lastl ? 0 : 8; P.n_extra = 0; P.G = F.G; P.c = (F.bid + 180) % F.G;
              g8::gemm_run(F.lds, P); }
            SEAM(pb + 1);
        }
        if (PHON(3) && IN(pb + 2)) for (int rep = 0; rep < NREP(3); ++rep) { LAUNDER(F);
#ifndef NO_ATTN
            attn_phase(F, l, !lastl);
#endif
#ifndef NO_FFT1
            Fft1Prob P; P.W1 = WSP(bf16_t, WS_W1); P.FT = WSP(bf16_t, WS_FT); P.WC = WSP(bf16_t, WS_WC); P.FCT = WSP(bf16_t, WS_FCT); P.T1 = WSP(bf16_t, WS_T1); P.XS = WSP(bf16_t, WS_XS);
            P.n0 = 512; P.n1 = lastl ? 0 : 16; P.G = F.G; P.c = F.bid;
            g8::gemm_run(F.lds, P);
#endif
            SEAM(pb + 2);
        }
        if (PHON(4) && IN(pb + 3)) for (int rep = 0; rep < NREP(4); ++rep) { LAUNDER(F);
            Fft2Prob P; P.MT = WSP(bf16_t, WS_MT); P.T1 = WSP(bf16_t, WS_T1); P.XS = WSP(bf16_t, WS_XS); P.G = F.G; P.c = F.bid;
            g8::gemm_run(F.lds, P); SEAM(pb + 3);
        }
        if (PHON(5) && IN(pb + 4)) for (int rep = 0; rep < NREP(5); ++rep) { LAUNDER(F);
            { MergeProb<0> P; P.A = WSP(bf16_t, WS_XS); P.W = WSP(bf16_t, WS_WFO) + (size_t)l * 1024 * 1024; P.lda = 1024; P.GATE = WSP(bf16_t, WS_GF); P.YB = WSP(bf16_t, WS_YB);
              P.xin = nullptr; P.cin = nullptr; P.XW = nullptr; P.CW = nullptr; P.g1x = nullptr; P.g1c = nullptr; P.nM = lastl ? 128 : 132; P.G = F.G; P.c = F.bid;
              g8::gemm_run(F.lds, P); }
            { MergeProb<1> P; P.A = WSP(bf16_t, WS_AO); P.W = WSP(bf16_t, WS_WAO) + (size_t)l * 1024 * 512; P.lda = 512; P.GATE = WSP(bf16_t, WS_GA); P.YB = WSP(bf16_t, WS_YB);
              P.xin = nullptr; P.cin = nullptr; P.XW = nullptr; P.CW = nullptr; P.g1x = nullptr; P.g1c = nullptr; P.nM = lastl ? 128 : 132; P.G = F.G; P.c = F.bid;
              g8::gemm_run(F.lds, P); }
            SEAM(pb + 4);
        }
        if (PHON(6) && IN(pb + 5)) { LAUNDER(F);
            MergeProb<2> P; P.A = WSP(bf16_t, WS_YB); P.W = WSP(bf16_t, WS_WOUT) + (size_t)l * 1024 * 1024; P.lda = 1024; P.GATE = nullptr; P.YB = nullptr;
            P.xin = (l == 0) ? INP(0) : WSP(float, WS_XW); P.cin = (l == 0) ? INP(2) : WSP(float, WS_CW); P.XW = WSP(float, WS_XW); P.CW = WSP(float, WS_CW);
            P.g1x = WSP(float, WS_MOD) + (size_t)l * 5 * 6144 + 2 * 1024; P.g1c = WSP(float, WS_MOD) + ((size_t)l * 5 + 4) * 6144 + 2 * 1024; P.nM = lastl ? 128 : 132; P.G = F.G; P.c = F.bid;
            g8::gemm_run(F.lds, P); SEAM(pb + 5);
        }
        if (PHON(7) && IN(pb + 6)) { LAUNDER(F); norm2_router_phase(F, l); SEAM(pb + 6); }
        if (PHON(8) && IN(pb + 7)) for (int rep = 0; rep < NREP(8); ++rep) { LAUNDER(F);
            MoeGuProb P; P.R = fill_tstart(F, l);
            P.H8 = WSP(signed char, WS_H8); P.W8 = WSP(signed char, WS_WGU) + (size_t)l * 32 * 2048 * 1024; P.sW = WSP(float, WS_SWGU) + (size_t)l * 32 * 2048; P.lsc = WSP(float, WS_LSC);
            P.bgu = INP(16) + (size_t)l * 32 * 2048; P.ACT = WSP(bf16_t, WS_ACT);
            P.list = WSP(int, WS_LIST); P.cnt = (const int*)(F.ws + WS_CTL + CTL_CNT) + l * 32; P.tstart = (const volatile LAS int*)(F.lds + LDS_MISC + 64); P.G = F.G; P.c = F.bid;
            g8::gemm_run(F.lds, P); SEAM(pb + 7);
        }
        if (PHON(9) && IN(pb + 8)) for (int rep = 0; rep < NREP(9); ++rep) { LAUNDER(F);
            MoeDnProb P; P.R = fill_tstart(F, l);
            P.ACT = WSP(bf16_t, WS_ACT); P.W = WSP(bf16_t, WS_WDN) + (size_t)l * 32 * 1024 * 1024; P.bdn = INP(18) + (size_t)l * 32 * 1024; P.YE = WSP(bf16_t, WS_YE);
            P.tstart = (const volatile LAS int*)(F.lds + LDS_MISC + 64); P.G = F.G; P.c = F.bid;
            g8::gemm_run(F.lds, P); SEAM(pb + 8);
        }
    }
#ifdef STOP_PH
    if (IN(PH_FINAL)) { LAUNDER(F);
        const size_t n = (size_t)TX * 1024;
        for (size_t i = (size_t)F.bid * 512 + F.tid; i < n; i += (size_t)F.G * 512) {
            F.out[i] = DUMP_EXPR(i);
        } }
#else
    if (PHON(10) && IN(PH_FINAL)) { LAUNDER(F); norm1_phase(F, DEPTH); }
#endif
#undef IN
#undef SEAM
}

extern "C" void kernel_launch(void* const* d_in, const int* in_sizes, int n_in, void* d_out, int out_size, void* d_ws, size_t ws_size, hipStream_t stream) {
    static int grid = 0;
    if (grid == 0) {
        if (n_in != 20 || ws_size < WS_END) { fprintf(stderr, "kernel_launch: bad arguments (n_in %d, ws %zu < %zu)\n", n_in, ws_size, (size_t)WS_END); grid = -1; return; }
        int dev = 0, cus = 0, per_cu = 0;
        if (hipGetDevice(&dev) != hipSuccess || hipDeviceGetAttribute(&cus, hipDeviceAttributeMultiprocessorCount, dev) != hipSuccess) { grid = -1; return; }
        if (hipFuncSetAttribute((const void*)fwd_kernel, hipFuncAttributeMaxDynamicSharedMemorySize, LDS_BYTES) != hipSuccess) { fprintf(stderr, "kernel_launch: hipFuncSetAttribute failed\n"); grid = -1; return; }
        if (hipOccupancyMaxActiveBlocksPerMultiprocessor(&per_cu, (const void*)fwd_kernel, 512, LDS_BYTES) != hipSuccess || per_cu < 1) { fprintf(stderr, "kernel_launch: occupancy query says %d\n", per_cu); }
        (void)hipGetLastError();
        grid = cus;
    }
    if (grid < 0) return;
    (void)hipMemsetAsync((char*)d_ws + WS_CTL, 0, CTL_BYTES, stream);
    Args a{};
    for (int i = 0; i < 20; ++i) a.in[i] = (const float*)d_in[i];
    a.out = (float*)d_out; a.ws = (unsigned char*)d_ws;
#if N_LAUNCH_MODE == 1
    a.ph_lo = 0; a.ph_hi = PH_COUNT;
    hipLaunchKernelGGL(fwd_kernel, dim3(grid), dim3(512), LDS_BYTES, stream, a);
#else
    for (int p = 0; p < PH_COUNT; ++p) { a.ph_lo = p; a.ph_hi = p + 1; hipLaunchKernelGGL(fwd_kernel, dim3(grid), dim3(512), LDS_BYTES, stream, a); }
#endif
    (void)in_sizes; (void)out_size;
}
```

```cpp
#include <hip/hip_runtime.h>
#include <cstdio>
#include <cstdint>

#define LAS __attribute__((address_space(3)))
typedef unsigned short bf16_t;
typedef short bf16x8 __attribute__((ext_vector_type(8)));
typedef short s16x4 __attribute__((ext_vector_type(4)));
typedef float f32x4 __attribute__((ext_vector_type(4)));
typedef float f32x16 __attribute__((ext_vector_type(16)));
typedef unsigned u32x4 __attribute__((ext_vector_type(4)));
typedef unsigned u32x2 __attribute__((ext_vector_type(2)));
typedef int i32x4 __attribute__((ext_vector_type(4)));
typedef int i32x8 __attribute__((ext_vector_type(8)));

#ifndef N_LAUNCH_MODE
#define N_LAUNCH_MODE 1
#endif
#ifndef DBG_CHECK
#define DBG_CHECK 0
#endif
#ifndef EMU8
#define EMU8 false
#endif
#ifndef NLAYERS_RUN
#define NLAYERS_RUN 4
#endif

constexpr int D = 1024, NB = 4, SEQ = 8192, TX = NB * SEQ, LC = 256, TC = NB * LC, TT = TX + TC, DEPTH = 4;
constexpr int IN_DIM = 3328, NEXP = 32;
constexpr int ROWS_MAX = TT * 4 + NEXP * 256;
constexpr float LOG2E = 1.4426950408889634f;
constexpr float QSCALE = 0.125f * LOG2E;
constexpr float EPS = 1e-5f;

constexpr size_t al256(size_t x) { return (x + 255) & ~(size_t)255; }
constexpr size_t WS_CTL = 0;
constexpr size_t CTL_BYTES = 65536;
constexpr size_t CTL_CNT = 16384;
constexpr size_t WS_MOD = WS_CTL + CTL_BYTES;
constexpr size_t WS_ROPE = WS_MOD + al256((size_t)DEPTH * 5 * 6144 * 4);
constexpr size_t WS_W1 = WS_ROPE + 16384;
constexpr size_t WS_MT = WS_W1 + 256 * 128 * 2;
constexpr size_t WS_WC = WS_MT + (size_t)64 * 256 * 128 * 2;
constexpr size_t WS_RWT = WS_WC + 512 * 256 * 2;
constexpr size_t WS_WIN = WS_RWT + (size_t)DEPTH * 32 * 1024 * 2;
constexpr size_t WS_WFO = WS_WIN + (size_t)DEPTH * IN_DIM * 1024 * 2;
constexpr size_t WS_WAO = WS_WFO + (size_t)DEPTH * 1024 * 1024 * 2;
constexpr size_t WS_WOUT = WS_WAO + (size_t)DEPTH * 1024 * 512 * 2;
constexpr size_t WS_WGU = WS_WOUT + (size_t)DEPTH * 1024 * 1024 * 2;
constexpr size_t WS_SWGU = WS_WGU + (size_t)DEPTH * 32 * 2048 * 1024;
constexpr size_t WS_WDN = WS_SWGU + (size_t)DEPTH * 32 * 2048 * 4;
constexpr size_t WS_H = WS_WDN + (size_t)DEPTH * 32 * 1024 * 1024 * 2;
constexpr size_t WS_FT = WS_H + (size_t)(TT + 256) * 1024 * 2;
constexpr size_t WS_FCT = WS_FT + (size_t)131072 * 128 * 2;
constexpr size_t WS_Q = WS_FCT + (size_t)2048 * 256 * 2;
constexpr size_t WS_K = WS_Q + (size_t)TT * 512 * 2;
constexpr size_t WS_V = WS_K + (size_t)TT * 128 * 2;
constexpr size_t WS_GF = WS_V + (size_t)TT * 128 * 2;
constexpr size_t WS_GA = WS_GF + (size_t)TT * 1024 * 2;
constexpr size_t WS_T1 = WS_GA + (size_t)TT * 1024 * 2;
constexpr size_t WS_XS = WS_T1 + (size_t)64 * 2048 * 128 * 2;
constexpr size_t WS_AO = WS_XS + (size_t)TT * 1024 * 2;
constexpr size_t WS_YB = WS_AO + (size_t)TT * 512 * 2;
constexpr size_t WS_XW = WS_YB + (size_t)TT * 1024 * 2;
constexpr size_t WS_CW = WS_XW + (size_t)TX * 1024 * 4;
constexpr size_t WS_ACT = WS_CW + (size_t)TC * 1024 * 4;
constexpr size_t WS_YE = WS_ACT + (size_t)ROWS_MAX * 1024 * 2;
constexpr size_t WS_LIST = WS_YE + (size_t)ROWS_MAX * 1024 * 2;
constexpr size_t WS_SLOT = WS_LIST + (size_t)32 * TT * 4;
constexpr size_t WS_GATE = WS_SLOT + (size_t)TT * 4 * 4;
constexpr size_t WS_H8 = WS_GATE + (size_t)TT * 4 * 4;
constexpr size_t WS_LSC = WS_H8 + (size_t)(TT + 256) * 1024;
constexpr size_t WS_END = WS_LSC + (size_t)32 * TT * 4;

constexpr int LDS_STAGE = 131072;
constexpr int LDS_MISC = LDS_STAGE;
constexpr int LDS_BYTES = 147456;

typedef __bf16 bf16v2_t __attribute__((ext_vector_type(2)));
typedef float f32x2_t __attribute__((ext_vector_type(2)));
__device__ __forceinline__ unsigned cvt_pk_bf16(float lo, float hi) { const f32x2_t v = {lo, hi}; const bf16v2_t b = __builtin_convertvector(v, bf16v2_t); return __builtin_bit_cast(unsigned, b); }
__device__ __forceinline__ float q8(float x) { const int p = __builtin_amdgcn_cvt_pk_fp8_f32(x, 0.f, 0, false); return __builtin_amdgcn_cvt_f32_fp8(p, 0); }
__device__ __forceinline__ unsigned pk4_fp8(float a, float b, float c, float d) { int p = __builtin_amdgcn_cvt_pk_fp8_f32(a, b, 0, false); p = __builtin_amdgcn_cvt_pk_fp8_f32(c, d, p, true); return (unsigned)p; }
__device__ __forceinline__ bf16_t f2bf(float f) { return (bf16_t)(cvt_pk_bf16(f, 0.f) & 0xffffu); }
__device__ __forceinline__ float bf_lo(unsigned u) { return __uint_as_float(u << 16); }
__device__ __forceinline__ float bf_hi(unsigned u) { return __uint_as_float(u & 0xffff0000u); }
__device__ __forceinline__ float bf2f(bf16_t b) { return __uint_as_float(((unsigned)b) << 16); }
__device__ __forceinline__ float sigmoidf_(float x) { return __builtin_amdgcn_rcpf(1.0f + __builtin_amdgcn_exp2f(-x * LOG2E)); }
__device__ __forceinline__ float wave_sum(float v) {
#pragma unroll
    for (int o = 32; o >= 1; o >>= 1) v += __shfl_xor(v, o);
    return v;
}

#define XB_TMO      128
#define XB_XCNT(j)  (256  + 64 * (j))
#define XB_XSUB(j)  (1280 + 64 * (j))
#define XB_XGEN(j)  (2304 + 64 * (j))
#define XB_TOP      3328
#define XB_TOPGEN   3392
#define XCD_BAR_WORDS 3456
#define XB_SPIN_CAP (1u << 22)

__device__ __forceinline__ unsigned xb_ld(unsigned* p)              { return __hip_atomic_load(p, __ATOMIC_RELAXED, __HIP_MEMORY_SCOPE_AGENT); }
__device__ __forceinline__ unsigned xb_add(unsigned* p, unsigned v) { return __hip_atomic_fetch_add(p, v, __ATOMIC_RELAXED, __HIP_MEMORY_SCOPE_AGENT); }
__device__ __forceinline__ unsigned xb_xcc_id() { return (unsigned)__builtin_amdgcn_s_getreg((3 << 11) | 20) & 0xFu; }
#define XB_SPIN(cond, bar) do { unsigned _sp = 0; while (cond) { __builtin_amdgcn_s_sleep(1); \
    if ((++_sp & 255u) == 0u) { if (xb_ld(&(bar)[XB_TMO])) break; if (_sp > XB_SPIN_CAP) { atomicAdd(&(bar)[XB_TMO], 1u); break; } } } } while (0)

struct XcdBarrier { unsigned* bar; unsigned x; volatile LAS unsigned* st; };

__device__ __forceinline__ XcdBarrier xcd_barrier_post(unsigned* bar, volatile LAS unsigned* st) {
    XcdBarrier b; b.bar = bar; b.x = xb_xcc_id(); b.st = st;
    if (threadIdx.x == 0) (void)xb_add(&bar[XB_XCNT(b.x)], 1u);
    return b;
}
__device__ __forceinline__ void xcd_barrier_complete(unsigned* bar, unsigned x, unsigned& nloc, unsigned& nx) {
    const unsigned G = gridDim.x * gridDim.y * gridDim.z;
    unsigned sum, cnt, mine, sp = 0u;
    for (;;) {
        sum = 0u; cnt = 0u; mine = 0u;
#pragma unroll
        for (unsigned j = 0; j < 16; ++j) { const unsigned c = xb_ld(&bar[XB_XCNT(j)]); sum += c; cnt += (c > 0u) ? 1u : 0u; mine = (j == x) ? c : mine; }
        if (sum == G) break;
        __builtin_amdgcn_s_sleep(1);
        if ((++sp & 255u) == 0u) { if (xb_ld(&bar[XB_TMO])) break; if (sp > XB_SPIN_CAP) { atomicAdd(&bar[XB_TMO], 1u); break; } }
    }
    nloc = mine > 0u ? mine : 1u; nx = cnt > 0u ? cnt : 1u;
}
__device__ __forceinline__ void xcd_barrier(const XcdBarrier& b) {
    asm volatile("s_waitcnt vmcnt(0)" ::: "memory");
    __syncthreads();
    if (threadIdx.x == 0) {
        unsigned* bar = b.bar;
        __builtin_amdgcn_s_waitcnt(0);
        unsigned nloc = b.st[0], nx = b.st[1];
        if (nloc == 0u) { xcd_barrier_complete(bar, b.x, nloc, nx); b.st[0] = nloc; b.st[1] = nx; }
        const unsigned old = xb_add(&bar[XB_XSUB(b.x)], 1u);
        const unsigned gen = old / nloc;
        if (old + 1u == (gen + 1u) * nloc) {
            __builtin_amdgcn_fence(__ATOMIC_RELEASE, "agent");
            asm volatile("s_waitcnt vmcnt(0)" ::: "memory");
            const unsigned og = xb_add(&bar[XB_TOP], 1u);
            const unsigned tg = og / nx;
            if (og + 1u == (tg + 1u) * nx) xb_add(&bar[XB_TOPGEN], 1u);
            else XB_SPIN(xb_ld(&bar[XB_TOPGEN]) == tg, bar);
            __builtin_amdgcn_fence(__ATOMIC_ACQUIRE, "agent");
            xb_add(&bar[XB_XGEN(b.x)], 1u);
            asm volatile("s_waitcnt vmcnt(0)" ::: "memory");
        } else {
            XB_SPIN(xb_ld(&bar[XB_XGEN(b.x)]) == gen, bar);
            __builtin_amdgcn_fence(__ATOMIC_ACQUIRE, "agent");
            asm volatile("s_waitcnt vmcnt(0)" ::: "memory");
        }
    }
    __syncthreads();
}

struct Fr {
    LAS unsigned char* lds;
    unsigned char* ws;
    float* out;
    int tid, lane, wave, G, bid;
};
__device__ __forceinline__ const float* in_ptr(const Fr& F, int i) {
    volatile LAS unsigned* p = (volatile LAS unsigned*)(F.lds + 131072 + 512) + 2 * i;
    const unsigned lo = __builtin_amdgcn_readfirstlane(p[0]), hi = __builtin_amdgcn_readfirstlane(p[1]);
    return (const float*)(((unsigned long long)hi << 32) | lo);
}
#define INP(i) in_ptr(F, (i))
#define LAUNDER(F) do { unsigned char* _w = (F).ws; asm volatile("" : "+s"(_w)); (F).ws = _w; int _t = threadIdx.x; asm volatile("" : "+v"(_t)); (F).tid = _t; (F).lane = _t & 63; (F).wave = __builtin_amdgcn_readfirstlane(_t >> 6); } while (0)
#define WSP(T, off) ((T*)(F.ws + (off)))

namespace g8 {
constexpr int BM = 256, BK = 64, HALF = 128, HTB = HALF * BK * 2, NXCD = 8, WGM = 8;
__device__ __forceinline__ int lds_byte(int r, int c) { const int st = (r >> 4) * 2 + (c >> 5), rr = r & 15, cc = c & 31, ob = rr * 64 + cc * 2; return st * 1024 + (ob ^ (((ob >> 9) & 1) << 5)); }
__device__ __forceinline__ void stage_rc(int b, int& R, int& C) { const int st = b / 1024, sb = b % 1024, swz = sb ^ (((sb >> 9) & 1) << 5); R = (st >> 1) * 16 + swz / 64; C = (st & 1) * 32 + (swz % 64) / 2; }
__device__ __forceinline__ int perm32(int rho) { const int n = rho >> 4, i = rho & 15; return 8 * (i >> 2) + 4 * n + (i & 3); }
__device__ __forceinline__ void order2d(int L, int nM, int nN, int& pm, int& pn) {
    const int nwg = nM * nN;
    int wgid = L; { const int q = nwg / NXCD, r = nwg % NXCD, xcd = wgid % NXCD, off = wgid / NXCD; wgid = (xcd < r ? xcd * (q + 1) : r * (q + 1) + (xcd - r) * q) + off; }
    const int nig = WGM * nN, gid = wgid / nig, fm = gid * WGM, gsz = (nM - fm) < WGM ? (nM - fm) : WGM;
    pm = fm + ((wgid % nig) % gsz); pn = (wgid % nig) / gsz;
}
__device__ __forceinline__ void lane_geom(int tid, int& R0, int& Rb0, int& C0) { asm volatile("" : "+v"(tid)); stage_rc(tid * 16, R0, C0); Rb0 = (R0 & ~31) + perm32(R0 & 31); }

#define G8_ROWS(ai, m) (128 * (ai) + 64 * wr + 16 * (m) + fr)
#define G8_COL0(bj) (128 * (bj) + 32 * wc + 8 * fq)

template <bool I8> __device__ __forceinline__ f32x4 mma1(const bf16x8& b, const bf16x8& a, const f32x4& c) { return __builtin_amdgcn_mfma_f32_16x16x32_bf16(b, a, c, 0, 0, 0); }
template <bool I8> __device__ __forceinline__ i32x4 mma1(const bf16x8& b, const bf16x8& a, const i32x4& c) { return __builtin_amdgcn_mfma_i32_16x16x64_i8(__builtin_bit_cast(i32x4, b), __builtin_bit_cast(i32x4, a), c, 0, 0, 0); }
__device__ __forceinline__ f32x4 mma8(const bf16x8& b0, const bf16x8& b1, const bf16x8& a0, const bf16x8& a1, const f32x4& c) {
    const i32x4 B0 = __builtin_bit_cast(i32x4, b0), B1 = __builtin_bit_cast(i32x4, b1), A0 = __builtin_bit_cast(i32x4, a0), A1 = __builtin_bit_cast(i32x4, a1);
    const i32x8 B = {B0[0], B0[1], B0[2], B0[3], B1[0], B1[1], B1[2], B1[3]}, A = {A0[0], A0[1], A0[2], A0[3], A1[0], A1[1], A1[2], A1[3]};
    return __builtin_amdgcn_mfma_scale_f32_16x16x128_f8f6f4(B, A, c, 0, 0, 0, 0x7F7F7F7F, 0, 0x7F7F7F7F);
}
template <class P>
__device__ __forceinline__ void gemm_run(LAS unsigned char* lds, P& prob) {
    int tid = threadIdx.x; asm volatile("" : "+v"(tid));
    const int wid = __builtin_amdgcn_readfirstlane(tid >> 6), lane = tid & 63, wr = wid >> 2, wc = wid & 3, fr = lane & 15, fq = lane >> 4;
    const size_t kstep = (size_t)(BK * 2);
    const unsigned ldsw = (unsigned)wid * 1024u;
    const int aoff = lds_byte(wr * 64 + fr, fq * 8), boff = lds_byte(wc * 32 + fr, fq * 8);
#define G8_SA(b, h) (((b) * 2 + (h)) * HTB)
#define G8_SB(b, h) ((4 + (b) * 2 + (h)) * HTB)
#define G8_STAGE_(bufoff, g0, o0, g1, o1) do { \
        __builtin_amdgcn_global_load_lds((const unsigned*)((const char*)(g0) + (o0)), (LAS unsigned*)(lds + (bufoff) + ldsw), 16, 0, 0); \
        __builtin_amdgcn_global_load_lds((const unsigned*)((const char*)(g1) + (o1)), (LAS unsigned*)(lds + (bufoff) + ldsw + 8192), 16, 0, 0); } while (0)
#define G8_OA(j) (P::GATHER_A ? oa[j] : oa[0])
#define G8_STA(bufoff, gbase, h) G8_STAGE_(bufoff, (gbase) + dA[2 * (h)], G8_OA(2 * (h)), (gbase) + dA[2 * (h) + 1], G8_OA(2 * (h) + 1))
#define G8_STB(bufoff, gbase, h) G8_STAGE_(bufoff, (gbase) + dB[2 * (h)], ob, (gbase) + dB[2 * (h) + 1], ob)
#define G8_LDA(dst, b, h) do { _Pragma("unroll") for (int m = 0; m < 4; ++m) _Pragma("unroll") for (int k = 0; k < 2; ++k) dst[m][k] = *(const LAS bf16x8*)(lds + G8_SA(b, h) + aoff + m * 2048 + k * 1024); } while (0)
#define G8_LDB(dst, b, h) do { _Pragma("unroll") for (int n = 0; n < 2; ++n) _Pragma("unroll") for (int k = 0; k < 2; ++k) dst[n][k] = *(const LAS bf16x8*)(lds + G8_SB(b, h) + boff + n * 2048 + k * 1024); } while (0)
#define G8_MMA(ai, bj, At, Bt) do { __builtin_amdgcn_s_setprio(1); \
        if constexpr (P::F8) { _Pragma("unroll") for (int m = 0; m < 4; ++m) _Pragma("unroll") for (int n = 0; n < 2; ++n) acc[ai][bj][m][n] = mma8(Bt[n][0], Bt[n][1], At[m][0], At[m][1], acc[ai][bj][m][n]); } \
        else { _Pragma("unroll") for (int m = 0; m < 4; ++m) _Pragma("unroll") for (int n = 0; n < 2; ++n) _Pragma("unroll") for (int k = 0; k < 2; ++k) \
        acc[ai][bj][m][n] = mma1<P::I8>(Bt[n][k], At[m][k], acc[ai][bj][m][n]); } __builtin_amdgcn_s_setprio(0); } while (0)
#define G8_WAIT_V(n) asm volatile("s_waitcnt vmcnt(" #n ")" ::: "memory")
#define G8_WAIT_L(n) asm volatile("s_waitcnt lgkmcnt(" #n ")" ::: "memory")
#define G8_BAR __builtin_amdgcn_s_barrier()
#define G8_SCHED __builtin_amdgcn_sched_barrier(0)
    typename P::U cur, nxt; int ui = 0;
    if (!prob.get(0, cur)) return;
    typedef typename P::Acc Acc;
    Acc acc[2][2][4][2];
#pragma unroll
    for (int a = 0; a < 2; ++a)
#pragma unroll
        for (int b = 0; b < 2; ++b)
#pragma unroll
            for (int m = 0; m < 4; ++m)
#pragma unroll
                for (int n = 0; n < 2; ++n) acc[a][b][m][n] = (Acc){0, 0, 0, 0};
    bf16x8 At[4][2], B0[2][2], B1[2][2];
    unsigned oa[4], ob, dA[4], dB[4]; const char* cA; const char* cB; int nt;
    prob.setup(cur, oa, ob, dA, dB, cA, cB, nt);
    G8_STB(G8_SB(0, 0), cB, 0); G8_STA(G8_SA(0, 0), cA, 0); G8_STB(G8_SB(0, 1), cB, 1); G8_STA(G8_SA(0, 1), cA, 1);
    if (wr == 1) G8_BAR;
    G8_WAIT_V(4); G8_BAR;
    G8_STB(G8_SB(1, 0), cB + kstep, 0); G8_STA(G8_SA(1, 0), cA + kstep, 0); G8_STB(G8_SB(1, 1), cB + kstep, 1);
    G8_WAIT_V(6); G8_BAR;
    for (;;) {
        const bool has_next = prob.get(ui + 1, nxt);
        int nnt = nt;
        for (int t = 0; t < nt; t += 2) {
            const bool last = (t == nt - 2);
            G8_LDB(B0, 0, 0); G8_SCHED; G8_LDA(At, 0, 0); G8_STA(G8_SA(1, 1), cA + (size_t)(t + 1) * kstep, 1);
            G8_WAIT_L(8); G8_BAR; G8_WAIT_L(0); G8_MMA(0, 0, At, B0); G8_BAR; G8_SCHED;
            const char* a2; const char* b2;
            if (last) { if (has_next) { prob.setup(nxt, oa, ob, dA, dB, cA, cB, nnt); } a2 = cA; b2 = cB; }
            else { a2 = cA + (size_t)(t + 2) * kstep; b2 = cB + (size_t)(t + 2) * kstep; }
            const char* a3 = a2 + kstep; const char* b3 = b2 + kstep;
            G8_LDB(B1, 0, 1); G8_STB(G8_SB(0, 0), b2, 0);
            G8_BAR; G8_WAIT_L(0); G8_MMA(0, 1, At, B1); G8_BAR;
            G8_LDA(At, 0, 1); G8_STA(G8_SA(0, 0), a2, 0);
            G8_BAR; G8_WAIT_L(0); G8_MMA(1, 0, At, B0); G8_BAR; G8_SCHED;
            G8_STB(G8_SB(0, 1), b2, 1);
            G8_WAIT_V(6); G8_BAR; G8_MMA(1, 1, At, B1); G8_BAR;
            G8_LDB(B0, 1, 0); G8_SCHED; G8_LDA(At, 1, 0); G8_STA(G8_SA(0, 1), a2, 1);
            G8_WAIT_L(8); G8_BAR; G8_WAIT_L(0); G8_MMA(0, 0, At, B0); G8_BAR; G8_SCHED;
            G8_LDB(B1, 1, 1); G8_STB(G8_SB(1, 0), b3, 0);
            G8_BAR; G8_WAIT_L(0); G8_MMA(0, 1, At, B1); G8_BAR;
            G8_LDA(At, 1, 1); G8_STA(G8_SA(1, 0), a3, 0);
            G8_BAR; G8_WAIT_L(0); G8_MMA(1, 0, At, B0); G8_BAR; G8_SCHED;
            G8_STB(G8_SB(1, 1), b3, 1);
            G8_WAIT_V(6); G8_BAR; G8_MMA(1, 1, At, B1); G8_BAR;
            if (last) break;
        }
        { int t2 = threadIdx.x; asm volatile("" : "+v"(t2)); const int l2 = t2 & 63; prob.epi(acc, cur, wr, wc, l2 & 15, l2 >> 4); }
        if (!has_next) break;
#pragma unroll
        for (int a = 0; a < 2; ++a)
#pragma unroll
            for (int b = 0; b < 2; ++b)
#pragma unroll
                for (int m = 0; m < 4; ++m)
#pragma unroll
                    for (int n = 0; n < 2; ++n) acc[a][b][m][n] = (Acc){0, 0, 0, 0};
        cur = nxt; nt = nnt; ++ui;
    }
    G8_WAIT_V(0);
    if (wr == 0) G8_BAR;
    G8_BAR;
}
}

__device__ __forceinline__ u32x4 pack8(const f32x4& v0, const f32x4& v1) {
    u32x4 w; w.x = cvt_pk_bf16(v0[0], v0[1]); w.y = cvt_pk_bf16(v0[2], v0[3]); w.z = cvt_pk_bf16(v1[0], v1[1]); w.w = cvt_pk_bf16(v1[2], v1[3]); return w;
}
__device__ __forceinline__ void unpack8(const u32x4& w, f32x4& v0, f32x4& v1) {
    v0 = (f32x4){bf_lo(w.x), bf_hi(w.x), bf_lo(w.y), bf_hi(w.y)}; v1 = (f32x4){bf_lo(w.z), bf_hi(w.z), bf_lo(w.w), bf_hi(w.w)};
}

template <int WHICH> struct InProjProb {
    static constexpr bool PERM = true, GATHER_A = false, I8 = false, F8 = false; typedef f32x4 Acc;
    struct U { int kind, pm, pn, b, j; };
    const bf16_t* H; const bf16_t* W;
    bf16_t *FT, *FCT, *Q, *Kb, *Vb, *GF, *GA; const float* rope;
    int nM, n_nat, n_fx, n_fc, n_extra, G, c;
    __device__ __forceinline__ bool get(int i, U& u) const {
        const int L = i * G + c;
        if (WHICH == 0) {
            if (L >= n_nat + n_extra) return false;
            const bool nat = L < n_nat;
            int pm, pn; g8::order2d(nat ? L : 0, nM, 11, pm, pn);
            u.kind = 2; u.pm = __builtin_amdgcn_readfirstlane(nat ? pm : (128 + L - n_nat)); u.pn = __builtin_amdgcn_readfirstlane(nat ? (pn + 2) : 4); u.b = 0; u.j = 0;
            return true;
        } else {
            if (L >= n_fx + n_fc) return false;
            const bool fx = L < n_fx; const int L2 = L - n_fx;
            u.kind = __builtin_amdgcn_readfirstlane(fx ? 0 : 1); u.b = __builtin_amdgcn_readfirstlane(fx ? (L >> 6) : (L2 >> 1)); u.j = __builtin_amdgcn_readfirstlane(fx ? ((L & 63) >> 1) : 0); u.pn = __builtin_amdgcn_readfirstlane(fx ? (L & 1) : (L2 & 1)); u.pm = 0;
            return true;
        }
    }
    __device__ __forceinline__ void setup(const U& u, unsigned (&oa)[4], unsigned& ob, unsigned (&dA)[4], unsigned (&dB)[4], const char*& pA, const char*& pB, int& nt) const {
        int R0, Rb0, C0; g8::lane_geom(threadIdx.x, R0, Rb0, C0);
        nt = 16;
#pragma unroll
        for (int j = 0; j < 4; ++j) { dA[j] = (unsigned)(64 * j * 1024) * 2u; dB[j] = dA[j]; }
        if (WHICH == 0) {
            pA = (const char*)H; pB = (const char*)W;
            oa[0] = (unsigned)((256 * u.pm + R0) * 1024 + C0) * 2u; ob = (unsigned)((256 * u.pn + Rb0) * 1024 + C0) * 2u;
        } else {
            pA = (const char*)W; pB = (const char*)H;
            oa[0] = (unsigned)((256 * u.pn + R0) * 1024 + C0) * 2u;
            if (u.kind == 0) { ob = (unsigned)((u.b * SEQ + 64 * Rb0 + 2 * u.j) * 1024 + C0) * 2u;
                dB[1] = (unsigned)(64 * 64 * 1024) * 2u; dB[2] = 2048u; dB[3] = dB[1] + 2048u; }
            else ob = (unsigned)((TX + u.b * LC + Rb0) * 1024 + C0) * 2u;
        }
    }
    __device__ __forceinline__ void epi(const f32x4 (&acc)[2][2][4][2], const U& u, int wr, int wc, int fr, int fq) const {
        if (WHICH == 0) {
            if (u.pn >= 5) {
                bf16_t* dst = (u.pn >= 9) ? GA : GF; const int cb = 256 * ((u.pn >= 9) ? u.pn - 9 : u.pn - 5);
#pragma unroll
                for (int ai = 0; ai < 2; ++ai)
#pragma unroll
                    for (int m = 0; m < 4; ++m) { const size_t tok = (size_t)256 * u.pm + G8_ROWS(ai, m);
#pragma unroll
                        for (int bj = 0; bj < 2; ++bj) { f32x4 v0 = acc[ai][bj][m][0], v1 = acc[ai][bj][m][1];
#pragma unroll
                            for (int e = 0; e < 4; ++e) { v0[e] = sigmoidf_(v0[e]); v1[e] = sigmoidf_(v1[e]); }
                            *(u32x4*)(dst + tok * 1024 + cb + G8_COL0(bj)) = pack8(v0, v1); } }
            } else {
#pragma unroll
                for (int ai = 0; ai < 2; ++ai)
#pragma unroll
                    for (int m = 0; m < 4; ++m) { const int tok = 256 * u.pm + G8_ROWS(ai, m);
                        const bool isx = tok < TX; const int n = tok & (SEQ - 1); const int prow = n >> 6, pcol = n & 63;
#pragma unroll
                        for (int bj = 0; bj < 2; ++bj) { f32x4 v0 = acc[ai][bj][m][0], v1 = acc[ai][bj][m][1];
                            const int c0 = G8_COL0(bj);
                            const bool isv = (u.pn == 4) && (bj == 1);
                            if (!isv) {
                                const int dp = c0 & 63; const int axis = dp >> 5, f0 = (dp & 31) >> 1;
                                if (isx) {
                                    const int pos = axis ? pcol : prow;
                                    const f32x4 cs = *(const f32x4*)(rope + pos * 16 + f0), sn = *(const f32x4*)(rope + 2048 + pos * 16 + f0);
                                    f32x4 r0, r1;
                                    r0[0] = v0[0] * cs[0] - v0[1] * sn[0]; r0[1] = v0[1] * cs[0] + v0[0] * sn[0];
                                    r0[2] = v0[2] * cs[1] - v0[3] * sn[1]; r0[3] = v0[3] * cs[1] + v0[2] * sn[1];
                                    r1[0] = v1[0] * cs[2] - v1[1] * sn[2]; r1[1] = v1[1] * cs[2] + v1[0] * sn[2];
                                    r1[2] = v1[2] * cs[3] - v1[3] * sn[3]; r1[3] = v1[3] * cs[3] + v1[2] * sn[3];
                                    v0 = r0; v1 = r1;
                                }
                            }
                            if (u.pn < 4) { v0 *= QSCALE; v1 *= QSCALE; *(u32x4*)(Q + (size_t)tok * 512 + 256 * (u.pn - 2) + c0) = pack8(v0, v1); }
                            else if (!isv) { *(u32x4*)(Kb + (size_t)tok * 128 + c0) = pack8(v0, v1); }
                            else { *(u32x4*)(Vb + (size_t)tok * 128 + (c0 - 128)) = pack8(v0, v1); }
                        } }
            }
        } else {
#pragma unroll
            for (int ai = 0; ai < 2; ++ai)
#pragma unroll
                for (int m = 0; m < 4; ++m) { const int ch = 256 * u.pn + G8_ROWS(ai, m);
#pragma unroll
                    for (int bj = 0; bj < 2; ++bj) { const int c0 = G8_COL0(bj);
                        const u32x4 w = pack8(acc[ai][bj][m][0], acc[ai][bj][m][1]);
                        if (u.kind == 0) { const int n2 = 2 * u.j + (c0 >> 7), n1 = c0 & 127; *(u32x4*)(FT + ((size_t)(u.b * 512 + ch) * 64 + n2) * 128 + n1) = w; }
                        else *(u32x4*)(FCT + (size_t)(u.b * 512 + ch) * 256 + c0) = w;
                    } }
        }
    }
};

struct Fft1Prob {
    static constexpr bool PERM = true, GATHER_A = false, I8 = false, F8 = false; typedef f32x4 Acc;
    struct U { int kind, pm, pn; };
    const bf16_t *W1, *FT, *WC, *FCT; bf16_t *T1, *XS;
    int n0, n1, G, c;
    __device__ __forceinline__ bool get(int i, U& u) const {
        const int L = i * G + c;
        if (L >= n0 + n1) return false;
        const bool k0 = L < n0; const int L2 = L - n0;
        u.kind = __builtin_amdgcn_readfirstlane(k0 ? 0 : 1); u.pm = __builtin_amdgcn_readfirstlane(k0 ? 0 : (L2 & 1)); u.pn = __builtin_amdgcn_readfirstlane(k0 ? L : (L2 >> 1));
        return true;
    }
    __device__ __forceinline__ void setup(const U& u, unsigned (&oa)[4], unsigned& ob, unsigned (&dA)[4], unsigned (&dB)[4], const char*& pA, const char*& pB, int& nt) const {
        int R0, Rb0, C0; g8::lane_geom(threadIdx.x, R0, Rb0, C0);
        if (u.kind == 0) { nt = 2; pA = (const char*)W1; pB = (const char*)FT;
#pragma unroll
            for (int j = 0; j < 4; ++j) { dA[j] = (unsigned)(64 * j * 128) * 2u; dB[j] = dA[j]; }
            oa[0] = (unsigned)(R0 * 128 + C0) * 2u; ob = (unsigned)((256 * u.pn + Rb0) * 128 + C0) * 2u;
        } else { nt = 4; pA = (const char*)WC; pB = (const char*)FCT;
#pragma unroll
            for (int j = 0; j < 4; ++j) { dA[j] = (unsigned)(64 * j * 256) * 2u; dB[j] = dA[j]; }
            oa[0] = (unsigned)((256 * u.pm + R0) * 256 + C0) * 2u; ob = (unsigned)((256 * u.pn + Rb0) * 256 + C0) * 2u;
        }
    }
    __device__ __forceinline__ void epi(const f32x4 (&acc)[2][2][4][2], const U& u, int wr, int wc, int fr, int fq) const {
        if (u.kind == 0) {
#pragma unroll
            for (int m = 0; m < 4; ++m) { const int r = G8_ROWS(0, m); const int k1p = r >> 1, part = r & 1;
#pragma unroll
                for (int bj = 0; bj < 2; ++bj) { const int col = 256 * u.pn + G8_COL0(bj); const int bc = col >> 6, n2 = col & 63;
                    *(u32x4*)(T1 + (((size_t)k1p * 2048 + bc) * 2 + part) * 64 + n2) = pack8(acc[0][bj][m][0], acc[0][bj][m][1]); } }
        } else {
#pragma unroll
            for (int ai = 0; ai < 2; ++ai)
#pragma unroll
                for (int m = 0; m < 4; ++m) { const int r = 256 * u.pm + G8_ROWS(ai, m); const int k = r >> 1, reim = r & 1;
#pragma unroll
                    for (int bj = 0; bj < 2; ++bj) { const int bc = 256 * u.pn + G8_COL0(bj); const int b = bc >> 9, ch = bc & 511, g = ch >> 7, d = ch & 127;
                        *(u32x4*)(XS + (size_t)(TX + b * LC + k) * 1024 + g * 256 + reim * 128 + d) = pack8(acc[ai][bj][m][0], acc[ai][bj][m][1]); } }
        }
    }
};

struct Fft2Prob {
    static constexpr bool PERM = true, GATHER_A = false, I8 = false, F8 = false; typedef f32x4 Acc;
    struct U { int k1p, pn; };
    const bf16_t *MT, *T1; bf16_t* XS; int G, c;
    __device__ __forceinline__ bool get(int i, U& u) const { const int L = i * G + c; if (L >= 512) return false; u.k1p = __builtin_amdgcn_readfirstlane(L >> 3); u.pn = __builtin_amdgcn_readfirstlane(L & 7); return true; }
    __device__ __forceinline__ void setup(const U& u, unsigned (&oa)[4], unsigned& ob, unsigned (&dA)[4], unsigned (&dB)[4], const char*& pA, const char*& pB, int& nt) const {
        int R0, Rb0, C0; g8::lane_geom(threadIdx.x, R0, Rb0, C0);
        nt = 2; pA = (const char*)MT; pB = (const char*)T1;
#pragma unroll
        for (int j = 0; j < 4; ++j) { dA[j] = (unsigned)(64 * j * 128) * 2u; dB[j] = dA[j]; }
        oa[0] = (unsigned)((u.k1p * 256 + R0) * 128 + C0) * 2u; ob = (unsigned)((u.k1p * 2048 + 256 * u.pn + Rb0) * 128 + C0) * 2u;
    }
    __device__ __forceinline__ void epi(const f32x4 (&acc)[2][2][4][2], const U& u, int wr, int wc, int fr, int fq) const {
#pragma unroll
        for (int ai = 0; ai < 2; ++ai)
#pragma unroll
            for (int m = 0; m < 4; ++m) { const int r = G8_ROWS(ai, m); const int s = r >> 7, k2 = (r & 127) >> 1, reim = r & 1;
                const int kb = (u.k1p == 0) ? 64 * s : (s ? 128 - u.k1p : u.k1p); const int k = kb + 128 * k2;
#pragma unroll
                for (int bj = 0; bj < 2; ++bj) { const int bc = 256 * u.pn + G8_COL0(bj); const int b = bc >> 9, ch = bc & 511, g = ch >> 7, d = ch & 127;
                    *(u32x4*)(XS + (size_t)(b * SEQ + k) * 1024 + g * 256 + reim * 128 + d) = pack8(acc[ai][bj][m][0], acc[ai][bj][m][1]); } }
    }
};

template <int MODE> struct MergeProb {
    static constexpr bool PERM = true, GATHER_A = false, I8 = false, F8 = false; typedef f32x4 Acc;
    struct U { int pm, pn; };
    const bf16_t* A; const bf16_t* W; int lda;
    const bf16_t* GATE; bf16_t* YB;
    const float* xin; const float* cin; float* XW; float* CW; const float* g1x; const float* g1c;
    int nM, G, c;
    __device__ __forceinline__ bool get(int i, U& u) const { const int L = i * G + c; if (L >= nM * 4) return false; int pm, pn; g8::order2d(L, nM, 4, pm, pn); u.pm = __builtin_amdgcn_readfirstlane(pm); u.pn = __builtin_amdgcn_readfirstlane(pn); return true; }
    __device__ __forceinline__ void setup(const U& u, unsigned (&oa)[4], unsigned& ob, unsigned (&dA)[4], unsigned (&dB)[4], const char*& pA, const char*& pB, int& nt) const {
        int R0, Rb0, C0; g8::lane_geom(threadIdx.x, R0, Rb0, C0);
        nt = lda >> 6; pA = (const char*)A; pB = (const char*)W;
#pragma unroll
        for (int j = 0; j < 4; ++j) { dA[j] = (unsigned)(64 * j * lda) * 2u; dB[j] = dA[j]; }
        oa[0] = (unsigned)((256 * u.pm + R0) * lda + C0) * 2u; ob = (unsigned)((256 * u.pn + Rb0) * lda + C0) * 2u;
    }
    __device__ __forceinline__ void epi(const f32x4 (&acc)[2][2][4][2], const U& u, int wr, int wc, int fr, int fq) const {
#pragma unroll
        for (int ai = 0; ai < 2; ++ai)
#pragma unroll
            for (int m = 0; m < 4; ++m) { const int tok = 256 * u.pm + G8_ROWS(ai, m);
#pragma unroll
                for (int bj = 0; bj < 2; ++bj) { const int col = 256 * u.pn + G8_COL0(bj);
                    f32x4 v0 = acc[ai][bj][m][0], v1 = acc[ai][bj][m][1];
                    if (MODE < 2) {
                        f32x4 g0, g1; unpack8(*(const u32x4*)(GATE + (size_t)tok * 1024 + col), g0, g1);
                        v0 *= g0; v1 *= g1;
                        if (MODE == 1) { f32x4 t0, t1; unpack8(*(const u32x4*)(YB + (size_t)tok * 1024 + col), t0, t1); v0 += t0; v1 += t1; }
                        *(u32x4*)(YB + (size_t)tok * 1024 + col) = pack8(v0, v1);
                    } else {
                        if (tok < TX) {
                            const float* gp = g1x + (tok >> 13) * 6144 + col; const f32x4 ga = *(const f32x4*)gp, gb = *(const f32x4*)(gp + 4);
                            const float* xp = xin + (size_t)tok * 1024 + col; float* op = XW + (size_t)tok * 1024 + col;
                            *(f32x4*)op = *(const f32x4*)xp + ga * v0; *(f32x4*)(op + 4) = *(const f32x4*)(xp + 4) + gb * v1;
                        } else {
                            const float* gp = g1c + col; const f32x4 ga = *(const f32x4*)gp, gb = *(const f32x4*)(gp + 4);
                            const float* xp = cin + (size_t)(tok - TX) * 1024 + col; float* op = CW + (size_t)(tok - TX) * 1024 + col;
                            *(f32x4*)op = *(const f32x4*)xp + ga * v0; *(f32x4*)(op + 4) = *(const f32x4*)(xp + 4) + gb * v1;
                        }
                    }
                } }
    }
};

struct MoeGuProb {
    static constexpr bool PERM = true, GATHER_A = true, I8 = true, F8 = false; typedef i32x4 Acc;
    struct U { int e, rt, pn, base, cnt; int tok[4]; };
    const signed char* H8; const signed char* W8; const float* sW; const float* lsc; const float* bgu; unsigned char* ACT; const int* list; const int* cnt;
    const volatile LAS int* tstart;
    int R, G, c;
    __device__ __forceinline__ bool get(int i, U& u) const {
        const int L = i * G + c; if (L >= R * 8) return false;
        int rt, pn; g8::order2d(L, R, 8, rt, pn);
        const int e = ((const volatile LAS unsigned char*)tstart)[(1024 - 64) + rt];
        u.e = __builtin_amdgcn_readfirstlane(e); u.rt = __builtin_amdgcn_readfirstlane(rt); u.pn = __builtin_amdgcn_readfirstlane(pn); u.base = __builtin_amdgcn_readfirstlane((rt - tstart[e]) * 256); u.cnt = __builtin_amdgcn_readfirstlane(cnt[e]);
        int R0, Rb0, C0; g8::lane_geom(threadIdx.x, R0, Rb0, C0);
#pragma unroll
        for (int j = 0; j < 4; ++j) { const int p = u.base + R0 + 64 * j; u.tok[j] = (p < u.cnt) ? list[(size_t)e * TT + p] : TT; }
        return true;
    }
    __device__ __forceinline__ void setup(const U& u, unsigned (&oa)[4], unsigned& ob, unsigned (&dA)[4], unsigned (&dB)[4], const char*& pA, const char*& pB, int& nt) const {
        int R0, Rb0, C0; g8::lane_geom(threadIdx.x, R0, Rb0, C0);
        nt = 8; pA = (const char*)H8; pB = (const char*)W8;
#pragma unroll
        for (int j = 0; j < 4; ++j) { dA[j] = 0u; dB[j] = (unsigned)(64 * j * 1024); oa[j] = (unsigned)(u.tok[j] * 1024 + C0 * 2); }
        ob = (unsigned)((u.e * 2048 + 256 * u.pn + Rb0) * 1024 + C0 * 2);
    }
    __device__ __forceinline__ void epi(const i32x4 (&acc)[2][2][4][2], const U& u, int wr, int wc, int fr, int fq) const {
        const int j0 = 128 * u.pn + 32 * wc + 8 * fq;
        const float* bp = bgu + (size_t)u.e * 2048 + j0;
        const f32x4 ba0 = *(const f32x4*)bp, ba1 = *(const f32x4*)(bp + 4), bu0 = *(const f32x4*)(bp + 1024), bu1 = *(const f32x4*)(bp + 1028);
        const float* sp = sW + (size_t)u.e * 2048 + 256 * u.pn + 32 * wc + 8 * fq;
        const f32x4 sa0 = *(const f32x4*)sp, sa1 = *(const f32x4*)(sp + 4), su0 = *(const f32x4*)(sp + 128), su1 = *(const f32x4*)(sp + 132);
#pragma unroll
        for (int ai = 0; ai < 2; ++ai)
#pragma unroll
            for (int m = 0; m < 4; ++m) { const int rr = G8_ROWS(ai, m); const size_t row = (size_t)256 * u.rt + rr;
                const int p = u.base + rr; const float rs = (p < u.cnt) ? lsc[(size_t)u.e * TT + p] : 0.0f;
                f32x4 a0, a1, u0, u1, y0, y1;
#pragma unroll
                for (int e = 0; e < 4; ++e) { a0[e] = (float)acc[ai][0][m][0][e] * rs * sa0[e] + ba0[e]; a1[e] = (float)acc[ai][0][m][1][e] * rs * sa1[e] + ba1[e];
                    u0[e] = (float)acc[ai][1][m][0][e] * rs * su0[e] + bu0[e]; u1[e] = (float)acc[ai][1][m][1][e] * rs * su1[e] + bu1[e]; }
#pragma unroll
                for (int e = 0; e < 4; ++e) {
                    float a = fminf(a0[e], 7.0f), uu = fminf(fmaxf(u0[e], -7.0f), 7.0f); y0[e] = a * sigmoidf_(1.702f * a) * (uu + 1.0f);
                    a = fminf(a1[e], 7.0f); uu = fminf(fmaxf(u1[e], -7.0f), 7.0f); y1[e] = a * sigmoidf_(1.702f * a) * (uu + 1.0f);
                }
                { u32x2 w; w.x = pk4_fp8(y0[0], y0[1], y0[2], y0[3]); w.y = pk4_fp8(y1[0], y1[1], y1[2], y1[3]); *(u32x2*)(ACT + row * 1024 + j0) = w; } }
    }
};
struct MoeDnProb {
    static constexpr bool PERM = true, GATHER_A = false, I8 = false, F8 = true; typedef f32x4 Acc;
    struct U { int e, rt, pn; };
    const unsigned char* ACT; const unsigned char* W; const float* bdn; bf16_t* YE;
    const volatile LAS int* tstart; int R, G, c;
    __device__ __forceinline__ bool get(int i, U& u) const {
        const int L = i * G + c; if (L >= R * 4) return false;
        int rt, pn; g8::order2d(L, R, 4, rt, pn);
        const int e = ((const volatile LAS unsigned char*)tstart)[(1024 - 64) + rt];
        u.e = __builtin_amdgcn_readfirstlane(e); u.rt = __builtin_amdgcn_readfirstlane(rt); u.pn = __builtin_amdgcn_readfirstlane(pn); return true;
    }
    __device__ __forceinline__ void setup(const U& u, unsigned (&oa)[4], unsigned& ob, unsigned (&dA)[4], unsigned (&dB)[4], const char*& pA, const char*& pB, int& nt) const {
        int R0, Rb0, C0; g8::lane_geom(threadIdx.x, R0, Rb0, C0);
        nt = 8; pA = (const char*)ACT; pB = (const char*)W;
#pragma unroll
        for (int j = 0; j < 4; ++j) { dA[j] = (unsigned)(64 * j * 1024); dB[j] = dA[j]; }
        oa[0] = (unsigned)((256 * u.rt + R0) * 1024 + C0 * 2); ob = (unsigned)((u.e * 1024 + 256 * u.pn + Rb0) * 1024 + C0 * 2);
    }
    __device__ __forceinline__ void epi(const f32x4 (&acc)[2][2][4][2], const U& u, int wr, int wc, int fr, int fq) const {
#pragma unroll
        for (int bj = 0; bj < 2; ++bj) { const int col = 256 * u.pn + G8_COL0(bj);
            const float* bp = bdn + (size_t)u.e * 1024 + col; const f32x4 b0 = *(const f32x4*)bp, b1 = *(const f32x4*)(bp + 4);
#pragma unroll
            for (int ai = 0; ai < 2; ++ai)
#pragma unroll
                for (int m = 0; m < 4; ++m) { const size_t row = (size_t)256 * u.rt + G8_ROWS(ai, m);
                    *(u32x4*)(YE + row * 1024 + col) = pack8(acc[ai][bj][m][0] * (1.0f / 32.0f) + b0, acc[ai][bj][m][1] * (1.0f / 32.0f) + b1); } }
    }
};

__device__ __forceinline__ int rope_perm(int d) { return (d & 32) | ((d & 15) << 1) | ((d >> 4) & 1); }
template <class RM>
__device__ __forceinline__ void transpose_tile(const Fr& F, const float* src, int N, int k0, int n0, bf16_t* dst, int Kd, RM rm) {
    LAS unsigned char* lds = F.lds;
    const int tid = F.tid;
    { const int kq = tid >> 4, c4 = (tid & 15) * 4; f32x4 v[4];
#pragma unroll
      for (int r = 0; r < 4; ++r) v[r] = *(const f32x4*)(src + (size_t)(k0 + 4 * kq + r) * N + n0 + c4);
#pragma unroll
      for (int e = 0; e < 4; ++e) { u32x2 w; w.x = cvt_pk_bf16(v[0][e], v[1][e]); w.y = cvt_pk_bf16(v[2][e], v[3][e]); *(LAS u32x2*)(lds + (c4 + e) * 272 + kq * 8) = w; } }
    __syncthreads();
    { const int n = tid >> 3, ch = tid & 7; const u32x4 w0 = *(const LAS u32x4*)(lds + n * 272 + ch * 32), w1 = *(const LAS u32x4*)(lds + n * 272 + ch * 32 + 16);
      bf16_t* dp = dst + (size_t)rm(n0 + n) * Kd + k0 + ch * 16; *(u32x4*)dp = w0; *(u32x4*)(dp + 8) = w1; }
    __syncthreads();
}
__device__ __forceinline__ void transpose_tile_fp8(const Fr& F, const float* src, int k0, int n0, unsigned char* dst) {
    LAS unsigned char* lds = F.lds;
    const int tid = F.tid;
    { const int kq = tid >> 4, c4 = (tid & 15) * 4; f32x4 v[4];
#pragma unroll
      for (int r = 0; r < 4; ++r) v[r] = *(const f32x4*)(src + (size_t)(k0 + 4 * kq + r) * 1024 + n0 + c4) * 32.0f;
#pragma unroll
      for (int e = 0; e < 4; ++e) *(LAS unsigned*)(lds + (c4 + e) * 144 + kq * 4) = pk4_fp8(v[0][e], v[1][e], v[2][e], v[3][e]); }
    __syncthreads();
    { const int n = tid >> 3, ch = tid & 7; const u32x4 w = *(const LAS u32x4*)(lds + n * 144 + ch * 16);
      *(u32x4*)(dst + (size_t)(n0 + n) * 1024 + k0 + ch * 16) = w; }
    __syncthreads();
}
__device__ __forceinline__ void quant_wgu_strip(const Fr& F, const float* src, int n0, signed char* dst, float* sdst) {
    LAS unsigned char* lds = F.lds;
    LAS float* red = (LAS float*)(lds + 16384);
    LAS float* inv = (LAS float*)(lds + 16384 + 8192);
    const int tid = F.tid, kq = tid >> 4, c4 = (tid & 15) * 4;
    f32x4 mx = {0.f, 0.f, 0.f, 0.f};
#pragma unroll 4
    for (int k = kq; k < 1024; k += 32) { const f32x4 v = *(const f32x4*)(src + (size_t)k * 2048 + n0 + c4);
#pragma unroll
        for (int e = 0; e < 4; ++e) mx[e] = fmaxf(mx[e], fabsf(v[e])); }
#pragma unroll
    for (int e = 0; e < 4; ++e) red[kq * 64 + c4 + e] = mx[e];
    __syncthreads();
    if (tid < 64) { float m = 0.f;
#pragma unroll
        for (int r = 0; r < 32; ++r) m = fmaxf(m, red[r * 64 + tid]);
        const int n = n0 + tid, bj = n >> 10, j = n & 1023; const int row = 256 * (j >> 7) + 128 * bj + (j & 127);
        sdst[row] = m * (1.0f / 127.0f); inv[tid] = m > 0.f ? 127.0f / m : 0.f; }
    __syncthreads();
    const f32x4 iv = *(const LAS f32x4*)(inv + c4);
#pragma unroll 1
    for (int kt = 0; kt < 8; ++kt) { f32x4 v[4];
#pragma unroll
        for (int r = 0; r < 4; ++r) v[r] = *(const f32x4*)(src + (size_t)(kt * 128 + 4 * kq + r) * 2048 + n0 + c4);
#pragma unroll
        for (int e = 0; e < 4; ++e) { const int q0 = __float2int_rn(v[0][e] * iv[e]), q1 = __float2int_rn(v[1][e] * iv[e]), q2 = __float2int_rn(v[2][e] * iv[e]), q3 = __float2int_rn(v[3][e] * iv[e]);
            *(LAS unsigned*)(lds + (c4 + e) * 144 + kq * 4) = (unsigned)(q0 & 255) | ((unsigned)(q1 & 255) << 8) | ((unsigned)(q2 & 255) << 16) | ((unsigned)(q3 & 255) << 24); }
        __syncthreads();
        { const int nl = tid >> 3, ch = tid & 7; const u32x4 w = *(const LAS u32x4*)(lds + nl * 144 + ch * 16);
          const int n = n0 + nl, bj = n >> 10, j = n & 1023; const int row = 256 * (j >> 7) + 128 * bj + (j & 127);
          *(u32x4*)(dst + (size_t)row * 1024 + kt * 128 + ch * 16) = w; }
        __syncthreads();
    }
}
struct RmId { __device__ int operator()(int n) const { return n; } };
struct RmWin { __device__ int operator()(int n) const { return (n >= 512 && n < 1152) ? ((n & ~63) | rope_perm(n & 63)) : n; } };

__device__ __forceinline__ void prologue_phase(const Fr& F) {
    const int tid = F.tid, G = F.G, bid = F.bid;
    const float PI2 = 6.283185307179586f;
    const size_t gtid = (size_t)bid * 512 + tid, gsz = (size_t)G * 512;
    { float* rope = WSP(float, WS_ROPE);
      for (size_t i = gtid; i < 2048; i += gsz) { const int pos = (int)(i >> 4), f = (int)(i & 15); const float inv = powf(10000.0f, -(float)f / 16.0f); const float a = (float)pos * inv; rope[i] = cosf(a); rope[2048 + i] = sinf(a); } }
    { bf16_t* W1 = WSP(bf16_t, WS_W1);
      for (size_t i = gtid; i < 256 * 128; i += gsz) { const int r = (int)(i >> 7), n1 = (int)(i & 127); float v = 0.f;
          if (r < 128) { const int k1p = r >> 1, part = r & 1;
              if (part == 0) v = cospif((float)((k1p * n1) & 127) / 64.0f);
              else if (k1p == 0) v = (n1 & 1) ? -1.0f : 1.0f;
              else v = -sinpif((float)((k1p * n1) & 127) / 64.0f); }
          W1[i] = f2bf(v); } }
    { bf16_t* MT = WSP(bf16_t, WS_MT);
      for (size_t i = gtid; i < (size_t)64 * 256 * 128; i += gsz) {
          const int kk = (int)(i & 127), r = (int)((i >> 7) & 255), k1p = (int)(i >> 15);
          const int part = kk >> 6, n2 = kk & 63, s = r >> 7, k2 = (r & 127) >> 1, reim = r & 1;
          float v;
          if (k1p == 0) { const int k = 64 * s + 128 * k2; const int mm = (n2 * k) & 8191; const float cm = cospif((float)mm / 4096.0f), sm = sinpif((float)mm / 4096.0f);
              v = (part == s) ? (reim ? -sm : cm) : 0.0f; }
          else { const int k = (s ? 128 - k1p : k1p) + 128 * k2; const int mm = (n2 * k) & 8191; const float cm = cospif((float)mm / 4096.0f), sm = sinpif((float)mm / 4096.0f);
              if (s == 0) v = reim ? (part ? cm : -sm) : (part ? sm : cm);
              else        v = reim ? (part ? -cm : -sm) : (part ? -sm : cm); }
          MT[i] = f2bf(v); } }
    { bf16_t* WC = WSP(bf16_t, WS_WC);
      const float sc = 5.656854249492381f;
      for (size_t i = gtid; i < 512 * 256; i += gsz) { const int n = (int)(i & 255), r = (int)(i >> 8), k = r >> 1, reim = r & 1; const int mm = (k * n) & 255;
          WC[i] = f2bf(sc * (reim ? -sinpif((float)mm / 128.0f) : cospif((float)mm / 128.0f))); } }
    { bf16_t* RWT = WSP(bf16_t, WS_RWT); const float* rw = INP(13);
      for (size_t i = gtid; i < (size_t)DEPTH * 32 * 1024; i += gsz) { const int k = (int)(i & 1023), e = (int)((i >> 10) & 31), l = (int)(i >> 15); RWT[i] = f2bf(rw[((size_t)l * 1024 + k) * 32 + e]); } }
    { bf16_t* H = WSP(bf16_t, WS_H); for (size_t i = gtid; i < 256 * 1024; i += gsz) H[(size_t)TT * 1024 + i] = 0;
      unsigned* H8z = (unsigned*)(WSP(signed char, WS_H8) + (size_t)TT * 1024); for (size_t i = gtid; i < 256 * 256; i += gsz) H8z[i] = 0u; }
    (void)PI2;
    {
        LAS float* sil = (LAS float*)(F.lds + 65536);
        LAS float* red = (LAS float*)(F.lds + 65536 + 20480);
        for (int i = tid; i < 5 * 1024; i += 512) { const int v = i >> 10, k = i & 1023; const float x = (v < 4) ? INP(1)[v * 1024 + k] : INP(3)[k]; sil[i] = x * sigmoidf_(x); }
        __syncthreads();
        float* MOD = WSP(float, WS_MOD);
        for (int u = bid; u < DEPTH * 96; u += G) {
            const int l = u / 96, j0 = (u % 96) * 64;
            const float* aw = INP(4) + (size_t)l * 1024 * 6144 + j0 + F.lane;
            float a0 = 0.f, a1 = 0.f, a2 = 0.f, a3 = 0.f, a4 = 0.f;
            for (int kk = 0; kk < 128; ++kk) { const int k = F.wave * 128 + kk; const float w = aw[(size_t)k * 6144];
                a0 += sil[k] * w; a1 += sil[1024 + k] * w; a2 += sil[2048 + k] * w; a3 += sil[3072 + k] * w; a4 += sil[4096 + k] * w; }
            red[(F.wave * 5 + 0) * 64 + F.lane] = a0; red[(F.wave * 5 + 1) * 64 + F.lane] = a1; red[(F.wave * 5 + 2) * 64 + F.lane] = a2; red[(F.wave * 5 + 3) * 64 + F.lane] = a3; red[(F.wave * 5 + 4) * 64 + F.lane] = a4;
            __syncthreads();
            if (tid < 320) { const int v = tid >> 6, jl = tid & 63; float s = INP(5)[(size_t)l * 6144 + j0 + jl];
#pragma unroll
                for (int w = 0; w < 8; ++w) s += red[(w * 5 + v) * 64 + jl];
                MOD[((size_t)l * 5 + v) * 6144 + j0 + jl] = s; }
            __syncthreads();
        }
    }
    {
        LAS float* tab = (LAS float*)(F.lds + 65536);
        if (tid < 128) { tab[tid] = cospif((float)tid / 64.0f); tab[128 + tid] = sinpif((float)tid / 64.0f); }
        __syncthreads();
        bf16_t* WFO = WSP(bf16_t, WS_WFO);
        for (int u = bid; u < DEPTH * 4 * 2 * 16; u += G) {
            const int dc = u & 15, reim = (u >> 4) & 1, g = (u >> 5) & 3, l = u >> 7;
            const float* wf = INP(10) + ((size_t)l * 512 + g * 128) * 1024;
#pragma unroll 1
            for (int oh = 0; oh < 2; ++oh) { const int o = tid + 512 * oh;
                float a[8] = {0.f, 0.f, 0.f, 0.f, 0.f, 0.f, 0.f, 0.f};
                for (int j = 0; j < 128; ++j) { const float w = wf[(size_t)j * 1024 + o];
#pragma unroll
                    for (int q = 0; q < 8; ++q) a[q] += tab[reim * 128 + ((j * (dc * 8 + q)) & 127)] * w; }
                u32x4 w4; w4.x = cvt_pk_bf16(a[0] * (1.f / 1024.f), a[1] * (1.f / 1024.f)); w4.y = cvt_pk_bf16(a[2] * (1.f / 1024.f), a[3] * (1.f / 1024.f));
                w4.z = cvt_pk_bf16(a[4] * (1.f / 1024.f), a[5] * (1.f / 1024.f)); w4.w = cvt_pk_bf16(a[6] * (1.f / 1024.f), a[7] * (1.f / 1024.f));
                *(u32x4*)(WFO + ((size_t)l * 1024 + o) * 1024 + g * 256 + reim * 128 + dc * 8) = w4; }
        }
        __syncthreads();
    }
    {
        constexpr int T_WIN = DEPTH * 8 * 52, T_WAO = DEPTH * 4 * 16, T_WOUT = DEPTH * 8 * 16, T_DN = DEPTH * 32 * 8 * 16, T_GU = DEPTH * 32 * 32;
        constexpr int T_ALL = T_GU + T_DN + T_WIN + T_WAO + T_WOUT;
        for (int t = bid; t < T_ALL; t += G) {
            int q = t;
            if (q < T_GU) { const int le = q >> 5, ns = q & 31;
                quant_wgu_strip(F, INP(15) + (size_t)le * 1024 * 2048, ns * 64, WSP(signed char, WS_WGU) + (size_t)le * 2048 * 1024, WSP(float, WS_SWGU) + (size_t)le * 2048); continue; }
            q -= T_GU;
            if (q < T_DN) { const int le = q / 128, r = q % 128, kt = r / 16, ntl = r % 16;
                transpose_tile_fp8(F, INP(17) + (size_t)le * 1024 * 1024, kt * 128, ntl * 64, WSP(unsigned char, WS_WDN) + (size_t)le * 1024 * 1024); continue; }
            q -= T_DN;
            if (q < T_WIN) { const int l = q / (8 * 52), r = q % (8 * 52), kt = r / 52, ntl = r % 52;
                transpose_tile(F, INP(8) + (size_t)l * 1024 * IN_DIM, IN_DIM, kt * 128, ntl * 64, WSP(bf16_t, WS_WIN) + (size_t)l * IN_DIM * 1024, 1024, RmWin()); continue; }
            q -= T_WIN;
            if (q < T_WAO) { const int l = q / 64, r = q % 64, kt = r / 16, ntl = r % 16;
                transpose_tile(F, INP(11) + (size_t)l * 512 * 1024, 1024, kt * 128, ntl * 64, WSP(bf16_t, WS_WAO) + (size_t)l * 1024 * 512, 512, RmId()); continue; }
            q -= T_WAO;
            { const int l = q / 128, r = q % 128, kt = r / 16, ntl = r % 16;
                transpose_tile(F, INP(12) + (size_t)l * 1024 * 1024, 1024, kt * 128, ntl * 64, WSP(bf16_t, WS_WOUT) + (size_t)l * 1024 * 1024, 1024, RmId()); }
        }
    }
}

__device__ __forceinline__ void moe_combine(const Fr& F, int tok, int lprev, const volatile LAS int* tstart, f32x4 (&m)[4]) {
    const int* slot = WSP(int, WS_SLOT); const float* gate = WSP(float, WS_GATE); const bf16_t* YE = WSP(bf16_t, WS_YE);
#pragma unroll
    for (int j = 0; j < 4; ++j) m[j] = (f32x4){0.f, 0.f, 0.f, 0.f};
#pragma unroll
    for (int k = 0; k < 4; ++k) {
        const int sl = slot[tok * 4 + k]; const float gk = gate[tok * 4 + k];
        const int e = sl >> 20, pos = sl & 0xfffff;
        const size_t row = (size_t)256 * tstart[e] + pos;
        const bf16_t* yp = YE + row * 1024 + 4 * F.lane;
#pragma unroll
        for (int j = 0; j < 4; ++j) { const u32x2 w = *(const u32x2*)(yp + 256 * j); m[j][0] += gk * bf_lo(w.x); m[j][1] += gk * bf_hi(w.x); m[j][2] += gk * bf_lo(w.y); m[j][3] += gk * bf_hi(w.y); }
    }
    (void)lprev;
}
__device__ __forceinline__ int fill_tstart(const Fr& F, int l) {
    volatile LAS int* ts = (volatile LAS int*)(F.lds + LDS_MISC + 64);
    __syncthreads();
    if (F.tid == 0) { const int* cnt = (const int*)(F.ws + WS_CTL + CTL_CNT) + l * 32; int s = 0; for (int e = 0; e < 32; ++e) { ts[e] = s; s += (cnt[e] + 255) >> 8; } ts[32] = s; }
    __syncthreads();
    { volatile LAS unsigned char* r2e = (volatile LAS unsigned char*)(F.lds + LDS_MISC + 1024);
      const int R = ts[32];
      for (int rt = F.tid; rt < R; rt += 512) { int e = 0;
#pragma unroll 1
          for (int q = 1; q < 32; ++q) e = (ts[q] <= rt) ? q : e;
          r2e[rt] = (unsigned char)e; } }
    __syncthreads();
    return ts[32];
}

__device__ __forceinline__ void norm1_phase(const Fr& F, int l) {
    const volatile LAS int* tstart = (const volatile LAS int*)(F.lds + LDS_MISC + 64);
    if (l > 0) fill_tstart(F, l - 1);
    const float* MOD = WSP(float, WS_MOD);
    const bool fin = (l == DEPTH);
    const int ntok = fin ? TX : TT;
    const bool tmo = fin && (xb_ld((unsigned*)(F.ws + WS_CTL) + XB_TMO) != 0u);
    const float* gvec = fin ? INP(19) : INP(6) + (size_t)l * 1024;
    float* XW = WSP(float, WS_XW); float* CW = WSP(float, WS_CW); bf16_t* H = WSP(bf16_t, WS_H);
    for (int tok = F.bid * 8 + F.wave; tok < ntok; tok += F.G * 8) {
        const bool isx = tok < TX; const int v = isx ? (tok >> 13) : 4;
        const float* src = (l == 0) ? (isx ? INP(0) + (size_t)tok * 1024 : INP(2) + (size_t)(tok - TX) * 1024) : (isx ? XW + (size_t)tok * 1024 : CW + (size_t)(tok - TX) * 1024);
        f32x4 x[4];
#pragma unroll
        for (int j = 0; j < 4; ++j) x[j] = *(const f32x4*)(src + 256 * j + 4 * F.lane);
        if (l > 0) {
            f32x4 mm[4]; moe_combine(F, tok, l - 1, tstart, mm);
            const float* g2 = MOD + ((size_t)(l - 1) * 5 + v) * 6144 + 5 * 1024;
            float* dst = isx ? XW + (size_t)tok * 1024 : CW + (size_t)(tok - TX) * 1024;
#pragma unroll
            for (int j = 0; j < 4; ++j) { x[j] += *(const f32x4*)(g2 + 256 * j + 4 * F.lane) * mm[j]; if (!fin) *(f32x4*)(dst + 256 * j + 4 * F.lane) = x[j]; }
        }
        float ss = 0.f;
#pragma unroll
        for (int j = 0; j < 4; ++j) ss += x[j][0] * x[j][0] + x[j][1] * x[j][1] + x[j][2] * x[j][2] + x[j][3] * x[j][3];
        ss = wave_sum(ss);
        const float rstd = rsqrtf(ss * (1.0f / 1024.0f) + EPS);
        if (fin) {
#pragma unroll
            for (int j = 0; j < 4; ++j) { const f32x4 g = *(const f32x4*)(gvec + 256 * j + 4 * F.lane); *(f32x4*)(F.out + (size_t)tok * 1024 + 256 * j + 4 * F.lane) = tmo ? (f32x4){__builtin_nanf(""), __builtin_nanf(""), __builtin_nanf(""), __builtin_nanf("")} : x[j] * rstd * g; }
        } else {
            const float* md = MOD + ((size_t)l * 5 + v) * 6144;
#pragma unroll
            for (int j = 0; j < 4; ++j) { const int c = 256 * j + 4 * F.lane; const f32x4 g = *(const f32x4*)(gvec + c), sh = *(const f32x4*)(md + c), sc = *(const f32x4*)(md + 1024 + c);
                const f32x4 y = x[j] * rstd * g * (sc + 1.0f) + sh;
                u32x2 w; w.x = cvt_pk_bf16(y[0], y[1]); w.y = cvt_pk_bf16(y[2], y[3]); *(u32x2*)(H + (size_t)tok * 1024 + c) = w; }
        }
    }
}

__device__ __forceinline__ void norm2_router_phase(const Fr& F, int l, bool fake = false) {
    const int ntok = (l == DEPTH - 1) ? TX : TT;
    const float* MOD = WSP(float, WS_MOD); const float* gvec = INP(7) + (size_t)l * 1024;
    const float* XW = WSP(float, WS_XW); const float* CW = WSP(float, WS_CW); bf16_t* H = WSP(bf16_t, WS_H);
    const bf16_t* RWT = WSP(bf16_t, WS_RWT) + (size_t)l * 32 * 1024; const float* rb = INP(14) + l * 32;
    int* cntg = (int*)(F.ws + WS_CTL + CTL_CNT) + l * 32; int* list = WSP(int, WS_LIST); int* slot = WSP(int, WS_SLOT); float* gate = WSP(float, WS_GATE);
    LAS unsigned char* hs = F.lds;
    LAS float* part = (LAS float*)(F.lds + 69632);
    LAS float* logit = (LAS float*)(F.lds + 69632 + 36864);
    LAS int* lcnt = (LAS int*)(F.lds + 69632 + 36864 + 4608);
    LAS int* lbase = lcnt + 32;
    LAS float* tsc = (LAS float*)(lbase + 32);
    signed char* H8 = WSP(signed char, WS_H8); float* lscg = WSP(float, WS_LSC);
    const int lane = F.lane, w = F.wave, l32 = lane & 31, hh = lane >> 5;
    for (int tl = F.bid; tl < ntok / 32; tl += F.G) {
        const int t0 = tl * 32;
        if (F.tid < 32) lcnt[F.tid] = 0;
#pragma unroll 1
        for (int q = 0; q < 4; ++q) {
            const int tloc = 4 * w + q, tok = t0 + tloc; const bool isx = tok < TX; const int v = isx ? (tok >> 13) : 4;
            const float* src = isx ? XW + (size_t)tok * 1024 : CW + (size_t)(tok - TX) * 1024;
            f32x4 x[4]; float ss = 0.f;
#pragma unroll
            for (int j = 0; j < 4; ++j) { x[j] = *(const f32x4*)(src + 256 * j + 4 * lane); ss += x[j][0] * x[j][0] + x[j][1] * x[j][1] + x[j][2] * x[j][2] + x[j][3] * x[j][3]; }
            ss = wave_sum(ss); const float rstd = rsqrtf(ss * (1.0f / 1024.0f) + EPS);
            const float* md = MOD + ((size_t)l * 5 + v) * 6144;
            float amax = 0.f;
#pragma unroll
            for (int j = 0; j < 4; ++j) { const int c = 256 * j + 4 * lane; const f32x4 g = *(const f32x4*)(gvec + c), sh = *(const f32x4*)(md + 3072 + c), sc = *(const f32x4*)(md + 4096 + c);
                x[j] = x[j] * rstd * g * (sc + 1.0f) + sh;
                amax = fmaxf(amax, fmaxf(fmaxf(fabsf(x[j][0]), fabsf(x[j][1])), fmaxf(fabsf(x[j][2]), fabsf(x[j][3]))));
                u32x2 wv; wv.x = cvt_pk_bf16(x[j][0], x[j][1]); wv.y = cvt_pk_bf16(x[j][2], x[j][3]);
                *(LAS u32x2*)(hs + tloc * 2064 + c * 2) = wv; }
#pragma unroll
            for (int o = 32; o >= 1; o >>= 1) amax = fmaxf(amax, __shfl_xor(amax, o));
            const float inv = amax > 0.f ? 127.0f / amax : 0.f;
#pragma unroll
            for (int j = 0; j < 4; ++j) { const int c = 256 * j + 4 * lane;
                const int q0 = __float2int_rn(x[j][0] * inv), q1 = __float2int_rn(x[j][1] * inv), q2 = __float2int_rn(x[j][2] * inv), q3 = __float2int_rn(x[j][3] * inv);
                *(unsigned*)(H8 + (size_t)tok * 1024 + c) = (unsigned)(q0 & 255) | ((unsigned)(q1 & 255) << 8) | ((unsigned)(q2 & 255) << 16) | ((unsigned)(q3 & 255) << 24); }
            if (lane == 0) tsc[tloc] = amax * (1.0f / 127.0f);
        }
        __syncthreads();
        {
            f32x16 acc;
#pragma unroll
            for (int e = 0; e < 16; ++e) acc[e] = 0.f;
#pragma unroll
            for (int s = 0; s < 8; ++s) { const int k = 128 * w + 16 * s + 8 * hh;
                const bf16x8 a = *(const LAS bf16x8*)(hs + l32 * 2064 + k * 2);
                const bf16x8 b = *(const bf16x8*)(RWT + (size_t)l32 * 1024 + k);
                acc = __builtin_amdgcn_mfma_f32_32x32x16_bf16(a, b, acc, 0, 0, 0); }
#pragma unroll
            for (int e = 0; e < 16; ++e) { const int trow = 8 * (e >> 2) + 4 * hh + (e & 3); part[(w * 32 + trow) * 33 + l32] = acc[e]; }
        }
        __syncthreads();
        { const int tr = F.tid >> 4, e0 = (F.tid & 15) * 2;
#pragma unroll
          for (int q = 0; q < 2; ++q) { float s = rb[e0 + q];
#pragma unroll
              for (int ww = 0; ww < 8; ++ww) s += part[(ww * 32 + tr) * 33 + e0 + q];
              logit[tr * 33 + e0 + q] = s; } }
        __syncthreads();
        int es[4], rk[4]; float gs[4];
        if (fake) { __syncthreads(); continue; }
        if (F.tid < 32) {
            float lv[4]; unsigned used = 0u;
#pragma unroll
            for (int k = 0; k < 4; ++k) { float best = -3.0e38f; int bi = 0;
#pragma unroll 1
                for (int e = 0; e < 32; ++e) { const float vv = logit[F.tid * 33 + e]; if (!((used >> e) & 1u) && vv > best) { best = vv; bi = e; } }
                used |= 1u << bi; es[k] = bi; lv[k] = best; }
            const float mx = lv[0]; float sum = 0.f;
#pragma unroll
            for (int k = 0; k < 4; ++k) { gs[k] = __expf(lv[k] - mx); sum += gs[k]; }
#pragma unroll
            for (int k = 0; k < 4; ++k) { gs[k] /= sum; rk[k] = __hip_atomic_fetch_add(&lcnt[es[k]], 1, __ATOMIC_RELAXED, __HIP_MEMORY_SCOPE_WORKGROUP); }
        }
        __syncthreads();
        if (F.tid < 32) { const int n = lcnt[F.tid]; lbase[F.tid] = n ? atomicAdd(&cntg[F.tid], n) : 0; }
        __syncthreads();
        if (F.tid < 32) { const int tok = t0 + F.tid;
#pragma unroll
            for (int k = 0; k < 4; ++k) { const int pos = lbase[es[k]] + rk[k]; list[(size_t)es[k] * TT + pos] = tok; lscg[(size_t)es[k] * TT + pos] = tsc[F.tid]; slot[tok * 4 + k] = (es[k] << 20) | pos; gate[tok * 4 + k] = gs[k]; } }
        __syncthreads();
    }
}

template <int OFF> __device__ __forceinline__ s16x4 tr_read(unsigned vb) { s16x4 r; asm volatile("ds_read_b64_tr_b16 %0, %1 offset:%2" : "=&v"(r) : "v"(vb), "i"(OFF) : "memory"); return r; }

__device__ __forceinline__ void attn_phase(const Fr& F, int l, bool with_ctx) {
    LAS unsigned char* lds = F.lds;
    const unsigned ldsb = (unsigned)(uintptr_t)lds;
    const bf16_t* Q = WSP(bf16_t, WS_Q); const bf16_t* Kb = WSP(bf16_t, WS_K); const bf16_t* Vb = WSP(bf16_t, WS_V); bf16_t* AO = WSP(bf16_t, WS_AO);
    const int tid = F.tid, lane = F.lane, w = F.wave, l32 = lane & 31, hh = lane >> 5;
    const int g = w >> 1, rhalf = w & 1;
    const int nunits = 512 + (with_ctx ? 16 : 0);
    const int skey = tid >> 3, sch = tid & 7;
    const unsigned k_st = (unsigned)(skey * 128 + ((sch ^ ((skey >> 1) & 7)) * 16));
    const unsigned v_st = (unsigned)(8192 + skey * 128 + ((((sch >> 1) ^ (((skey >> 1) & 1) << 1)) * 32) + (sch & 1) * 16));
    unsigned vbase[2];
    { const int li = lane & 15, q = li >> 2, p = li & 3, g16 = l32 >> 4; const int key = 4 * hh + q;
#pragma unroll
      for (int db = 0; db < 2; ++db) { const int c32 = 2 * db + g16; vbase[db] = ldsb + 8192u + (unsigned)(key * 128 + ((c32 ^ (((key >> 1) & 1) << 1)) * 32) + 8 * p); } }
    for (int u = F.bid; u < nunits; u += F.G) {
        int b, qb, kvh; bool isctx;
        if (u < 512) { b = u >> 7; qb = (u >> 1) & 63; kvh = u & 1; isctx = false; }
        else { const int uu = u - 512; b = uu >> 2; qb = (uu >> 1) & 1; kvh = uu & 1; isctx = true; }
        const int head = kvh * 4 + g;
        const int qtok0 = isctx ? (TX + b * LC + qb * 128) : (b * SEQ + qb * 128);
        bf16x8 qf[2][4];
#pragma unroll
        for (int qk = 0; qk < 2; ++qk)
#pragma unroll
            for (int s = 0; s < 4; ++s) qf[qk][s] = *(const bf16x8*)(Q + (size_t)(qtok0 + rhalf * 64 + qk * 32 + l32) * 512 + head * 64 + 16 * s + 8 * hh);
        const float sink2 = INP(9)[l * 8 + head] * LOG2E;
        float m_run[2] = {sink2, sink2}, l_run[2] = {hh ? 0.f : 1.f, hh ? 0.f : 1.f};
        f32x16 O[2][2];
#pragma unroll
        for (int a = 0; a < 2; ++a)
#pragma unroll
            for (int c = 0; c < 2; ++c)
#pragma unroll
                for (int e = 0; e < 16; ++e) O[a][c][e] = 0.f;
        int t = isctx ? 6 : (qb == 0 ? 2 : 0);
        u32x4 kreg, vreg;
        { const int tok0 = (t < 6) ? (b * SEQ + (qb - 1) * 128 + 64 * t) : (TX + b * LC + 64 * (t - 6));
          kreg = *(const u32x4*)(Kb + (size_t)(tok0 + skey) * 128 + kvh * 64 + sch * 8); vreg = *(const u32x4*)(Vb + (size_t)(tok0 + skey) * 128 + kvh * 64 + sch * 8); }
        for (;;) {
            __syncthreads();
            *(LAS u32x4*)(lds + k_st) = kreg; *(LAS u32x4*)(lds + v_st) = vreg;
            int tn = t + 1; if (!isctx && qb == 63 && (tn == 4 || tn == 5)) tn = 6;
            const bool more = tn < 10;
            if (more) { const int tok0 = (tn < 6) ? (b * SEQ + (qb - 1) * 128 + 64 * tn) : (TX + b * LC + 64 * (tn - 6));
                kreg = *(const u32x4*)(Kb + (size_t)(tok0 + skey) * 128 + kvh * 64 + sch * 8); vreg = *(const u32x4*)(Vb + (size_t)(tok0 + skey) * 128 + kvh * 64 + sch * 8); }
            __syncthreads();
            const bool local = (!isctx) && (t < 6);
            const bool skip = local && ((rhalf == 0 && t == 5) || (rhalf == 1 && t == 0));
            if (!skip) {
                f32x16 S[2][2];
#pragma unroll
                for (int kb = 0; kb < 2; ++kb)
#pragma unroll
                    for (int qk = 0; qk < 2; ++qk)
#pragma unroll
                        for (int e = 0; e < 16; ++e) S[kb][qk][e] = 0.f;
#pragma unroll
                for (int kb = 0; kb < 2; ++kb)
#pragma unroll
                    for (int s = 0; s < 4; ++s) { const int key = 32 * kb + l32, ch = 2 * s + hh;
                        const bf16x8 kf = *(const LAS bf16x8*)(lds + key * 128 + ((ch ^ ((key >> 1) & 7)) * 16));
#pragma unroll
                        for (int qk = 0; qk < 2; ++qk) S[kb][qk] = __builtin_amdgcn_mfma_f32_32x32x16_bf16(kf, qf[qk][s], S[kb][qk], 0, 0, 0); }
                bf16x8 pf[2][2][2];
#pragma unroll
                for (int qk = 0; qk < 2; ++qk) {
                    if (local) { const int rq = rhalf * 64 + qk * 32 + l32;
#pragma unroll
                        for (int kb = 0; kb < 2; ++kb)
#pragma unroll
                            for (int e = 0; e < 16; ++e) { const int kk = 64 * t + 32 * kb + 8 * (e >> 2) + 4 * hh + (e & 3); const int rel = kk - 128 - rq; if (rel < -128 || rel > 128) S[kb][qk][e] = -__builtin_inff(); } }
                    float mx = -__builtin_inff();
#pragma unroll
                    for (int kb = 0; kb < 2; ++kb)
#pragma unroll
                        for (int e = 0; e < 16; ++e) mx = fmaxf(mx, S[kb][qk][e]);
                    mx = fmaxf(mx, __shfl_xor(mx, 32));
                    const float mn = fmaxf(m_run[qk], mx); const float alpha = __builtin_amdgcn_exp2f(m_run[qk] - mn); m_run[qk] = mn;
                    float rs = 0.f;
#pragma unroll
                    for (int kb = 0; kb < 2; ++kb)
#pragma unroll
                        for (int e = 0; e < 16; ++e) { const float p = __builtin_amdgcn_exp2f(S[kb][qk][e] - mn); S[kb][qk][e] = p; rs += p; }
                    l_run[qk] = l_run[qk] * alpha + rs;
#pragma unroll
                    for (int db = 0; db < 2; ++db)
#pragma unroll
                        for (int e = 0; e < 16; ++e) O[db][qk][e] *= alpha;
#pragma unroll
                    for (int kb = 0; kb < 2; ++kb)
#pragma unroll
                        for (int sp = 0; sp < 2; ++sp) { u32x4 pw;
                            pw.x = cvt_pk_bf16(S[kb][qk][8 * sp + 0], S[kb][qk][8 * sp + 1]); pw.y = cvt_pk_bf16(S[kb][qk][8 * sp + 2], S[kb][qk][8 * sp + 3]);
                            pw.z = cvt_pk_bf16(S[kb][qk][8 * sp + 4], S[kb][qk][8 * sp + 5]); pw.w = cvt_pk_bf16(S[kb][qk][8 * sp + 6], S[kb][qk][8 * sp + 7]);
                            pf[kb][sp][qk] = __builtin_bit_cast(bf16x8, pw); }
                }
#define PV_STEP(KB, SP) do { \
                    const s16x4 a0 = tr_read<((32 * (KB) + 16 * (SP)) * 128)>(vbase[0]), a1 = tr_read<((32 * (KB) + 16 * (SP) + 8) * 128)>(vbase[0]); \
                    const s16x4 c0 = tr_read<((32 * (KB) + 16 * (SP)) * 128)>(vbase[1]), c1 = tr_read<((32 * (KB) + 16 * (SP) + 8) * 128)>(vbase[1]); \
                    asm volatile("s_waitcnt lgkmcnt(0)" ::: "memory"); __builtin_amdgcn_sched_barrier(0); \
                    const bf16x8 vf0 = (bf16x8){a0[0], a0[1], a0[2], a0[3], a1[0], a1[1], a1[2], a1[3]}, vf1 = (bf16x8){c0[0], c0[1], c0[2], c0[3], c1[0], c1[1], c1[2], c1[3]}; \
                    O[0][0] = __builtin_amdgcn_mfma_f32_32x32x16_bf16(vf0, pf[KB][SP][0], O[0][0], 0, 0, 0); O[0][1] = __builtin_amdgcn_mfma_f32_32x32x16_bf16(vf0, pf[KB][SP][1], O[0][1], 0, 0, 0); \
                    O[1][0] = __builtin_amdgcn_mfma_f32_32x32x16_bf16(vf1, pf[KB][SP][0], O[1][0], 0, 0, 0); O[1][1] = __builtin_amdgcn_mfma_f32_32x32x16_bf16(vf1, pf[KB][SP][1], O[1][1], 0, 0, 0); } while (0)
                PV_STEP(0, 0); PV_STEP(0, 1); PV_STEP(1, 0); PV_STEP(1, 1);
#undef PV_STEP
            }
            if (!more) break;
            t = tn;
        }
#pragma unroll
        for (int qk = 0; qk < 2; ++qk) {
            const float lt = l_run[qk] + __shfl_xor(l_run[qk], 32); const float inv = 1.0f / lt;
            const size_t tok = (size_t)(qtok0 + rhalf * 64 + qk * 32 + l32);
#pragma unroll
            for (int db = 0; db < 2; ++db)
#pragma unroll
                for (int vq = 0; vq < 4; ++vq) { u32x2 wv; wv.x = cvt_pk_bf16(O[db][qk][4 * vq] * inv, O[db][qk][4 * vq + 1] * inv); wv.y = cvt_pk_bf16(O[db][qk][4 * vq + 2] * inv, O[db][qk][4 * vq + 3] * inv);
                    *(u32x2*)(AO + tok * 512 + head * 64 + 32 * db + 8 * vq + 4 * hh) = wv; }
        }
    }
    __syncthreads();
}

struct Args { const float* in[20]; float* out; unsigned char* ws; int ph_lo, ph_hi; };

constexpr int PH_PER_LAYER = 9;
constexpr int PH_FINAL = 1 + DEPTH * PH_PER_LAYER;
constexpr int PH_COUNT = PH_FINAL + 1;

__global__ void __launch_bounds__(512, 2) fwd_kernel(Args args) {
    extern __shared__ __attribute__((aligned(16))) unsigned char lds_raw[];
    Fr F;
    F.lds = (LAS unsigned char*)lds_raw; F.ws = args.ws; F.out = args.out;
    F.tid = threadIdx.x; F.lane = F.tid & 63; F.wave = __builtin_amdgcn_readfirstlane(F.tid >> 6); F.G = gridDim.x; F.bid = blockIdx.x;
    volatile LAS unsigned* misc = (volatile LAS unsigned*)(F.lds + LDS_MISC);
    if (F.tid < 64) misc[F.tid] = 0u;
    if (F.tid < 20) { const unsigned long long pv = (unsigned long long)args.in[F.tid]; misc[128 + 2 * F.tid] = (unsigned)pv; misc[128 + 2 * F.tid + 1] = (unsigned)(pv >> 32); }
    __syncthreads();
    XcdBarrier bar; bar.bar = (unsigned*)(F.ws + WS_CTL); bar.x = 0; bar.st = misc;
    const bool one = (args.ph_hi - args.ph_lo) > 1;
    if (one) bar = xcd_barrier_post((unsigned*)(F.ws + WS_CTL), misc);
    const int lo = args.ph_lo, hi = args.ph_hi;
#ifdef STOP_PH
#define IN(k) (lo <= (k) && (k) < hi && ((k) < STOP_PH || (k) == PH_FINAL))
#else
#define IN(k) (lo <= (k) && (k) < hi)
#endif
#ifndef DUP_PH
#define DUP_PH -1
#endif
#define NREP(b) ((DUP_PH == (b)) ? 2 : 1)
#define SEAM(k) do { if (lo <= (k) + 1 && (k) + 1 < hi) xcd_barrier(bar); } while (0)

#ifndef PHM
#define PHM 0xFFFF
#endif
#define PHON(b) ((PHM >> (b)) & 1)
    if (PHON(0) && IN(0)) { for (int rep = 0; rep < NREP(0); ++rep) { LAUNDER(F); prologue_phase(F); SEAM(0); } }

#pragma unroll 1
    for (int l = 0; l < NLAYERS_RUN; ++l) {
        const int pb = 1 + l * PH_PER_LAYER;
        const bool lastl = (l == DEPTH - 1);
        if (PHON(1) && IN(pb + 0)) { LAUNDER(F); norm1_phase(F, l); SEAM(pb + 0); }
        if (PHON(2) && IN(pb + 1)) for (int rep = 0; rep < NREP(2); ++rep) { LAUNDER(F);
            { InProjProb<0> P; P.H = WSP(bf16_t, WS_H); P.W = WSP(bf16_t, WS_WIN) + (size_t)l * IN_DIM * 1024;
              P.FT = WSP(bf16_t, WS_FT); P.FCT = WSP(bf16_t, WS_FCT); P.Q = WSP(bf16_t, WS_Q); P.Kb = WSP(bf16_t, WS_K); P.Vb = WSP(bf16_t, WS_V); P.GF = WSP(bf16_t, WS_GF); P.GA = WSP(bf16_t, WS_GA);
              P.rope = WSP(float, WS_ROPE);
              P.nM = lastl ? 128 : 132; P.n_nat = P.nM * 11; P.n_fx = 256; P.n_fc = lastl ? 0 : 8; P.n_extra = lastl ? 4 : 0; P.G = F.G; P.c = F.bid;
              g8::gemm_run(F.lds, P); }
            { InProjProb<1> P; P.H = WSP(bf16_t, WS_H); P.W = WSP(bf16_t, WS_WIN) + (size_t)l * IN_DIM * 1024;
              P.FT = WSP(bf16_t, WS_FT); P.FCT = WSP(bf16_t, WS_FCT); P.Q = nullptr; P.Kb = nullptr; P.Vb = nullptr; P.GF = nullptr; P.GA = nullptr; P.rope = nullptr;
              P.nM = 0; P.n_nat = 0; P.n_fx = 256; P.n_fc = lastl ? 0 : 8; P.n_extra = 0; P.G = F.G; P.c = (F.bid + 180) % F.G;
              g8::gemm_run(F.lds, P); }
            SEAM(pb + 1);
        }
        if (PHON(3) && IN(pb + 2)) for (int rep = 0; rep < NREP(3); ++rep) { LAUNDER(F);
#ifndef NO_ATTN
            attn_phase(F, l, !lastl);
#endif
#ifndef NO_FFT1
            Fft1Prob P; P.W1 = WSP(bf16_t, WS_W1); P.FT = WSP(bf16_t, WS_FT); P.WC = WSP(bf16_t, WS_WC); P.FCT = WSP(bf16_t, WS_FCT); P.T1 = WSP(bf16_t, WS_T1); P.XS = WSP(bf16_t, WS_XS);
            P.n0 = 512; P.n1 = lastl ? 0 : 16; P.G = F.G; P.c = F.bid;
            g8::gemm_run(F.lds, P);
#endif
            SEAM(pb + 2);
        }
        if (PHON(4) && IN(pb + 3)) for (int rep = 0; rep < NREP(4); ++rep) { LAUNDER(F);
            Fft2Prob P; P.MT = WSP(bf16_t, WS_MT); P.T1 = WSP(bf16_t, WS_T1); P.XS = WSP(bf16_t, WS_XS); P.G = F.G; P.c = F.bid;
            g8::gemm_run(F.lds, P); SEAM(pb + 3);
        }
        if (PHON(5) && IN(pb + 4)) for (int rep = 0; rep < NREP(5); ++rep) { LAUNDER(F);
            { MergeProb<0> P; P.A = WSP(bf16_t, WS_XS); P.W = WSP(bf16_t, WS_WFO) + (size_t)l * 1024 * 1024; P.lda = 1024; P.GATE = WSP(bf16_t, WS_GF); P.YB = WSP(bf16_t, WS_YB);
              P.xin = nullptr; P.cin = nullptr; P.XW = nullptr; P.CW = nullptr; P.g1x = nullptr; P.g1c = nullptr; P.nM = lastl ? 128 : 132; P.G = F.G; P.c = F.bid;
              g8::gemm_run(F.lds, P); }
            { MergeProb<1> P; P.A = WSP(bf16_t, WS_AO); P.W = WSP(bf16_t, WS_WAO) + (size_t)l * 1024 * 512; P.lda = 512; P.GATE = WSP(bf16_t, WS_GA); P.YB = WSP(bf16_t, WS_YB);
              P.xin = nullptr; P.cin = nullptr; P.XW = nullptr; P.CW = nullptr; P.g1x = nullptr; P.g1c = nullptr; P.nM = lastl ? 128 : 132; P.G = F.G; P.c = F.bid;
              g8::gemm_run(F.lds, P); }
            SEAM(pb + 4);
        }
        if (PHON(6) && IN(pb + 5)) { LAUNDER(F);
            MergeProb<2> P; P.A = WSP(bf16_t, WS_YB); P.W = WSP(bf16_t, WS_WOUT) + (size_t)l * 1024 * 1024; P.lda = 1024; P.GATE = nullptr; P.YB = nullptr;
            P.xin = (l == 0) ? INP(0) : WSP(float, WS_XW); P.cin = (l == 0) ? INP(2) : WSP(float, WS_CW); P.XW = WSP(float, WS_XW); P.CW = WSP(float, WS_CW);
            P.g1x = WSP(float, WS_MOD) + (size_t)l * 5 * 6144 + 2 * 1024; P.g1c = WSP(float, WS_MOD) + ((size_t)l * 5 + 4) * 6144 + 2 * 1024; P.nM = lastl ? 128 : 132; P.G = F.G; P.c = F.bid;
            g8::gemm_run(F.lds, P); SEAM(pb + 5);
        }
        if (PHON(7) && IN(pb + 6)) for (int rep = 0; rep < NREP(7); ++rep) { LAUNDER(F); norm2_router_phase(F, l, rep + 1 < NREP(7)); SEAM(pb + 6); }
        if (PHON(8) && IN(pb + 7)) for (int rep = 0; rep < NREP(8); ++rep) { LAUNDER(F);
            MoeGuProb P; P.R = fill_tstart(F, l);
            P.H8 = WSP(signed char, WS_H8); P.W8 = WSP(signed char, WS_WGU) + (size_t)l * 32 * 2048 * 1024; P.sW = WSP(float, WS_SWGU) + (size_t)l * 32 * 2048; P.lsc = WSP(float, WS_LSC);
            P.bgu = INP(16) + (size_t)l * 32 * 2048; P.ACT = WSP(unsigned char, WS_ACT);
            P.list = WSP(int, WS_LIST); P.cnt = (const int*)(F.ws + WS_CTL + CTL_CNT) + l * 32; P.tstart = (const volatile LAS int*)(F.lds + LDS_MISC + 64); P.G = F.G; P.c = F.bid;
            g8::gemm_run(F.lds, P); SEAM(pb + 7);
        }
        if (PHON(9) && IN(pb + 8)) for (int rep = 0; rep < NREP(9); ++rep) { LAUNDER(F);
            MoeDnProb P; P.R = fill_tstart(F, l);
            P.ACT = WSP(unsigned char, WS_ACT); P.W = WSP(unsigned char, WS_WDN) + (size_t)l * 32 * 1024 * 1024; P.bdn = INP(18) + (size_t)l * 32 * 1024; P.YE = WSP(bf16_t, WS_YE);
            P.tstart = (const volatile LAS int*)(F.lds + LDS_MISC + 64); P.G = F.G; P.c = F.bid;
            g8::gemm_run(F.lds, P); SEAM(pb + 8);
        }
    }
#ifdef STOP_PH
    if (IN(PH_FINAL)) { LAUNDER(F);
        const size_t n = (size_t)TX * 1024;
        for (size_t i = (size_t)F.bid * 512 + F.tid; i < n; i += (size_t)F.G * 512) {
            F.out[i] = DUMP_EXPR(i);
        } }
#else
    if (PHON(10) && IN(PH_FINAL)) for (int rep = 0; rep < NREP(10); ++rep) { LAUNDER(F); norm1_phase(F, DEPTH); if (rep + 1 < NREP(10)) xcd_barrier(bar); }
#endif
#undef IN
#undef SEAM
}

extern "C" void kernel_launch(void* const* d_in, const int* in_sizes, int n_in, void* d_out, int out_size, void* d_ws, size_t ws_size, hipStream_t stream) {
    static int grid = 0;
    if (grid == 0) {
        if (n_in != 20 || ws_size < WS_END) { fprintf(stderr, "kernel_launch: bad arguments (n_in %d, ws %zu < %zu)\n", n_in, ws_size, (size_t)WS_END); grid = -1; return; }
        int dev = 0, cus = 0, per_cu = 0;
        if (hipGetDevice(&dev) != hipSuccess || hipDeviceGetAttribute(&cus, hipDeviceAttributeMultiprocessorCount, dev) != hipSuccess) { grid = -1; return; }
        if (hipFuncSetAttribute((const void*)fwd_kernel, hipFuncAttributeMaxDynamicSharedMemorySize, LDS_BYTES) != hipSuccess) { fprintf(stderr, "kernel_launch: hipFuncSetAttribute failed\n"); grid = -1; return; }
        if (hipOccupancyMaxActiveBlocksPerMultiprocessor(&per_cu, (const void*)fwd_kernel, 512, LDS_BYTES) != hipSuccess || per_cu < 1) { fprintf(stderr, "kernel_launch: occupancy query says %d\n", per_cu); }
        (void)hipGetLastError();
        grid = cus;
    }
    if (grid < 0) return;
    (void)hipMemsetAsync((char*)d_ws + WS_CTL, 0, CTL_BYTES, stream);
    Args a{};
    for (int i = 0; i < 20; ++i) a.in[i] = (const float*)d_in[i];
    a.out = (float*)d_out; a.ws = (unsigned char*)d_ws;
#if N_LAUNCH_MODE == 1
    a.ph_lo = 0; a.ph_hi = PH_COUNT;
    hipLaunchKernelGGL(fwd_kernel, dim3(grid), dim3(512), LDS_BYTES, stream, a);
#else
    for (int p = 0; p < PH_COUNT; ++p) { a.ph_lo = p; a.ph_hi = p + 1; hipLaunchKernelGGL(fwd_kernel, dim3(grid), dim3(512), LDS_BYTES, stream, a); }
#endif
    (void)in_sizes; (void)out_size;
}
```

```cpp
#include <hip/hip_runtime.h>
#include <cstdio>
#include <cstdint>

#define LAS __attribute__((address_space(3)))
typedef unsigned short bf16_t;
typedef short bf16x8 __attribute__((ext_vector_type(8)));
typedef short s16x4 __attribute__((ext_vector_type(4)));
typedef float f32x4 __attribute__((ext_vector_type(4)));
typedef float f32x16 __attribute__((ext_vector_type(16)));
typedef unsigned u32x4 __attribute__((ext_vector_type(4)));
typedef unsigned u32x2 __attribute__((ext_vector_type(2)));
typedef int i32x4 __attribute__((ext_vector_type(4)));
typedef int i32x8 __attribute__((ext_vector_type(8)));

#ifndef N_LAUNCH_MODE
#define N_LAUNCH_MODE 1
#endif
#ifndef DBG_CHECK
#define DBG_CHECK 0
#endif
#ifndef EMU8
#define EMU8 false
#endif
#ifndef NLAYERS_RUN
#define NLAYERS_RUN 4
#endif

constexpr int D = 1024, NB = 4, SEQ = 8192, TX = NB * SEQ, LC = 256, TC = NB * LC, TT = TX + TC, DEPTH = 4;
constexpr int IN_DIM = 3328, NEXP = 32;
constexpr int ROWS_MAX = TT * 4 + NEXP * 256;
constexpr float LOG2E = 1.4426950408889634f;
constexpr float QSCALE = 0.125f * LOG2E;
constexpr float EPS = 1e-5f;

constexpr size_t al256(size_t x) { return (x + 255) & ~(size_t)255; }
constexpr size_t WS_CTL = 0;
constexpr size_t CTL_BYTES = 65536;
constexpr size_t CTL_CNT = 16384;
constexpr size_t WS_MOD = WS_CTL + CTL_BYTES;
constexpr size_t WS_ROPE = WS_MOD + al256((size_t)DEPTH * 5 * 6144 * 4);
constexpr size_t WS_W1 = WS_ROPE + 16384;
constexpr size_t WS_MT = WS_W1 + 256 * 128 * 2;
constexpr size_t WS_WC = WS_MT + (size_t)64 * 256 * 128 * 2;
constexpr size_t WS_RWT = WS_WC + 512 * 256 * 2;
constexpr size_t WS_WIN = WS_RWT + (size_t)DEPTH * 32 * 1024 * 2;
constexpr size_t WS_SWIN = WS_WIN + (size_t)DEPTH * IN_DIM * 1024;
constexpr size_t WS_WFO = WS_SWIN + al256((size_t)DEPTH * IN_DIM * 4);
constexpr size_t WS_WAO = WS_WFO + (size_t)DEPTH * 1024 * 1024 * 2;
constexpr size_t WS_WOUT = WS_WAO + (size_t)DEPTH * 1024 * 512 * 2;
constexpr size_t WS_WGU = WS_WOUT + (size_t)DEPTH * 1024 * 1024 * 2;
constexpr size_t WS_SWGU = WS_WGU + (size_t)DEPTH * 32 * 2048 * 1024;
constexpr size_t WS_WDN = WS_SWGU + (size_t)DEPTH * 32 * 2048 * 4;
constexpr size_t WS_H = WS_WDN + (size_t)DEPTH * 32 * 1024 * 1024 * 2;
constexpr size_t WS_FT = WS_H + (size_t)(TT + 256) * 1024 * 2;
constexpr size_t WS_FCT = WS_FT + (size_t)131072 * 128 * 2;
constexpr size_t WS_Q = WS_FCT + (size_t)2048 * 256 * 2;
constexpr size_t WS_K = WS_Q + (size_t)TT * 512 * 2;
constexpr size_t WS_V = WS_K + (size_t)TT * 128 * 2;
constexpr size_t WS_GF = WS_V + (size_t)TT * 128 * 2;
constexpr size_t WS_GA = WS_GF + (size_t)TT * 1024 * 2;
constexpr size_t WS_T1 = WS_GA + (size_t)TT * 1024 * 2;
constexpr size_t WS_XS = WS_T1 + (size_t)64 * 2048 * 128 * 2;
constexpr size_t WS_AO = WS_XS + (size_t)TT * 1024 * 2;
constexpr size_t WS_YB = WS_AO + (size_t)TT * 512 * 2;
constexpr size_t WS_XW = WS_YB + (size_t)TT * 1024 * 2;
constexpr size_t WS_CW = WS_XW + (size_t)TX * 1024 * 4;
constexpr size_t WS_ACT = WS_CW + (size_t)TC * 1024 * 4;
constexpr size_t WS_YE = WS_ACT + (size_t)ROWS_MAX * 1024 * 2;
constexpr size_t WS_LIST = WS_YE + (size_t)ROWS_MAX * 1024 * 2;
constexpr size_t WS_SLOT = WS_LIST + (size_t)32 * TT * 4;
constexpr size_t WS_GATE = WS_SLOT + (size_t)TT * 4 * 4;
constexpr size_t WS_H8 = WS_GATE + (size_t)TT * 4 * 4;
constexpr size_t WS_LSC = WS_H8 + (size_t)(TT + 256) * 1024;
constexpr size_t WS_SH = WS_LSC + (size_t)32 * TT * 4;
constexpr size_t WS_END = WS_SH + (size_t)(TT + 256) * 4;

constexpr int LDS_STAGE = 131072;
constexpr int LDS_MISC = LDS_STAGE;
constexpr int LDS_BYTES = 147456;

typedef __bf16 bf16v2_t __attribute__((ext_vector_type(2)));
typedef float f32x2_t __attribute__((ext_vector_type(2)));
__device__ __forceinline__ unsigned cvt_pk_bf16(float lo, float hi) { const f32x2_t v = {lo, hi}; const bf16v2_t b = __builtin_convertvector(v, bf16v2_t); return __builtin_bit_cast(unsigned, b); }
__device__ __forceinline__ float q8(float x) { const int p = __builtin_amdgcn_cvt_pk_fp8_f32(x, 0.f, 0, false); return __builtin_amdgcn_cvt_f32_fp8(p, 0); }
__device__ __forceinline__ unsigned pk4_fp8(float a, float b, float c, float d) { int p = __builtin_amdgcn_cvt_pk_fp8_f32(a, b, 0, false); p = __builtin_amdgcn_cvt_pk_fp8_f32(c, d, p, true); return (unsigned)p; }
__device__ __forceinline__ bf16_t f2bf(float f) { return (bf16_t)(cvt_pk_bf16(f, 0.f) & 0xffffu); }
__device__ __forceinline__ float bf_lo(unsigned u) { return __uint_as_float(u << 16); }
__device__ __forceinline__ float bf_hi(unsigned u) { return __uint_as_float(u & 0xffff0000u); }
__device__ __forceinline__ float bf2f(bf16_t b) { return __uint_as_float(((unsigned)b) << 16); }
__device__ __forceinline__ float sigmoidf_(float x) { return __builtin_amdgcn_rcpf(1.0f + __builtin_amdgcn_exp2f(-x * LOG2E)); }
__device__ __forceinline__ float wave_sum(float v) {
#pragma unroll
    for (int o = 32; o >= 1; o >>= 1) v += __shfl_xor(v, o);
    return v;
}

#define XB_TMO      128
#define XB_XCNT(j)  (256  + 64 * (j))
#define XB_XSUB(j)  (1280 + 64 * (j))
#define XB_XGEN(j)  (2304 + 64 * (j))
#define XB_TOP      3328
#define XB_TOPGEN   3392
#define XCD_BAR_WORDS 3456
#define XB_SPIN_CAP (1u << 22)

__device__ __forceinline__ unsigned xb_ld(unsigned* p)              { return __hip_atomic_load(p, __ATOMIC_RELAXED, __HIP_MEMORY_SCOPE_AGENT); }
__device__ __forceinline__ unsigned xb_add(unsigned* p, unsigned v) { return __hip_atomic_fetch_add(p, v, __ATOMIC_RELAXED, __HIP_MEMORY_SCOPE_AGENT); }
__device__ __forceinline__ unsigned xb_xcc_id() { return (unsigned)__builtin_amdgcn_s_getreg((3 << 11) | 20) & 0xFu; }
#define XB_SPIN(cond, bar) do { unsigned _sp = 0; while (cond) { __builtin_amdgcn_s_sleep(1); \
    if ((++_sp & 255u) == 0u) { if (xb_ld(&(bar)[XB_TMO])) break; if (_sp > XB_SPIN_CAP) { atomicAdd(&(bar)[XB_TMO], 1u); break; } } } } while (0)

struct XcdBarrier { unsigned* bar; unsigned x; volatile LAS unsigned* st; };

__device__ __forceinline__ XcdBarrier xcd_barrier_post(unsigned* bar, volatile LAS unsigned* st) {
    XcdBarrier b; b.bar = bar; b.x = xb_xcc_id(); b.st = st;
    if (threadIdx.x == 0) (void)xb_add(&bar[XB_XCNT(b.x)], 1u);
    return b;
}
__device__ __forceinline__ void xcd_barrier_complete(unsigned* bar, unsigned x, unsigned& nloc, unsigned& nx) {
    const unsigned G = gridDim.x * gridDim.y * gridDim.z;
    unsigned sum, cnt, mine, sp = 0u;
    for (;;) {
        sum = 0u; cnt = 0u; mine = 0u;
#pragma unroll
        for (unsigned j = 0; j < 16; ++j) { const unsigned c = xb_ld(&bar[XB_XCNT(j)]); sum += c; cnt += (c > 0u) ? 1u : 0u; mine = (j == x) ? c : mine; }
        if (sum == G) break;
        __builtin_amdgcn_s_sleep(1);
        if ((++sp & 255u) == 0u) { if (xb_ld(&bar[XB_TMO])) break; if (sp > XB_SPIN_CAP) { atomicAdd(&bar[XB_TMO], 1u); break; } }
    }
    nloc = mine > 0u ? mine : 1u; nx = cnt > 0u ? cnt : 1u;
}
__device__ __forceinline__ void xcd_barrier(const XcdBarrier& b) {
    asm volatile("s_waitcnt vmcnt(0)" ::: "memory");
    __syncthreads();
    if (threadIdx.x == 0) {
        unsigned* bar = b.bar;
        __builtin_amdgcn_s_waitcnt(0);
        unsigned nloc = b.st[0], nx = b.st[1];
        if (nloc == 0u) { xcd_barrier_complete(bar, b.x, nloc, nx); b.st[0] = nloc; b.st[1] = nx; }
        const unsigned old = xb_add(&bar[XB_XSUB(b.x)], 1u);
        const unsigned gen = old / nloc;
        if (old + 1u == (gen + 1u) * nloc) {
            __builtin_amdgcn_fence(__ATOMIC_RELEASE, "agent");
            asm volatile("s_waitcnt vmcnt(0)" ::: "memory");
            const unsigned og = xb_add(&bar[XB_TOP], 1u);
            const unsigned tg = og / nx;
            if (og + 1u == (tg + 1u) * nx) xb_add(&bar[XB_TOPGEN], 1u);
            else XB_SPIN(xb_ld(&bar[XB_TOPGEN]) == tg, bar);
            __builtin_amdgcn_fence(__ATOMIC_ACQUIRE, "agent");
            xb_add(&bar[XB_XGEN(b.x)], 1u);
            asm volatile("s_waitcnt vmcnt(0)" ::: "memory");
        } else {
            XB_SPIN(xb_ld(&bar[XB_XGEN(b.x)]) == gen, bar);
            __builtin_amdgcn_fence(__ATOMIC_ACQUIRE, "agent");
            asm volatile("s_waitcnt vmcnt(0)" ::: "memory");
        }
    }
    __syncthreads();
}

struct Fr {
    LAS unsigned char* lds;
    unsigned char* ws;
    float* out;
    int tid, lane, wave, G, bid;
};
__device__ __forceinline__ const float* in_ptr(const Fr& F, int i) {
    volatile LAS unsigned* p = (volatile LAS unsigned*)(F.lds + 131072 + 512) + 2 * i;
    const unsigned lo = __builtin_amdgcn_readfirstlane(p[0]), hi = __builtin_amdgcn_readfirstlane(p[1]);
    return (const float*)(((unsigned long long)hi << 32) | lo);
}
#define INP(i) in_ptr(F, (i))
#define LAUNDER(F) do { unsigned char* _w = (F).ws; asm volatile("" : "+s"(_w)); (F).ws = _w; int _t = threadIdx.x; asm volatile("" : "+v"(_t)); (F).tid = _t; (F).lane = _t & 63; (F).wave = __builtin_amdgcn_readfirstlane(_t >> 6); } while (0)
#define WSP(T, off) ((T*)(F.ws + (off)))

namespace g8 {
constexpr int BM = 256, BK = 64, HALF = 128, HTB = HALF * BK * 2, NXCD = 8, WGM = 8;
__device__ __forceinline__ int lds_byte(int r, int c) { const int st = (r >> 4) * 2 + (c >> 5), rr = r & 15, cc = c & 31, ob = rr * 64 + cc * 2; return st * 1024 + (ob ^ (((ob >> 9) & 1) << 5)); }
__device__ __forceinline__ void stage_rc(int b, int& R, int& C) { const int st = b / 1024, sb = b % 1024, swz = sb ^ (((sb >> 9) & 1) << 5); R = (st >> 1) * 16 + swz / 64; C = (st & 1) * 32 + (swz % 64) / 2; }
__device__ __forceinline__ int perm32(int rho) { const int n = rho >> 4, i = rho & 15; return 8 * (i >> 2) + 4 * n + (i & 3); }
__device__ __forceinline__ void order2d(int L, int nM, int nN, int& pm, int& pn) {
    const int nwg = nM * nN;
    int wgid = L; { const int q = nwg / NXCD, r = nwg % NXCD, xcd = wgid % NXCD, off = wgid / NXCD; wgid = (xcd < r ? xcd * (q + 1) : r * (q + 1) + (xcd - r) * q) + off; }
    const int nig = WGM * nN, gid = wgid / nig, fm = gid * WGM, gsz = (nM - fm) < WGM ? (nM - fm) : WGM;
    pm = fm + ((wgid % nig) % gsz); pn = (wgid % nig) / gsz;
}
__device__ __forceinline__ void lane_geom(int tid, int& R0, int& Rb0, int& C0) { asm volatile("" : "+v"(tid)); stage_rc(tid * 16, R0, C0); Rb0 = (R0 & ~31) + perm32(R0 & 31); }

#define G8_ROWS(ai, m) (128 * (ai) + 64 * wr + 16 * (m) + fr)
#define G8_COL0(bj) (128 * (bj) + 32 * wc + 8 * fq)

template <bool I8> __device__ __forceinline__ f32x4 mma1(const bf16x8& b, const bf16x8& a, const f32x4& c) { return __builtin_amdgcn_mfma_f32_16x16x32_bf16(b, a, c, 0, 0, 0); }
template <bool I8> __device__ __forceinline__ i32x4 mma1(const bf16x8& b, const bf16x8& a, const i32x4& c) { return __builtin_amdgcn_mfma_i32_16x16x64_i8(__builtin_bit_cast(i32x4, b), __builtin_bit_cast(i32x4, a), c, 0, 0, 0); }
__device__ __forceinline__ f32x4 mma8(const bf16x8& b0, const bf16x8& b1, const bf16x8& a0, const bf16x8& a1, const f32x4& c) {
    const i32x4 B0 = __builtin_bit_cast(i32x4, b0), B1 = __builtin_bit_cast(i32x4, b1), A0 = __builtin_bit_cast(i32x4, a0), A1 = __builtin_bit_cast(i32x4, a1);
    const i32x8 B = {B0[0], B0[1], B0[2], B0[3], B1[0], B1[1], B1[2], B1[3]}, A = {A0[0], A0[1], A0[2], A0[3], A1[0], A1[1], A1[2], A1[3]};
    return __builtin_amdgcn_mfma_scale_f32_16x16x128_f8f6f4(B, A, c, 0, 0, 0, 0x7F7F7F7F, 0, 0x7F7F7F7F);
}
template <class P>
__device__ __forceinline__ void gemm_run(LAS unsigned char* lds, P& prob) {
    int tid = threadIdx.x; asm volatile("" : "+v"(tid));
    const int wid = __builtin_amdgcn_readfirstlane(tid >> 6), lane = tid & 63, wr = wid >> 2, wc = wid & 3, fr = lane & 15, fq = lane >> 4;
    const size_t kstep = (size_t)(BK * 2);
    const unsigned ldsw = (unsigned)wid * 1024u;
    const int aoff = lds_byte(wr * 64 + fr, fq * 8), boff = lds_byte(wc * 32 + fr, fq * 8);
#define G8_SA(b, h) (((b) * 2 + (h)) * HTB)
#define G8_SB(b, h) ((4 + (b) * 2 + (h)) * HTB)
#define G8_STAGE_(bufoff, g0, o0, g1, o1) do { \
        __builtin_amdgcn_global_load_lds((const unsigned*)((const char*)(g0) + (o0)), (LAS unsigned*)(lds + (bufoff) + ldsw), 16, 0, 0); \
        __builtin_amdgcn_global_load_lds((const unsigned*)((const char*)(g1) + (o1)), (LAS unsigned*)(lds + (bufoff) + ldsw + 8192), 16, 0, 0); } while (0)
#define G8_OA(j) (P::GATHER_A ? oa[j] : oa[0])
#define G8_STA(bufoff, gbase, h) G8_STAGE_(bufoff, (gbase) + dA[2 * (h)], G8_OA(2 * (h)), (gbase) + dA[2 * (h) + 1], G8_OA(2 * (h) + 1))
#define G8_STB(bufoff, gbase, h) G8_STAGE_(bufoff, (gbase) + dB[2 * (h)], ob, (gbase) + dB[2 * (h) + 1], ob)
#define G8_LDA(dst, b, h) do { _Pragma("unroll") for (int m = 0; m < 4; ++m) _Pragma("unroll") for (int k = 0; k < 2; ++k) dst[m][k] = *(const LAS bf16x8*)(lds + G8_SA(b, h) + aoff + m * 2048 + k * 1024); } while (0)
#define G8_LDB(dst, b, h) do { _Pragma("unroll") for (int n = 0; n < 2; ++n) _Pragma("unroll") for (int k = 0; k < 2; ++k) dst[n][k] = *(const LAS bf16x8*)(lds + G8_SB(b, h) + boff + n * 2048 + k * 1024); } while (0)
#define G8_MMA(ai, bj, At, Bt) do { __builtin_amdgcn_s_setprio(1); \
        if constexpr (P::F8) { _Pragma("unroll") for (int m = 0; m < 4; ++m) _Pragma("unroll") for (int n = 0; n < 2; ++n) acc[ai][bj][m][n] = mma8(Bt[n][0], Bt[n][1], At[m][0], At[m][1], acc[ai][bj][m][n]); } \
        else { _Pragma("unroll") for (int m = 0; m < 4; ++m) _Pragma("unroll") for (int n = 0; n < 2; ++n) _Pragma("unroll") for (int k = 0; k < 2; ++k) \
        acc[ai][bj][m][n] = mma1<P::I8>(Bt[n][k], At[m][k], acc[ai][bj][m][n]); } __builtin_amdgcn_s_setprio(0); } while (0)
#define G8_WAIT_V(n) asm volatile("s_waitcnt vmcnt(" #n ")" ::: "memory")
#define G8_WAIT_L(n) asm volatile("s_waitcnt lgkmcnt(" #n ")" ::: "memory")
#define G8_BAR __builtin_amdgcn_s_barrier()
#define G8_SCHED __builtin_amdgcn_sched_barrier(0)
    typename P::U cur, nxt; int ui = 0;
    if (!prob.get(0, cur)) return;
    typedef typename P::Acc Acc;
    Acc acc[2][2][4][2];
#pragma unroll
    for (int a = 0; a < 2; ++a)
#pragma unroll
        for (int b = 0; b < 2; ++b)
#pragma unroll
            for (int m = 0; m < 4; ++m)
#pragma unroll
                for (int n = 0; n < 2; ++n) acc[a][b][m][n] = (Acc){0, 0, 0, 0};
    bf16x8 At[4][2], B0[2][2], B1[2][2];
    unsigned oa[4], ob, dA[4], dB[4]; const char* cA; const char* cB; int nt;
    prob.setup(cur, oa, ob, dA, dB, cA, cB, nt);
    G8_STB(G8_SB(0, 0), cB, 0); G8_STA(G8_SA(0, 0), cA, 0); G8_STB(G8_SB(0, 1), cB, 1); G8_STA(G8_SA(0, 1), cA, 1);
    if (wr == 1) G8_BAR;
    G8_WAIT_V(4); G8_BAR;
    G8_STB(G8_SB(1, 0), cB + kstep, 0); G8_STA(G8_SA(1, 0), cA + kstep, 0); G8_STB(G8_SB(1, 1), cB + kstep, 1);
    G8_WAIT_V(6); G8_BAR;
    for (;;) {
        const bool has_next = prob.get(ui + 1, nxt);
        int nnt = nt;
        for (int t = 0; t < nt; t += 2) {
            const bool last = (t == nt - 2);
            G8_LDB(B0, 0, 0); G8_SCHED; G8_LDA(At, 0, 0); G8_STA(G8_SA(1, 1), cA + (size_t)(t + 1) * kstep, 1);
            G8_WAIT_L(8); G8_BAR; G8_WAIT_L(0); G8_MMA(0, 0, At, B0); G8_BAR; G8_SCHED;
            const char* a2; const char* b2;
            if (last) { if (has_next) { prob.setup(nxt, oa, ob, dA, dB, cA, cB, nnt); } a2 = cA; b2 = cB; }
            else { a2 = cA + (size_t)(t + 2) * kstep; b2 = cB + (size_t)(t + 2) * kstep; }
            const char* a3 = a2 + kstep; const char* b3 = b2 + kstep;
            G8_LDB(B1, 0, 1); G8_STB(G8_SB(0, 0), b2, 0);
            G8_BAR; G8_WAIT_L(0); G8_MMA(0, 1, At, B1); G8_BAR;
            G8_LDA(At, 0, 1); G8_STA(G8_SA(0, 0), a2, 0);
            G8_BAR; G8_WAIT_L(0); G8_MMA(1, 0, At, B0); G8_BAR; G8_SCHED;
            G8_STB(G8_SB(0, 1), b2, 1);
            G8_WAIT_V(6); G8_BAR; G8_MMA(1, 1, At, B1); G8_BAR;
            G8_LDB(B0, 1, 0); G8_SCHED; G8_LDA(At, 1, 0); G8_STA(G8_SA(0, 1), a2, 1);
            G8_WAIT_L(8); G8_BAR; G8_WAIT_L(0); G8_MMA(0, 0, At, B0); G8_BAR; G8_SCHED;
            G8_LDB(B1, 1, 1); G8_STB(G8_SB(1, 0), b3, 0);
            G8_BAR; G8_WAIT_L(0); G8_MMA(0, 1, At, B1); G8_BAR;
            G8_LDA(At, 1, 1); G8_STA(G8_SA(1, 0), a3, 0);
            G8_BAR; G8_WAIT_L(0); G8_MMA(1, 0, At, B0); G8_BAR; G8_SCHED;
            G8_STB(G8_SB(1, 1), b3, 1);
            G8_WAIT_V(6); G8_BAR; G8_MMA(1, 1, At, B1); G8_BAR;
            if (last) break;
        }
        { int t2 = threadIdx.x; asm volatile("" : "+v"(t2)); const int l2 = t2 & 63; prob.epi(acc, cur, wr, wc, l2 & 15, l2 >> 4); }
        if (!has_next) break;
#pragma unroll
        for (int a = 0; a < 2; ++a)
#pragma unroll
            for (int b = 0; b < 2; ++b)
#pragma unroll
                for (int m = 0; m < 4; ++m)
#pragma unroll
                    for (int n = 0; n < 2; ++n) acc[a][b][m][n] = (Acc){0, 0, 0, 0};
        cur = nxt; nt = nnt; ++ui;
    }
    G8_WAIT_V(0);
    if (wr == 0) G8_BAR;
    G8_BAR;
}
}

__device__ __forceinline__ u32x4 pack8(const f32x4& v0, const f32x4& v1) {
    u32x4 w; w.x = cvt_pk_bf16(v0[0], v0[1]); w.y = cvt_pk_bf16(v0[2], v0[3]); w.z = cvt_pk_bf16(v1[0], v1[1]); w.w = cvt_pk_bf16(v1[2], v1[3]); return w;
}
__device__ __forceinline__ void unpack8(const u32x4& w, f32x4& v0, f32x4& v1) {
    v0 = (f32x4){bf_lo(w.x), bf_hi(w.x), bf_lo(w.y), bf_hi(w.y)}; v1 = (f32x4){bf_lo(w.z), bf_hi(w.z), bf_lo(w.w), bf_hi(w.w)};
}

template <int WHICH> struct InProjProb {
    static constexpr bool PERM = true, GATHER_A = false, I8 = true, F8 = false; typedef i32x4 Acc;
    struct U { int kind, pm, pn, b, j; };
    const signed char* H; const signed char* W; const float* sH; const float* sW;
    bf16_t *FT, *FCT, *Q, *Kb, *Vb, *GF, *GA; const float* rope;
    int nM, n_nat, n_fx, n_fc, n_extra, G, c;
    __device__ __forceinline__ bool get(int i, U& u) const {
        const int L = i * G + c;
        if (WHICH == 0) {
            if (L >= n_nat + n_extra) return false;
            const bool nat = L < n_nat;
            int pm, pn; g8::order2d(nat ? L : 0, nM, 11, pm, pn);
            u.kind = 2; u.pm = __builtin_amdgcn_readfirstlane(nat ? pm : (128 + L - n_nat)); u.pn = __builtin_amdgcn_readfirstlane(nat ? (pn + 2) : 4); u.b = 0; u.j = 0;
            return true;
        } else {
            if (L >= n_fx + n_fc) return false;
            const bool fx = L < n_fx; const int L2 = L - n_fx;
            u.kind = __builtin_amdgcn_readfirstlane(fx ? 0 : 1); u.b = __builtin_amdgcn_readfirstlane(fx ? (L >> 6) : (L2 >> 1)); u.j = __builtin_amdgcn_readfirstlane(fx ? ((L & 63) >> 1) : 0); u.pn = __builtin_amdgcn_readfirstlane(fx ? (L & 1) : (L2 & 1)); u.pm = 0;
            return true;
        }
    }
    __device__ __forceinline__ void setup(const U& u, unsigned (&oa)[4], unsigned& ob, unsigned (&dA)[4], unsigned (&dB)[4], const char*& pA, const char*& pB, int& nt) const {
        int R0, Rb0, C0; g8::lane_geom(threadIdx.x, R0, Rb0, C0);
        nt = 8;
#pragma unroll
        for (int j = 0; j < 4; ++j) { dA[j] = (unsigned)(64 * j * 1024); dB[j] = dA[j]; }
        if (WHICH == 0) {
            pA = (const char*)H; pB = (const char*)W;
            oa[0] = (unsigned)((256 * u.pm + R0) * 1024 + C0 * 2); ob = (unsigned)((256 * u.pn + Rb0) * 1024 + C0 * 2);
        } else {
            pA = (const char*)W; pB = (const char*)H;
            oa[0] = (unsigned)((256 * u.pn + R0) * 1024 + C0 * 2);
            if (u.kind == 0) { ob = (unsigned)((u.b * SEQ + 64 * Rb0 + 2 * u.j) * 1024 + C0 * 2);
                dB[1] = (unsigned)(64 * 64 * 1024); dB[2] = 1024u; dB[3] = dB[1] + 1024u; }
            else ob = (unsigned)((TX + u.b * LC + Rb0) * 1024 + C0 * 2);
        }
    }
    __device__ __forceinline__ void epi(const i32x4 (&acc)[2][2][4][2], const U& u, int wr, int wc, int fr, int fq) const {
        if (WHICH == 0) {
            f32x4 sw[2][2];
#pragma unroll
            for (int bj = 0; bj < 2; ++bj) { const float* sp = sW + 256 * u.pn + G8_COL0(bj); sw[bj][0] = *(const f32x4*)sp; sw[bj][1] = *(const f32x4*)(sp + 4); }
            if (u.pn >= 5) {
                bf16_t* dst = (u.pn >= 9) ? GA : GF; const int cb = 256 * ((u.pn >= 9) ? u.pn - 9 : u.pn - 5);
#pragma unroll
                for (int ai = 0; ai < 2; ++ai)
#pragma unroll
                    for (int m = 0; m < 4; ++m) { const size_t tok = (size_t)256 * u.pm + G8_ROWS(ai, m); const float rs = sH[tok];
#pragma unroll
                        for (int bj = 0; bj < 2; ++bj) { f32x4 v0, v1;
#pragma unroll
                            for (int e = 0; e < 4; ++e) { v0[e] = sigmoidf_((float)acc[ai][bj][m][0][e] * rs * sw[bj][0][e]); v1[e] = sigmoidf_((float)acc[ai][bj][m][1][e] * rs * sw[bj][1][e]); }
                            *(u32x4*)(dst + tok * 1024 + cb + G8_COL0(bj)) = pack8(v0, v1); } }
            } else {
#pragma unroll
                for (int ai = 0; ai < 2; ++ai)
#pragma unroll
                    for (int m = 0; m < 4; ++m) { const int tok = 256 * u.pm + G8_ROWS(ai, m); const float rs = sH[tok];
                        const bool isx = tok < TX; const int n = tok & (SEQ - 1); const int prow = n >> 6, pcol = n & 63;
#pragma unroll
                        for (int bj = 0; bj < 2; ++bj) { f32x4 v0, v1;
#pragma unroll
                            for (int e = 0; e < 4; ++e) { v0[e] = (float)acc[ai][bj][m][0][e] * rs * sw[bj][0][e]; v1[e] = (float)acc[ai][bj][m][1][e] * rs * sw[bj][1][e]; }
                            const int c0 = G8_COL0(bj);
                            const bool isv = (u.pn == 4) && (bj == 1);
                            if (!isv) {
                                const int dp = c0 & 63; const int axis = dp >> 5, f0 = (dp & 31) >> 1;
                                if (isx) {
                                    const int pos = axis ? pcol : prow;
                                    const f32x4 cs = *(const f32x4*)(rope + pos * 16 + f0), sn = *(const f32x4*)(rope + 2048 + pos * 16 + f0);
                                    f32x4 r0, r1;
                                    r0[0] = v0[0] * cs[0] - v0[1] * sn[0]; r0[1] = v0[1] * cs[0] + v0[0] * sn[0];
                                    r0[2] = v0[2] * cs[1] - v0[3] * sn[1]; r0[3] = v0[3] * cs[1] + v0[2] * sn[1];
                                    r1[0] = v1[0] * cs[2] - v1[1] * sn[2]; r1[1] = v1[1] * cs[2] + v1[0] * sn[2];
                                    r1[2] = v1[2] * cs[3] - v1[3] * sn[3]; r1[3] = v1[3] * cs[3] + v1[2] * sn[3];
                                    v0 = r0; v1 = r1;
                                }
                            }
                            if (u.pn < 4) { v0 *= QSCALE; v1 *= QSCALE; *(u32x4*)(Q + (size_t)tok * 512 + 256 * (u.pn - 2) + c0) = pack8(v0, v1); }
                            else if (!isv) { *(u32x4*)(Kb + (size_t)tok * 128 + c0) = pack8(v0, v1); }
                            else { *(u32x4*)(Vb + (size_t)tok * 128 + (c0 - 128)) = pack8(v0, v1); }
                        } }
            }
        } else {
            f32x4 st[2][2];
#pragma unroll
            for (int bj = 0; bj < 2; ++bj) { const int c0 = G8_COL0(bj);
                if (u.kind == 0) { const float* tp = sH + (size_t)u.b * SEQ + 64 * (c0 & 127) + 2 * u.j + (c0 >> 7);
#pragma unroll
                    for (int e = 0; e < 4; ++e) { st[bj][0][e] = tp[64 * e]; st[bj][1][e] = tp[64 * (4 + e)]; } }
                else { const float* tp = sH + TX + u.b * LC + c0; st[bj][0] = *(const f32x4*)tp; st[bj][1] = *(const f32x4*)(tp + 4); } }
#pragma unroll
            for (int ai = 0; ai < 2; ++ai)
#pragma unroll
                for (int m = 0; m < 4; ++m) { const int ch = 256 * u.pn + G8_ROWS(ai, m); const float rs = sW[ch];
#pragma unroll
                    for (int bj = 0; bj < 2; ++bj) { const int c0 = G8_COL0(bj); f32x4 v0, v1;
#pragma unroll
                        for (int e = 0; e < 4; ++e) { v0[e] = (float)acc[ai][bj][m][0][e] * rs * st[bj][0][e]; v1[e] = (float)acc[ai][bj][m][1][e] * rs * st[bj][1][e]; }
                        const u32x4 w = pack8(v0, v1);
                        if (u.kind == 0) { const int n2 = 2 * u.j + (c0 >> 7), n1 = c0 & 127; *(u32x4*)(FT + ((size_t)(u.b * 512 + ch) * 64 + n2) * 128 + n1) = w; }
                        else *(u32x4*)(FCT + (size_t)(u.b * 512 + ch) * 256 + c0) = w;
                    } }
        }
    }
};

struct Fft1Prob {
    static constexpr bool PERM = true, GATHER_A = false, I8 = false, F8 = false; typedef f32x4 Acc;
    struct U { int kind, pm, pn; };
    const bf16_t *W1, *FT, *WC, *FCT; bf16_t *T1, *XS;
    int n0, n1, G, c;
    __device__ __forceinline__ bool get(int i, U& u) const {
        const int L = i * G + c;
        if (L >= n0 + n1) return false;
        const bool k0 = L < n0; const int L2 = L - n0;
        u.kind = __builtin_amdgcn_readfirstlane(k0 ? 0 : 1); u.pm = __builtin_amdgcn_readfirstlane(k0 ? 0 : (L2 & 1)); u.pn = __builtin_amdgcn_readfirstlane(k0 ? L : (L2 >> 1));
        return true;
    }
    __device__ __forceinline__ void setup(const U& u, unsigned (&oa)[4], unsigned& ob, unsigned (&dA)[4], unsigned (&dB)[4], const char*& pA, const char*& pB, int& nt) const {
        int R0, Rb0, C0; g8::lane_geom(threadIdx.x, R0, Rb0, C0);
        if (u.kind == 0) { nt = 2; pA = (const char*)W1; pB = (const char*)FT;
#pragma unroll
            for (int j = 0; j < 4; ++j) { dA[j] = (unsigned)(64 * j * 128) * 2u; dB[j] = dA[j]; }
            oa[0] = (unsigned)(R0 * 128 + C0) * 2u; ob = (unsigned)((256 * u.pn + Rb0) * 128 + C0) * 2u;
        } else { nt = 4; pA = (const char*)WC; pB = (const char*)FCT;
#pragma unroll
            for (int j = 0; j < 4; ++j) { dA[j] = (unsigned)(64 * j * 256) * 2u; dB[j] = dA[j]; }
            oa[0] = (unsigned)((256 * u.pm + R0) * 256 + C0) * 2u; ob = (unsigned)((256 * u.pn + Rb0) * 256 + C0) * 2u;
        }
    }
    __device__ __forceinline__ void epi(const f32x4 (&acc)[2][2][4][2], const U& u, int wr, int wc, int fr, int fq) const {
        if (u.kind == 0) {
#pragma unroll
            for (int m = 0; m < 4; ++m) { const int r = G8_ROWS(0, m); const int k1p = r >> 1, part = r & 1;
#pragma unroll
                for (int bj = 0; bj < 2; ++bj) { const int col = 256 * u.pn + G8_COL0(bj); const int bc = col >> 6, n2 = col & 63;
                    *(u32x4*)(T1 + (((size_t)k1p * 2048 + bc) * 2 + part) * 64 + n2) = pack8(acc[0][bj][m][0], acc[0][bj][m][1]); } }
        } else {
#pragma unroll
            for (int ai = 0; ai < 2; ++ai)
#pragma unroll
                for (int m = 0; m < 4; ++m) { const int r = 256 * u.pm + G8_ROWS(ai, m); const int k = r >> 1, reim = r & 1;
#pragma unroll
                    for (int bj = 0; bj < 2; ++bj) { const int bc = 256 * u.pn + G8_COL0(bj); const int b = bc >> 9, ch = bc & 511, g = ch >> 7, d = ch & 127;
                        *(u32x4*)(XS + (size_t)(TX + b * LC + k) * 1024 + g * 256 + reim * 128 + d) = pack8(acc[ai][bj][m][0], acc[ai][bj][m][1]); } }
        }
    }
};

struct Fft2Prob {
    static constexpr bool PERM = true, GATHER_A = false, I8 = false, F8 = false; typedef f32x4 Acc;
    struct U { int k1p, pn; };
    const bf16_t *MT, *T1; bf16_t* XS; int G, c;
    __device__ __forceinline__ bool get(int i, U& u) const { const int L = i * G + c; if (L >= 512) return false; u.k1p = __builtin_amdgcn_readfirstlane(L >> 3); u.pn = __builtin_amdgcn_readfirstlane(L & 7); return true; }
    __device__ __forceinline__ void setup(const U& u, unsigned (&oa)[4], unsigned& ob, unsigned (&dA)[4], unsigned (&dB)[4], const char*& pA, const char*& pB, int& nt) const {
        int R0, Rb0, C0; g8::lane_geom(threadIdx.x, R0, Rb0, C0);
        nt = 2; pA = (const char*)MT; pB = (const char*)T1;
#pragma unroll
        for (int j = 0; j < 4; ++j) { dA[j] = (unsigned)(64 * j * 128) * 2u; dB[j] = dA[j]; }
        oa[0] = (unsigned)((u.k1p * 256 + R0) * 128 + C0) * 2u; ob = (unsigned)((u.k1p * 2048 + 256 * u.pn + Rb0) * 128 + C0) * 2u;
    }
    __device__ __forceinline__ void epi(const f32x4 (&acc)[2][2][4][2], const U& u, int wr, int wc, int fr, int fq) const {
#pragma unroll
        for (int ai = 0; ai < 2; ++ai)
#pragma unroll
            for (int m = 0; m < 4; ++m) { const int r = G8_ROWS(ai, m); const int s = r >> 7, k2 = (r & 127) >> 1, reim = r & 1;
                const int kb = (u.k1p == 0) ? 64 * s : (s ? 128 - u.k1p : u.k1p); const int k = kb + 128 * k2;
#pragma unroll
                for (int bj = 0; bj < 2; ++bj) { const int bc = 256 * u.pn + G8_COL0(bj); const int b = bc >> 9, ch = bc & 511, g = ch >> 7, d = ch & 127;
                    *(u32x4*)(XS + (size_t)(b * SEQ + k) * 1024 + g * 256 + reim * 128 + d) = pack8(acc[ai][bj][m][0], acc[ai][bj][m][1]); } }
    }
};

template <int MODE> struct MergeProb {
    static constexpr bool PERM = true, GATHER_A = false, I8 = false, F8 = false; typedef f32x4 Acc;
    struct U { int pm, pn; };
    const bf16_t* A; const bf16_t* W; int lda;
    const bf16_t* GATE; bf16_t* YB;
    const float* xin; const float* cin; float* XW; float* CW; const float* g1x; const float* g1c;
    int nM, G, c;
    __device__ __forceinline__ bool get(int i, U& u) const { const int L = i * G + c; if (L >= nM * 4) return false; int pm, pn; g8::order2d(L, nM, 4, pm, pn); u.pm = __builtin_amdgcn_readfirstlane(pm); u.pn = __builtin_amdgcn_readfirstlane(pn); return true; }
    __device__ __forceinline__ void setup(const U& u, unsigned (&oa)[4], unsigned& ob, unsigned (&dA)[4], unsigned (&dB)[4], const char*& pA, const char*& pB, int& nt) const {
        int R0, Rb0, C0; g8::lane_geom(threadIdx.x, R0, Rb0, C0);
        nt = lda >> 6; pA = (const char*)A; pB = (const char*)W;
#pragma unroll
        for (int j = 0; j < 4; ++j) { dA[j] = (unsigned)(64 * j * lda) * 2u; dB[j] = dA[j]; }
        oa[0] = (unsigned)((256 * u.pm + R0) * lda + C0) * 2u; ob = (unsigned)((256 * u.pn + Rb0) * lda + C0) * 2u;
    }
    __device__ __forceinline__ void epi(const f32x4 (&acc)[2][2][4][2], const U& u, int wr, int wc, int fr, int fq) const {
#pragma unroll
        for (int ai = 0; ai < 2; ++ai)
#pragma unroll
            for (int m = 0; m < 4; ++m) { const int tok = 256 * u.pm + G8_ROWS(ai, m);
#pragma unroll
                for (int bj = 0; bj < 2; ++bj) { const int col = 256 * u.pn + G8_COL0(bj);
                    f32x4 v0 = acc[ai][bj][m][0], v1 = acc[ai][bj][m][1];
                    if (MODE < 2) {
                        f32x4 g0, g1; unpack8(*(const u32x4*)(GATE + (size_t)tok * 1024 + col), g0, g1);
                        v0 *= g0; v1 *= g1;
                        if (MODE == 1) { f32x4 t0, t1; unpack8(*(const u32x4*)(YB + (size_t)tok * 1024 + col), t0, t1); v0 += t0; v1 += t1; }
                        *(u32x4*)(YB + (size_t)tok * 1024 + col) = pack8(v0, v1);
                    } else {
                        if (tok < TX) {
                            const float* gp = g1x + (tok >> 13) * 6144 + col; const f32x4 ga = *(const f32x4*)gp, gb = *(const f32x4*)(gp + 4);
                            const float* xp = xin + (size_t)tok * 1024 + col; float* op = XW + (size_t)tok * 1024 + col;
                            *(f32x4*)op = *(const f32x4*)xp + ga * v0; *(f32x4*)(op + 4) = *(const f32x4*)(xp + 4) + gb * v1;
                        } else {
                            const float* gp = g1c + col; const f32x4 ga = *(const f32x4*)gp, gb = *(const f32x4*)(gp + 4);
                            const float* xp = cin + (size_t)(tok - TX) * 1024 + col; float* op = CW + (size_t)(tok - TX) * 1024 + col;
                            *(f32x4*)op = *(const f32x4*)xp + ga * v0; *(f32x4*)(op + 4) = *(const f32x4*)(xp + 4) + gb * v1;
                        }
                    }
                } }
    }
};

struct MoeGuProb {
    static constexpr bool PERM = true, GATHER_A = true, I8 = true, F8 = false; typedef i32x4 Acc;
    struct U { int e, rt, pn, base, cnt; int tok[4]; };
    const signed char* H8; const signed char* W8; const float* sW; const float* lsc; const float* bgu; unsigned char* ACT; const int* list; const int* cnt;
    const volatile LAS int* tstart;
    int R, G, c;
    __device__ __forceinline__ bool get(int i, U& u) const {
        const int L = i * G + c; if (L >= R * 8) return false;
        int rt, pn; g8::order2d(L, R, 8, rt, pn);
        const int e = ((const volatile LAS unsigned char*)tstart)[(1024 - 64) + rt];
        u.e = __builtin_amdgcn_readfirstlane(e); u.rt = __builtin_amdgcn_readfirstlane(rt); u.pn = __builtin_amdgcn_readfirstlane(pn); u.base = __builtin_amdgcn_readfirstlane((rt - tstart[e]) * 256); u.cnt = __builtin_amdgcn_readfirstlane(cnt[e]);
        int R0, Rb0, C0; g8::lane_geom(threadIdx.x, R0, Rb0, C0);
#pragma unroll
        for (int j = 0; j < 4; ++j) { const int p = u.base + R0 + 64 * j; u.tok[j] = (p < u.cnt) ? list[(size_t)e * TT + p] : TT; }
        return true;
    }
    __device__ __forceinline__ void setup(const U& u, unsigned (&oa)[4], unsigned& ob, unsigned (&dA)[4], unsigned (&dB)[4], const char*& pA, const char*& pB, int& nt) const {
        int R0, Rb0, C0; g8::lane_geom(threadIdx.x, R0, Rb0, C0);
        nt = 8; pA = (const char*)H8; pB = (const char*)W8;
#pragma unroll
        for (int j = 0; j < 4; ++j) { dA[j] = 0u; dB[j] = (unsigned)(64 * j * 1024); oa[j] = (unsigned)(u.tok[j] * 1024 + C0 * 2); }
        ob = (unsigned)((u.e * 2048 + 256 * u.pn + Rb0) * 1024 + C0 * 2);
    }
    __device__ __forceinline__ void epi(const i32x4 (&acc)[2][2][4][2], const U& u, int wr, int wc, int fr, int fq) const {
        const int j0 = 128 * u.pn + 32 * wc + 8 * fq;
        const float* bp = bgu + (size_t)u.e * 2048 + j0;
        const f32x4 ba0 = *(const f32x4*)bp, ba1 = *(const f32x4*)(bp + 4), bu0 = *(const f32x4*)(bp + 1024), bu1 = *(const f32x4*)(bp + 1028);
        const float* sp = sW + (size_t)u.e * 2048 + 256 * u.pn + 32 * wc + 8 * fq;
        const f32x4 sa0 = *(const f32x4*)sp, sa1 = *(const f32x4*)(sp + 4), su0 = *(const f32x4*)(sp + 128), su1 = *(const f32x4*)(sp + 132);
#pragma unroll
        for (int ai = 0; ai < 2; ++ai)
#pragma unroll
            for (int m = 0; m < 4; ++m) { const int rr = G8_ROWS(ai, m); const size_t row = (size_t)256 * u.rt + rr;
                const int p = u.base + rr; const float rs = (p < u.cnt) ? lsc[(size_t)u.e * TT + p] : 0.0f;
                f32x4 a0, a1, u0, u1, y0, y1;
#pragma unroll
                for (int e = 0; e < 4; ++e) { a0[e] = (float)acc[ai][0][m][0][e] * rs * sa0[e] + ba0[e]; a1[e] = (float)acc[ai][0][m][1][e] * rs * sa1[e] + ba1[e];
                    u0[e] = (float)acc[ai][1][m][0][e] * rs * su0[e] + bu0[e]; u1[e] = (float)acc[ai][1][m][1][e] * rs * su1[e] + bu1[e]; }
#pragma unroll
                for (int e = 0; e < 4; ++e) {
                    float a = fminf(a0[e], 7.0f), uu = fminf(fmaxf(u0[e], -7.0f), 7.0f); y0[e] = a * sigmoidf_(1.702f * a) * (uu + 1.0f);
                    a = fminf(a1[e], 7.0f); uu = fminf(fmaxf(u1[e], -7.0f), 7.0f); y1[e] = a * sigmoidf_(1.702f * a) * (uu + 1.0f);
                }
                { u32x2 w; w.x = pk4_fp8(y0[0], y0[1], y0[2], y0[3]); w.y = pk4_fp8(y1[0], y1[1], y1[2], y1[3]); *(u32x2*)(ACT + row * 1024 + j0) = w; } }
    }
};
struct MoeDnProb {
    static constexpr bool PERM = true, GATHER_A = false, I8 = false, F8 = true; typedef f32x4 Acc;
    struct U { int e, rt, pn; };
    const unsigned char* ACT; const unsigned char* W; const float* bdn; bf16_t* YE;
    const volatile LAS int* tstart; int R, G, c;
    __device__ __forceinline__ bool get(int i, U& u) const {
        const int L = i * G + c; if (L >= R * 4) return false;
        int rt, pn; g8::order2d(L, R, 4, rt, pn);
        const int e = ((const volatile LAS unsigned char*)tstart)[(1024 - 64) + rt];
        u.e = __builtin_amdgcn_readfirstlane(e); u.rt = __builtin_amdgcn_readfirstlane(rt); u.pn = __builtin_amdgcn_readfirstlane(pn); return true;
    }
    __device__ __forceinline__ void setup(const U& u, unsigned (&oa)[4], unsigned& ob, unsigned (&dA)[4], unsigned (&dB)[4], const char*& pA, const char*& pB, int& nt) const {
        int R0, Rb0, C0; g8::lane_geom(threadIdx.x, R0, Rb0, C0);
        nt = 8; pA = (const char*)ACT; pB = (const char*)W;
#pragma unroll
        for (int j = 0; j < 4; ++j) { dA[j] = (unsigned)(64 * j * 1024); dB[j] = dA[j]; }
        oa[0] = (unsigned)((256 * u.rt + R0) * 1024 + C0 * 2); ob = (unsigned)((u.e * 1024 + 256 * u.pn + Rb0) * 1024 + C0 * 2);
    }
    __device__ __forceinline__ void epi(const f32x4 (&acc)[2][2][4][2], const U& u, int wr, int wc, int fr, int fq) const {
#pragma unroll
        for (int bj = 0; bj < 2; ++bj) { const int col = 256 * u.pn + G8_COL0(bj);
            const float* bp = bdn + (size_t)u.e * 1024 + col; const f32x4 b0 = *(const f32x4*)bp, b1 = *(const f32x4*)(bp + 4);
#pragma unroll
            for (int ai = 0; ai < 2; ++ai)
#pragma unroll
                for (int m = 0; m < 4; ++m) { const size_t row = (size_t)256 * u.rt + G8_ROWS(ai, m);
                    *(u32x4*)(YE + row * 1024 + col) = pack8(acc[ai][bj][m][0] * (1.0f / 32.0f) + b0, acc[ai][bj][m][1] * (1.0f / 32.0f) + b1); } }
    }
};

__device__ __forceinline__ int rope_perm(int d) { return (d & 32) | ((d & 15) << 1) | ((d >> 4) & 1); }
template <class RM>
__device__ __forceinline__ void transpose_tile(const Fr& F, const float* src, int N, int k0, int n0, bf16_t* dst, int Kd, RM rm) {
    LAS unsigned char* lds = F.lds;
    const int tid = F.tid;
    { const int kq = tid >> 4, c4 = (tid & 15) * 4; f32x4 v[4];
#pragma unroll
      for (int r = 0; r < 4; ++r) v[r] = *(const f32x4*)(src + (size_t)(k0 + 4 * kq + r) * N + n0 + c4);
#pragma unroll
      for (int e = 0; e < 4; ++e) { u32x2 w; w.x = cvt_pk_bf16(v[0][e], v[1][e]); w.y = cvt_pk_bf16(v[2][e], v[3][e]); *(LAS u32x2*)(lds + (c4 + e) * 272 + kq * 8) = w; } }
    __syncthreads();
    { const int n = tid >> 3, ch = tid & 7; const u32x4 w0 = *(const LAS u32x4*)(lds + n * 272 + ch * 32), w1 = *(const LAS u32x4*)(lds + n * 272 + ch * 32 + 16);
      bf16_t* dp = dst + (size_t)rm(n0 + n) * Kd + k0 + ch * 16; *(u32x4*)dp = w0; *(u32x4*)(dp + 8) = w1; }
    __syncthreads();
}
__device__ __forceinline__ void transpose_tile_fp8(const Fr& F, const float* src, int k0, int n0, unsigned char* dst) {
    LAS unsigned char* lds = F.lds;
    const int tid = F.tid;
    { const int kq = tid >> 4, c4 = (tid & 15) * 4; f32x4 v[4];
#pragma unroll
      for (int r = 0; r < 4; ++r) v[r] = *(const f32x4*)(src + (size_t)(k0 + 4 * kq + r) * 1024 + n0 + c4) * 32.0f;
#pragma unroll
      for (int e = 0; e < 4; ++e) *(LAS unsigned*)(lds + (c4 + e) * 144 + kq * 4) = pk4_fp8(v[0][e], v[1][e], v[2][e], v[3][e]); }
    __syncthreads();
    { const int n = tid >> 3, ch = tid & 7; const u32x4 w = *(const LAS u32x4*)(lds + n * 144 + ch * 16);
      *(u32x4*)(dst + (size_t)(n0 + n) * 1024 + k0 + ch * 16) = w; }
    __syncthreads();
}
struct RmGu { __device__ int operator()(int n) const { const int bj = n >> 10, j = n & 1023; return 256 * (j >> 7) + 128 * bj + (j & 127); } };
template <int N, class RM>
__device__ __forceinline__ void quant_strip(const Fr& F, const float* src, int n0, signed char* dst, float* sdst, RM rm) {
    LAS unsigned char* lds = F.lds;
    LAS float* red = (LAS float*)(lds + 16384);
    LAS float* inv = (LAS float*)(lds + 16384 + 8192);
    const int tid = F.tid, kq = tid >> 4, c4 = (tid & 15) * 4;
    f32x4 mx = {0.f, 0.f, 0.f, 0.f};
#pragma unroll 4
    for (int k = kq; k < 1024; k += 32) { const f32x4 v = *(const f32x4*)(src + (size_t)k * N + n0 + c4);
#pragma unroll
        for (int e = 0; e < 4; ++e) mx[e] = fmaxf(mx[e], fabsf(v[e])); }
#pragma unroll
    for (int e = 0; e < 4; ++e) red[kq * 64 + c4 + e] = mx[e];
    __syncthreads();
    if (tid < 64) { float m = 0.f;
#pragma unroll
        for (int r = 0; r < 32; ++r) m = fmaxf(m, red[r * 64 + tid]);
        const int row = rm(n0 + tid);
        sdst[row] = m * (1.0f / 127.0f); inv[tid] = m > 0.f ? 127.0f / m : 0.f; }
    __syncthreads();
    const f32x4 iv = *(const LAS f32x4*)(inv + c4);
#pragma unroll 1
    for (int kt = 0; kt < 8; ++kt) { f32x4 v[4];
#pragma unroll
        for (int r = 0; r < 4; ++r) v[r] = *(const f32x4*)(src + (size_t)(kt * 128 + 4 * kq + r) * N + n0 + c4);
#pragma unroll
        for (int e = 0; e < 4; ++e) { const int q0 = __float2int_rn(v[0][e] * iv[e]), q1 = __float2int_rn(v[1][e] * iv[e]), q2 = __float2int_rn(v[2][e] * iv[e]), q3 = __float2int_rn(v[3][e] * iv[e]);
            *(LAS unsigned*)(lds + (c4 + e) * 144 + kq * 4) = (unsigned)(q0 & 255) | ((unsigned)(q1 & 255) << 8) | ((unsigned)(q2 & 255) << 16) | ((unsigned)(q3 & 255) << 24); }
        __syncthreads();
        { const int nl = tid >> 3, ch = tid & 7; const u32x4 w = *(const LAS u32x4*)(lds + nl * 144 + ch * 16);
          const int row = rm(n0 + nl);
          *(u32x4*)(dst + (size_t)row * 1024 + kt * 128 + ch * 16) = w; }
        __syncthreads();
    }
}
struct RmId { __device__ int operator()(int n) const { return n; } };
struct RmWin { __device__ int operator()(int n) const { return (n >= 512 && n < 1152) ? ((n & ~63) | rope_perm(n & 63)) : n; } };

__device__ __forceinline__ void prologue_phase(const Fr& F) {
    const int tid = F.tid, G = F.G, bid = F.bid;
    const float PI2 = 6.283185307179586f;
    const size_t gtid = (size_t)bid * 512 + tid, gsz = (size_t)G * 512;
    { float* rope = WSP(float, WS_ROPE);
      for (size_t i = gtid; i < 2048; i += gsz) { const int pos = (int)(i >> 4), f = (int)(i & 15); const float inv = powf(10000.0f, -(float)f / 16.0f); const float a = (float)pos * inv; rope[i] = cosf(a); rope[2048 + i] = sinf(a); } }
    { bf16_t* W1 = WSP(bf16_t, WS_W1);
      for (size_t i = gtid; i < 256 * 128; i += gsz) { const int r = (int)(i >> 7), n1 = (int)(i & 127); float v = 0.f;
          if (r < 128) { const int k1p = r >> 1, part = r & 1;
              if (part == 0) v = cospif((float)((k1p * n1) & 127) / 64.0f);
              else if (k1p == 0) v = (n1 & 1) ? -1.0f : 1.0f;
              else v = -sinpif((float)((k1p * n1) & 127) / 64.0f); }
          W1[i] = f2bf(v); } }
    { bf16_t* MT = WSP(bf16_t, WS_MT);
      for (size_t i = gtid; i < (size_t)64 * 256 * 128; i += gsz) {
          const int kk = (int)(i & 127), r = (int)((i >> 7) & 255), k1p = (int)(i >> 15);
          const int part = kk >> 6, n2 = kk & 63, s = r >> 7, k2 = (r & 127) >> 1, reim = r & 1;
          float v;
          if (k1p == 0) { const int k = 64 * s + 128 * k2; const int mm = (n2 * k) & 8191; const float cm = cospif((float)mm / 4096.0f), sm = sinpif((float)mm / 4096.0f);
              v = (part == s) ? (reim ? -sm : cm) : 0.0f; }
          else { const int k = (s ? 128 - k1p : k1p) + 128 * k2; const int mm = (n2 * k) & 8191; const float cm = cospif((float)mm / 4096.0f), sm = sinpif((float)mm / 4096.0f);
              if (s == 0) v = reim ? (part ? cm : -sm) : (part ? sm : cm);
              else        v = reim ? (part ? -cm : -sm) : (part ? -sm : cm); }
          MT[i] = f2bf(v); } }
    { bf16_t* WC = WSP(bf16_t, WS_WC);
      const float sc = 5.656854249492381f;
      for (size_t i = gtid; i < 512 * 256; i += gsz) { const int n = (int)(i & 255), r = (int)(i >> 8), k = r >> 1, reim = r & 1; const int mm = (k * n) & 255;
          WC[i] = f2bf(sc * (reim ? -sinpif((float)mm / 128.0f) : cospif((float)mm / 128.0f))); } }
    { bf16_t* RWT = WSP(bf16_t, WS_RWT); const float* rw = INP(13);
      for (size_t i = gtid; i < (size_t)DEPTH * 32 * 1024; i += gsz) { const int k = (int)(i & 1023), e = (int)((i >> 10) & 31), l = (int)(i >> 15); RWT[i] = f2bf(rw[((size_t)l * 1024 + k) * 32 + e]); } }
    { bf16_t* H = WSP(bf16_t, WS_H); for (size_t i = gtid; i < 256 * 1024; i += gsz) H[(size_t)TT * 1024 + i] = 0;
      unsigned* H8z = (unsigned*)(WSP(signed char, WS_H8) + (size_t)TT * 1024); for (size_t i = gtid; i < 256 * 256; i += gsz) H8z[i] = 0u; }
    (void)PI2;
    {
        LAS float* sil = (LAS float*)(F.lds + 65536);
        LAS float* red = (LAS float*)(F.lds + 65536 + 20480);
        for (int i = tid; i < 5 * 1024; i += 512) { const int v = i >> 10, k = i & 1023; const float x = (v < 4) ? INP(1)[v * 1024 + k] : INP(3)[k]; sil[i] = x * sigmoidf_(x); }
        __syncthreads();
        float* MOD = WSP(float, WS_MOD);
        for (int u = bid; u < DEPTH * 96; u += G) {
            const int l = u / 96, j0 = (u % 96) * 64;
            const float* aw = INP(4) + (size_t)l * 1024 * 6144 + j0 + F.lane;
            float a0 = 0.f, a1 = 0.f, a2 = 0.f, a3 = 0.f, a4 = 0.f;
            for (int kk = 0; kk < 128; ++kk) { const int k = F.wave * 128 + kk; const float w = aw[(size_t)k * 6144];
                a0 += sil[k] * w; a1 += sil[1024 + k] * w; a2 += sil[2048 + k] * w; a3 += sil[3072 + k] * w; a4 += sil[4096 + k] * w; }
            red[(F.wave * 5 + 0) * 64 + F.lane] = a0; red[(F.wave * 5 + 1) * 64 + F.lane] = a1; red[(F.wave * 5 + 2) * 64 + F.lane] = a2; red[(F.wave * 5 + 3) * 64 + F.lane] = a3; red[(F.wave * 5 + 4) * 64 + F.lane] = a4;
            __syncthreads();
            if (tid < 320) { const int v = tid >> 6, jl = tid & 63; float s = INP(5)[(size_t)l * 6144 + j0 + jl];
#pragma unroll
                for (int w = 0; w < 8; ++w) s += red[(w * 5 + v) * 64 + jl];
                MOD[((size_t)l * 5 + v) * 6144 + j0 + jl] = s; }
            __syncthreads();
        }
    }
    {
        LAS float* tab = (LAS float*)(F.lds + 65536);
        if (tid < 128) { tab[tid] = cospif((float)tid / 64.0f); tab[128 + tid] = sinpif((float)tid / 64.0f); }
        __syncthreads();
        bf16_t* WFO = WSP(bf16_t, WS_WFO);
        for (int u = bid; u < DEPTH * 4 * 2 * 16; u += G) {
            const int dc = u & 15, reim = (u >> 4) & 1, g = (u >> 5) & 3, l = u >> 7;
            const float* wf = INP(10) + ((size_t)l * 512 + g * 128) * 1024;
#pragma unroll 1
            for (int oh = 0; oh < 2; ++oh) { const int o = tid + 512 * oh;
                float a[8] = {0.f, 0.f, 0.f, 0.f, 0.f, 0.f, 0.f, 0.f};
                for (int j = 0; j < 128; ++j) { const float w = wf[(size_t)j * 1024 + o];
#pragma unroll
                    for (int q = 0; q < 8; ++q) a[q] += tab[reim * 128 + ((j * (dc * 8 + q)) & 127)] * w; }
                u32x4 w4; w4.x = cvt_pk_bf16(a[0] * (1.f / 1024.f), a[1] * (1.f / 1024.f)); w4.y = cvt_pk_bf16(a[2] * (1.f / 1024.f), a[3] * (1.f / 1024.f));
                w4.z = cvt_pk_bf16(a[4] * (1.f / 1024.f), a[5] * (1.f / 1024.f)); w4.w = cvt_pk_bf16(a[6] * (1.f / 1024.f), a[7] * (1.f / 1024.f));
                *(u32x4*)(WFO + ((size_t)l * 1024 + o) * 1024 + g * 256 + reim * 128 + dc * 8) = w4; }
        }
        __syncthreads();
    }
    {
        constexpr int T_WIN = DEPTH * 52, T_WAO = DEPTH * 4 * 16, T_WOUT = DEPTH * 8 * 16, T_DN = DEPTH * 32 * 8 * 16, T_GU = DEPTH * 32 * 32;
        constexpr int T_ALL = T_GU + T_DN + T_WIN + T_WAO + T_WOUT;
        for (int t = bid; t < T_ALL; t += G) {
            int q = t;
            if (q < T_GU) { const int le = q >> 5, ns = q & 31;
                quant_strip<2048>(F, INP(15) + (size_t)le * 1024 * 2048, ns * 64, WSP(signed char, WS_WGU) + (size_t)le * 2048 * 1024, WSP(float, WS_SWGU) + (size_t)le * 2048, RmGu()); continue; }
            q -= T_GU;
            if (q < T_DN) { const int le = q / 128, r = q % 128, kt = r / 16, ntl = r % 16;
                transpose_tile_fp8(F, INP(17) + (size_t)le * 1024 * 1024, kt * 128, ntl * 64, WSP(unsigned char, WS_WDN) + (size_t)le * 1024 * 1024); continue; }
            q -= T_DN;
            if (q < T_WIN) { const int l = q / 52, ns = q % 52;
                quant_strip<IN_DIM>(F, INP(8) + (size_t)l * 1024 * IN_DIM, ns * 64, WSP(signed char, WS_WIN) + (size_t)l * IN_DIM * 1024, WSP(float, WS_SWIN) + (size_t)l * IN_DIM, RmWin()); continue; }
            q -= T_WIN;
            if (q < T_WAO) { const int l = q / 64, r = q % 64, kt = r / 16, ntl = r % 16;
                transpose_tile(F, INP(11) + (size_t)l * 512 * 1024, 1024, kt * 128, ntl * 64, WSP(bf16_t, WS_WAO) + (size_t)l * 1024 * 512, 512, RmId()); continue; }
            q -= T_WAO;
            { const int l = q / 128, r = q % 128, kt = r / 16, ntl = r % 16;
                transpose_tile(F, INP(12) + (size_t)l * 1024 * 1024, 1024, kt * 128, ntl * 64, WSP(bf16_t, WS_WOUT) + (size_t)l * 1024 * 1024, 1024, RmId()); }
        }
    }
}

__device__ __forceinline__ void moe_combine(const Fr& F, int tok, int lprev, const volatile LAS int* tstart, f32x4 (&m)[4]) {
    const int* slot = WSP(int, WS_SLOT); const float* gate = WSP(float, WS_GATE); const bf16_t* YE = WSP(bf16_t, WS_YE);
#pragma unroll
    for (int j = 0; j < 4; ++j) m[j] = (f32x4){0.f, 0.f, 0.f, 0.f};
#pragma unroll
    for (int k = 0; k < 4; ++k) {
        const int sl = slot[tok * 4 + k]; const float gk = gate[tok * 4 + k];
        const int e = sl >> 20, pos = sl & 0xfffff;
        const size_t row = (size_t)256 * tstart[e] + pos;
        const bf16_t* yp = YE + row * 1024 + 4 * F.lane;
#pragma unroll
        for (int j = 0; j < 4; ++j) { const u32x2 w = *(const u32x2*)(yp + 256 * j); m[j][0] += gk * bf_lo(w.x); m[j][1] += gk * bf_hi(w.x); m[j][2] += gk * bf_lo(w.y); m[j][3] += gk * bf_hi(w.y); }
    }
    (void)lprev;
}
__device__ __forceinline__ int fill_tstart(const Fr& F, int l) {
    volatile LAS int* ts = (volatile LAS int*)(F.lds + LDS_MISC + 64);
    __syncthreads();
    if (F.tid == 0) { const int* cnt = (const int*)(F.ws + WS_CTL + CTL_CNT) + l * 32; int s = 0; for (int e = 0; e < 32; ++e) { ts[e] = s; s += (cnt[e] + 255) >> 8; } ts[32] = s; }
    __syncthreads();
    { volatile LAS unsigned char* r2e = (volatile LAS unsigned char*)(F.lds + LDS_MISC + 1024);
      const int R = ts[32];
      for (int rt = F.tid; rt < R; rt += 512) { int e = 0;
#pragma unroll 1
          for (int q = 1; q < 32; ++q) e = (ts[q] <= rt) ? q : e;
          r2e[rt] = (unsigned char)e; } }
    __syncthreads();
    return ts[32];
}

__device__ __forceinline__ void norm1_phase(const Fr& F, int l) {
    const volatile LAS int* tstart = (const volatile LAS int*)(F.lds + LDS_MISC + 64);
    if (l > 0) fill_tstart(F, l - 1);
    const float* MOD = WSP(float, WS_MOD);
    const bool fin = (l == DEPTH);
    const int ntok = fin ? TX : TT;
    const bool tmo = fin && (xb_ld((unsigned*)(F.ws + WS_CTL) + XB_TMO) != 0u);
    const float* gvec = fin ? INP(19) : INP(6) + (size_t)l * 1024;
    float* XW = WSP(float, WS_XW); float* CW = WSP(float, WS_CW); signed char* H8 = WSP(signed char, WS_H8); float* SHv = WSP(float, WS_SH);
    for (int tok = F.bid * 8 + F.wave; tok < ntok; tok += F.G * 8) {
        const bool isx = tok < TX; const int v = isx ? (tok >> 13) : 4;
        const float* src = (l == 0) ? (isx ? INP(0) + (size_t)tok * 1024 : INP(2) + (size_t)(tok - TX) * 1024) : (isx ? XW + (size_t)tok * 1024 : CW + (size_t)(tok - TX) * 1024);
        f32x4 x[4];
#pragma unroll
        for (int j = 0; j < 4; ++j) x[j] = *(const f32x4*)(src + 256 * j + 4 * F.lane);
        if (l > 0) {
            f32x4 mm[4]; moe_combine(F, tok, l - 1, tstart, mm);
            const float* g2 = MOD + ((size_t)(l - 1) * 5 + v) * 6144 + 5 * 1024;
            float* dst = isx ? XW + (size_t)tok * 1024 : CW + (size_t)(tok - TX) * 1024;
#pragma unroll
            for (int j = 0; j < 4; ++j) { x[j] += *(const f32x4*)(g2 + 256 * j + 4 * F.lane) * mm[j]; if (!fin) *(f32x4*)(dst + 256 * j + 4 * F.lane) = x[j]; }
        }
        float ss = 0.f;
#pragma unroll
        for (int j = 0; j < 4; ++j) ss += x[j][0] * x[j][0] + x[j][1] * x[j][1] + x[j][2] * x[j][2] + x[j][3] * x[j][3];
        ss = wave_sum(ss);
        const float rstd = rsqrtf(ss * (1.0f / 1024.0f) + EPS);
        if (fin) {
#pragma unroll
            for (int j = 0; j < 4; ++j) { const f32x4 g = *(const f32x4*)(gvec + 256 * j + 4 * F.lane); *(f32x4*)(F.out + (size_t)tok * 1024 + 256 * j + 4 * F.lane) = tmo ? (f32x4){__builtin_nanf(""), __builtin_nanf(""), __builtin_nanf(""), __builtin_nanf("")} : x[j] * rstd * g; }
        } else {
            const float* md = MOD + ((size_t)l * 5 + v) * 6144;
            float amax = 0.f;
#pragma unroll
            for (int j = 0; j < 4; ++j) { const int c = 256 * j + 4 * F.lane; const f32x4 g = *(const f32x4*)(gvec + c), sh = *(const f32x4*)(md + c), sc = *(const f32x4*)(md + 1024 + c);
                x[j] = x[j] * rstd * g * (sc + 1.0f) + sh;
                amax = fmaxf(amax, fmaxf(fmaxf(fabsf(x[j][0]), fabsf(x[j][1])), fmaxf(fabsf(x[j][2]), fabsf(x[j][3])))); }
#pragma unroll
            for (int o = 32; o >= 1; o >>= 1) amax = fmaxf(amax, __shfl_xor(amax, o));
            const float inv = amax > 0.f ? 127.0f / amax : 0.f;
#pragma unroll
            for (int j = 0; j < 4; ++j) { const int c = 256 * j + 4 * F.lane;
                const int q0 = __float2int_rn(x[j][0] * inv), q1 = __float2int_rn(x[j][1] * inv), q2 = __float2int_rn(x[j][2] * inv), q3 = __float2int_rn(x[j][3] * inv);
                *(unsigned*)(H8 + (size_t)tok * 1024 + c) = (unsigned)(q0 & 255) | ((unsigned)(q1 & 255) << 8) | ((unsigned)(q2 & 255) << 16) | ((unsigned)(q3 & 255) << 24); }
            if (F.lane == 0) SHv[tok] = amax * (1.0f / 127.0f);
        }
    }
}

__device__ __forceinline__ void norm2_router_phase(const Fr& F, int l, bool fake = false) {
    const int ntok = (l == DEPTH - 1) ? TX : TT;
    const float* MOD = WSP(float, WS_MOD); const float* gvec = INP(7) + (size_t)l * 1024;
    const float* XW = WSP(float, WS_XW); const float* CW = WSP(float, WS_CW); bf16_t* H = WSP(bf16_t, WS_H);
    const bf16_t* RWT = WSP(bf16_t, WS_RWT) + (size_t)l * 32 * 1024; const float* rb = INP(14) + l * 32;
    int* cntg = (int*)(F.ws + WS_CTL + CTL_CNT) + l * 32; int* list = WSP(int, WS_LIST); int* slot = WSP(int, WS_SLOT); float* gate = WSP(float, WS_GATE);
    LAS unsigned char* hs = F.lds;
    LAS float* part = (LAS float*)(F.lds + 69632);
    LAS float* logit = (LAS float*)(F.lds + 69632 + 36864);
    LAS int* lcnt = (LAS int*)(F.lds + 69632 + 36864 + 4608);
    LAS int* lbase = lcnt + 32;
    LAS float* tsc = (LAS float*)(lbase + 32);
    signed char* H8 = WSP(signed char, WS_H8); float* lscg = WSP(float, WS_LSC);
    const int lane = F.lane, w = F.wave, l32 = lane & 31, hh = lane >> 5;
    for (int tl = F.bid; tl < ntok / 32; tl += F.G) {
        const int t0 = tl * 32;
        if (F.tid < 32) lcnt[F.tid] = 0;
#pragma unroll 1
        for (int q = 0; q < 4; ++q) {
            const int tloc = 4 * w + q, tok = t0 + tloc; const bool isx = tok < TX; const int v = isx ? (tok >> 13) : 4;
            const float* src = isx ? XW + (size_t)tok * 1024 : CW + (size_t)(tok - TX) * 1024;
            f32x4 x[4]; float ss = 0.f;
#pragma unroll
            for (int j = 0; j < 4; ++j) { x[j] = *(const f32x4*)(src + 256 * j + 4 * lane); ss += x[j][0] * x[j][0] + x[j][1] * x[j][1] + x[j][2] * x[j][2] + x[j][3] * x[j][3]; }
            ss = wave_sum(ss); const float rstd = rsqrtf(ss * (1.0f / 1024.0f) + EPS);
            const float* md = MOD + ((size_t)l * 5 + v) * 6144;
            float amax = 0.f;
#pragma unroll
            for (int j = 0; j < 4; ++j) { const int c = 256 * j + 4 * lane; const f32x4 g = *(const f32x4*)(gvec + c), sh = *(const f32x4*)(md + 3072 + c), sc = *(const f32x4*)(md + 4096 + c);
                x[j] = x[j] * rstd * g * (sc + 1.0f) + sh;
                amax = fmaxf(amax, fmaxf(fmaxf(fabsf(x[j][0]), fabsf(x[j][1])), fmaxf(fabsf(x[j][2]), fabsf(x[j][3]))));
                u32x2 wv; wv.x = cvt_pk_bf16(x[j][0], x[j][1]); wv.y = cvt_pk_bf16(x[j][2], x[j][3]);
                *(LAS u32x2*)(hs + tloc * 2064 + c * 2) = wv; }
#pragma unroll
            for (int o = 32; o >= 1; o >>= 1) amax = fmaxf(amax, __shfl_xor(amax, o));
            const float inv = amax > 0.f ? 127.0f / amax : 0.f;
#pragma unroll
            for (int j = 0; j < 4; ++j) { const int c = 256 * j + 4 * lane;
                const int q0 = __float2int_rn(x[j][0] * inv), q1 = __float2int_rn(x[j][1] * inv), q2 = __float2int_rn(x[j][2] * inv), q3 = __float2int_rn(x[j][3] * inv);
                *(unsigned*)(H8 + (size_t)tok * 1024 + c) = (unsigned)(q0 & 255) | ((unsigned)(q1 & 255) << 8) | ((unsigned)(q2 & 255) << 16) | ((unsigned)(q3 & 255) << 24); }
            if (lane == 0) tsc[tloc] = amax * (1.0f / 127.0f);
        }
        __syncthreads();
        {
            f32x16 acc;
#pragma unroll
            for (int e = 0; e < 16; ++e) acc[e] = 0.f;
#pragma unroll
            for (int s = 0; s < 8; ++s) { const int k = 128 * w + 16 * s + 8 * hh;
                const bf16x8 a = *(const LAS bf16x8*)(hs + l32 * 2064 + k * 2);
                const bf16x8 b = *(const bf16x8*)(RWT + (size_t)l32 * 1024 + k);
                acc = __builtin_amdgcn_mfma_f32_32x32x16_bf16(a, b, acc, 0, 0, 0); }
#pragma unroll
            for (int e = 0; e < 16; ++e) { const int trow = 8 * (e >> 2) + 4 * hh + (e & 3); part[(w * 32 + trow) * 33 + l32] = acc[e]; }
        }
        __syncthreads();
        { const int tr = F.tid >> 4, e0 = (F.tid & 15) * 2;
#pragma unroll
          for (int q = 0; q < 2; ++q) { float s = rb[e0 + q];
#pragma unroll
              for (int ww = 0; ww < 8; ++ww) s += part[(ww * 32 + tr) * 33 + e0 + q];
              logit[tr * 33 + e0 + q] = s; } }
        __syncthreads();
        int es[4], rk[4]; float gs[4];
        if (fake) { __syncthreads(); continue; }
        if (F.tid < 32) {
            float lv[4]; unsigned used = 0u;
#pragma unroll
            for (int k = 0; k < 4; ++k) { float best = -3.0e38f; int bi = 0;
#pragma unroll 1
                for (int e = 0; e < 32; ++e) { const float vv = logit[F.tid * 33 + e]; if (!((used >> e) & 1u) && vv > best) { best = vv; bi = e; } }
                used |= 1u << bi; es[k] = bi; lv[k] = best; }
            const float mx = lv[0]; float sum = 0.f;
#pragma unroll
            for (int k = 0; k < 4; ++k) { gs[k] = __expf(lv[k] - mx); sum += gs[k]; }
#pragma unroll
            for (int k = 0; k < 4; ++k) { gs[k] /= sum; rk[k] = __hip_atomic_fetch_add(&lcnt[es[k]], 1, __ATOMIC_RELAXED, __HIP_MEMORY_SCOPE_WORKGROUP); }
        }
        __syncthreads();
        if (F.tid < 32) { const int n = lcnt[F.tid]; lbase[F.tid] = n ? atomicAdd(&cntg[F.tid], n) : 0; }
        __syncthreads();
        if (F.tid < 32) { const int tok = t0 + F.tid;
#pragma unroll
            for (int k = 0; k < 4; ++k) { const int pos = lbase[es[k]] + rk[k]; list[(size_t)es[k] * TT + pos] = tok; lscg[(size_t)es[k] * TT + pos] = tsc[F.tid]; slot[tok * 4 + k] = (es[k] << 20) | pos; gate[tok * 4 + k] = gs[k]; } }
        __syncthreads();
    }
}

template <int OFF> __device__ __forceinline__ s16x4 tr_read(unsigned vb) { s16x4 r; asm volatile("ds_read_b64_tr_b16 %0, %1 offset:%2" : "=&v"(r) : "v"(vb), "i"(OFF) : "memory"); return r; }

__device__ __forceinline__ void attn_phase(const Fr& F, int l, bool with_ctx) {
    LAS unsigned char* lds = F.lds;
    const unsigned ldsb = (unsigned)(uintptr_t)lds;
    const bf16_t* Q = WSP(bf16_t, WS_Q); const bf16_t* Kb = WSP(bf16_t, WS_K); const bf16_t* Vb = WSP(bf16_t, WS_V); bf16_t* AO = WSP(bf16_t, WS_AO);
    const int tid = F.tid, lane = F.lane, w = F.wave, l32 = lane & 31, hh = lane >> 5;
    const int g = w >> 1, rhalf = w & 1;
    const int nunits = 512 + (with_ctx ? 16 : 0);
    const int skey = tid >> 3, sch = tid & 7;
    const unsigned k_st = (unsigned)(skey * 128 + ((sch ^ ((skey >> 1) & 7)) * 16));
    const unsigned v_st = (unsigned)(8192 + skey * 128 + ((((sch >> 1) ^ (((skey >> 1) & 1) << 1)) * 32) + (sch & 1) * 16));
    unsigned vbase[2];
    { const int li = lane & 15, q = li >> 2, p = li & 3, g16 = l32 >> 4; const int key = 4 * hh + q;
#pragma unroll
      for (int db = 0; db < 2; ++db) { const int c32 = 2 * db + g16; vbase[db] = ldsb + 8192u + (unsigned)(key * 128 + ((c32 ^ (((key >> 1) & 1) << 1)) * 32) + 8 * p); } }
    for (int u = F.bid; u < nunits; u += F.G) {
        int b, qb, kvh; bool isctx;
        if (u < 512) { b = u >> 7; qb = (u >> 1) & 63; kvh = u & 1; isctx = false; }
        else { const int uu = u - 512; b = uu >> 2; qb = (uu >> 1) & 1; kvh = uu & 1; isctx = true; }
        const int head = kvh * 4 + g;
        const int qtok0 = isctx ? (TX + b * LC + qb * 128) : (b * SEQ + qb * 128);
        bf16x8 qf[2][4];
#pragma unroll
        for (int qk = 0; qk < 2; ++qk)
#pragma unroll
            for (int s = 0; s < 4; ++s) qf[qk][s] = *(const bf16x8*)(Q + (size_t)(qtok0 + rhalf * 64 + qk * 32 + l32) * 512 + head * 64 + 16 * s + 8 * hh);
        const float sink2 = INP(9)[l * 8 + head] * LOG2E;
        float m_run[2] = {sink2, sink2}, l_run[2] = {hh ? 0.f : 1.f, hh ? 0.f : 1.f};
        f32x16 O[2][2];
#pragma unroll
        for (int a = 0; a < 2; ++a)
#pragma unroll
            for (int c = 0; c < 2; ++c)
#pragma unroll
                for (int e = 0; e < 16; ++e) O[a][c][e] = 0.f;
        int t = isctx ? 6 : (qb == 0 ? 2 : 0);
        u32x4 kreg, vreg;
        { const int tok0 = (t < 6) ? (b * SEQ + (qb - 1) * 128 + 64 * t) : (TX + b * LC + 64 * (t - 6));
          kreg = *(const u32x4*)(Kb + (size_t)(tok0 + skey) * 128 + kvh * 64 + sch * 8); vreg = *(const u32x4*)(Vb + (size_t)(tok0 + skey) * 128 + kvh * 64 + sch * 8); }
        for (;;) {
            __syncthreads();
            *(LAS u32x4*)(lds + k_st) = kreg; *(LAS u32x4*)(lds + v_st) = vreg;
            int tn = t + 1; if (!isctx && qb == 63 && (tn == 4 || tn == 5)) tn = 6;
            const bool more = tn < 10;
            if (more) { const int tok0 = (tn < 6) ? (b * SEQ + (qb - 1) * 128 + 64 * tn) : (TX + b * LC + 64 * (tn - 6));
                kreg = *(const u32x4*)(Kb + (size_t)(tok0 + skey) * 128 + kvh * 64 + sch * 8); vreg = *(const u32x4*)(Vb + (size_t)(tok0 + skey) * 128 + kvh * 64 + sch * 8); }
            __syncthreads();
            const bool local = (!isctx) && (t < 6);
            const bool skip = local && ((rhalf == 0 && t == 5) || (rhalf == 1 && t == 0));
            if (!skip) {
                f32x16 S[2][2];
#pragma unroll
                for (int kb = 0; kb < 2; ++kb)
#pragma unroll
                    for (int qk = 0; qk < 2; ++qk)
#pragma unroll
                        for (int e = 0; e < 16; ++e) S[kb][qk][e] = 0.f;
#pragma unroll
                for (int kb = 0; kb < 2; ++kb)
#pragma unroll
                    for (int s = 0; s < 4; ++s) { const int key = 32 * kb + l32, ch = 2 * s + hh;
                        const bf16x8 kf = *(const LAS bf16x8*)(lds + key * 128 + ((ch ^ ((key >> 1) & 7)) * 16));
#pragma unroll
                        for (int qk = 0; qk < 2; ++qk) S[kb][qk] = __builtin_amdgcn_mfma_f32_32x32x16_bf16(kf, qf[qk][s], S[kb][qk], 0, 0, 0); }
                bf16x8 pf[2][2][2];
#pragma unroll
                for (int qk = 0; qk < 2; ++qk) {
                    if (local) { const int rq = rhalf * 64 + qk * 32 + l32;
#pragma unroll
                        for (int kb = 0; kb < 2; ++kb)
#pragma unroll
                            for (int e = 0; e < 16; ++e) { const int kk = 64 * t + 32 * kb + 8 * (e >> 2) + 4 * hh + (e & 3); const int rel = kk - 128 - rq; if (rel < -128 || rel > 128) S[kb][qk][e] = -__builtin_inff(); } }
                    float mx = -__builtin_inff();
#pragma unroll
                    for (int kb = 0; kb < 2; ++kb)
#pragma unroll
                        for (int e = 0; e < 16; ++e) mx = fmaxf(mx, S[kb][qk][e]);
                    mx = fmaxf(mx, __shfl_xor(mx, 32));
                    const float mn = fmaxf(m_run[qk], mx); const float alpha = __builtin_amdgcn_exp2f(m_run[qk] - mn); m_run[qk] = mn;
                    float rs = 0.f;
#pragma unroll
                    for (int kb = 0; kb < 2; ++kb)
#pragma unroll
                        for (int e = 0; e < 16; ++e) { const float p = __builtin_amdgcn_exp2f(S[kb][qk][e] - mn); S[kb][qk][e] = p; rs += p; }
                    l_run[qk] = l_run[qk] * alpha + rs;
#pragma unroll
                    for (int db = 0; db < 2; ++db)
#pragma unroll
                        for (int e = 0; e < 16; ++e) O[db][qk][e] *= alpha;
#pragma unroll
                    for (int kb = 0; kb < 2; ++kb)
#pragma unroll
                        for (int sp = 0; sp < 2; ++sp) { u32x4 pw;
                            pw.x = cvt_pk_bf16(S[kb][qk][8 * sp + 0], S[kb][qk][8 * sp + 1]); pw.y = cvt_pk_bf16(S[kb][qk][8 * sp + 2], S[kb][qk][8 * sp + 3]);
                            pw.z = cvt_pk_bf16(S[kb][qk][8 * sp + 4], S[kb][qk][8 * sp + 5]); pw.w = cvt_pk_bf16(S[kb][qk][8 * sp + 6], S[kb][qk][8 * sp + 7]);
                            pf[kb][sp][qk] = __builtin_bit_cast(bf16x8, pw); }
                }
#define PV_STEP(KB, SP) do { \
                    const s16x4 a0 = tr_read<((32 * (KB) + 16 * (SP)) * 128)>(vbase[0]), a1 = tr_read<((32 * (KB) + 16 * (SP) + 8) * 128)>(vbase[0]); \
                    const s16x4 c0 = tr_read<((32 * (KB) + 16 * (SP)) * 128)>(vbase[1]), c1 = tr_read<((32 * (KB) + 16 * (SP) + 8) * 128)>(vbase[1]); \
                    asm volatile("s_waitcnt lgkmcnt(0)" ::: "memory"); __builtin_amdgcn_sched_barrier(0); \
                    const bf16x8 vf0 = (bf16x8){a0[0], a0[1], a0[2], a0[3], a1[0], a1[1], a1[2], a1[3]}, vf1 = (bf16x8){c0[0], c0[1], c0[2], c0[3], c1[0], c1[1], c1[2], c1[3]}; \
                    O[0][0] = __builtin_amdgcn_mfma_f32_32x32x16_bf16(vf0, pf[KB][SP][0], O[0][0], 0, 0, 0); O[0][1] = __builtin_amdgcn_mfma_f32_32x32x16_bf16(vf0, pf[KB][SP][1], O[0][1], 0, 0, 0); \
                    O[1][0] = __builtin_amdgcn_mfma_f32_32x32x16_bf16(vf1, pf[KB][SP][0], O[1][0], 0, 0, 0); O[1][1] = __builtin_amdgcn_mfma_f32_32x32x16_bf16(vf1, pf[KB][SP][1], O[1][1], 0, 0, 0); } while (0)
                PV_STEP(0, 0); PV_STEP(0, 1); PV_STEP(1, 0); PV_STEP(1, 1);
#undef PV_STEP
            }
            if (!more) break;
            t = tn;
        }
#pragma unroll
        for (int qk = 0; qk < 2; ++qk) {
            const float lt = l_run[qk] + __shfl_xor(l_run[qk], 32); const float inv = 1.0f / lt;
            const size_t tok = (size_t)(qtok0 + rhalf * 64 + qk * 32 + l32);
#pragma unroll
            for (int db = 0; db < 2; ++db)
#pragma unroll
                for (int vq = 0; vq < 4; ++vq) { u32x2 wv; wv.x = cvt_pk_bf16(O[db][qk][4 * vq] * inv, O[db][qk][4 * vq + 1] * inv); wv.y = cvt_pk_bf16(O[db][qk][4 * vq + 2] * inv, O[db][qk][4 * vq + 3] * inv);
                    *(u32x2*)(AO + tok * 512 + head * 64 + 32 * db + 8 * vq + 4 * hh) = wv; }
        }
    }
    __syncthreads();
}

struct Args { const float* in[20]; float* out; unsigned char* ws; int ph_lo, ph_hi; };

constexpr int PH_PER_LAYER = 9;
constexpr int PH_FINAL = 1 + DEPTH * PH_PER_LAYER;
constexpr int PH_COUNT = PH_FINAL + 1;

__global__ void __launch_bounds__(512, 2) fwd_kernel(Args args) {
    extern __shared__ __attribute__((aligned(16))) unsigned char lds_raw[];
    Fr F;
    F.lds = (LAS unsigned char*)lds_raw; F.ws = args.ws; F.out = args.out;
    F.tid = threadIdx.x; F.lane = F.tid & 63; F.wave = __builtin_amdgcn_readfirstlane(F.tid >> 6); F.G = gridDim.x; F.bid = blockIdx.x;
    volatile LAS unsigned* misc = (volatile LAS unsigned*)(F.lds + LDS_MISC);
    if (F.tid < 64) misc[F.tid] = 0u;
    if (F.tid < 20) { const unsigned long long pv = (unsigned long long)args.in[F.tid]; misc[128 + 2 * F.tid] = (unsigned)pv; misc[128 + 2 * F.tid + 1] = (unsigned)(pv >> 32); }
    __syncthreads();
    XcdBarrier bar; bar.bar = (unsigned*)(F.ws + WS_CTL); bar.x = 0; bar.st = misc;
    const bool one = (args.ph_hi - args.ph_lo) > 1;
    if (one) bar = xcd_barrier_post((unsigned*)(F.ws + WS_CTL), misc);
    const int lo = args.ph_lo, hi = args.ph_hi;
#ifdef STOP_PH
#define IN(k) (lo <= (k) && (k) < hi && ((k) < STOP_PH || (k) == PH_FINAL))
#else
#define IN(k) (lo <= (k) && (k) < hi)
#endif
#ifndef DUP_PH
#define DUP_PH -1
#endif
#define NREP(b) ((DUP_PH == (b)) ? 2 : 1)
#define SEAM(k) do { if (lo <= (k) + 1 && (k) + 1 < hi) xcd_barrier(bar); } while (0)

#ifndef PHM
#define PHM 0xFFFF
#endif
#define PHON(b) ((PHM >> (b)) & 1)
    if (PHON(0) && IN(0)) { for (int rep = 0; rep < NREP(0); ++rep) { LAUNDER(F); prologue_phase(F); SEAM(0); } }

#pragma unroll 1
    for (int l = 0; l < NLAYERS_RUN; ++l) {
        const int pb = 1 + l * PH_PER_LAYER;
        const bool lastl = (l == DEPTH - 1);
        if (PHON(1) && IN(pb + 0)) { LAUNDER(F); norm1_phase(F, l); SEAM(pb + 0); }
        if (PHON(2) && IN(pb + 1)) for (int rep = 0; rep < NREP(2); ++rep) { LAUNDER(F);
            { InProjProb<0> P; P.H = WSP(signed char, WS_H8); P.W = WSP(signed char, WS_WIN) + (size_t)l * IN_DIM * 1024; P.sH = WSP(float, WS_SH); P.sW = WSP(float, WS_SWIN) + (size_t)l * IN_DIM;
              P.FT = WSP(bf16_t, WS_FT); P.FCT = WSP(bf16_t, WS_FCT); P.Q = WSP(bf16_t, WS_Q); P.Kb = WSP(bf16_t, WS_K); P.Vb = WSP(bf16_t, WS_V); P.GF = WSP(bf16_t, WS_GF); P.GA = WSP(bf16_t, WS_GA);
              P.rope = WSP(float, WS_ROPE);
              P.nM = lastl ? 128 : 132; P.n_nat = P.nM * 11; P.n_fx = 256; P.n_fc = lastl ? 0 : 8; P.n_extra = lastl ? 4 : 0; P.G = F.G; P.c = F.bid;
              g8::gemm_run(F.lds, P); }
            { InProjProb<1> P; P.H = WSP(signed char, WS_H8); P.W = WSP(signed char, WS_WIN) + (size_t)l * IN_DIM * 1024; P.sH = WSP(float, WS_SH); P.sW = WSP(float, WS_SWIN) + (size_t)l * IN_DIM;
              P.FT = WSP(bf16_t, WS_FT); P.FCT = WSP(bf16_t, WS_FCT); P.Q = nullptr; P.Kb = nullptr; P.Vb = nullptr; P.GF = nullptr; P.GA = nullptr; P.rope = nullptr;
              P.nM = 0; P.n_nat = 0; P.n_fx = 256; P.n_fc = lastl ? 0 : 8; P.n_extra = 0; P.G = F.G; P.c = (F.bid + 180) % F.G;
              g8::gemm_run(F.lds, P); }
            SEAM(pb + 1);
        }
        if (PHON(3) && IN(pb + 2)) for (int rep = 0; rep < NREP(3); ++rep) { LAUNDER(F);
#ifndef NO_ATTN
            attn_phase(F, l, !lastl);
#endif
#ifndef NO_FFT1
            Fft1Prob P; P.W1 = WSP(bf16_t, WS_W1); P.FT = WSP(bf16_t, WS_FT); P.WC = WSP(bf16_t, WS_WC); P.FCT = WSP(bf16_t, WS_FCT); P.T1 = WSP(bf16_t, WS_T1); P.XS = WSP(bf16_t, WS_XS);
            P.n0 = 512; P.n1 = lastl ? 0 : 16; P.G = F.G; P.c = F.bid;
            g8::gemm_run(F.lds, P);
#endif
            SEAM(pb + 2);
        }
        if (PHON(4) && IN(pb + 3)) for (int rep = 0; rep < NREP(4); ++rep) { LAUNDER(F);
            Fft2Prob P; P.MT = WSP(bf16_t, WS_MT); P.T1 = WSP(bf16_t, WS_T1); P.XS = WSP(bf16_t, WS_XS); P.G = F.G; P.c = F.bid;
            g8::gemm_run(F.lds, P); SEAM(pb + 3);
        }
        if (PHON(5) && IN(pb + 4)) for (int rep = 0; rep < NREP(5); ++rep) { LAUNDER(F);
            { MergeProb<0> P; P.A = WSP(bf16_t, WS_XS); P.W = WSP(bf16_t, WS_WFO) + (size_t)l * 1024 * 1024; P.lda = 1024; P.GATE = WSP(bf16_t, WS_GF); P.YB = WSP(bf16_t, WS_YB);
              P.xin = nullptr; P.cin = nullptr; P.XW = nullptr; P.CW = nullptr; P.g1x = nullptr; P.g1c = nullptr; P.nM = lastl ? 128 : 132; P.G = F.G; P.c = F.bid;
              g8::gemm_run(F.lds, P); }
            { MergeProb<1> P; P.A = WSP(bf16_t, WS_AO); P.W = WSP(bf16_t, WS_WAO) + (size_t)l * 1024 * 512; P.lda = 512; P.GATE = WSP(bf16_t, WS_GA); P.YB = WSP(bf16_t, WS_YB);
              P.xin = nullptr; P.cin = nullptr; P.XW = nullptr; P.CW = nullptr; P.g1x = nullptr; P.g1c = nullptr; P.nM = lastl ? 128 : 132; P.G = F.G; P.c = F.bid;
              g8::gemm_run(F.lds, P); }
            SEAM(pb + 4);
        }
        if (PHON(6) && IN(pb + 5)) { LAUNDER(F);
            MergeProb<2> P; P.A = WSP(bf16_t, WS_YB); P.W = WSP(bf16_t, WS_WOUT) + (size_t)l * 1024 * 1024; P.lda = 1024; P.GATE = nullptr; P.YB = nullptr;
            P.xin = (l == 0) ? INP(0) : WSP(float, WS_XW); P.cin = (l == 0) ? INP(2) : WSP(float, WS_CW); P.XW = WSP(float, WS_XW); P.CW = WSP(float, WS_CW);
            P.g1x = WSP(float, WS_MOD) + (size_t)l * 5 * 6144 + 2 * 1024; P.g1c = WSP(float, WS_MOD) + ((size_t)l * 5 + 4) * 6144 + 2 * 1024; P.nM = lastl ? 128 : 132; P.G = F.G; P.c = F.bid;
            g8::gemm_run(F.lds, P); SEAM(pb + 5);
        }
        if (PHON(7) && IN(pb + 6)) for (int rep = 0; rep < NREP(7); ++rep) { LAUNDER(F); norm2_router_phase(F, l, rep + 1 < NREP(7)); SEAM(pb + 6); }
        if (PHON(8) && IN(pb + 7)) for (int rep = 0; rep < NREP(8); ++rep) { LAUNDER(F);
            MoeGuProb P; P.R = fill_tstart(F, l);
            P.H8 = WSP(signed char, WS_H8); P.W8 = WSP(signed char, WS_WGU) + (size_t)l * 32 * 2048 * 1024; P.sW = WSP(float, WS_SWGU) + (size_t)l * 32 * 2048; P.lsc = WSP(float, WS_LSC);
            P.bgu = INP(16) + (size_t)l * 32 * 2048; P.ACT = WSP(unsigned char, WS_ACT);
            P.list = WSP(int, WS_LIST); P.cnt = (const int*)(F.ws + WS_CTL + CTL_CNT) + l * 32; P.tstart = (const volatile LAS int*)(F.lds + LDS_MISC + 64); P.G = F.G; P.c = F.bid;
            g8::gemm_run(F.lds, P); SEAM(pb + 7);
        }
        if (PHON(9) && IN(pb + 8)) for (int rep = 0; rep < NREP(9); ++rep) { LAUNDER(F);
            MoeDnProb P; P.R = fill_tstart(F, l);
            P.ACT = WSP(unsigned char, WS_ACT); P.W = WSP(unsigned char, WS_WDN) + (size_t)l * 32 * 1024 * 1024; P.bdn = INP(18) + (size_t)l * 32 * 1024; P.YE = WSP(bf16_t, WS_YE);
            P.tstart = (const volatile LAS int*)(F.lds + LDS_MISC + 64); P.G = F.G; P.c = F.bid;
            g8::gemm_run(F.lds, P); SEAM(pb + 8);
        }
    }
#ifdef STOP_PH
    if (IN(PH_FINAL)) { LAUNDER(F);
        const size_t n = (size_t)TX * 1024;
        for (size_t i = (size_t)F.bid * 512 + F.tid; i < n; i += (size_t)F.G * 512) {
            F.out[i] = DUMP_EXPR(i);
        } }
#else
    if (PHON(10) && IN(PH_FINAL)) for (int rep = 0; rep < NREP(10); ++rep) { LAUNDER(F); norm1_phase(F, DEPTH); if (rep + 1 < NREP(10)) xcd_barrier(bar); }
#endif
#undef IN
#undef SEAM
}

extern "C" void kernel_launch(void* const* d_in, const int* in_sizes, int n_in, void* d_out, int out_size, void* d_ws, size_t ws_size, hipStream_t stream) {
    static int grid = 0;
    if (grid == 0) {
        if (n_in != 20 || ws_size < WS_END) { fprintf(stderr, "kernel_launch: bad arguments (n_in %d, ws %zu < %zu)\n", n_in, ws_size, (size_t)WS_END); grid = -1; return; }
        int dev = 0, cus = 0, per_cu = 0;
        if (hipGetDevice(&dev) != hipSuccess || hipDeviceGetAttribute(&cus, hipDeviceAttributeMultiprocessorCount, dev) != hipSuccess) { grid = -1; return; }
        if (hipFuncSetAttribute((const void*)fwd_kernel, hipFuncAttributeMaxDynamicSharedMemorySize, LDS_BYTES) != hipSuccess) { fprintf(stderr, "kernel_launch: hipFuncSetAttribute failed\n"); grid = -1; return; }
        if (hipOccupancyMaxActiveBlocksPerMultiprocessor(&per_cu, (const void*)fwd_kernel, 512, LDS_BYTES) != hipSuccess || per_cu < 1) { fprintf(stderr, "kernel_launch: occupancy query says %d\n", per_cu); }
        (void)hipGetLastError();
        grid = cus;
    }
    if (grid < 0) return;
    (void)hipMemsetAsync((char*)d_ws + WS_CTL, 0, CTL_BYTES, stream);
    Args a{};
    for (int i = 0; i < 20; ++i) a.in[i] = (const float*)d_in[i];
    a.out = (float*)d_out; a.ws = (unsigned char*)d_ws;
#if N_LAUNCH_MODE == 1
    a.ph_lo = 0; a.ph_hi = PH_COUNT;
    hipLaunchKernelGGL(fwd_kernel, dim3(grid), dim3(512), LDS_BYTES, stream, a);
#else
    for (int p = 0; p < PH_COUNT; ++p) { a.ph_lo = p; a.ph_hi = p + 1; hipLaunchKernelGGL(fwd_kernel, dim3(grid), dim3(512), LDS_BYTES, stream, a); }
#endif
    (void)in_sizes; (void)out_size;
}
```

```cpp
#include <hip/hip_runtime.h>
#include <cstdio>
#include <cstdint>

#define LAS __attribute__((address_space(3)))
typedef unsigned short bf16_t;
typedef short bf16x8 __attribute__((ext_vector_type(8)));
typedef short s16x4 __attribute__((ext_vector_type(4)));
typedef float f32x4 __attribute__((ext_vector_type(4)));
typedef float f32x16 __attribute__((ext_vector_type(16)));
typedef unsigned u32x4 __attribute__((ext_vector_type(4)));
typedef unsigned u32x2 __attribute__((ext_vector_type(2)));
typedef int i32x4 __attribute__((ext_vector_type(4)));
typedef int i32x8 __attribute__((ext_vector_type(8)));

#ifndef N_LAUNCH_MODE
#define N_LAUNCH_MODE 1
#endif
#ifndef DBG_CHECK
#define DBG_CHECK 0
#endif
#ifndef EMU8
#define EMU8 false
#endif
#ifndef NLAYERS_RUN
#define NLAYERS_RUN 4
#endif

constexpr int D = 1024, NB = 4, SEQ = 8192, TX = NB * SEQ, LC = 256, TC = NB * LC, TT = TX + TC, DEPTH = 4;
constexpr int IN_DIM = 3328, NEXP = 32;
constexpr int ROWS_MAX = TT * 4 + NEXP * 256;
constexpr float LOG2E = 1.4426950408889634f;
constexpr float QSCALE = 0.125f * LOG2E;
constexpr float EPS = 1e-5f;

constexpr size_t al256(size_t x) { return (x + 255) & ~(size_t)255; }
constexpr size_t WS_CTL = 0;
constexpr size_t CTL_BYTES = 65536;
constexpr size_t CTL_CNT = 16384;
constexpr size_t WS_MOD = WS_CTL + CTL_BYTES;
constexpr size_t WS_ROPE = WS_MOD + al256((size_t)DEPTH * 5 * 6144 * 4);
constexpr size_t WS_W1 = WS_ROPE + 16384;
constexpr size_t WS_MT = WS_W1 + 256 * 128 * 2;
constexpr size_t WS_WC = WS_MT + (size_t)64 * 256 * 128 * 2;
constexpr size_t WS_RWT = WS_WC + 512 * 256 * 2;
constexpr size_t WS_WIN = WS_RWT + (size_t)DEPTH * 32 * 1024 * 2;
constexpr size_t WS_SWIN = WS_WIN + (size_t)DEPTH * IN_DIM * 1024;
constexpr size_t WS_WFO = WS_SWIN + al256((size_t)DEPTH * IN_DIM * 4);
constexpr size_t WS_WAO = WS_WFO + (size_t)DEPTH * 1024 * 1024 * 2;
constexpr size_t WS_WOUT = WS_WAO + (size_t)DEPTH * 1024 * 512 * 2;
constexpr size_t WS_WGU = WS_WOUT + (size_t)DEPTH * 1024 * 1024 * 2;
constexpr size_t WS_SWGU = WS_WGU + (size_t)DEPTH * 32 * 2048 * 1024;
constexpr size_t WS_WDN = WS_SWGU + (size_t)DEPTH * 32 * 2048 * 4;
constexpr size_t WS_H = WS_WDN + (size_t)DEPTH * 32 * 1024 * 1024 * 2;
constexpr size_t WS_FT = WS_H + (size_t)(TT + 256) * 1024 * 2;
constexpr size_t WS_FCT = WS_FT + (size_t)131072 * 128 * 2;
constexpr size_t WS_Q = WS_FCT + (size_t)2048 * 256 * 2;
constexpr size_t WS_K = WS_Q + (size_t)TT * 512 * 2;
constexpr size_t WS_V = WS_K + (size_t)TT * 128 * 2;
constexpr size_t WS_GF = WS_V + (size_t)TT * 128 * 2;
constexpr size_t WS_GA = WS_GF + (size_t)TT * 1024 * 2;
constexpr size_t WS_T1 = WS_GA + (size_t)TT * 1024 * 2;
constexpr size_t WS_XS = WS_T1 + (size_t)64 * 2048 * 128 * 2;
constexpr size_t WS_AO = WS_XS + (size_t)TT * 1024 * 2;
constexpr size_t WS_YB = WS_AO + (size_t)TT * 512 * 2;
constexpr size_t WS_XW = WS_YB + (size_t)TT * 1024 * 2;
constexpr size_t WS_CW = WS_XW + (size_t)TX * 1024 * 4;
constexpr size_t WS_ACT = WS_CW + (size_t)TC * 1024 * 4;
constexpr size_t WS_YE = WS_ACT + (size_t)ROWS_MAX * 1024 * 2;
constexpr size_t WS_LIST = WS_YE + (size_t)ROWS_MAX * 1024 * 2;
constexpr size_t WS_SLOT = WS_LIST + (size_t)32 * TT * 4;
constexpr size_t WS_GATE = WS_SLOT + (size_t)TT * 4 * 4;
constexpr size_t WS_H8 = WS_GATE + (size_t)TT * 4 * 4;
constexpr size_t WS_LSC = WS_H8 + (size_t)(TT + 256) * 1024;
constexpr size_t WS_SH = WS_LSC + (size_t)32 * TT * 4;
constexpr size_t WS_END = WS_SH + (size_t)(TT + 256) * 4;

constexpr int LDS_STAGE = 131072;
constexpr int LDS_MISC = LDS_STAGE;
constexpr int LDS_BYTES = 147456;

typedef __bf16 bf16v2_t __attribute__((ext_vector_type(2)));
typedef float f32x2_t __attribute__((ext_vector_type(2)));
__device__ __forceinline__ unsigned cvt_pk_bf16(float lo, float hi) { const f32x2_t v = {lo, hi}; const bf16v2_t b = __builtin_convertvector(v, bf16v2_t); return __builtin_bit_cast(unsigned, b); }
__device__ __forceinline__ float q8(float x) { const int p = __builtin_amdgcn_cvt_pk_fp8_f32(x, 0.f, 0, false); return __builtin_amdgcn_cvt_f32_fp8(p, 0); }
__device__ __forceinline__ unsigned pk4_fp8(float a, float b, float c, float d) { int p = __builtin_amdgcn_cvt_pk_fp8_f32(a, b, 0, false); p = __builtin_amdgcn_cvt_pk_fp8_f32(c, d, p, true); return (unsigned)p; }
__device__ __forceinline__ bf16_t f2bf(float f) { return (bf16_t)(cvt_pk_bf16(f, 0.f) & 0xffffu); }
__device__ __forceinline__ float bf_lo(unsigned u) { return __uint_as_float(u << 16); }
__device__ __forceinline__ float bf_hi(unsigned u) { return __uint_as_float(u & 0xffff0000u); }
__device__ __forceinline__ float bf2f(bf16_t b) { return __uint_as_float(((unsigned)b) << 16); }
__device__ __forceinline__ float sigmoidf_(float x) { return __builtin_amdgcn_rcpf(1.0f + __builtin_amdgcn_exp2f(-x * LOG2E)); }
__device__ __forceinline__ float wave_sum(float v) {
#pragma unroll
    for (int o = 32; o >= 1; o >>= 1) v += __shfl_xor(v, o);
    return v;
}

#define XB_TMO      128
#define XB_XCNT(j)  (256  + 64 * (j))
#define XB_XSUB(j)  (1280 + 64 * (j))
#define XB_XGEN(j)  (2304 + 64 * (j))
#define XB_TOP      3328
#define XB_TOPGEN   3392
#define XCD_BAR_WORDS 3456
#define XB_SPIN_CAP (1u << 22)

__device__ __forceinline__ unsigned xb_ld(unsigned* p)              { return __hip_atomic_load(p, __ATOMIC_RELAXED, __HIP_MEMORY_SCOPE_AGENT); }
__device__ __forceinline__ unsigned xb_add(unsigned* p, unsigned v) { return __hip_atomic_fetch_add(p, v, __ATOMIC_RELAXED, __HIP_MEMORY_SCOPE_AGENT); }
__device__ __forceinline__ unsigned xb_xcc_id() { return (unsigned)__builtin_amdgcn_s_getreg((3 << 11) | 20) & 0xFu; }
#define XB_SPIN(cond, bar) do { unsigned _sp = 0; while (cond) { __builtin_amdgcn_s_sleep(1); \
    if ((++_sp & 255u) == 0u) { if (xb_ld(&(bar)[XB_TMO])) break; if (_sp > XB_SPIN_CAP) { atomicAdd(&(bar)[XB_TMO], 1u); break; } } } } while (0)

struct XcdBarrier { unsigned* bar; unsigned x; volatile LAS unsigned* st; };

__device__ __forceinline__ XcdBarrier xcd_barrier_post(unsigned* bar, volatile LAS unsigned* st) {
    XcdBarrier b; b.bar = bar; b.x = xb_xcc_id(); b.st = st;
    if (threadIdx.x == 0) (void)xb_add(&bar[XB_XCNT(b.x)], 1u);
    return b;
}
__device__ __forceinline__ void xcd_barrier_complete(unsigned* bar, unsigned x, unsigned& nloc, unsigned& nx) {
    const unsigned G = gridDim.x * gridDim.y * gridDim.z;
    unsigned sum, cnt, mine, sp = 0u;
    for (;;) {
        sum = 0u; cnt = 0u; mine = 0u;
#pragma unroll
        for (unsigned j = 0; j < 16; ++j) { const unsigned c = xb_ld(&bar[XB_XCNT(j)]); sum += c; cnt += (c > 0u) ? 1u : 0u; mine = (j == x) ? c : mine; }
        if (sum == G) break;
        __builtin_amdgcn_s_sleep(1);
        if ((++sp & 255u) == 0u) { if (xb_ld(&bar[XB_TMO])) break; if (sp > XB_SPIN_CAP) { atomicAdd(&bar[XB_TMO], 1u); break; } }
    }
    nloc = mine > 0u ? mine : 1u; nx = cnt > 0u ? cnt : 1u;
}
__device__ __forceinline__ void xcd_barrier(const XcdBarrier& b) {
    asm volatile("s_waitcnt vmcnt(0)" ::: "memory");
    __syncthreads();
    if (threadIdx.x == 0) {
        unsigned* bar = b.bar;
        __builtin_amdgcn_s_waitcnt(0);
        unsigned nloc = b.st[0], nx = b.st[1];
        if (nloc == 0u) { xcd_barrier_complete(bar, b.x, nloc, nx); b.st[0] = nloc; b.st[1] = nx; }
        const unsigned old = xb_add(&bar[XB_XSUB(b.x)], 1u);
        const unsigned gen = old / nloc;
        if (old + 1u == (gen + 1u) * nloc) {
            __builtin_amdgcn_fence(__ATOMIC_RELEASE, "agent");
            asm volatile("s_waitcnt vmcnt(0)" ::: "memory");
            const unsigned og = xb_add(&bar[XB_TOP], 1u);
            const unsigned tg = og / nx;
            if (og + 1u == (tg + 1u) * nx) xb_add(&bar[XB_TOPGEN], 1u);
            else XB_SPIN(xb_ld(&bar[XB_TOPGEN]) == tg, bar);
            __builtin_amdgcn_fence(__ATOMIC_ACQUIRE, "agent");
            xb_add(&bar[XB_XGEN(b.x)], 1u);
            asm volatile("s_waitcnt vmcnt(0)" ::: "memory");
        } else {
            XB_SPIN(xb_ld(&bar[XB_XGEN(b.x)]) == gen, bar);
            __builtin_amdgcn_fence(__ATOMIC_ACQUIRE, "agent");
            asm volatile("s_waitcnt vmcnt(0)" ::: "memory");
        }
    }
    __syncthreads();
}

struct Fr {
    LAS unsigned char* lds;
    unsigned char* ws;
    float* out;
    int tid, lane, wave, G, bid;
};
__device__ __forceinline__ const float* in_ptr(const Fr& F, int i) {
    volatile LAS unsigned* p = (volatile LAS unsigned*)(F.lds + 131072 + 512) + 2 * i;
    const unsigned lo = __builtin_amdgcn_readfirstlane(p[0]), hi = __builtin_amdgcn_readfirstlane(p[1]);
    return (const float*)(((unsigned long long)hi << 32) | lo);
}
#define INP(i) in_ptr(F, (i))
#define LAUNDER(F) do { unsigned char* _w = (F).ws; asm volatile("" : "+s"(_w)); (F).ws = _w; int _t = threadIdx.x; asm volatile("" : "+v"(_t)); (F).tid = _t; (F).lane = _t & 63; (F).wave = __builtin_amdgcn_readfirstlane(_t >> 6); } while (0)
#define WSP(T, off) ((T*)(F.ws + (off)))

namespace g8 {
constexpr int BM = 256, BK = 64, HALF = 128, HTB = HALF * BK * 2, NXCD = 8, WGM = 8;
__device__ __forceinline__ int lds_byte(int r, int c) { const int st = (r >> 4) * 2 + (c >> 5), rr = r & 15, cc = c & 31, ob = rr * 64 + cc * 2; return st * 1024 + (ob ^ (((ob >> 9) & 1) << 5)); }
__device__ __forceinline__ void stage_rc(int b, int& R, int& C) { const int st = b / 1024, sb = b % 1024, swz = sb ^ (((sb >> 9) & 1) << 5); R = (st >> 1) * 16 + swz / 64; C = (st & 1) * 32 + (swz % 64) / 2; }
__device__ __forceinline__ int perm32(int rho) { const int n = rho >> 4, i = rho & 15; return 8 * (i >> 2) + 4 * n + (i & 3); }
__device__ __forceinline__ void order2d(int L, int nM, int nN, int& pm, int& pn) {
    const int nwg = nM * nN;
    int wgid = L; { const int q = nwg / NXCD, r = nwg % NXCD, xcd = wgid % NXCD, off = wgid / NXCD; wgid = (xcd < r ? xcd * (q + 1) : r * (q + 1) + (xcd - r) * q) + off; }
    const int nig = WGM * nN, gid = wgid / nig, fm = gid * WGM, gsz = (nM - fm) < WGM ? (nM - fm) : WGM;
    pm = fm + ((wgid % nig) % gsz); pn = (wgid % nig) / gsz;
}
__device__ __forceinline__ void lane_geom(int tid, int& R0, int& Rb0, int& C0) { asm volatile("" : "+v"(tid)); stage_rc(tid * 16, R0, C0); Rb0 = (R0 & ~31) + perm32(R0 & 31); }

#define G8_ROWS(ai, m) (128 * (ai) + 64 * wr + 16 * (m) + fr)
#define G8_COL0(bj) (128 * (bj) + 32 * wc + 8 * fq)

template <bool I8> __device__ __forceinline__ f32x4 mma1(const bf16x8& b, const bf16x8& a, const f32x4& c) { return __builtin_amdgcn_mfma_f32_16x16x32_bf16(b, a, c, 0, 0, 0); }
template <bool I8> __device__ __forceinline__ i32x4 mma1(const bf16x8& b, const bf16x8& a, const i32x4& c) { return __builtin_amdgcn_mfma_i32_16x16x64_i8(__builtin_bit_cast(i32x4, b), __builtin_bit_cast(i32x4, a), c, 0, 0, 0); }
__device__ __forceinline__ f32x4 mma8(const bf16x8& b0, const bf16x8& b1, const bf16x8& a0, const bf16x8& a1, const f32x4& c) {
    const i32x4 B0 = __builtin_bit_cast(i32x4, b0), B1 = __builtin_bit_cast(i32x4, b1), A0 = __builtin_bit_cast(i32x4, a0), A1 = __builtin_bit_cast(i32x4, a1);
    const i32x8 B = {B0[0], B0[1], B0[2], B0[3], B1[0], B1[1], B1[2], B1[3]}, A = {A0[0], A0[1], A0[2], A0[3], A1[0], A1[1], A1[2], A1[3]};
    return __builtin_amdgcn_mfma_scale_f32_16x16x128_f8f6f4(B, A, c, 0, 0, 0, 0x7F7F7F7F, 0, 0x7F7F7F7F);
}
template <class P>
__device__ __forceinline__ void gemm_run(LAS unsigned char* lds, P& prob) {
    int tid = threadIdx.x; asm volatile("" : "+v"(tid));
    const int wid = __builtin_amdgcn_readfirstlane(tid >> 6), lane = tid & 63, wr = wid >> 2, wc = wid & 3, fr = lane & 15, fq = lane >> 4;
    const size_t kstep = (size_t)(BK * 2);
    const unsigned ldsw = (unsigned)wid * 1024u;
    const int aoff = lds_byte(wr * 64 + fr, fq * 8), boff = lds_byte(wc * 32 + fr, fq * 8);
#define G8_SA(b, h) (((b) * 2 + (h)) * HTB)
#define G8_SB(b, h) ((4 + (b) * 2 + (h)) * HTB)
#define G8_STAGE_(bufoff, g0, o0, g1, o1) do { \
        __builtin_amdgcn_global_load_lds((const unsigned*)((const char*)(g0) + (o0)), (LAS unsigned*)(lds + (bufoff) + ldsw), 16, 0, 0); \
        __builtin_amdgcn_global_load_lds((const unsigned*)((const char*)(g1) + (o1)), (LAS unsigned*)(lds + (bufoff) + ldsw + 8192), 16, 0, 0); } while (0)
#define G8_OA(j) (P::GATHER_A ? oa[j] : oa[0])
#define G8_STA(bufoff, gbase, h) G8_STAGE_(bufoff, (gbase) + dA[2 * (h)], G8_OA(2 * (h)), (gbase) + dA[2 * (h) + 1], G8_OA(2 * (h) + 1))
#define G8_STB(bufoff, gbase, h) G8_STAGE_(bufoff, (gbase) + dB[2 * (h)], ob, (gbase) + dB[2 * (h) + 1], ob)
#define G8_LDA(dst, b, h) do { _Pragma("unroll") for (int m = 0; m < 4; ++m) _Pragma("unroll") for (int k = 0; k < 2; ++k) dst[m][k] = *(const LAS bf16x8*)(lds + G8_SA(b, h) + aoff + m * 2048 + k * 1024); } while (0)
#define G8_LDB(dst, b, h) do { _Pragma("unroll") for (int n = 0; n < 2; ++n) _Pragma("unroll") for (int k = 0; k < 2; ++k) dst[n][k] = *(const LAS bf16x8*)(lds + G8_SB(b, h) + boff + n * 2048 + k * 1024); } while (0)
#define G8_MMA(ai, bj, At, Bt) do { __builtin_amdgcn_s_setprio(1); \
        if constexpr (P::F8) { _Pragma("unroll") for (int m = 0; m < 4; ++m) _Pragma("unroll") for (int n = 0; n < 2; ++n) acc[ai][bj][m][n] = mma8(Bt[n][0], Bt[n][1], At[m][0], At[m][1], acc[ai][bj][m][n]); } \
        else { _Pragma("unroll") for (int m = 0; m < 4; ++m) _Pragma("unroll") for (int n = 0; n < 2; ++n) _Pragma("unroll") for (int k = 0; k < 2; ++k) \
        acc[ai][bj][m][n] = mma1<P::I8>(Bt[n][k], At[m][k], acc[ai][bj][m][n]); } __builtin_amdgcn_s_setprio(0); } while (0)
#define G8_WAIT_V(n) asm volatile("s_waitcnt vmcnt(" #n ")" ::: "memory")
#define G8_WAIT_L(n) asm volatile("s_waitcnt lgkmcnt(" #n ")" ::: "memory")
#define G8_BAR __builtin_amdgcn_s_barrier()
#define G8_SCHED __builtin_amdgcn_sched_barrier(0)
    typename P::U cur, nxt; int ui = 0;
    if (!prob.get(0, cur)) return;
    typedef typename P::Acc Acc;
    Acc acc[2][2][4][2];
#pragma unroll
    for (int a = 0; a < 2; ++a)
#pragma unroll
        for (int b = 0; b < 2; ++b)
#pragma unroll
            for (int m = 0; m < 4; ++m)
#pragma unroll
                for (int n = 0; n < 2; ++n) acc[a][b][m][n] = (Acc){0, 0, 0, 0};
    bf16x8 At[4][2], B0[2][2], B1[2][2];
    unsigned oa[4], ob, dA[4], dB[4]; const char* cA; const char* cB; int nt;
    prob.setup(cur, oa, ob, dA, dB, cA, cB, nt);
    G8_STB(G8_SB(0, 0), cB, 0); G8_STA(G8_SA(0, 0), cA, 0); G8_STB(G8_SB(0, 1), cB, 1); G8_STA(G8_SA(0, 1), cA, 1);
    if (wr == 1) G8_BAR;
    G8_WAIT_V(4); G8_BAR;
    G8_STB(G8_SB(1, 0), cB + kstep, 0); G8_STA(G8_SA(1, 0), cA + kstep, 0); G8_STB(G8_SB(1, 1), cB + kstep, 1);
    G8_WAIT_V(6); G8_BAR;
    for (;;) {
        const bool has_next = prob.get(ui + 1, nxt);
        int nnt = nt;
        for (int t = 0; t < nt; t += 2) {
            const bool last = (t == nt - 2);
            G8_LDB(B0, 0, 0); G8_SCHED; G8_LDA(At, 0, 0); G8_STA(G8_SA(1, 1), cA + (size_t)(t + 1) * kstep, 1);
            G8_WAIT_L(8); G8_BAR; G8_WAIT_L(0); G8_MMA(0, 0, At, B0); G8_BAR; G8_SCHED;
            const char* a2; const char* b2;
            if (last) { if (has_next) { prob.setup(nxt, oa, ob, dA, dB, cA, cB, nnt); } a2 = cA; b2 = cB; }
            else { a2 = cA + (size_t)(t + 2) * kstep; b2 = cB + (size_t)(t + 2) * kstep; }
            const char* a3 = a2 + kstep; const char* b3 = b2 + kstep;
            G8_LDB(B1, 0, 1); G8_STB(G8_SB(0, 0), b2, 0);
            G8_BAR; G8_WAIT_L(0); G8_MMA(0, 1, At, B1); G8_BAR;
            G8_LDA(At, 0, 1); G8_STA(G8_SA(0, 0), a2, 0);
            G8_BAR; G8_WAIT_L(0); G8_MMA(1, 0, At, B0); G8_BAR; G8_SCHED;
            G8_STB(G8_SB(0, 1), b2, 1);
            G8_WAIT_V(6); G8_BAR; G8_MMA(1, 1, At, B1); G8_BAR;
            G8_LDB(B0, 1, 0); G8_SCHED; G8_LDA(At, 1, 0); G8_STA(G8_SA(0, 1), a2, 1);
            G8_WAIT_L(8); G8_BAR; G8_WAIT_L(0); G8_MMA(0, 0, At, B0); G8_BAR; G8_SCHED;
            G8_LDB(B1, 1, 1); G8_STB(G8_SB(1, 0), b3, 0);
            G8_BAR; G8_WAIT_L(0); G8_MMA(0, 1, At, B1); G8_BAR;
            G8_LDA(At, 1, 1); G8_STA(G8_SA(1, 0), a3, 0);
            G8_BAR; G8_WAIT_L(0); G8_MMA(1, 0, At, B0); G8_BAR; G8_SCHED;
            G8_STB(G8_SB(1, 1), b3, 1);
            G8_WAIT_V(6); G8_BAR; G8_MMA(1, 1, At, B1); G8_BAR;
            if (last) break;
        }
        { int t2 = threadIdx.x; asm volatile("" : "+v"(t2)); const int l2 = t2 & 63; prob.epi(acc, cur, wr, wc, l2 & 15, l2 >> 4); }
        if (!has_next) break;
#pragma unroll
        for (int a = 0; a < 2; ++a)
#pragma unroll
            for (int b = 0; b < 2; ++b)
#pragma unroll
                for (int m = 0; m < 4; ++m)
#pragma unroll
                    for (int n = 0; n < 2; ++n) acc[a][b][m][n] = (Acc){0, 0, 0, 0};
        cur = nxt; nt = nnt; ++ui;
    }
    G8_WAIT_V(0);
    if (wr == 0) G8_BAR;
    G8_BAR;
}
}

__device__ __forceinline__ u32x4 pack8(const f32x4& v0, const f32x4& v1) {
    u32x4 w; w.x = cvt_pk_bf16(v0[0], v0[1]); w.y = cvt_pk_bf16(v0[2], v0[3]); w.z = cvt_pk_bf16(v1[0], v1[1]); w.w = cvt_pk_bf16(v1[2], v1[3]); return w;
}
__device__ __forceinline__ void unpack8(const u32x4& w, f32x4& v0, f32x4& v1) {
    v0 = (f32x4){bf_lo(w.x), bf_hi(w.x), bf_lo(w.y), bf_hi(w.y)}; v1 = (f32x4){bf_lo(w.z), bf_hi(w.z), bf_lo(w.w), bf_hi(w.w)};
}

template <int WHICH> struct InProjProb {
    static constexpr bool PERM = true, GATHER_A = false, I8 = true, F8 = false; typedef i32x4 Acc;
    struct U { int kind, pm, pn, b, j; };
    const signed char* H; const signed char* W; const float* sH; const float* sW;
    bf16_t *FT, *FCT, *Q, *Kb, *Vb, *GF, *GA; const float* rope;
    int nM, n_nat, n_fx, n_fc, n_extra, G, c;
    __device__ __forceinline__ bool get(int i, U& u) const {
        const int L = i * G + c;
        if (WHICH == 0) {
            if (L >= n_nat + n_extra) return false;
            const bool nat = L < n_nat;
            int pm, pn; g8::order2d(nat ? L : 0, nM, 11, pm, pn);
            u.kind = 2; u.pm = __builtin_amdgcn_readfirstlane(nat ? pm : (128 + L - n_nat)); u.pn = __builtin_amdgcn_readfirstlane(nat ? (pn + 2) : 4); u.b = 0; u.j = 0;
            return true;
        } else {
            if (L >= n_fx + n_fc) return false;
            const bool fx = L < n_fx; const int L2 = L - n_fx;
            u.kind = __builtin_amdgcn_readfirstlane(fx ? 0 : 1); u.b = __builtin_amdgcn_readfirstlane(fx ? (L >> 6) : (L2 >> 1)); u.j = __builtin_amdgcn_readfirstlane(fx ? ((L & 63) >> 1) : 0); u.pn = __builtin_amdgcn_readfirstlane(fx ? (L & 1) : (L2 & 1)); u.pm = 0;
            return true;
        }
    }
    __device__ __forceinline__ void setup(const U& u, unsigned (&oa)[4], unsigned& ob, unsigned (&dA)[4], unsigned (&dB)[4], const char*& pA, const char*& pB, int& nt) const {
        int R0, Rb0, C0; g8::lane_geom(threadIdx.x, R0, Rb0, C0);
        nt = 8;
#pragma unroll
        for (int j = 0; j < 4; ++j) { dA[j] = (unsigned)(64 * j * 1024); dB[j] = dA[j]; }
        if (WHICH == 0) {
            pA = (const char*)H; pB = (const char*)W;
            oa[0] = (unsigned)((256 * u.pm + R0) * 1024 + C0 * 2); ob = (unsigned)((256 * u.pn + Rb0) * 1024 + C0 * 2);
        } else {
            pA = (const char*)W; pB = (const char*)H;
            oa[0] = (unsigned)((256 * u.pn + R0) * 1024 + C0 * 2);
            if (u.kind == 0) { ob = (unsigned)((u.b * SEQ + 64 * Rb0 + 2 * u.j) * 1024 + C0 * 2);
                dB[1] = (unsigned)(64 * 64 * 1024); dB[2] = 1024u; dB[3] = dB[1] + 1024u; }
            else ob = (unsigned)((TX + u.b * LC + Rb0) * 1024 + C0 * 2);
        }
    }
    __device__ __forceinline__ void epi(const i32x4 (&acc)[2][2][4][2], const U& u, int wr, int wc, int fr, int fq) const {
        if (WHICH == 0) {
            f32x4 sw[2][2];
#pragma unroll
            for (int bj = 0; bj < 2; ++bj) { const float* sp = sW + 256 * u.pn + G8_COL0(bj); sw[bj][0] = *(const f32x4*)sp; sw[bj][1] = *(const f32x4*)(sp + 4); }
            float rsv[2][4];
#pragma unroll
            for (int ai = 0; ai < 2; ++ai)
#pragma unroll
                for (int m = 0; m < 4; ++m) rsv[ai][m] = sH[256 * u.pm + G8_ROWS(ai, m)];
            if (u.pn >= 5) {
                bf16_t* dst = (u.pn >= 9) ? GA : GF; const int cb = 256 * ((u.pn >= 9) ? u.pn - 9 : u.pn - 5);
#pragma unroll
                for (int ai = 0; ai < 2; ++ai)
#pragma unroll
                    for (int m = 0; m < 4; ++m) { const size_t tok = (size_t)256 * u.pm + G8_ROWS(ai, m); const float rs = rsv[ai][m];
#pragma unroll
                        for (int bj = 0; bj < 2; ++bj) { f32x4 v0, v1;
#pragma unroll
                            for (int e = 0; e < 4; ++e) { v0[e] = sigmoidf_((float)acc[ai][bj][m][0][e] * rs * sw[bj][0][e]); v1[e] = sigmoidf_((float)acc[ai][bj][m][1][e] * rs * sw[bj][1][e]); }
                            *(u32x4*)(dst + tok * 1024 + cb + G8_COL0(bj)) = pack8(v0, v1); } }
            } else {
#pragma unroll
                for (int ai = 0; ai < 2; ++ai)
#pragma unroll
                    for (int m = 0; m < 4; ++m) { const int tok = 256 * u.pm + G8_ROWS(ai, m); const float rs = rsv[ai][m];
                        const bool isx = tok < TX; const int n = tok & (SEQ - 1); const int prow = n >> 6, pcol = n & 63;
#pragma unroll
                        for (int bj = 0; bj < 2; ++bj) { f32x4 v0, v1;
#pragma unroll
                            for (int e = 0; e < 4; ++e) { v0[e] = (float)acc[ai][bj][m][0][e] * rs * sw[bj][0][e]; v1[e] = (float)acc[ai][bj][m][1][e] * rs * sw[bj][1][e]; }
                            const int c0 = G8_COL0(bj);
                            const bool isv = (u.pn == 4) && (bj == 1);
                            if (!isv) {
                                const int dp = c0 & 63; const int axis = dp >> 5, f0 = (dp & 31) >> 1;
                                if (isx) {
                                    const int pos = axis ? pcol : prow;
                                    const f32x4 cs = *(const f32x4*)(rope + pos * 16 + f0), sn = *(const f32x4*)(rope + 2048 + pos * 16 + f0);
                                    f32x4 r0, r1;
                                    r0[0] = v0[0] * cs[0] - v0[1] * sn[0]; r0[1] = v0[1] * cs[0] + v0[0] * sn[0];
                                    r0[2] = v0[2] * cs[1] - v0[3] * sn[1]; r0[3] = v0[3] * cs[1] + v0[2] * sn[1];
                                    r1[0] = v1[0] * cs[2] - v1[1] * sn[2]; r1[1] = v1[1] * cs[2] + v1[0] * sn[2];
                                    r1[2] = v1[2] * cs[3] - v1[3] * sn[3]; r1[3] = v1[3] * cs[3] + v1[2] * sn[3];
                                    v0 = r0; v1 = r1;
                                }
                            }
                            if (u.pn < 4) { v0 *= QSCALE; v1 *= QSCALE; *(u32x4*)(Q + (size_t)tok * 512 + 256 * (u.pn - 2) + c0) = pack8(v0, v1); }
                            else if (!isv) { *(u32x4*)(Kb + (size_t)tok * 128 + c0) = pack8(v0, v1); }
                            else { *(u32x4*)(Vb + (size_t)tok * 128 + (c0 - 128)) = pack8(v0, v1); }
                        } }
            }
        } else {
            f32x4 st[2][2];
#pragma unroll
            for (int bj = 0; bj < 2; ++bj) { const int c0 = G8_COL0(bj);
                if (u.kind == 0) { const float* tp = sH + (size_t)u.b * SEQ + 64 * (c0 & 127) + 2 * u.j + (c0 >> 7);
#pragma unroll
                    for (int e = 0; e < 4; ++e) { st[bj][0][e] = tp[64 * e]; st[bj][1][e] = tp[64 * (4 + e)]; } }
                else { const float* tp = sH + TX + u.b * LC + c0; st[bj][0] = *(const f32x4*)tp; st[bj][1] = *(const f32x4*)(tp + 4); } }
            float rsw[2][4];
#pragma unroll
            for (int ai = 0; ai < 2; ++ai)
#pragma unroll
                for (int m = 0; m < 4; ++m) rsw[ai][m] = sW[256 * u.pn + G8_ROWS(ai, m)];
#pragma unroll
            for (int ai = 0; ai < 2; ++ai)
#pragma unroll
                for (int m = 0; m < 4; ++m) { const int ch = 256 * u.pn + G8_ROWS(ai, m); const float rs = rsw[ai][m];
#pragma unroll
                    for (int bj = 0; bj < 2; ++bj) { const int c0 = G8_COL0(bj); f32x4 v0, v1;
#pragma unroll
                        for (int e = 0; e < 4; ++e) { v0[e] = (float)acc[ai][bj][m][0][e] * rs * st[bj][0][e]; v1[e] = (float)acc[ai][bj][m][1][e] * rs * st[bj][1][e]; }
                        const u32x4 w = pack8(v0, v1);
                        if (u.kind == 0) { const int n2 = 2 * u.j + (c0 >> 7), n1 = c0 & 127; *(u32x4*)(FT + ((size_t)(u.b * 512 + ch) * 64 + n2) * 128 + n1) = w; }
                        else *(u32x4*)(FCT + (size_t)(u.b * 512 + ch) * 256 + c0) = w;
                    } }
        }
    }
};

struct Fft1Prob {
    static constexpr bool PERM = true, GATHER_A = false, I8 = false, F8 = false; typedef f32x4 Acc;
    struct U { int kind, pm, pn; };
    const bf16_t *W1, *FT, *WC, *FCT; bf16_t *T1, *XS;
    int n0, n1, G, c;
    __device__ __forceinline__ bool get(int i, U& u) const {
        const int L = i * G + c;
        if (L >= n0 + n1) return false;
        const bool k0 = L < n0; const int L2 = L - n0;
        u.kind = __builtin_amdgcn_readfirstlane(k0 ? 0 : 1); u.pm = __builtin_amdgcn_readfirstlane(k0 ? 0 : (L2 & 1)); u.pn = __builtin_amdgcn_readfirstlane(k0 ? L : (L2 >> 1));
        return true;
    }
    __device__ __forceinline__ void setup(const U& u, unsigned (&oa)[4], unsigned& ob, unsigned (&dA)[4], unsigned (&dB)[4], const char*& pA, const char*& pB, int& nt) const {
        int R0, Rb0, C0; g8::lane_geom(threadIdx.x, R0, Rb0, C0);
        if (u.kind == 0) { nt = 2; pA = (const char*)W1; pB = (const char*)FT;
#pragma unroll
            for (int j = 0; j < 4; ++j) { dA[j] = (unsigned)(64 * j * 128) * 2u; dB[j] = dA[j]; }
            oa[0] = (unsigned)(R0 * 128 + C0) * 2u; ob = (unsigned)((256 * u.pn + Rb0) * 128 + C0) * 2u;
        } else { nt = 4; pA = (const char*)WC; pB = (const char*)FCT;
#pragma unroll
            for (int j = 0; j < 4; ++j) { dA[j] = (unsigned)(64 * j * 256) * 2u; dB[j] = dA[j]; }
            oa[0] = (unsigned)((256 * u.pm + R0) * 256 + C0) * 2u; ob = (unsigned)((256 * u.pn + Rb0) * 256 + C0) * 2u;
        }
    }
    __device__ __forceinline__ void epi(const f32x4 (&acc)[2][2][4][2], const U& u, int wr, int wc, int fr, int fq) const {
        if (u.kind == 0) {
#pragma unroll
            for (int m = 0; m < 4; ++m) { const int r = G8_ROWS(0, m); const int k1p = r >> 1, part = r & 1;
#pragma unroll
                for (int bj = 0; bj < 2; ++bj) { const int col = 256 * u.pn + G8_COL0(bj); const int bc = col >> 6, n2 = col & 63;
                    *(u32x4*)(T1 + (((size_t)k1p * 2048 + bc) * 2 + part) * 64 + n2) = pack8(acc[0][bj][m][0], acc[0][bj][m][1]); } }
        } else {
#pragma unroll
            for (int ai = 0; ai < 2; ++ai)
#pragma unroll
                for (int m = 0; m < 4; ++m) { const int r = 256 * u.pm + G8_ROWS(ai, m); const int k = r >> 1, reim = r & 1;
#pragma unroll
                    for (int bj = 0; bj < 2; ++bj) { const int bc = 256 * u.pn + G8_COL0(bj); const int b = bc >> 9, ch = bc & 511, g = ch >> 7, d = ch & 127;
                        *(u32x4*)(XS + (size_t)(TX + b * LC + k) * 1024 + g * 256 + reim * 128 + d) = pack8(acc[ai][bj][m][0], acc[ai][bj][m][1]); } }
        }
    }
};

struct Fft2Prob {
    static constexpr bool PERM = true, GATHER_A = false, I8 = false, F8 = false; typedef f32x4 Acc;
    struct U { int k1p, pn; };
    const bf16_t *MT, *T1; bf16_t* XS; int G, c;
    __device__ __forceinline__ bool get(int i, U& u) const { const int L = i * G + c; if (L >= 512) return false; u.k1p = __builtin_amdgcn_readfirstlane(L >> 3); u.pn = __builtin_amdgcn_readfirstlane(L & 7); return true; }
    __device__ __forceinline__ void setup(const U& u, unsigned (&oa)[4], unsigned& ob, unsigned (&dA)[4], unsigned (&dB)[4], const char*& pA, const char*& pB, int& nt) const {
        int R0, Rb0, C0; g8::lane_geom(threadIdx.x, R0, Rb0, C0);
        nt = 2; pA = (const char*)MT; pB = (const char*)T1;
#pragma unroll
        for (int j = 0; j < 4; ++j) { dA[j] = (unsigned)(64 * j * 128) * 2u; dB[j] = dA[j]; }
        oa[0] = (unsigned)((u.k1p * 256 + R0) * 128 + C0) * 2u; ob = (unsigned)((u.k1p * 2048 + 256 * u.pn + Rb0) * 128 + C0) * 2u;
    }
    __device__ __forceinline__ void epi(const f32x4 (&acc)[2][2][4][2], const U& u, int wr, int wc, int fr, int fq) const {
#pragma unroll
        for (int ai = 0; ai < 2; ++ai)
#pragma unroll
            for (int m = 0; m < 4; ++m) { const int r = G8_ROWS(ai, m); const int s = r >> 7, k2 = (r & 127) >> 1, reim = r & 1;
                const int kb = (u.k1p == 0) ? 64 * s : (s ? 128 - u.k1p : u.k1p); const int k = kb + 128 * k2;
#pragma unroll
                for (int bj = 0; bj < 2; ++bj) { const int bc = 256 * u.pn + G8_COL0(bj); const int b = bc >> 9, ch = bc & 511, g = ch >> 7, d = ch & 127;
                    *(u32x4*)(XS + (size_t)(b * SEQ + k) * 1024 + g * 256 + reim * 128 + d) = pack8(acc[ai][bj][m][0], acc[ai][bj][m][1]); } }
    }
};

template <int MODE> struct MergeProb {
    static constexpr bool PERM = true, GATHER_A = false, I8 = false, F8 = false; typedef f32x4 Acc;
    struct U { int pm, pn; };
    const bf16_t* A; const bf16_t* W; int lda;
    const bf16_t* GATE; bf16_t* YB;
    const float* xin; const float* cin; float* XW; float* CW; const float* g1x; const float* g1c;
    int nM, G, c;
    __device__ __forceinline__ bool get(int i, U& u) const { const int L = i * G + c; if (L >= nM * 4) return false; int pm, pn; g8::order2d(L, nM, 4, pm, pn); u.pm = __builtin_amdgcn_readfirstlane(pm); u.pn = __builtin_amdgcn_readfirstlane(pn); return true; }
    __device__ __forceinline__ void setup(const U& u, unsigned (&oa)[4], unsigned& ob, unsigned (&dA)[4], unsigned (&dB)[4], const char*& pA, const char*& pB, int& nt) const {
        int R0, Rb0, C0; g8::lane_geom(threadIdx.x, R0, Rb0, C0);
        nt = lda >> 6; pA = (const char*)A; pB = (const char*)W;
#pragma unroll
        for (int j = 0; j < 4; ++j) { dA[j] = (unsigned)(64 * j * lda) * 2u; dB[j] = dA[j]; }
        oa[0] = (unsigned)((256 * u.pm + R0) * lda + C0) * 2u; ob = (unsigned)((256 * u.pn + Rb0) * lda + C0) * 2u;
    }
    __device__ __forceinline__ void epi(const f32x4 (&acc)[2][2][4][2], const U& u, int wr, int wc, int fr, int fq) const {
        if (MODE == 0) {
            u32x4 gt[2][4][2];
#pragma unroll
            for (int ai = 0; ai < 2; ++ai)
#pragma unroll
                for (int m = 0; m < 4; ++m)
#pragma unroll
                    for (int bj = 0; bj < 2; ++bj) gt[ai][m][bj] = *(const u32x4*)(GATE + (size_t)(256 * u.pm + G8_ROWS(ai, m)) * 1024 + 256 * u.pn + G8_COL0(bj));
#pragma unroll
            for (int ai = 0; ai < 2; ++ai)
#pragma unroll
                for (int m = 0; m < 4; ++m)
#pragma unroll
                    for (int bj = 0; bj < 2; ++bj) { f32x4 g0, g1; unpack8(gt[ai][m][bj], g0, g1);
                        *(u32x4*)(YB + (size_t)(256 * u.pm + G8_ROWS(ai, m)) * 1024 + 256 * u.pn + G8_COL0(bj)) = pack8(acc[ai][bj][m][0] * g0, acc[ai][bj][m][1] * g1); }
        } else if (MODE == 1) {
#pragma unroll
            for (int ai = 0; ai < 2; ++ai) {
                u32x4 gt[4][2], tt[4][2];
#pragma unroll
                for (int m = 0; m < 4; ++m)
#pragma unroll
                    for (int bj = 0; bj < 2; ++bj) { const size_t o = (size_t)(256 * u.pm + G8_ROWS(ai, m)) * 1024 + 256 * u.pn + G8_COL0(bj); gt[m][bj] = *(const u32x4*)(GATE + o); tt[m][bj] = *(const u32x4*)(YB + o); }
#pragma unroll
                for (int m = 0; m < 4; ++m)
#pragma unroll
                    for (int bj = 0; bj < 2; ++bj) { const size_t o = (size_t)(256 * u.pm + G8_ROWS(ai, m)) * 1024 + 256 * u.pn + G8_COL0(bj);
                        f32x4 g0, g1, t0, t1; unpack8(gt[m][bj], g0, g1); unpack8(tt[m][bj], t0, t1);
                        *(u32x4*)(YB + o) = pack8(acc[ai][bj][m][0] * g0 + t0, acc[ai][bj][m][1] * g1 + t1); }
            }
        } else {
            f32x4 gv[2][2];
            const bool isx = (256 * u.pm) < TX;
            { const float* gp = isx ? (g1x + ((256 * u.pm) >> 13) * 6144) : g1c;
#pragma unroll
              for (int bj = 0; bj < 2; ++bj) { gv[bj][0] = *(const f32x4*)(gp + 256 * u.pn + G8_COL0(bj)); gv[bj][1] = *(const f32x4*)(gp + 256 * u.pn + G8_COL0(bj) + 4); } }
            const float* xb = isx ? xin : cin - (size_t)TX * 1024; float* ob = isx ? XW : CW - (size_t)TX * 1024;
#pragma unroll
            for (int ai = 0; ai < 2; ++ai) {
                f32x4 xv[4][2][2];
#pragma unroll
                for (int m = 0; m < 4; ++m)
#pragma unroll
                    for (int bj = 0; bj < 2; ++bj) { const float* xp = xb + (size_t)(256 * u.pm + G8_ROWS(ai, m)) * 1024 + 256 * u.pn + G8_COL0(bj); xv[m][bj][0] = *(const f32x4*)xp; xv[m][bj][1] = *(const f32x4*)(xp + 4); }
#pragma unroll
                for (int m = 0; m < 4; ++m)
#pragma unroll
                    for (int bj = 0; bj < 2; ++bj) { float* op = ob + (size_t)(256 * u.pm + G8_ROWS(ai, m)) * 1024 + 256 * u.pn + G8_COL0(bj);
                        *(f32x4*)op = xv[m][bj][0] + gv[bj][0] * acc[ai][bj][m][0]; *(f32x4*)(op + 4) = xv[m][bj][1] + gv[bj][1] * acc[ai][bj][m][1]; }
            }
        }
    }
};

struct MoeGuProb {
    static constexpr bool PERM = true, GATHER_A = true, I8 = true, F8 = false; typedef i32x4 Acc;
    struct U { int e, rt, pn, base, cnt; int tok[4]; };
    const signed char* H8; const signed char* W8; const float* sW; const float* lsc; const float* bgu; unsigned char* ACT; const int* list; const int* cnt;
    const volatile LAS int* tstart;
    int R, G, c;
    __device__ __forceinline__ bool get(int i, U& u) const {
        const int L = i * G + c; if (L >= R * 8) return false;
        int rt, pn; g8::order2d(L, R, 8, rt, pn);
        const int e = ((const volatile LAS unsigned char*)tstart)[(1024 - 64) + rt];
        u.e = __builtin_amdgcn_readfirstlane(e); u.rt = __builtin_amdgcn_readfirstlane(rt); u.pn = __builtin_amdgcn_readfirstlane(pn); u.base = __builtin_amdgcn_readfirstlane((rt - tstart[e]) * 256); u.cnt = __builtin_amdgcn_readfirstlane(cnt[e]);
        int R0, Rb0, C0; g8::lane_geom(threadIdx.x, R0, Rb0, C0);
#pragma unroll
        for (int j = 0; j < 4; ++j) { const int p = u.base + R0 + 64 * j; u.tok[j] = (p < u.cnt) ? list[(size_t)e * TT + p] : TT; }
        return true;
    }
    __device__ __forceinline__ void setup(const U& u, unsigned (&oa)[4], unsigned& ob, unsigned (&dA)[4], unsigned (&dB)[4], const char*& pA, const char*& pB, int& nt) const {
        int R0, Rb0, C0; g8::lane_geom(threadIdx.x, R0, Rb0, C0);
        nt = 8; pA = (const char*)H8; pB = (const char*)W8;
#pragma unroll
        for (int j = 0; j < 4; ++j) { dA[j] = 0u; dB[j] = (unsigned)(64 * j * 1024); oa[j] = (unsigned)(u.tok[j] * 1024 + C0 * 2); }
        ob = (unsigned)((u.e * 2048 + 256 * u.pn + Rb0) * 1024 + C0 * 2);
    }
    __device__ __forceinline__ void epi(const i32x4 (&acc)[2][2][4][2], const U& u, int wr, int wc, int fr, int fq) const {
        const int j0 = 128 * u.pn + 32 * wc + 8 * fq;
        const float* bp = bgu + (size_t)u.e * 2048 + j0;
        const f32x4 ba0 = *(const f32x4*)bp, ba1 = *(const f32x4*)(bp + 4), bu0 = *(const f32x4*)(bp + 1024), bu1 = *(const f32x4*)(bp + 1028);
        const float* sp = sW + (size_t)u.e * 2048 + 256 * u.pn + 32 * wc + 8 * fq;
        const f32x4 sa0 = *(const f32x4*)sp, sa1 = *(const f32x4*)(sp + 4), su0 = *(const f32x4*)(sp + 128), su1 = *(const f32x4*)(sp + 132);
        float rsv[2][4];
#pragma unroll
        for (int ai = 0; ai < 2; ++ai)
#pragma unroll
            for (int m = 0; m < 4; ++m) { const int p = u.base + G8_ROWS(ai, m); rsv[ai][m] = (p < u.cnt) ? lsc[(size_t)u.e * TT + p] : 0.0f; }
#pragma unroll
        for (int ai = 0; ai < 2; ++ai)
#pragma unroll
            for (int m = 0; m < 4; ++m) { const int rr = G8_ROWS(ai, m); const size_t row = (size_t)256 * u.rt + rr;
                const float rs = rsv[ai][m];
                f32x4 a0, a1, u0, u1, y0, y1;
#pragma unroll
                for (int e = 0; e < 4; ++e) { a0[e] = (float)acc[ai][0][m][0][e] * rs * sa0[e] + ba0[e]; a1[e] = (float)acc[ai][0][m][1][e] * rs * sa1[e] + ba1[e];
                    u0[e] = (float)acc[ai][1][m][0][e] * rs * su0[e] + bu0[e]; u1[e] = (float)acc[ai][1][m][1][e] * rs * su1[e] + bu1[e]; }
#pragma unroll
                for (int e = 0; e < 4; ++e) {
                    float a = fminf(a0[e], 7.0f), uu = fminf(fmaxf(u0[e], -7.0f), 7.0f); y0[e] = a * sigmoidf_(1.702f * a) * (uu + 1.0f);
                    a = fminf(a1[e], 7.0f); uu = fminf(fmaxf(u1[e], -7.0f), 7.0f); y1[e] = a * sigmoidf_(1.702f * a) * (uu + 1.0f);
                }
                { u32x2 w; w.x = pk4_fp8(y0[0], y0[1], y0[2], y0[3]); w.y = pk4_fp8(y1[0], y1[1], y1[2], y1[3]); *(u32x2*)(ACT + row * 1024 + j0) = w; } }
    }
};
struct MoeDnProb {
    static constexpr bool PERM = true, GATHER_A = false, I8 = false, F8 = true; typedef f32x4 Acc;
    struct U { int e, rt, pn; };
    const unsigned char* ACT; const unsigned char* W; const float* bdn; bf16_t* YE;
    const volatile LAS int* tstart; int R, G, c;
    __device__ __forceinline__ bool get(int i, U& u) const {
        const int L = i * G + c; if (L >= R * 4) return false;
        int rt, pn; g8::order2d(L, R, 4, rt, pn);
        const int e = ((const volatile LAS unsigned char*)tstart)[(1024 - 64) + rt];
        u.e = __builtin_amdgcn_readfirstlane(e); u.rt = __builtin_amdgcn_readfirstlane(rt); u.pn = __builtin_amdgcn_readfirstlane(pn); return true;
    }
    __device__ __forceinline__ void setup(const U& u, unsigned (&oa)[4], unsigned& ob, unsigned (&dA)[4], unsigned (&dB)[4], const char*& pA, const char*& pB, int& nt) const {
        int R0, Rb0, C0; g8::lane_geom(threadIdx.x, R0, Rb0, C0);
        nt = 8; pA = (const char*)ACT; pB = (const char*)W;
#pragma unroll
        for (int j = 0; j < 4; ++j) { dA[j] = (unsigned)(64 * j * 1024); dB[j] = dA[j]; }
        oa[0] = (unsigned)((256 * u.rt + R0) * 1024 + C0 * 2); ob = (unsigned)((u.e * 1024 + 256 * u.pn + Rb0) * 1024 + C0 * 2);
    }
    __device__ __forceinline__ void epi(const f32x4 (&acc)[2][2][4][2], const U& u, int wr, int wc, int fr, int fq) const {
#pragma unroll
        for (int bj = 0; bj < 2; ++bj) { const int col = 256 * u.pn + G8_COL0(bj);
            const float* bp = bdn + (size_t)u.e * 1024 + col; const f32x4 b0 = *(const f32x4*)bp, b1 = *(const f32x4*)(bp + 4);
#pragma unroll
            for (int ai = 0; ai < 2; ++ai)
#pragma unroll
                for (int m = 0; m < 4; ++m) { const size_t row = (size_t)256 * u.rt + G8_ROWS(ai, m);
                    *(u32x4*)(YE + row * 1024 + col) = pack8(acc[ai][bj][m][0] * (1.0f / 32.0f) + b0, acc[ai][bj][m][1] * (1.0f / 32.0f) + b1); } }
    }
};

__device__ __forceinline__ int rope_perm(int d) { return (d & 32) | ((d & 15) << 1) | ((d >> 4) & 1); }
template <class RM>
__device__ __forceinline__ void transpose_tile(const Fr& F, const float* src, int N, int k0, int n0, bf16_t* dst, int Kd, RM rm) {
    LAS unsigned char* lds = F.lds;
    const int tid = F.tid;
    { const int kq = tid >> 4, c4 = (tid & 15) * 4; f32x4 v[4];
#pragma unroll
      for (int r = 0; r < 4; ++r) v[r] = *(const f32x4*)(src + (size_t)(k0 + 4 * kq + r) * N + n0 + c4);
#pragma unroll
      for (int e = 0; e < 4; ++e) { u32x2 w; w.x = cvt_pk_bf16(v[0][e], v[1][e]); w.y = cvt_pk_bf16(v[2][e], v[3][e]); *(LAS u32x2*)(lds + (c4 + e) * 272 + kq * 8) = w; } }
    __syncthreads();
    { const int n = tid >> 3, ch = tid & 7; const u32x4 w0 = *(const LAS u32x4*)(lds + n * 272 + ch * 32), w1 = *(const LAS u32x4*)(lds + n * 272 + ch * 32 + 16);
      bf16_t* dp = dst + (size_t)rm(n0 + n) * Kd + k0 + ch * 16; *(u32x4*)dp = w0; *(u32x4*)(dp + 8) = w1; }
    __syncthreads();
}
__device__ __forceinline__ void transpose_tile_fp8(const Fr& F, const float* src, int k0, int n0, unsigned char* dst) {
    LAS unsigned char* lds = F.lds;
    const int tid = F.tid;
    { const int kq = tid >> 4, c4 = (tid & 15) * 4; f32x4 v[4];
#pragma unroll
      for (int r = 0; r < 4; ++r) v[r] = *(const f32x4*)(src + (size_t)(k0 + 4 * kq + r) * 1024 + n0 + c4) * 32.0f;
#pragma unroll
      for (int e = 0; e < 4; ++e) *(LAS unsigned*)(lds + (c4 + e) * 144 + kq * 4) = pk4_fp8(v[0][e], v[1][e], v[2][e], v[3][e]); }
    __syncthreads();
    { const int n = tid >> 3, ch = tid & 7; const u32x4 w = *(const LAS u32x4*)(lds + n * 144 + ch * 16);
      *(u32x4*)(dst + (size_t)(n0 + n) * 1024 + k0 + ch * 16) = w; }
    __syncthreads();
}
struct RmGu { __device__ int operator()(int n) const { const int bj = n >> 10, j = n & 1023; return 256 * (j >> 7) + 128 * bj + (j & 127); } };
template <int N, class RM>
__device__ __forceinline__ void quant_strip(const Fr& F, const float* src, int n0, signed char* dst, float* sdst, RM rm) {
    LAS unsigned char* lds = F.lds;
    LAS float* red = (LAS float*)(lds + 16384);
    LAS float* inv = (LAS float*)(lds + 16384 + 8192);
    const int tid = F.tid, kq = tid >> 4, c4 = (tid & 15) * 4;
    f32x4 mx = {0.f, 0.f, 0.f, 0.f};
#pragma unroll 4
    for (int k = kq; k < 1024; k += 32) { const f32x4 v = *(const f32x4*)(src + (size_t)k * N + n0 + c4);
#pragma unroll
        for (int e = 0; e < 4; ++e) mx[e] = fmaxf(mx[e], fabsf(v[e])); }
#pragma unroll
    for (int e = 0; e < 4; ++e) red[kq * 64 + c4 + e] = mx[e];
    __syncthreads();
    if (tid < 64) { float m = 0.f;
#pragma unroll
        for (int r = 0; r < 32; ++r) m = fmaxf(m, red[r * 64 + tid]);
        const int row = rm(n0 + tid);
        sdst[row] = m * (1.0f / 127.0f); inv[tid] = m > 0.f ? 127.0f / m : 0.f; }
    __syncthreads();
    const f32x4 iv = *(const LAS f32x4*)(inv + c4);
#pragma unroll 1
    for (int kt = 0; kt < 8; ++kt) { f32x4 v[4];
#pragma unroll
        for (int r = 0; r < 4; ++r) v[r] = *(const f32x4*)(src + (size_t)(kt * 128 + 4 * kq + r) * N + n0 + c4);
#pragma unroll
        for (int e = 0; e < 4; ++e) { const int q0 = __float2int_rn(v[0][e] * iv[e]), q1 = __float2int_rn(v[1][e] * iv[e]), q2 = __float2int_rn(v[2][e] * iv[e]), q3 = __float2int_rn(v[3][e] * iv[e]);
            *(LAS unsigned*)(lds + (c4 + e) * 144 + kq * 4) = (unsigned)(q0 & 255) | ((unsigned)(q1 & 255) << 8) | ((unsigned)(q2 & 255) << 16) | ((unsigned)(q3 & 255) << 24); }
        __syncthreads();
        { const int nl = tid >> 3, ch = tid & 7; const u32x4 w = *(const LAS u32x4*)(lds + nl * 144 + ch * 16);
          const int row = rm(n0 + nl);
          *(u32x4*)(dst + (size_t)row * 1024 + kt * 128 + ch * 16) = w; }
        __syncthreads();
    }
}
struct RmId { __device__ int operator()(int n) const { return n; } };
struct RmWin { __device__ int operator()(int n) const { return (n >= 512 && n < 1152) ? ((n & ~63) | rope_perm(n & 63)) : n; } };

__device__ __forceinline__ void prologue_phase(const Fr& F) {
    const int tid = F.tid, G = F.G, bid = F.bid;
    const float PI2 = 6.283185307179586f;
    const size_t gtid = (size_t)bid * 512 + tid, gsz = (size_t)G * 512;
    { float* rope = WSP(float, WS_ROPE);
      for (size_t i = gtid; i < 2048; i += gsz) { const int pos = (int)(i >> 4), f = (int)(i & 15); const float inv = powf(10000.0f, -(float)f / 16.0f); const float a = (float)pos * inv; rope[i] = cosf(a); rope[2048 + i] = sinf(a); } }
    { bf16_t* W1 = WSP(bf16_t, WS_W1);
      for (size_t i = gtid; i < 256 * 128; i += gsz) { const int r = (int)(i >> 7), n1 = (int)(i & 127); float v = 0.f;
          if (r < 128) { const int k1p = r >> 1, part = r & 1;
              if (part == 0) v = cospif((float)((k1p * n1) & 127) / 64.0f);
              else if (k1p == 0) v = (n1 & 1) ? -1.0f : 1.0f;
              else v = -sinpif((float)((k1p * n1) & 127) / 64.0f); }
          W1[i] = f2bf(v); } }
    { bf16_t* MT = WSP(bf16_t, WS_MT);
      for (size_t i = gtid; i < (size_t)64 * 256 * 128; i += gsz) {
          const int kk = (int)(i & 127), r = (int)((i >> 7) & 255), k1p = (int)(i >> 15);
          const int part = kk >> 6, n2 = kk & 63, s = r >> 7, k2 = (r & 127) >> 1, reim = r & 1;
          float v;
          if (k1p == 0) { const int k = 64 * s + 128 * k2; const int mm = (n2 * k) & 8191; const float cm = cospif((float)mm / 4096.0f), sm = sinpif((float)mm / 4096.0f);
              v = (part == s) ? (reim ? -sm : cm) : 0.0f; }
          else { const int k = (s ? 128 - k1p : k1p) + 128 * k2; const int mm = (n2 * k) & 8191; const float cm = cospif((float)mm / 4096.0f), sm = sinpif((float)mm / 4096.0f);
              if (s == 0) v = reim ? (part ? cm : -sm) : (part ? sm : cm);
              else        v = reim ? (part ? -cm : -sm) : (part ? -sm : cm); }
          MT[i] = f2bf(v); } }
    { bf16_t* WC = WSP(bf16_t, WS_WC);
      const float sc = 5.656854249492381f;
      for (size_t i = gtid; i < 512 * 256; i += gsz) { const int n = (int)(i & 255), r = (int)(i >> 8), k = r >> 1, reim = r & 1; const int mm = (k * n) & 255;
          WC[i] = f2bf(sc * (reim ? -sinpif((float)mm / 128.0f) : cospif((float)mm / 128.0f))); } }
    { bf16_t* RWT = WSP(bf16_t, WS_RWT); const float* rw = INP(13);
      for (size_t i = gtid; i < (size_t)DEPTH * 32 * 1024; i += gsz) { const int k = (int)(i & 1023), e = (int)((i >> 10) & 31), l = (int)(i >> 15); RWT[i] = f2bf(rw[((size_t)l * 1024 + k) * 32 + e]); } }
    { bf16_t* H = WSP(bf16_t, WS_H); for (size_t i = gtid; i < 256 * 1024; i += gsz) H[(size_t)TT * 1024 + i] = 0;
      unsigned* H8z = (unsigned*)(WSP(signed char, WS_H8) + (size_t)TT * 1024); for (size_t i = gtid; i < 256 * 256; i += gsz) H8z[i] = 0u; }
    (void)PI2;
    {
        LAS float* sil = (LAS float*)(F.lds + 65536);
        LAS float* red = (LAS float*)(F.lds + 65536 + 20480);
        for (int i = tid; i < 5 * 1024; i += 512) { const int v = i >> 10, k = i & 1023; const float x = (v < 4) ? INP(1)[v * 1024 + k] : INP(3)[k]; sil[i] = x * sigmoidf_(x); }
        __syncthreads();
        float* MOD = WSP(float, WS_MOD);
        for (int u = bid; u < DEPTH * 96; u += G) {
            const int l = u / 96, j0 = (u % 96) * 64;
            const float* aw = INP(4) + (size_t)l * 1024 * 6144 + j0 + F.lane;
            float a0 = 0.f, a1 = 0.f, a2 = 0.f, a3 = 0.f, a4 = 0.f;
            for (int kk = 0; kk < 128; ++kk) { const int k = F.wave * 128 + kk; const float w = aw[(size_t)k * 6144];
                a0 += sil[k] * w; a1 += sil[1024 + k] * w; a2 += sil[2048 + k] * w; a3 += sil[3072 + k] * w; a4 += sil[4096 + k] * w; }
            red[(F.wave * 5 + 0) * 64 + F.lane] = a0; red[(F.wave * 5 + 1) * 64 + F.lane] = a1; red[(F.wave * 5 + 2) * 64 + F.lane] = a2; red[(F.wave * 5 + 3) * 64 + F.lane] = a3; red[(F.wave * 5 + 4) * 64 + F.lane] = a4;
            __syncthreads();
            if (tid < 320) { const int v = tid >> 6, jl = tid & 63; float s = INP(5)[(size_t)l * 6144 + j0 + jl];
#pragma unroll
                for (int w = 0; w < 8; ++w) s += red[(w * 5 + v) * 64 + jl];
                MOD[((size_t)l * 5 + v) * 6144 + j0 + jl] = s; }
            __syncthreads();
        }
    }
    {
        LAS float* tab = (LAS float*)(F.lds + 65536);
        if (tid < 128) { tab[tid] = cospif((float)tid / 64.0f); tab[128 + tid] = sinpif((float)tid / 64.0f); }
        __syncthreads();
        bf16_t* WFO = WSP(bf16_t, WS_WFO);
        for (int u = bid; u < DEPTH * 4 * 2 * 16; u += G) {
            const int dc = u & 15, reim = (u >> 4) & 1, g = (u >> 5) & 3, l = u >> 7;
            const float* wf = INP(10) + ((size_t)l * 512 + g * 128) * 1024;
#pragma unroll 1
            for (int oh = 0; oh < 2; ++oh) { const int o = tid + 512 * oh;
                float a[8] = {0.f, 0.f, 0.f, 0.f, 0.f, 0.f, 0.f, 0.f};
                for (int j = 0; j < 128; ++j) { const float w = wf[(size_t)j * 1024 + o];
#pragma unroll
                    for (int q = 0; q < 8; ++q) a[q] += tab[reim * 128 + ((j * (dc * 8 + q)) & 127)] * w; }
                u32x4 w4; w4.x = cvt_pk_bf16(a[0] * (1.f / 1024.f), a[1] * (1.f / 1024.f)); w4.y = cvt_pk_bf16(a[2] * (1.f / 1024.f), a[3] * (1.f / 1024.f));
                w4.z = cvt_pk_bf16(a[4] * (1.f / 1024.f), a[5] * (1.f / 1024.f)); w4.w = cvt_pk_bf16(a[6] * (1.f / 1024.f), a[7] * (1.f / 1024.f));
                *(u32x4*)(WFO + ((size_t)l * 1024 + o) * 1024 + g * 256 + reim * 128 + dc * 8) = w4; }
        }
        __syncthreads();
    }
    {
        constexpr int T_WIN = DEPTH * 52, T_WAO = DEPTH * 4 * 16, T_WOUT = DEPTH * 8 * 16, T_DN = DEPTH * 32 * 8 * 16, T_GU = DEPTH * 32 * 32;
        constexpr int T_ALL = T_GU + T_DN + T_WIN + T_WAO + T_WOUT;
        for (int t = bid; t < T_ALL; t += G) {
            int q = t;
            if (q < T_GU) { const int le = q >> 5, ns = q & 31;
                quant_strip<2048>(F, INP(15) + (size_t)le * 1024 * 2048, ns * 64, WSP(signed char, WS_WGU) + (size_t)le * 2048 * 1024, WSP(float, WS_SWGU) + (size_t)le * 2048, RmGu()); continue; }
            q -= T_GU;
            if (q < T_DN) { const int le = q / 128, r = q % 128, kt = r / 16, ntl = r % 16;
                transpose_tile_fp8(F, INP(17) + (size_t)le * 1024 * 1024, kt * 128, ntl * 64, WSP(unsigned char, WS_WDN) + (size_t)le * 1024 * 1024); continue; }
            q -= T_DN;
            if (q < T_WIN) { const int l = q / 52, ns = q % 52;
                quant_strip<IN_DIM>(F, INP(8) + (size_t)l * 1024 * IN_DIM, ns * 64, WSP(signed char, WS_WIN) + (size_t)l * IN_DIM * 1024, WSP(float, WS_SWIN) + (size_t)l * IN_DIM, RmWin()); continue; }
            q -= T_WIN;
            if (q < T_WAO) { const int l = q / 64, r = q % 64, kt = r / 16, ntl = r % 16;
                transpose_tile(F, INP(11) + (size_t)l * 512 * 1024, 1024, kt * 128, ntl * 64, WSP(bf16_t, WS_WAO) + (size_t)l * 1024 * 512, 512, RmId()); continue; }
            q -= T_WAO;
            { const int l = q / 128, r = q % 128, kt = r / 16, ntl = r % 16;
                transpose_tile(F, INP(12) + (size_t)l * 1024 * 1024, 1024, kt * 128, ntl * 64, WSP(bf16_t, WS_WOUT) + (size_t)l * 1024 * 1024, 1024, RmId()); }
        }
    }
}

__device__ __forceinline__ void moe_combine(const Fr& F, int tok, int lprev, const volatile LAS int* tstart, f32x4 (&m)[4]) {
    const int* slot = WSP(int, WS_SLOT); const float* gate = WSP(float, WS_GATE); const bf16_t* YE = WSP(bf16_t, WS_YE);
#pragma unroll
    for (int j = 0; j < 4; ++j) m[j] = (f32x4){0.f, 0.f, 0.f, 0.f};
#pragma unroll
    for (int k = 0; k < 4; ++k) {
        const int sl = slot[tok * 4 + k]; const float gk = gate[tok * 4 + k];
        const int e = sl >> 20, pos = sl & 0xfffff;
        const size_t row = (size_t)256 * tstart[e] + pos;
        const bf16_t* yp = YE + row * 1024 + 4 * F.lane;
#pragma unroll
        for (int j = 0; j < 4; ++j) { const u32x2 w = *(const u32x2*)(yp + 256 * j); m[j][0] += gk * bf_lo(w.x); m[j][1] += gk * bf_hi(w.x); m[j][2] += gk * bf_lo(w.y); m[j][3] += gk * bf_hi(w.y); }
    }
    (void)lprev;
}
__device__ __forceinline__ int fill_tstart(const Fr& F, int l) {
    volatile LAS int* ts = (volatile LAS int*)(F.lds + LDS_MISC + 64);
    __syncthreads();
    if (F.tid == 0) { const int* cnt = (const int*)(F.ws + WS_CTL + CTL_CNT) + l * 32; int s = 0; for (int e = 0; e < 32; ++e) { ts[e] = s; s += (cnt[e] + 255) >> 8; } ts[32] = s; }
    __syncthreads();
    { volatile LAS unsigned char* r2e = (volatile LAS unsigned char*)(F.lds + LDS_MISC + 1024);
      const int R = ts[32];
      for (int rt = F.tid; rt < R; rt += 512) { int e = 0;
#pragma unroll 1
          for (int q = 1; q < 32; ++q) e = (ts[q] <= rt) ? q : e;
          r2e[rt] = (unsigned char)e; } }
    __syncthreads();
    return ts[32];
}

__device__ __forceinline__ void norm1_phase(const Fr& F, int l) {
    const volatile LAS int* tstart = (const volatile LAS int*)(F.lds + LDS_MISC + 64);
    if (l > 0) fill_tstart(F, l - 1);
    const float* MOD = WSP(float, WS_MOD);
    const bool fin = (l == DEPTH);
    const int ntok = fin ? TX : TT;
    const bool tmo = fin && (xb_ld((unsigned*)(F.ws + WS_CTL) + XB_TMO) != 0u);
    const float* gvec = fin ? INP(19) : INP(6) + (size_t)l * 1024;
    float* XW = WSP(float, WS_XW); float* CW = WSP(float, WS_CW); signed char* H8 = WSP(signed char, WS_H8); float* SHv = WSP(float, WS_SH);
    for (int tok = F.bid * 8 + F.wave; tok < ntok; tok += F.G * 8) {
        const bool isx = tok < TX; const int v = isx ? (tok >> 13) : 4;
        const float* src = (l == 0) ? (isx ? INP(0) + (size_t)tok * 1024 : INP(2) + (size_t)(tok - TX) * 1024) : (isx ? XW + (size_t)tok * 1024 : CW + (size_t)(tok - TX) * 1024);
        f32x4 x[4];
#pragma unroll
        for (int j = 0; j < 4; ++j) x[j] = *(const f32x4*)(src + 256 * j + 4 * F.lane);
        if (l > 0) {
            f32x4 mm[4]; moe_combine(F, tok, l - 1, tstart, mm);
            const float* g2 = MOD + ((size_t)(l - 1) * 5 + v) * 6144 + 5 * 1024;
            float* dst = isx ? XW + (size_t)tok * 1024 : CW + (size_t)(tok - TX) * 1024;
#pragma unroll
            for (int j = 0; j < 4; ++j) { x[j] += *(const f32x4*)(g2 + 256 * j + 4 * F.lane) * mm[j]; if (!fin) *(f32x4*)(dst + 256 * j + 4 * F.lane) = x[j]; }
        }
        float ss = 0.f;
#pragma unroll
        for (int j = 0; j < 4; ++j) ss += x[j][0] * x[j][0] + x[j][1] * x[j][1] + x[j][2] * x[j][2] + x[j][3] * x[j][3];
        ss = wave_sum(ss);
        const float rstd = rsqrtf(ss * (1.0f / 1024.0f) + EPS);
        if (fin) {
#pragma unroll
            for (int j = 0; j < 4; ++j) { const f32x4 g = *(const f32x4*)(gvec + 256 * j + 4 * F.lane); *(f32x4*)(F.out + (size_t)tok * 1024 + 256 * j + 4 * F.lane) = tmo ? (f32x4){__builtin_nanf(""), __builtin_nanf(""), __builtin_nanf(""), __builtin_nanf("")} : x[j] * rstd * g; }
        } else {
            const float* md = MOD + ((size_t)l * 5 + v) * 6144;
            float amax = 0.f;
#pragma unroll
            for (int j = 0; j < 4; ++j) { const int c = 256 * j + 4 * F.lane; const f32x4 g = *(const f32x4*)(gvec + c), sh = *(const f32x4*)(md + c), sc = *(const f32x4*)(md + 1024 + c);
                x[j] = x[j] * rstd * g * (sc + 1.0f) + sh;
                amax = fmaxf(amax, fmaxf(fmaxf(fabsf(x[j][0]), fabsf(x[j][1])), fmaxf(fabsf(x[j][2]), fabsf(x[j][3])))); }
#pragma unroll
            for (int o = 32; o >= 1; o >>= 1) amax = fmaxf(amax, __shfl_xor(amax, o));
            const float inv = amax > 0.f ? 127.0f / amax : 0.f;
#pragma unroll
            for (int j = 0; j < 4; ++j) { const int c = 256 * j + 4 * F.lane;
                const int q0 = __float2int_rn(x[j][0] * inv), q1 = __float2int_rn(x[j][1] * inv), q2 = __float2int_rn(x[j][2] * inv), q3 = __float2int_rn(x[j][3] * inv);
                *(unsigned*)(H8 + (size_t)tok * 1024 + c) = (unsigned)(q0 & 255) | ((unsigned)(q1 & 255) << 8) | ((unsigned)(q2 & 255) << 16) | ((unsigned)(q3 & 255) << 24); }
            if (F.lane == 0) SHv[tok] = amax * (1.0f / 127.0f);
        }
    }
}

__device__ __forceinline__ void norm2_router_phase(const Fr& F, int l, bool fake = false) {
    const int ntok = (l == DEPTH - 1) ? TX : TT;
    const float* MOD = WSP(float, WS_MOD); const float* gvec = INP(7) + (size_t)l * 1024;
    const float* XW = WSP(float, WS_XW); const float* CW = WSP(float, WS_CW); bf16_t* H = WSP(bf16_t, WS_H);
    const bf16_t* RWT = WSP(bf16_t, WS_RWT) + (size_t)l * 32 * 1024; const float* rb = INP(14) + l * 32;
    int* cntg = (int*)(F.ws + WS_CTL + CTL_CNT) + l * 32; int* list = WSP(int, WS_LIST); int* slot = WSP(int, WS_SLOT); float* gate = WSP(float, WS_GATE);
    LAS unsigned char* hs = F.lds;
    LAS float* part = (LAS float*)(F.lds + 69632);
    LAS float* logit = (LAS float*)(F.lds + 69632 + 36864);
    LAS int* lcnt = (LAS int*)(F.lds + 69632 + 36864 + 4608);
    LAS int* lbase = lcnt + 32;
    LAS float* tsc = (LAS float*)(lbase + 32);
    signed char* H8 = WSP(signed char, WS_H8); float* lscg = WSP(float, WS_LSC);
    const int lane = F.lane, w = F.wave, l32 = lane & 31, hh = lane >> 5;
    for (int tl = F.bid; tl < ntok / 32; tl += F.G) {
        const int t0 = tl * 32;
        if (F.tid < 32) lcnt[F.tid] = 0;
#pragma unroll 1
        for (int q = 0; q < 4; ++q) {
            const int tloc = 4 * w + q, tok = t0 + tloc; const bool isx = tok < TX; const int v = isx ? (tok >> 13) : 4;
            const float* src = isx ? XW + (size_t)tok * 1024 : CW + (size_t)(tok - TX) * 1024;
            f32x4 x[4]; float ss = 0.f;
#pragma unroll
            for (int j = 0; j < 4; ++j) { x[j] = *(const f32x4*)(src + 256 * j + 4 * lane); ss += x[j][0] * x[j][0] + x[j][1] * x[j][1] + x[j][2] * x[j][2] + x[j][3] * x[j][3]; }
            ss = wave_sum(ss); const float rstd = rsqrtf(ss * (1.0f / 1024.0f) + EPS);
            const float* md = MOD + ((size_t)l * 5 + v) * 6144;
            float amax = 0.f;
#pragma unroll
            for (int j = 0; j < 4; ++j) { const int c = 256 * j + 4 * lane; const f32x4 g = *(const f32x4*)(gvec + c), sh = *(const f32x4*)(md + 3072 + c), sc = *(const f32x4*)(md + 4096 + c);
                x[j] = x[j] * rstd * g * (sc + 1.0f) + sh;
                amax = fmaxf(amax, fmaxf(fmaxf(fabsf(x[j][0]), fabsf(x[j][1])), fmaxf(fabsf(x[j][2]), fabsf(x[j][3]))));
                u32x2 wv; wv.x = cvt_pk_bf16(x[j][0], x[j][1]); wv.y = cvt_pk_bf16(x[j][2], x[j][3]);
                *(LAS u32x2*)(hs + tloc * 2064 + c * 2) = wv; }
#pragma unroll
            for (int o = 32; o >= 1; o >>= 1) amax = fmaxf(amax, __shfl_xor(amax, o));
            const float inv = amax > 0.f ? 127.0f / amax : 0.f;
#pragma unroll
            for (int j = 0; j < 4; ++j) { const int c = 256 * j + 4 * lane;
                const int q0 = __float2int_rn(x[j][0] * inv), q1 = __float2int_rn(x[j][1] * inv), q2 = __float2int_rn(x[j][2] * inv), q3 = __float2int_rn(x[j][3] * inv);
                *(unsigned*)(H8 + (size_t)tok * 1024 + c) = (unsigned)(q0 & 255) | ((unsigned)(q1 & 255) << 8) | ((unsigned)(q2 & 255) << 16) | ((unsigned)(q3 & 255) << 24); }
            if (lane == 0) tsc[tloc] = amax * (1.0f / 127.0f);
        }
        __syncthreads();
        {
            f32x16 acc;
#pragma unroll
            for (int e = 0; e < 16; ++e) acc[e] = 0.f;
#pragma unroll
            for (int s = 0; s < 8; ++s) { const int k = 128 * w + 16 * s + 8 * hh;
                const bf16x8 a = *(const LAS bf16x8*)(hs + l32 * 2064 + k * 2);
                const bf16x8 b = *(const bf16x8*)(RWT + (size_t)l32 * 1024 + k);
                acc = __builtin_amdgcn_mfma_f32_32x32x16_bf16(a, b, acc, 0, 0, 0); }
#pragma unroll
            for (int e = 0; e < 16; ++e) { const int trow = 8 * (e >> 2) + 4 * hh + (e & 3); part[(w * 32 + trow) * 33 + l32] = acc[e]; }
        }
        __syncthreads();
        { const int tr = F.tid >> 4, e0 = (F.tid & 15) * 2;
#pragma unroll
          for (int q = 0; q < 2; ++q) { float s = rb[e0 + q];
#pragma unroll
              for (int ww = 0; ww < 8; ++ww) s += part[(ww * 32 + tr) * 33 + e0 + q];
              logit[tr * 33 + e0 + q] = s; } }
        __syncthreads();
        int es[4], rk[4]; float gs[4];
        if (fake) { __syncthreads(); continue; }
        if (F.tid < 32) {
            float lv[4]; unsigned used = 0u;
#pragma unroll
            for (int k = 0; k < 4; ++k) { float best = -3.0e38f; int bi = 0;
#pragma unroll 1
                for (int e = 0; e < 32; ++e) { const float vv = logit[F.tid * 33 + e]; if (!((used >> e) & 1u) && vv > best) { best = vv; bi = e; } }
                used |= 1u << bi; es[k] = bi; lv[k] = best; }
            const float mx = lv[0]; float sum = 0.f;
#pragma unroll
            for (int k = 0; k < 4; ++k) { gs[k] = __expf(lv[k] - mx); sum += gs[k]; }
#pragma unroll
            for (int k = 0; k < 4; ++k) { gs[k] /= sum; rk[k] = __hip_atomic_fetch_add(&lcnt[es[k]], 1, __ATOMIC_RELAXED, __HIP_MEMORY_SCOPE_WORKGROUP); }
        }
        __syncthreads();
        if (F.tid < 32) { const int n = lcnt[F.tid]; lbase[F.tid] = n ? atomicAdd(&cntg[F.tid], n) : 0; }
        __syncthreads();
        if (F.tid < 32) { const int tok = t0 + F.tid;
#pragma unroll
            for (int k = 0; k < 4; ++k) { const int pos = lbase[es[k]] + rk[k]; list[(size_t)es[k] * TT + pos] = tok; lscg[(size_t)es[k] * TT + pos] = tsc[F.tid]; slot[tok * 4 + k] = (es[k] << 20) | pos; gate[tok * 4 + k] = gs[k]; } }
        __syncthreads();
    }
}

template <int OFF> __device__ __forceinline__ s16x4 tr_read(unsigned vb) { s16x4 r; asm volatile("ds_read_b64_tr_b16 %0, %1 offset:%2" : "=&v"(r) : "v"(vb), "i"(OFF) : "memory"); return r; }

__device__ __forceinline__ void attn_phase(const Fr& F, int l, bool with_ctx) {
    LAS unsigned char* lds = F.lds;
    const unsigned ldsb = (unsigned)(uintptr_t)lds;
    const bf16_t* Q = WSP(bf16_t, WS_Q); const bf16_t* Kb = WSP(bf16_t, WS_K); const bf16_t* Vb = WSP(bf16_t, WS_V); bf16_t* AO = WSP(bf16_t, WS_AO);
    const int tid = F.tid, lane = F.lane, w = F.wave, l32 = lane & 31, hh = lane >> 5;
    const int g = w >> 1, rhalf = w & 1;
    const int nunits = 512 + (with_ctx ? 16 : 0);
    const int skey = tid >> 3, sch = tid & 7;
    const unsigned k_st = (unsigned)(skey * 128 + ((sch ^ ((skey >> 1) & 7)) * 16));
    const unsigned v_st = (unsigned)(8192 + skey * 128 + ((((sch >> 1) ^ (((skey >> 1) & 1) << 1)) * 32) + (sch & 1) * 16));
    unsigned vbase[2];
    { const int li = lane & 15, q = li >> 2, p = li & 3, g16 = l32 >> 4; const int key = 4 * hh + q;
#pragma unroll
      for (int db = 0; db < 2; ++db) { const int c32 = 2 * db + g16; vbase[db] = ldsb + 8192u + (unsigned)(key * 128 + ((c32 ^ (((key >> 1) & 1) << 1)) * 32) + 8 * p); } }
    for (int u = F.bid; u < nunits; u += F.G) {
        int b, qb, kvh; bool isctx;
        if (u < 512) { b = u >> 7; qb = (u >> 1) & 63; kvh = u & 1; isctx = false; }
        else { const int uu = u - 512; b = uu >> 2; qb = (uu >> 1) & 1; kvh = uu & 1; isctx = true; }
        const int head = kvh * 4 + g;
        const int qtok0 = isctx ? (TX + b * LC + qb * 128) : (b * SEQ + qb * 128);
        bf16x8 qf[2][4];
#pragma unroll
        for (int qk = 0; qk < 2; ++qk)
#pragma unroll
            for (int s = 0; s < 4; ++s) qf[qk][s] = *(const bf16x8*)(Q + (size_t)(qtok0 + rhalf * 64 + qk * 32 + l32) * 512 + head * 64 + 16 * s + 8 * hh);
        const float sink2 = INP(9)[l * 8 + head] * LOG2E;
        float m_run[2] = {sink2, sink2}, l_run[2] = {hh ? 0.f : 1.f, hh ? 0.f : 1.f};
        f32x16 O[2][2];
#pragma unroll
        for (int a = 0; a < 2; ++a)
#pragma unroll
            for (int c = 0; c < 2; ++c)
#pragma unroll
                for (int e = 0; e < 16; ++e) O[a][c][e] = 0.f;
        int t = isctx ? 6 : (qb == 0 ? 2 : 0);
        u32x4 kreg, vreg;
        { const int tok0 = (t < 6) ? (b * SEQ + (qb - 1) * 128 + 64 * t) : (TX + b * LC + 64 * (t - 6));
          kreg = *(const u32x4*)(Kb + (size_t)(tok0 + skey) * 128 + kvh * 64 + sch * 8); vreg = *(const u32x4*)(Vb + (size_t)(tok0 + skey) * 128 + kvh * 64 + sch * 8); }
        for (;;) {
            __syncthreads();
            *(LAS u32x4*)(lds + k_st) = kreg; *(LAS u32x4*)(lds + v_st) = vreg;
            int tn = t + 1; if (!isctx && qb == 63 && (tn == 4 || tn == 5)) tn = 6;
            const bool more = tn < 10;
            if (more) { const int tok0 = (tn < 6) ? (b * SEQ + (qb - 1) * 128 + 64 * tn) : (TX + b * LC + 64 * (tn - 6));
                kreg = *(const u32x4*)(Kb + (size_t)(tok0 + skey) * 128 + kvh * 64 + sch * 8); vreg = *(const u32x4*)(Vb + (size_t)(tok0 + skey) * 128 + kvh * 64 + sch * 8); }
            __syncthreads();
            const bool local = (!isctx) && (t < 6);
            const bool skip = local && ((rhalf == 0 && t == 5) || (rhalf == 1 && t == 0));
            if (!skip) {
                f32x16 S[2][2];
#pragma unroll
                for (int kb = 0; kb < 2; ++kb)
#pragma unroll
                    for (int qk = 0; qk < 2; ++qk)
#pragma unroll
                        for (int e = 0; e < 16; ++e) S[kb][qk][e] = 0.f;
#pragma unroll
                for (int kb = 0; kb < 2; ++kb)
#pragma unroll
                    for (int s = 0; s < 4; ++s) { const int key = 32 * kb + l32, ch = 2 * s + hh;
                        const bf16x8 kf = *(const LAS bf16x8*)(lds + key * 128 + ((ch ^ ((key >> 1) & 7)) * 16));
#pragma unroll
                        for (int qk = 0; qk < 2; ++qk) S[kb][qk] = __builtin_amdgcn_mfma_f32_32x32x16_bf16(kf, qf[qk][s], S[kb][qk], 0, 0, 0); }
                bf16x8 pf[2][2][2];
#pragma unroll
                for (int qk = 0; qk < 2; ++qk) {
                    if (local) { const int rq = rhalf * 64 + qk * 32 + l32;
#pragma unroll
                        for (int kb = 0; kb < 2; ++kb)
#pragma unroll
                            for (int e = 0; e < 16; ++e) { const int kk = 64 * t + 32 * kb + 8 * (e >> 2) + 4 * hh + (e & 3); const int rel = kk - 128 - rq; if (rel < -128 || rel > 128) S[kb][qk][e] = -__builtin_inff(); } }
                    float mx = -__builtin_inff();
#pragma unroll
                    for (int kb = 0; kb < 2; ++kb)
#pragma unroll
                        for (int e = 0; e < 16; ++e) mx = fmaxf(mx, S[kb][qk][e]);
                    mx = fmaxf(mx, __shfl_xor(mx, 32));
                    const float mn = fmaxf(m_run[qk], mx); const float alpha = __builtin_amdgcn_exp2f(m_run[qk] - mn); m_run[qk] = mn;
                    float rs = 0.f;
#pragma unroll
                    for (int kb = 0; kb < 2; ++kb)
#pragma unroll
                        for (int e = 0; e < 16; ++e) { const float p = __builtin_amdgcn_exp2f(S[kb][qk][e] - mn); S[kb][qk][e] = p; rs += p; }
                    l_run[qk] = l_run[qk] * alpha + rs;
#pragma unroll
                    for (int db = 0; db < 2; ++db)
#pragma unroll
                        for (int e = 0; e < 16; ++e) O[db][qk][e] *= alpha;
#pragma unroll
                    for (int kb = 0; kb < 2; ++kb)
#pragma unroll
                        for (int sp = 0; sp < 2; ++sp) { u32x4 pw;
                            pw.x = cvt_pk_bf16(S[kb][qk][8 * sp + 0], S[kb][qk][8 * sp + 1]); pw.y = cvt_pk_bf16(S[kb][qk][8 * sp + 2], S[kb][qk][8 * sp + 3]);
                            pw.z = cvt_pk_bf16(S[kb][qk][8 * sp + 4], S[kb][qk][8 * sp + 5]); pw.w = cvt_pk_bf16(S[kb][qk][8 * sp + 6], S[kb][qk][8 * sp + 7]);
                            pf[kb][sp][qk] = __builtin_bit_cast(bf16x8, pw); }
                }
#define PV_STEP(KB, SP) do { \
                    const s16x4 a0 = tr_read<((32 * (KB) + 16 * (SP)) * 128)>(vbase[0]), a1 = tr_read<((32 * (KB) + 16 * (SP) + 8) * 128)>(vbase[0]); \
                    const s16x4 c0 = tr_read<((32 * (KB) + 16 * (SP)) * 128)>(vbase[1]), c1 = tr_read<((32 * (KB) + 16 * (SP) + 8) * 128)>(vbase[1]); \
                    asm volatile("s_waitcnt lgkmcnt(0)" ::: "memory"); __builtin_amdgcn_sched_barrier(0); \
                    const bf16x8 vf0 = (bf16x8){a0[0], a0[1], a0[2], a0[3], a1[0], a1[1], a1[2], a1[3]}, vf1 = (bf16x8){c0[0], c0[1], c0[2], c0[3], c1[0], c1[1], c1[2], c1[3]}; \
                    O[0][0] = __builtin_amdgcn_mfma_f32_32x32x16_bf16(vf0, pf[KB][SP][0], O[0][0], 0, 0, 0); O[0][1] = __builtin_amdgcn_mfma_f32_32x32x16_bf16(vf0, pf[KB][SP][1], O[0][1], 0, 0, 0); \
                    O[1][0] = __builtin_amdgcn_mfma_f32_32x32x16_bf16(vf1, pf[KB][SP][0], O[1][0], 0, 0, 0); O[1][1] = __builtin_amdgcn_mfma_f32_32x32x16_bf16(vf1, pf[KB][SP][1], O[1][1], 0, 0, 0); } while (0)
                PV_STEP(0, 0); PV_STEP(0, 1); PV_STEP(1, 0); PV_STEP(1, 1);
#undef PV_STEP
            }
            if (!more) break;
            t = tn;
        }
#pragma unroll
        for (int qk = 0; qk < 2; ++qk) {
            const float lt = l_run[qk] + __shfl_xor(l_run[qk], 32); const float inv = 1.0f / lt;
            const size_t tok = (size_t)(qtok0 + rhalf * 64 + qk * 32 + l32);
#pragma unroll
            for (int db = 0; db < 2; ++db)
#pragma unroll
                for (int vq = 0; vq < 4; ++vq) { u32x2 wv; wv.x = cvt_pk_bf16(O[db][qk][4 * vq] * inv, O[db][qk][4 * vq + 1] * inv); wv.y = cvt_pk_bf16(O[db][qk][4 * vq + 2] * inv, O[db][qk][4 * vq + 3] * inv);
                    *(u32x2*)(AO + tok * 512 + head * 64 + 32 * db + 8 * vq + 4 * hh) = wv; }
        }
    }
    __syncthreads();
}

struct Args { const float* in[20]; float* out; unsigned char* ws; int ph_lo, ph_hi; };

constexpr int PH_PER_LAYER = 9;
constexpr int PH_FINAL = 1 + DEPTH * PH_PER_LAYER;
constexpr int PH_COUNT = PH_FINAL + 1;

__global__ void __launch_bounds__(512, 2) fwd_kernel(Args args) {
    extern __shared__ __attribute__((aligned(16))) unsigned char lds_raw[];
    Fr F;
    F.lds = (LAS unsigned char*)lds_raw; F.ws = args.ws; F.out = args.out;
    F.tid = threadIdx.x; F.lane = F.tid & 63; F.wave = __builtin_amdgcn_readfirstlane(F.tid >> 6); F.G = gridDim.x; F.bid = blockIdx.x;
    volatile LAS unsigned* misc = (volatile LAS unsigned*)(F.lds + LDS_MISC);
    if (F.tid < 64) misc[F.tid] = 0u;
    if (F.tid < 20) { const unsigned long long pv = (unsigned long long)args.in[F.tid]; misc[128 + 2 * F.tid] = (unsigned)pv; misc[128 + 2 * F.tid + 1] = (unsigned)(pv >> 32); }
    __syncthreads();
    XcdBarrier bar; bar.bar = (unsigned*)(F.ws + WS_CTL); bar.x = 0; bar.st = misc;
    const bool one = (args.ph_hi - args.ph_lo) > 1;
    if (one) bar = xcd_barrier_post((unsigned*)(F.ws + WS_CTL), misc);
    const int lo = args.ph_lo, hi = args.ph_hi;
#ifdef STOP_PH
#define IN(k) (lo <= (k) && (k) < hi && ((k) < STOP_PH || (k) == PH_FINAL))
#else
#define IN(k) (lo <= (k) && (k) < hi)
#endif
#ifndef DUP_PH
#define DUP_PH -1
#endif
#define NREP(b) ((DUP_PH == (b)) ? 2 : 1)
#define SEAM(k) do { if (lo <= (k) + 1 && (k) + 1 < hi) xcd_barrier(bar); } while (0)

#ifndef PHM
#define PHM 0xFFFF
#endif
#define PHON(b) ((PHM >> (b)) & 1)
    if (PHON(0) && IN(0)) { for (int rep = 0; rep < NREP(0); ++rep) { LAUNDER(F); prologue_phase(F); SEAM(0); } }

#pragma unroll 1
    for (int l = 0; l < NLAYERS_RUN; ++l) {
        const int pb = 1 + l * PH_PER_LAYER;
        const bool lastl = (l == DEPTH - 1);
        if (PHON(1) && IN(pb + 0)) { LAUNDER(F); norm1_phase(F, l); SEAM(pb + 0); }
        if (PHON(2) && IN(pb + 1)) for (int rep = 0; rep < NREP(2); ++rep) { LAUNDER(F);
            { InProjProb<0> P; P.H = WSP(signed char, WS_H8); P.W = WSP(signed char, WS_WIN) + (size_t)l * IN_DIM * 1024; P.sH = WSP(float, WS_SH); P.sW = WSP(float, WS_SWIN) + (size_t)l * IN_DIM;
              P.FT = WSP(bf16_t, WS_FT); P.FCT = WSP(bf16_t, WS_FCT); P.Q = WSP(bf16_t, WS_Q); P.Kb = WSP(bf16_t, WS_K); P.Vb = WSP(bf16_t, WS_V); P.GF = WSP(bf16_t, WS_GF); P.GA = WSP(bf16_t, WS_GA);
              P.rope = WSP(float, WS_ROPE);
              P.nM = lastl ? 128 : 132; P.n_nat = P.nM * 11; P.n_fx = 256; P.n_fc = lastl ? 0 : 8; P.n_extra = lastl ? 4 : 0; P.G = F.G; P.c = F.bid;
              g8::gemm_run(F.lds, P); }
            { InProjProb<1> P; P.H = WSP(signed char, WS_H8); P.W = WSP(signed char, WS_WIN) + (size_t)l * IN_DIM * 1024; P.sH = WSP(float, WS_SH); P.sW = WSP(float, WS_SWIN) + (size_t)l * IN_DIM;
              P.FT = WSP(bf16_t, WS_FT); P.FCT = WSP(bf16_t, WS_FCT); P.Q = nullptr; P.Kb = nullptr; P.Vb = nullptr; P.GF = nullptr; P.GA = nullptr; P.rope = nullptr;
              P.nM = 0; P.n_nat = 0; P.n_fx = 256; P.n_fc = lastl ? 0 : 8; P.n_extra = 0; P.G = F.G; P.c = (F.bid + 84) % F.G;
              g8::gemm_run(F.lds, P); }
            SEAM(pb + 1);
        }
        if (PHON(3) && IN(pb + 2)) for (int rep = 0; rep < NREP(3); ++rep) { LAUNDER(F);
#ifndef NO_ATTN
            attn_phase(F, l, !lastl);
#endif
#ifndef NO_FFT1
            Fft1Prob P; P.W1 = WSP(bf16_t, WS_W1); P.FT = WSP(bf16_t, WS_FT); P.WC = WSP(bf16_t, WS_WC); P.FCT = WSP(bf16_t, WS_FCT); P.T1 = WSP(bf16_t, WS_T1); P.XS = WSP(bf16_t, WS_XS);
            P.n0 = 512; P.n1 = lastl ? 0 : 16; P.G = F.G; P.c = (F.bid + 128) % F.G;
            g8::gemm_run(F.lds, P);
#endif
            SEAM(pb + 2);
        }
        if (PHON(4) && IN(pb + 3)) for (int rep = 0; rep < NREP(4); ++rep) { LAUNDER(F);
            Fft2Prob P; P.MT = WSP(bf16_t, WS_MT); P.T1 = WSP(bf16_t, WS_T1); P.XS = WSP(bf16_t, WS_XS); P.G = F.G; P.c = F.bid;
            g8::gemm_run(F.lds, P); SEAM(pb + 3);
        }
        if (PHON(5) && IN(pb + 4)) for (int rep = 0; rep < NREP(5); ++rep) { LAUNDER(F);
            { MergeProb<0> P; P.A = WSP(bf16_t, WS_XS); P.W = WSP(bf16_t, WS_WFO) + (size_t)l * 1024 * 1024; P.lda = 1024; P.GATE = WSP(bf16_t, WS_GF); P.YB = WSP(bf16_t, WS_YB);
              P.xin = nullptr; P.cin = nullptr; P.XW = nullptr; P.CW = nullptr; P.g1x = nullptr; P.g1c = nullptr; P.nM = lastl ? 128 : 132; P.G = F.G; P.c = F.bid;
              g8::gemm_run(F.lds, P); }
            { MergeProb<1> P; P.A = WSP(bf16_t, WS_AO); P.W = WSP(bf16_t, WS_WAO) + (size_t)l * 1024 * 512; P.lda = 512; P.GATE = WSP(bf16_t, WS_GA); P.YB = WSP(bf16_t, WS_YB);
              P.xin = nullptr; P.cin = nullptr; P.XW = nullptr; P.CW = nullptr; P.g1x = nullptr; P.g1c = nullptr; P.nM = lastl ? 128 : 132; P.G = F.G; P.c = F.bid;
              g8::gemm_run(F.lds, P); }
            SEAM(pb + 4);
        }
        if (PHON(6) && IN(pb + 5)) { LAUNDER(F);
            MergeProb<2> P; P.A = WSP(bf16_t, WS_YB); P.W = WSP(bf16_t, WS_WOUT) + (size_t)l * 1024 * 1024; P.lda = 1024; P.GATE = nullptr; P.YB = nullptr;
            P.xin = (l == 0) ? INP(0) : WSP(float, WS_XW); P.cin = (l == 0) ? INP(2) : WSP(float, WS_CW); P.XW = WSP(float, WS_XW); P.CW = WSP(float, WS_CW);
            P.g1x = WSP(float, WS_MOD) + (size_t)l * 5 * 6144 + 2 * 1024; P.g1c = WSP(float, WS_MOD) + ((size_t)l * 5 + 4) * 6144 + 2 * 1024; P.nM = lastl ? 128 : 132; P.G = F.G; P.c = F.bid;
            g8::gemm_run(F.lds, P); SEAM(pb + 5);
        }
        if (PHON(7) && IN(pb + 6)) for (int rep = 0; rep < NREP(7); ++rep) { LAUNDER(F); norm2_router_phase(F, l, rep + 1 < NREP(7)); SEAM(pb + 6); }
        if (PHON(8) && IN(pb + 7)) for (int rep = 0; rep < NREP(8); ++rep) { LAUNDER(F);
            MoeGuProb P; P.R = fill_tstart(F, l);
            P.H8 = WSP(signed char, WS_H8); P.W8 = WSP(signed char, WS_WGU) + (size_t)l * 32 * 2048 * 1024; P.sW = WSP(float, WS_SWGU) + (size_t)l * 32 * 2048; P.lsc = WSP(float, WS_LSC);
            P.bgu = INP(16) + (size_t)l * 32 * 2048; P.ACT = WSP(unsigned char, WS_ACT);
            P.list = WSP(int, WS_LIST); P.cnt = (const int*)(F.ws + WS_CTL + CTL_CNT) + l * 32; P.tstart = (const volatile LAS int*)(F.lds + LDS_MISC + 64); P.G = F.G; P.c = F.bid;
            g8::gemm_run(F.lds, P); SEAM(pb + 7);
        }
        if (PHON(9) && IN(pb + 8)) for (int rep = 0; rep < NREP(9); ++rep) { LAUNDER(F);
            MoeDnProb P; P.R = fill_tstart(F, l);
            P.ACT = WSP(unsigned char, WS_ACT); P.W = WSP(unsigned char, WS_WDN) + (size_t)l * 32 * 1024 * 1024; P.bdn = INP(18) + (size_t)l * 32 * 1024; P.YE = WSP(bf16_t, WS_YE);
            P.tstart = (const volatile LAS int*)(F.lds + LDS_MISC + 64); P.G = F.G; P.c = F.bid;
            g8::gemm_run(F.lds, P); SEAM(pb + 8);
        }
    }
#ifdef STOP_PH
    if (IN(PH_FINAL)) { LAUNDER(F);
        const size_t n = (size_t)TX * 1024;
        for (size_t i = (size_t)F.bid * 512 + F.tid; i < n; i += (size_t)F.G * 512) {
            F.out[i] = DUMP_EXPR(i);
        } }
#else
    if (PHON(10) && IN(PH_FINAL)) for (int rep = 0; rep < NREP(10); ++rep) { LAUNDER(F); norm1_phase(F, DEPTH); if (rep + 1 < NREP(10)) xcd_barrier(bar); }
#endif
#undef IN
#undef SEAM
}

extern "C" void kernel_launch(void* const* d_in, const int* in_sizes, int n_in, void* d_out, int out_size, void* d_ws, size_t ws_size, hipStream_t stream) {
    static int grid = 0;
    if (grid == 0) {
        if (n_in != 20 || ws_size < WS_END) { fprintf(stderr, "kernel_launch: bad arguments (n_in %d, ws %zu < %zu)\n", n_in, ws_size, (size_t)WS_END); grid = -1; return; }
        int dev = 0, cus = 0, per_cu = 0;
        if (hipGetDevice(&dev) != hipSuccess || hipDeviceGetAttribute(&cus, hipDeviceAttributeMultiprocessorCount, dev) != hipSuccess) { grid = -1; return; }
        if (hipFuncSetAttribute((const void*)fwd_kernel, hipFuncAttributeMaxDynamicSharedMemorySize, LDS_BYTES) != hipSuccess) { fprintf(stderr, "kernel_launch: hipFuncSetAttribute failed\n"); grid = -1; return; }
        if (hipOccupancyMaxActiveBlocksPerMultiprocessor(&per_cu, (const void*)fwd_kernel, 512, LDS_BYTES) != hipSuccess || per_cu < 1) { fprintf(stderr, "kernel_launch: occupancy query says %d\n", per_cu); }
        (void)hipGetLastError();
        grid = cus;
    }
    if (grid < 0) return;
    (void)hipMemsetAsync((char*)d_ws + WS_CTL, 0, CTL_BYTES, stream);
    Args a{};
    for (int i = 0; i < 20; ++i) a.in[i] = (const float*)d_in[i];
    a.out = (float*)d_out; a.ws = (unsigned char*)d_ws;
#if N_LAUNCH_MODE == 1
    a.ph_lo = 0; a.ph_hi = PH_COUNT;
    hipLaunchKernelGGL(fwd_kernel, dim3(grid), dim3(512), LDS_BYTES, stream, a);
#else
    for (int p = 0; p < PH_COUNT; ++p) { a.ph_lo = p; a.ph_hi = p + 1; hipLaunchKernelGGL(fwd_kernel, dim3(grid), dim3(512), LDS_BYTES, stream, a); }
#endif
    (void)in_sizes; (void)out_size;
}
```

```cpp
#include <hip/hip_runtime.h>
#include <cstdio>
#include <cstdint>

#define LAS __attribute__((address_space(3)))
typedef unsigned short bf16_t;
typedef short bf16x8 __attribute__((ext_vector_type(8)));
typedef short s16x4 __attribute__((ext_vector_type(4)));
typedef float f32x4 __attribute__((ext_vector_type(4)));
typedef float f32x16 __attribute__((ext_vector_type(16)));
typedef unsigned u32x4 __attribute__((ext_vector_type(4)));
typedef unsigned u32x2 __attribute__((ext_vector_type(2)));
typedef int i32x4 __attribute__((ext_vector_type(4)));
typedef int i32x8 __attribute__((ext_vector_type(8)));

#ifndef N_LAUNCH_MODE
#define N_LAUNCH_MODE 1
#endif
#ifndef DBG_CHECK
#define DBG_CHECK 0
#endif
#ifndef EMU8
#define EMU8 false
#endif
#ifndef NLAYERS_RUN
#define NLAYERS_RUN 4
#endif

constexpr int D = 1024, NB = 4, SEQ = 8192, TX = NB * SEQ, LC = 256, TC = NB * LC, TT = TX + TC, DEPTH = 4;
constexpr int IN_DIM = 3328, NEXP = 32;
constexpr int ROWS_MAX = TT * 4 + NEXP * 256;
constexpr float LOG2E = 1.4426950408889634f;
constexpr float QSCALE = 0.125f * LOG2E;
constexpr float EPS = 1e-5f;

constexpr size_t al256(size_t x) { return (x + 255) & ~(size_t)255; }
constexpr size_t WS_CTL = 0;
constexpr size_t CTL_BYTES = 65536;
constexpr size_t CTL_CNT = 16384;
constexpr size_t WS_MOD = WS_CTL + CTL_BYTES;
constexpr size_t WS_ROPE = WS_MOD + al256((size_t)DEPTH * 5 * 6144 * 4);
constexpr size_t WS_W1 = WS_ROPE + 16384;
constexpr size_t WS_MT = WS_W1 + 256 * 128 * 2;
constexpr size_t WS_WC = WS_MT + (size_t)64 * 256 * 128 * 2;
constexpr size_t WS_RWT = WS_WC + 512 * 256 * 2;
constexpr size_t WS_WIN = WS_RWT + (size_t)DEPTH * 32 * 1024 * 2;
constexpr size_t WS_SWIN = WS_WIN + (size_t)DEPTH * IN_DIM * 1024;
constexpr size_t WS_WFO = WS_SWIN + al256((size_t)DEPTH * IN_DIM * 4);
constexpr size_t WS_WAO = WS_WFO + (size_t)DEPTH * 1024 * 1024 * 2;
constexpr size_t WS_WOUT = WS_WAO + (size_t)DEPTH * 1024 * 512 * 2;
constexpr size_t WS_WGU = WS_WOUT + (size_t)DEPTH * 1024 * 1024 * 2;
constexpr size_t WS_SWGU = WS_WGU + (size_t)DEPTH * 32 * 2048 * 1024;
constexpr size_t WS_WDN = WS_SWGU + (size_t)DEPTH * 32 * 2048 * 4;
constexpr size_t WS_H = WS_WDN + (size_t)DEPTH * 32 * 1024 * 1024 * 2;
constexpr size_t WS_FT = WS_H + (size_t)(TT + 256) * 1024 * 2;
constexpr size_t WS_FCT = WS_FT + (size_t)131072 * 128 * 2;
constexpr size_t WS_Q = WS_FCT + (size_t)2048 * 256 * 2;
constexpr size_t WS_K = WS_Q + (size_t)TT * 512 * 2;
constexpr size_t WS_V = WS_K + (size_t)TT * 128 * 2;
constexpr size_t WS_GF = WS_V + (size_t)TT * 128 * 2;
constexpr size_t WS_GA = WS_GF + (size_t)TT * 1024 * 2;
constexpr size_t WS_T1 = WS_GA + (size_t)TT * 1024 * 2;
constexpr size_t WS_XS = WS_T1 + (size_t)64 * 2048 * 128 * 2;
constexpr size_t WS_AO = WS_XS + (size_t)TT * 1024 * 2;
constexpr size_t WS_YB = WS_AO + (size_t)TT * 512 * 2;
constexpr size_t WS_XW = WS_YB + (size_t)TT * 1024 * 2;
constexpr size_t WS_CW = WS_XW + (size_t)TX * 1024 * 4;
constexpr size_t WS_ACT = WS_CW + (size_t)TC * 1024 * 4;
constexpr size_t WS_YE = WS_ACT + (size_t)ROWS_MAX * 1024 * 2;
constexpr size_t WS_LIST = WS_YE + (size_t)ROWS_MAX * 1024 * 2;
constexpr size_t WS_SLOT = WS_LIST + (size_t)32 * TT * 4;
constexpr size_t WS_GATE = WS_SLOT + (size_t)TT * 4 * 4;
constexpr size_t WS_H8 = WS_GATE + (size_t)TT * 4 * 4;
constexpr size_t WS_LSC = WS_H8 + (size_t)(TT + 256) * 1024;
constexpr size_t WS_SH = WS_LSC + (size_t)32 * TT * 4;
constexpr size_t WS_END = WS_SH + (size_t)(TT + 256) * 4;

constexpr int LDS_STAGE = 131072;
constexpr int LDS_MISC = LDS_STAGE;
constexpr int LDS_ROPE = LDS_MISC + 4096;
constexpr int LDS_BYTES = 163840;

typedef __bf16 bf16v2_t __attribute__((ext_vector_type(2)));
typedef float f32x2_t __attribute__((ext_vector_type(2)));
__device__ __forceinline__ unsigned cvt_pk_bf16(float lo, float hi) { const f32x2_t v = {lo, hi}; const bf16v2_t b = __builtin_convertvector(v, bf16v2_t); return __builtin_bit_cast(unsigned, b); }
__device__ __forceinline__ float q8(float x) { const int p = __builtin_amdgcn_cvt_pk_fp8_f32(x, 0.f, 0, false); return __builtin_amdgcn_cvt_f32_fp8(p, 0); }
__device__ __forceinline__ unsigned pk4_fp8(float a, float b, float c, float d) { int p = __builtin_amdgcn_cvt_pk_fp8_f32(a, b, 0, false); p = __builtin_amdgcn_cvt_pk_fp8_f32(c, d, p, true); return (unsigned)p; }
__device__ __forceinline__ bf16_t f2bf(float f) { return (bf16_t)(cvt_pk_bf16(f, 0.f) & 0xffffu); }
__device__ __forceinline__ float bf_lo(unsigned u) { return __uint_as_float(u << 16); }
__device__ __forceinline__ float bf_hi(unsigned u) { return __uint_as_float(u & 0xffff0000u); }
__device__ __forceinline__ float bf2f(bf16_t b) { return __uint_as_float(((unsigned)b) << 16); }
__device__ __forceinline__ float sigmoidf_(float x) { return __builtin_amdgcn_rcpf(1.0f + __builtin_amdgcn_exp2f(-x * LOG2E)); }
__device__ __forceinline__ float wave_sum(float v) {
#pragma unroll
    for (int o = 32; o >= 1; o >>= 1) v += __shfl_xor(v, o);
    return v;
}

#define XB_TMO      128
#define XB_XCNT(j)  (256  + 64 * (j))
#define XB_XSUB(j)  (1280 + 64 * (j))
#define XB_XGEN(j)  (2304 + 64 * (j))
#define XB_TOP      3328
#define XB_TOPGEN   3392
#define XCD_BAR_WORDS 3456
#define XB_SPIN_CAP (1u << 22)

__device__ __forceinline__ unsigned xb_ld(unsigned* p)              { return __hip_atomic_load(p, __ATOMIC_RELAXED, __HIP_MEMORY_SCOPE_AGENT); }
__device__ __forceinline__ unsigned xb_add(unsigned* p, unsigned v) { return __hip_atomic_fetch_add(p, v, __ATOMIC_RELAXED, __HIP_MEMORY_SCOPE_AGENT); }
__device__ __forceinline__ unsigned xb_xcc_id() { return (unsigned)__builtin_amdgcn_s_getreg((3 << 11) | 20) & 0xFu; }
#define XB_SPIN(cond, bar) do { unsigned _sp = 0; while (cond) { __builtin_amdgcn_s_sleep(1); \
    if ((++_sp & 255u) == 0u) { if (xb_ld(&(bar)[XB_TMO])) break; if (_sp > XB_SPIN_CAP) { atomicAdd(&(bar)[XB_TMO], 1u); break; } } } } while (0)

struct XcdBarrier { unsigned* bar; unsigned x; volatile LAS unsigned* st; };

__device__ __forceinline__ XcdBarrier xcd_barrier_post(unsigned* bar, volatile LAS unsigned* st) {
    XcdBarrier b; b.bar = bar; b.x = xb_xcc_id(); b.st = st;
    if (threadIdx.x == 0) (void)xb_add(&bar[XB_XCNT(b.x)], 1u);
    return b;
}
__device__ __forceinline__ void xcd_barrier_complete(unsigned* bar, unsigned x, unsigned& nloc, unsigned& nx) {
    const unsigned G = gridDim.x * gridDim.y * gridDim.z;
    unsigned sum, cnt, mine, sp = 0u;
    for (;;) {
        sum = 0u; cnt = 0u; mine = 0u;
#pragma unroll
        for (unsigned j = 0; j < 16; ++j) { const unsigned c = xb_ld(&bar[XB_XCNT(j)]); sum += c; cnt += (c > 0u) ? 1u : 0u; mine = (j == x) ? c : mine; }
        if (sum == G) break;
        __builtin_amdgcn_s_sleep(1);
        if ((++sp & 255u) == 0u) { if (xb_ld(&bar[XB_TMO])) break; if (sp > XB_SPIN_CAP) { atomicAdd(&bar[XB_TMO], 1u); break; } }
    }
    nloc = mine > 0u ? mine : 1u; nx = cnt > 0u ? cnt : 1u;
}
__device__ __forceinline__ void xcd_barrier(const XcdBarrier& b) {
    asm volatile("s_waitcnt vmcnt(0)" ::: "memory");
    __syncthreads();
    if (threadIdx.x == 0) {
        unsigned* bar = b.bar;
        __builtin_amdgcn_s_waitcnt(0);
        unsigned nloc = b.st[0], nx = b.st[1];
        if (nloc == 0u) { xcd_barrier_complete(bar, b.x, nloc, nx); b.st[0] = nloc; b.st[1] = nx; }
        const unsigned old = xb_add(&bar[XB_XSUB(b.x)], 1u);
        const unsigned gen = old / nloc;
        if (old + 1u == (gen + 1u) * nloc) {
            __builtin_amdgcn_fence(__ATOMIC_RELEASE, "agent");
            asm volatile("s_waitcnt vmcnt(0)" ::: "memory");
            const unsigned og = xb_add(&bar[XB_TOP], 1u);
            const unsigned tg = og / nx;
            if (og + 1u == (tg + 1u) * nx) xb_add(&bar[XB_TOPGEN], 1u);
            else XB_SPIN(xb_ld(&bar[XB_TOPGEN]) == tg, bar);
            __builtin_amdgcn_fence(__ATOMIC_ACQUIRE, "agent");
            xb_add(&bar[XB_XGEN(b.x)], 1u);
            asm volatile("s_waitcnt vmcnt(0)" ::: "memory");
        } else {
            XB_SPIN(xb_ld(&bar[XB_XGEN(b.x)]) == gen, bar);
            __builtin_amdgcn_fence(__ATOMIC_ACQUIRE, "agent");
            asm volatile("s_waitcnt vmcnt(0)" ::: "memory");
        }
    }
    __syncthreads();
}

struct Fr {
    LAS unsigned char* lds;
    unsigned char* ws;
    float* out;
    int tid, lane, wave, G, bid;
};
__device__ __forceinline__ const float* in_ptr(const Fr& F, int i) {
    volatile LAS unsigned* p = (volatile LAS unsigned*)(F.lds + 131072 + 512) + 2 * i;
    const unsigned lo = __builtin_amdgcn_readfirstlane(p[0]), hi = __builtin_amdgcn_readfirstlane(p[1]);
    return (const float*)(((unsigned long long)hi << 32) | lo);
}
#define INP(i) in_ptr(F, (i))
#define LAUNDER(F) do { unsigned char* _w = (F).ws; asm volatile("" : "+s"(_w)); (F).ws = _w; int _t = threadIdx.x; asm volatile("" : "+v"(_t)); (F).tid = _t; (F).lane = _t & 63; (F).wave = __builtin_amdgcn_readfirstlane(_t >> 6); } while (0)
#define WSP(T, off) ((T*)(F.ws + (off)))

namespace g8 {
constexpr int BM = 256, BK = 64, HALF = 128, HTB = HALF * BK * 2, NXCD = 8, WGM = 8;
__device__ __forceinline__ int lds_byte(int r, int c) { const int st = (r >> 4) * 2 + (c >> 5), rr = r & 15, cc = c & 31, ob = rr * 64 + cc * 2; return st * 1024 + (ob ^ (((ob >> 9) & 1) << 5)); }
__device__ __forceinline__ void stage_rc(int b, int& R, int& C) { const int st = b / 1024, sb = b % 1024, swz = sb ^ (((sb >> 9) & 1) << 5); R = (st >> 1) * 16 + swz / 64; C = (st & 1) * 32 + (swz % 64) / 2; }
__device__ __forceinline__ int perm32(int rho) { const int n = rho >> 4, i = rho & 15; return 8 * (i >> 2) + 4 * n + (i & 3); }
__device__ __forceinline__ void order2d(int L, int nM, int nN, int& pm, int& pn) {
    const int nwg = nM * nN;
    int wgid = L; { const int q = nwg / NXCD, r = nwg % NXCD, xcd = wgid % NXCD, off = wgid / NXCD; wgid = (xcd < r ? xcd * (q + 1) : r * (q + 1) + (xcd - r) * q) + off; }
    const int nig = WGM * nN, gid = wgid / nig, fm = gid * WGM, gsz = (nM - fm) < WGM ? (nM - fm) : WGM;
    pm = fm + ((wgid % nig) % gsz); pn = (wgid % nig) / gsz;
}
__device__ __forceinline__ void lane_geom(int tid, int& R0, int& Rb0, int& C0) { asm volatile("" : "+v"(tid)); stage_rc(tid * 16, R0, C0); Rb0 = (R0 & ~31) + perm32(R0 & 31); }

#define G8_ROWS(ai, m) (128 * (ai) + 64 * wr + 16 * (m) + fr)
#define G8_COL0(bj) (128 * (bj) + 32 * wc + 8 * fq)

template <bool I8> __device__ __forceinline__ f32x4 mma1(const bf16x8& b, const bf16x8& a, const f32x4& c) { return __builtin_amdgcn_mfma_f32_16x16x32_bf16(b, a, c, 0, 0, 0); }
template <bool I8> __device__ __forceinline__ i32x4 mma1(const bf16x8& b, const bf16x8& a, const i32x4& c) { return __builtin_amdgcn_mfma_i32_16x16x64_i8(__builtin_bit_cast(i32x4, b), __builtin_bit_cast(i32x4, a), c, 0, 0, 0); }
__device__ __forceinline__ f32x4 mma8(const bf16x8& b0, const bf16x8& b1, const bf16x8& a0, const bf16x8& a1, const f32x4& c) {
    const i32x4 B0 = __builtin_bit_cast(i32x4, b0), B1 = __builtin_bit_cast(i32x4, b1), A0 = __builtin_bit_cast(i32x4, a0), A1 = __builtin_bit_cast(i32x4, a1);
    const i32x8 B = {B0[0], B0[1], B0[2], B0[3], B1[0], B1[1], B1[2], B1[3]}, A = {A0[0], A0[1], A0[2], A0[3], A1[0], A1[1], A1[2], A1[3]};
    return __builtin_amdgcn_mfma_scale_f32_16x16x128_f8f6f4(B, A, c, 0, 0, 0, 0x7F7F7F7F, 0, 0x7F7F7F7F);
}
template <class P>
__device__ __forceinline__ void gemm_run(LAS unsigned char* lds, P& prob) {
    int tid = threadIdx.x; asm volatile("" : "+v"(tid));
    const int wid = __builtin_amdgcn_readfirstlane(tid >> 6), lane = tid & 63, wr = wid >> 2, wc = wid & 3, fr = lane & 15, fq = lane >> 4;
    const size_t kstep = (size_t)(BK * 2);
    const unsigned ldsw = (unsigned)wid * 1024u;
    const int aoff = lds_byte(wr * 64 + fr, fq * 8), boff = lds_byte(wc * 32 + fr, fq * 8);
#define G8_SA(b, h) (((b) * 2 + (h)) * HTB)
#define G8_SB(b, h) ((4 + (b) * 2 + (h)) * HTB)
#define G8_STAGE_(bufoff, g0, o0, g1, o1) do { \
        __builtin_amdgcn_global_load_lds((const unsigned*)((const char*)(g0) + (o0)), (LAS unsigned*)(lds + (bufoff) + ldsw), 16, 0, 0); \
        __builtin_amdgcn_global_load_lds((const unsigned*)((const char*)(g1) + (o1)), (LAS unsigned*)(lds + (bufoff) + ldsw + 8192), 16, 0, 0); } while (0)
#define G8_OA(j) (P::GATHER_A ? oa[j] : oa[0])
#define G8_STA(bufoff, gbase, h) G8_STAGE_(bufoff, (gbase) + dA[2 * (h)], G8_OA(2 * (h)), (gbase) + dA[2 * (h) + 1], G8_OA(2 * (h) + 1))
#define G8_STB(bufoff, gbase, h) G8_STAGE_(bufoff, (gbase) + dB[2 * (h)], ob, (gbase) + dB[2 * (h) + 1], ob)
#define G8_LDA(dst, b, h) do { _Pragma("unroll") for (int m = 0; m < 4; ++m) _Pragma("unroll") for (int k = 0; k < 2; ++k) dst[m][k] = *(const LAS bf16x8*)(lds + G8_SA(b, h) + aoff + m * 2048 + k * 1024); } while (0)
#define G8_LDB(dst, b, h) do { _Pragma("unroll") for (int n = 0; n < 2; ++n) _Pragma("unroll") for (int k = 0; k < 2; ++k) dst[n][k] = *(const LAS bf16x8*)(lds + G8_SB(b, h) + boff + n * 2048 + k * 1024); } while (0)
#define G8_MMA(ai, bj, At, Bt) do { __builtin_amdgcn_s_setprio(1); \
        if constexpr (P::F8) { _Pragma("unroll") for (int m = 0; m < 4; ++m) _Pragma("unroll") for (int n = 0; n < 2; ++n) acc[ai][bj][m][n] = mma8(Bt[n][0], Bt[n][1], At[m][0], At[m][1], acc[ai][bj][m][n]); } \
        else { _Pragma("unroll") for (int m = 0; m < 4; ++m) _Pragma("unroll") for (int n = 0; n < 2; ++n) _Pragma("unroll") for (int k = 0; k < 2; ++k) \
        acc[ai][bj][m][n] = mma1<P::I8>(Bt[n][k], At[m][k], acc[ai][bj][m][n]); } __builtin_amdgcn_s_setprio(0); } while (0)
#define G8_WAIT_V(n) asm volatile("s_waitcnt vmcnt(" #n ")" ::: "memory")
#define G8_WAIT_L(n) asm volatile("s_waitcnt lgkmcnt(" #n ")" ::: "memory")
#define G8_BAR __builtin_amdgcn_s_barrier()
#define G8_SCHED __builtin_amdgcn_sched_barrier(0)
    typename P::U cur, nxt; int ui = 0;
    if (!prob.get(0, cur)) return;
    typedef typename P::Acc Acc;
    Acc acc[2][2][4][2];
#pragma unroll
    for (int a = 0; a < 2; ++a)
#pragma unroll
        for (int b = 0; b < 2; ++b)
#pragma unroll
            for (int m = 0; m < 4; ++m)
#pragma unroll
                for (int n = 0; n < 2; ++n) acc[a][b][m][n] = (Acc){0, 0, 0, 0};
    bf16x8 At[4][2], B0[2][2], B1[2][2];
    unsigned oa[4], ob, dA[4], dB[4]; const char* cA; const char* cB; int nt;
    prob.setup(cur, oa, ob, dA, dB, cA, cB, nt);
    G8_STB(G8_SB(0, 0), cB, 0); G8_STA(G8_SA(0, 0), cA, 0); G8_STB(G8_SB(0, 1), cB, 1); G8_STA(G8_SA(0, 1), cA, 1);
    if (wr == 1) G8_BAR;
    G8_WAIT_V(4); G8_BAR;
    G8_STB(G8_SB(1, 0), cB + kstep, 0); G8_STA(G8_SA(1, 0), cA + kstep, 0); G8_STB(G8_SB(1, 1), cB + kstep, 1);
    G8_WAIT_V(6); G8_BAR;
    for (;;) {
        const bool has_next = prob.get(ui + 1, nxt);
        int nnt = nt;
        for (int t = 0; t < nt; t += 2) {
            const bool last = (t == nt - 2);
            G8_LDB(B0, 0, 0); G8_SCHED; G8_LDA(At, 0, 0); G8_STA(G8_SA(1, 1), cA + (size_t)(t + 1) * kstep, 1);
            G8_WAIT_L(8); G8_BAR; G8_WAIT_L(0); G8_MMA(0, 0, At, B0); G8_BAR; G8_SCHED;
            const char* a2; const char* b2;
            if (last) { if (has_next) { prob.setup(nxt, oa, ob, dA, dB, cA, cB, nnt); } a2 = cA; b2 = cB; }
            else { a2 = cA + (size_t)(t + 2) * kstep; b2 = cB + (size_t)(t + 2) * kstep; }
            const char* a3 = a2 + kstep; const char* b3 = b2 + kstep;
            G8_LDB(B1, 0, 1); G8_STB(G8_SB(0, 0), b2, 0);
            G8_BAR; G8_WAIT_L(0); G8_MMA(0, 1, At, B1); G8_BAR;
            G8_LDA(At, 0, 1); G8_STA(G8_SA(0, 0), a2, 0);
            G8_BAR; G8_WAIT_L(0); G8_MMA(1, 0, At, B0); G8_BAR; G8_SCHED;
            G8_STB(G8_SB(0, 1), b2, 1);
            G8_WAIT_V(6); G8_BAR; G8_MMA(1, 1, At, B1); G8_BAR;
            G8_LDB(B0, 1, 0); G8_SCHED; G8_LDA(At, 1, 0); G8_STA(G8_SA(0, 1), a2, 1);
            G8_WAIT_L(8); G8_BAR; G8_WAIT_L(0); G8_MMA(0, 0, At, B0); G8_BAR; G8_SCHED;
            G8_LDB(B1, 1, 1); G8_STB(G8_SB(1, 0), b3, 0);
            G8_BAR; G8_WAIT_L(0); G8_MMA(0, 1, At, B1); G8_BAR;
            G8_LDA(At, 1, 1); G8_STA(G8_SA(1, 0), a3, 0);
            G8_BAR; G8_WAIT_L(0); G8_MMA(1, 0, At, B0); G8_BAR; G8_SCHED;
            G8_STB(G8_SB(1, 1), b3, 1);
            G8_WAIT_V(6); G8_BAR; G8_MMA(1, 1, At, B1); G8_BAR;
            if (last) break;
        }
        { int t2 = threadIdx.x; asm volatile("" : "+v"(t2)); const int l2 = t2 & 63; prob.epi(acc, cur, wr, wc, l2 & 15, l2 >> 4); }
        if (!has_next) break;
#pragma unroll
        for (int a = 0; a < 2; ++a)
#pragma unroll
            for (int b = 0; b < 2; ++b)
#pragma unroll
                for (int m = 0; m < 4; ++m)
#pragma unroll
                    for (int n = 0; n < 2; ++n) acc[a][b][m][n] = (Acc){0, 0, 0, 0};
        cur = nxt; nt = nnt; ++ui;
    }
    G8_WAIT_V(0);
    if (wr == 0) G8_BAR;
    G8_BAR;
}
}

__device__ __forceinline__ u32x4 pack8(const f32x4& v0, const f32x4& v1) {
    u32x4 w; w.x = cvt_pk_bf16(v0[0], v0[1]); w.y = cvt_pk_bf16(v0[2], v0[3]); w.z = cvt_pk_bf16(v1[0], v1[1]); w.w = cvt_pk_bf16(v1[2], v1[3]); return w;
}
__device__ __forceinline__ void unpack8(const u32x4& w, f32x4& v0, f32x4& v1) {
    v0 = (f32x4){bf_lo(w.x), bf_hi(w.x), bf_lo(w.y), bf_hi(w.y)}; v1 = (f32x4){bf_lo(w.z), bf_hi(w.z), bf_lo(w.w), bf_hi(w.w)};
}

template <int WHICH> struct InProjProb {
    static constexpr bool PERM = true, GATHER_A = false, I8 = true, F8 = false; typedef i32x4 Acc;
    struct U { int kind, pm, pn, b, j; };
    const signed char* H; const signed char* W; const float* sH; const float* sW;
    bf16_t *FT, *FCT, *Q, *Kb, *Vb, *GF, *GA; const LAS float* rope;
    int nM, n_nat, n_fx, n_fc, n_extra, G, c;
    __device__ __forceinline__ bool get(int i, U& u) const {
        const int L = i * G + c;
        if (WHICH == 0) {
            if (L >= n_nat + n_extra) return false;
            const bool nat = L < n_nat;
            int pm, pn; g8::order2d(nat ? L : 0, nM, 11, pm, pn);
            u.kind = 2; u.pm = __builtin_amdgcn_readfirstlane(nat ? pm : (128 + L - n_nat)); u.pn = __builtin_amdgcn_readfirstlane(nat ? (pn + 2) : 4); u.b = 0; u.j = 0;
            return true;
        } else {
            if (L >= n_fx + n_fc) return false;
            const bool fx = L < n_fx; const int L2 = L - n_fx;
            u.kind = __builtin_amdgcn_readfirstlane(fx ? 0 : 1); u.b = __builtin_amdgcn_readfirstlane(fx ? (L >> 6) : (L2 >> 1)); u.j = __builtin_amdgcn_readfirstlane(fx ? ((L & 63) >> 1) : 0); u.pn = __builtin_amdgcn_readfirstlane(fx ? (L & 1) : (L2 & 1)); u.pm = 0;
            return true;
        }
    }
    __device__ __forceinline__ void setup(const U& u, unsigned (&oa)[4], unsigned& ob, unsigned (&dA)[4], unsigned (&dB)[4], const char*& pA, const char*& pB, int& nt) const {
        int R0, Rb0, C0; g8::lane_geom(threadIdx.x, R0, Rb0, C0);
        nt = 8;
#pragma unroll
        for (int j = 0; j < 4; ++j) { dA[j] = (unsigned)(64 * j * 1024); dB[j] = dA[j]; }
        if (WHICH == 0) {
            pA = (const char*)H; pB = (const char*)W;
            oa[0] = (unsigned)((256 * u.pm + R0) * 1024 + C0 * 2); ob = (unsigned)((256 * u.pn + Rb0) * 1024 + C0 * 2);
        } else {
            pA = (const char*)W; pB = (const char*)H;
            oa[0] = (unsigned)((256 * u.pn + R0) * 1024 + C0 * 2);
            if (u.kind == 0) { ob = (unsigned)((u.b * SEQ + 64 * Rb0 + 2 * u.j) * 1024 + C0 * 2);
                dB[1] = (unsigned)(64 * 64 * 1024); dB[2] = 1024u; dB[3] = dB[1] + 1024u; }
            else ob = (unsigned)((TX + u.b * LC + Rb0) * 1024 + C0 * 2);
        }
    }
    __device__ __forceinline__ void epi(const i32x4 (&acc)[2][2][4][2], const U& u, int wr, int wc, int fr, int fq) const {
        if (WHICH == 0) {
            f32x4 sw[2][2];
#pragma unroll
            for (int bj = 0; bj < 2; ++bj) { const float* sp = sW + 256 * u.pn + G8_COL0(bj); sw[bj][0] = *(const f32x4*)sp; sw[bj][1] = *(const f32x4*)(sp + 4); }
            float rsv[2][4];
#pragma unroll
            for (int ai = 0; ai < 2; ++ai)
#pragma unroll
                for (int m = 0; m < 4; ++m) rsv[ai][m] = sH[256 * u.pm + G8_ROWS(ai, m)];
            if (u.pn >= 5) {
                bf16_t* dst = (u.pn >= 9) ? GA : GF; const int cb = 256 * ((u.pn >= 9) ? u.pn - 9 : u.pn - 5);
#pragma unroll
                for (int ai = 0; ai < 2; ++ai)
#pragma unroll
                    for (int m = 0; m < 4; ++m) { const size_t tok = (size_t)256 * u.pm + G8_ROWS(ai, m); const float rs = rsv[ai][m];
#pragma unroll
                        for (int bj = 0; bj < 2; ++bj) { f32x4 v0, v1;
#pragma unroll
                            for (int e = 0; e < 4; ++e) { v0[e] = sigmoidf_((float)acc[ai][bj][m][0][e] * rs * sw[bj][0][e]); v1[e] = sigmoidf_((float)acc[ai][bj][m][1][e] * rs * sw[bj][1][e]); }
                            *(u32x4*)(dst + tok * 1024 + cb + G8_COL0(bj)) = pack8(v0, v1); } }
            } else {
#pragma unroll
                for (int ai = 0; ai < 2; ++ai)
#pragma unroll
                    for (int m = 0; m < 4; ++m) { const int tok = 256 * u.pm + G8_ROWS(ai, m); const float rs = rsv[ai][m];
                        const bool isx = tok < TX; const int n = tok & (SEQ - 1); const int prow = n >> 6, pcol = n & 63;
#pragma unroll
                        for (int bj = 0; bj < 2; ++bj) { f32x4 v0, v1;
#pragma unroll
                            for (int e = 0; e < 4; ++e) { v0[e] = (float)acc[ai][bj][m][0][e] * rs * sw[bj][0][e]; v1[e] = (float)acc[ai][bj][m][1][e] * rs * sw[bj][1][e]; }
                            const int c0 = G8_COL0(bj);
                            const bool isv = (u.pn == 4) && (bj == 1);
                            if (!isv) {
                                const int dp = c0 & 63; const int axis = dp >> 5, f0 = (dp & 31) >> 1;
                                if (isx) {
                                    const int pos = axis ? pcol : prow;
                                    const f32x4 cs = *(const LAS f32x4*)(rope + pos * 16 + f0), sn = *(const LAS f32x4*)(rope + 2048 + pos * 16 + f0);
                                    f32x4 r0, r1;
                                    r0[0] = v0[0] * cs[0] - v0[1] * sn[0]; r0[1] = v0[1] * cs[0] + v0[0] * sn[0];
                                    r0[2] = v0[2] * cs[1] - v0[3] * sn[1]; r0[3] = v0[3] * cs[1] + v0[2] * sn[1];
                                    r1[0] = v1[0] * cs[2] - v1[1] * sn[2]; r1[1] = v1[1] * cs[2] + v1[0] * sn[2];
                                    r1[2] = v1[2] * cs[3] - v1[3] * sn[3]; r1[3] = v1[3] * cs[3] + v1[2] * sn[3];
                                    v0 = r0; v1 = r1;
                                }
                            }
                            if (u.pn < 4) { v0 *= QSCALE; v1 *= QSCALE; *(u32x4*)(Q + (size_t)tok * 512 + 256 * (u.pn - 2) + c0) = pack8(v0, v1); }
                            else if (!isv) { *(u32x4*)(Kb + (size_t)tok * 128 + c0) = pack8(v0, v1); }
                            else { *(u32x4*)(Vb + (size_t)tok * 128 + (c0 - 128)) = pack8(v0, v1); }
                        } }
            }
        } else {
            f32x4 st[2][2];
#pragma unroll
            for (int bj = 0; bj < 2; ++bj) { const int c0 = G8_COL0(bj);
                if (u.kind == 0) { const float* tp = sH + (size_t)u.b * SEQ + 64 * (c0 & 127) + 2 * u.j + (c0 >> 7);
#pragma unroll
                    for (int e = 0; e < 4; ++e) { st[bj][0][e] = tp[64 * e]; st[bj][1][e] = tp[64 * (4 + e)]; } }
                else { const float* tp = sH + TX + u.b * LC + c0; st[bj][0] = *(const f32x4*)tp; st[bj][1] = *(const f32x4*)(tp + 4); } }
            float rsw[2][4];
#pragma unroll
            for (int ai = 0; ai < 2; ++ai)
#pragma unroll
                for (int m = 0; m < 4; ++m) rsw[ai][m] = sW[256 * u.pn + G8_ROWS(ai, m)];
#pragma unroll
            for (int ai = 0; ai < 2; ++ai)
#pragma unroll
                for (int m = 0; m < 4; ++m) { const int ch = 256 * u.pn + G8_ROWS(ai, m); const float rs = rsw[ai][m];
#pragma unroll
                    for (int bj = 0; bj < 2; ++bj) { const int c0 = G8_COL0(bj); f32x4 v0, v1;
#pragma unroll
                        for (int e = 0; e < 4; ++e) { v0[e] = (float)acc[ai][bj][m][0][e] * rs * st[bj][0][e]; v1[e] = (float)acc[ai][bj][m][1][e] * rs * st[bj][1][e]; }
                        const u32x4 w = pack8(v0, v1);
                        if (u.kind == 0) { const int n2 = 2 * u.j + (c0 >> 7), n1 = c0 & 127; *(u32x4*)(FT + ((size_t)(u.b * 512 + ch) * 64 + n2) * 128 + n1) = w; }
                        else *(u32x4*)(FCT + (size_t)(u.b * 512 + ch) * 256 + c0) = w;
                    } }
        }
    }
};

struct Fft1Prob {
    static constexpr bool PERM = true, GATHER_A = false, I8 = false, F8 = false; typedef f32x4 Acc;
    struct U { int kind, pm, pn; };
    const bf16_t *W1, *FT, *WC, *FCT; bf16_t *T1, *XS;
    int n0, n1, G, c;
    __device__ __forceinline__ bool get(int i, U& u) const {
        const int L = i * G + c;
        if (L >= n0 + n1) return false;
        const bool k0 = L < n0; const int L2 = L - n0;
        u.kind = __builtin_amdgcn_readfirstlane(k0 ? 0 : 1); u.pm = __builtin_amdgcn_readfirstlane(k0 ? 0 : (L2 & 1)); u.pn = __builtin_amdgcn_readfirstlane(k0 ? L : (L2 >> 1));
        return true;
    }
    __device__ __forceinline__ void setup(const U& u, unsigned (&oa)[4], unsigned& ob, unsigned (&dA)[4], unsigned (&dB)[4], const char*& pA, const char*& pB, int& nt) const {
        int R0, Rb0, C0; g8::lane_geom(threadIdx.x, R0, Rb0, C0);
        if (u.kind == 0) { nt = 2; pA = (const char*)W1; pB = (const char*)FT;
#pragma unroll
            for (int j = 0; j < 4; ++j) { dA[j] = (unsigned)(64 * j * 128) * 2u; dB[j] = dA[j]; }
            oa[0] = (unsigned)(R0 * 128 + C0) * 2u; ob = (unsigned)((256 * u.pn + Rb0) * 128 + C0) * 2u;
        } else { nt = 4; pA = (const char*)WC; pB = (const char*)FCT;
#pragma unroll
            for (int j = 0; j < 4; ++j) { dA[j] = (unsigned)(64 * j * 256) * 2u; dB[j] = dA[j]; }
            oa[0] = (unsigned)((256 * u.pm + R0) * 256 + C0) * 2u; ob = (unsigned)((256 * u.pn + Rb0) * 256 + C0) * 2u;
        }
    }
    __device__ __forceinline__ void epi(const f32x4 (&acc)[2][2][4][2], const U& u, int wr, int wc, int fr, int fq) const {
        if (u.kind == 0) {
#pragma unroll
            for (int m = 0; m < 4; ++m) { const int r = G8_ROWS(0, m); const int k1p = r >> 1, part = r & 1;
#pragma unroll
                for (int bj = 0; bj < 2; ++bj) { const int col = 256 * u.pn + G8_COL0(bj); const int bc = col >> 6, n2 = col & 63;
                    *(u32x4*)(T1 + (((size_t)k1p * 2048 + bc) * 2 + part) * 64 + n2) = pack8(acc[0][bj][m][0], acc[0][bj][m][1]); } }
        } else {
#pragma unroll
            for (int ai = 0; ai < 2; ++ai)
#pragma unroll
                for (int m = 0; m < 4; ++m) { const int r = 256 * u.pm + G8_ROWS(ai, m); const int k = r >> 1, reim = r & 1;
#pragma unroll
                    for (int bj = 0; bj < 2; ++bj) { const int bc = 256 * u.pn + G8_COL0(bj); const int b = bc >> 9, ch = bc & 511, g = ch >> 7, d = ch & 127;
                        *(u32x4*)(XS + (size_t)(TX + b * LC + k) * 1024 + g * 256 + reim * 128 + d) = pack8(acc[ai][bj][m][0], acc[ai][bj][m][1]); } }
        }
    }
};

struct Fft2Prob {
    static constexpr bool PERM = true, GATHER_A = false, I8 = false, F8 = false; typedef f32x4 Acc;
    struct U { int k1p, pn; };
    const bf16_t *MT, *T1; bf16_t* XS; int G, c;
    __device__ __forceinline__ bool get(int i, U& u) const { const int L = i * G + c; if (L >= 512) return false; u.k1p = __builtin_amdgcn_readfirstlane(L >> 3); u.pn = __builtin_amdgcn_readfirstlane(L & 7); return true; }
    __device__ __forceinline__ void setup(const U& u, unsigned (&oa)[4], unsigned& ob, unsigned (&dA)[4], unsigned (&dB)[4], const char*& pA, const char*& pB, int& nt) const {
        int R0, Rb0, C0; g8::lane_geom(threadIdx.x, R0, Rb0, C0);
        nt = 2; pA = (const char*)MT; pB = (const char*)T1;
#pragma unroll
        for (int j = 0; j < 4; ++j) { dA[j] = (unsigned)(64 * j * 128) * 2u; dB[j] = dA[j]; }
        oa[0] = (unsigned)((u.k1p * 256 + R0) * 128 + C0) * 2u; ob = (unsigned)((u.k1p * 2048 + 256 * u.pn + Rb0) * 128 + C0) * 2u;
    }
    __device__ __forceinline__ void epi(const f32x4 (&acc)[2][2][4][2], const U& u, int wr, int wc, int fr, int fq) const {
#pragma unroll
        for (int ai = 0; ai < 2; ++ai)
#pragma unroll
            for (int m = 0; m < 4; ++m) { const int r = G8_ROWS(ai, m); const int s = r >> 7, k2 = (r & 127) >> 1, reim = r & 1;
                const int kb = (u.k1p == 0) ? 64 * s : (s ? 128 - u.k1p : u.k1p); const int k = kb + 128 * k2;
#pragma unroll
                for (int bj = 0; bj < 2; ++bj) { const int bc = 256 * u.pn + G8_COL0(bj); const int b = bc >> 9, ch = bc & 511, g = ch >> 7, d = ch & 127;
                    *(u32x4*)(XS + (size_t)(b * SEQ + k) * 1024 + g * 256 + reim * 128 + d) = pack8(acc[ai][bj][m][0], acc[ai][bj][m][1]); } }
    }
};

template <int MODE> struct MergeProb {
    static constexpr bool PERM = true, GATHER_A = false, I8 = false, F8 = false; typedef f32x4 Acc;
    struct U { int pm, pn; };
    const bf16_t* A; const bf16_t* W; int lda;
    const bf16_t* GATE; bf16_t* YB;
    const float* xin; const float* cin; float* XW; float* CW; const float* g1x; const float* g1c;
    int nM, G, c;
    __device__ __forceinline__ bool get(int i, U& u) const { const int L = i * G + c; if (L >= nM * 4) return false; int pm, pn; g8::order2d(L, nM, 4, pm, pn); u.pm = __builtin_amdgcn_readfirstlane(pm); u.pn = __builtin_amdgcn_readfirstlane(pn); return true; }
    __device__ __forceinline__ void setup(const U& u, unsigned (&oa)[4], unsigned& ob, unsigned (&dA)[4], unsigned (&dB)[4], const char*& pA, const char*& pB, int& nt) const {
        int R0, Rb0, C0; g8::lane_geom(threadIdx.x, R0, Rb0, C0);
        nt = lda >> 6; pA = (const char*)A; pB = (const char*)W;
#pragma unroll
        for (int j = 0; j < 4; ++j) { dA[j] = (unsigned)(64 * j * lda) * 2u; dB[j] = dA[j]; }
        oa[0] = (unsigned)((256 * u.pm + R0) * lda + C0) * 2u; ob = (unsigned)((256 * u.pn + Rb0) * lda + C0) * 2u;
    }
    __device__ __forceinline__ void epi(const f32x4 (&acc)[2][2][4][2], const U& u, int wr, int wc, int fr, int fq) const {
        if (MODE == 0) {
            u32x4 gt[2][4][2];
#pragma unroll
            for (int ai = 0; ai < 2; ++ai)
#pragma unroll
                for (int m = 0; m < 4; ++m)
#pragma unroll
                    for (int bj = 0; bj < 2; ++bj) gt[ai][m][bj] = *(const u32x4*)(GATE + (size_t)(256 * u.pm + G8_ROWS(ai, m)) * 1024 + 256 * u.pn + G8_COL0(bj));
#pragma unroll
            for (int ai = 0; ai < 2; ++ai)
#pragma unroll
                for (int m = 0; m < 4; ++m)
#pragma unroll
                    for (int bj = 0; bj < 2; ++bj) { f32x4 g0, g1; unpack8(gt[ai][m][bj], g0, g1);
                        *(u32x4*)(YB + (size_t)(256 * u.pm + G8_ROWS(ai, m)) * 1024 + 256 * u.pn + G8_COL0(bj)) = pack8(acc[ai][bj][m][0] * g0, acc[ai][bj][m][1] * g1); }
        } else if (MODE == 1) {
#pragma unroll
            for (int ai = 0; ai < 2; ++ai) {
                u32x4 gt[4][2], tt[4][2];
#pragma unroll
                for (int m = 0; m < 4; ++m)
#pragma unroll
                    for (int bj = 0; bj < 2; ++bj) { const size_t o = (size_t)(256 * u.pm + G8_ROWS(ai, m)) * 1024 + 256 * u.pn + G8_COL0(bj); gt[m][bj] = *(const u32x4*)(GATE + o); tt[m][bj] = *(const u32x4*)(YB + o); }
#pragma unroll
                for (int m = 0; m < 4; ++m)
#pragma unroll
                    for (int bj = 0; bj < 2; ++bj) { const size_t o = (size_t)(256 * u.pm + G8_ROWS(ai, m)) * 1024 + 256 * u.pn + G8_COL0(bj);
                        f32x4 g0, g1, t0, t1; unpack8(gt[m][bj], g0, g1); unpack8(tt[m][bj], t0, t1);
                        *(u32x4*)(YB + o) = pack8(acc[ai][bj][m][0] * g0 + t0, acc[ai][bj][m][1] * g1 + t1); }
            }
        } else {
            f32x4 gv[2][2];
            const bool isx = (256 * u.pm) < TX;
            { const float* gp = isx ? (g1x + ((256 * u.pm) >> 13) * 6144) : g1c;
#pragma unroll
              for (int bj = 0; bj < 2; ++bj) { gv[bj][0] = *(const f32x4*)(gp + 256 * u.pn + G8_COL0(bj)); gv[bj][1] = *(const f32x4*)(gp + 256 * u.pn + G8_COL0(bj) + 4); } }
            const float* xb = isx ? xin : cin - (size_t)TX * 1024; float* ob = isx ? XW : CW - (size_t)TX * 1024;
#pragma unroll
            for (int ai = 0; ai < 2; ++ai) {
                f32x4 xv[4][2][2];
#pragma unroll
                for (int m = 0; m < 4; ++m)
#pragma unroll
                    for (int bj = 0; bj < 2; ++bj) { const float* xp = xb + (size_t)(256 * u.pm + G8_ROWS(ai, m)) * 1024 + 256 * u.pn + G8_COL0(bj); xv[m][bj][0] = *(const f32x4*)xp; xv[m][bj][1] = *(const f32x4*)(xp + 4); }
#pragma unroll
                for (int m = 0; m < 4; ++m)
#pragma unroll
                    for (int bj = 0; bj < 2; ++bj) { float* op = ob + (size_t)(256 * u.pm + G8_ROWS(ai, m)) * 1024 + 256 * u.pn + G8_COL0(bj);
                        *(f32x4*)op = xv[m][bj][0] + gv[bj][0] * acc[ai][bj][m][0]; *(f32x4*)(op + 4) = xv[m][bj][1] + gv[bj][1] * acc[ai][bj][m][1]; }
            }
        }
    }
};

struct MoeGuProb {
    static constexpr bool PERM = true, GATHER_A = true, I8 = true, F8 = false; typedef i32x4 Acc;
    struct U { int e, rt, pn, base, cnt; int tok[4]; };
    const signed char* H8; const signed char* W8; const float* sW; const float* lsc; const float* bgu; unsigned char* ACT; const int* list; const int* cnt;
    const volatile LAS int* tstart;
    int R, G, c;
    __device__ __forceinline__ bool get(int i, U& u) const {
        const int L = i * G + c; if (L >= R * 8) return false;
        int rt, pn; g8::order2d(L, R, 8, rt, pn);
        const int e = ((const volatile LAS unsigned char*)tstart)[(1024 - 64) + rt];
        u.e = __builtin_amdgcn_readfirstlane(e); u.rt = __builtin_amdgcn_readfirstlane(rt); u.pn = __builtin_amdgcn_readfirstlane(pn); u.base = __builtin_amdgcn_readfirstlane((rt - tstart[e]) * 256); u.cnt = __builtin_amdgcn_readfirstlane(cnt[e]);
        int R0, Rb0, C0; g8::lane_geom(threadIdx.x, R0, Rb0, C0);
#pragma unroll
        for (int j = 0; j < 4; ++j) { const int p = u.base + R0 + 64 * j; u.tok[j] = (p < u.cnt) ? list[(size_t)e * TT + p] : TT; }
        return true;
    }
    __device__ __forceinline__ void setup(const U& u, unsigned (&oa)[4], unsigned& ob, unsigned (&dA)[4], unsigned (&dB)[4], const char*& pA, const char*& pB, int& nt) const {
        int R0, Rb0, C0; g8::lane_geom(threadIdx.x, R0, Rb0, C0);
        nt = 8; pA = (const char*)H8; pB = (const char*)W8;
#pragma unroll
        for (int j = 0; j < 4; ++j) { dA[j] = 0u; dB[j] = (unsigned)(64 * j * 1024); oa[j] = (unsigned)(u.tok[j] * 1024 + C0 * 2); }
        ob = (unsigned)((u.e * 2048 + 256 * u.pn + Rb0) * 1024 + C0 * 2);
    }
    __device__ __forceinline__ void epi(const i32x4 (&acc)[2][2][4][2], const U& u, int wr, int wc, int fr, int fq) const {
        const int j0 = 128 * u.pn + 32 * wc + 8 * fq;
        const float* bp = bgu + (size_t)u.e * 2048 + j0;
        const f32x4 ba0 = *(const f32x4*)bp, ba1 = *(const f32x4*)(bp + 4), bu0 = *(const f32x4*)(bp + 1024), bu1 = *(const f32x4*)(bp + 1028);
        const float* sp = sW + (size_t)u.e * 2048 + 256 * u.pn + 32 * wc + 8 * fq;
        const f32x4 sa0 = *(const f32x4*)sp, sa1 = *(const f32x4*)(sp + 4), su0 = *(const f32x4*)(sp + 128), su1 = *(const f32x4*)(sp + 132);
        float rsv[2][4];
#pragma unroll
        for (int ai = 0; ai < 2; ++ai)
#pragma unroll
            for (int m = 0; m < 4; ++m) { const int p = u.base + G8_ROWS(ai, m); rsv[ai][m] = (p < u.cnt) ? lsc[(size_t)u.e * TT + p] : 0.0f; }
#pragma unroll
        for (int ai = 0; ai < 2; ++ai)
#pragma unroll
            for (int m = 0; m < 4; ++m) { const int rr = G8_ROWS(ai, m); const size_t row = (size_t)256 * u.rt + rr;
                const float rs = rsv[ai][m];
                f32x4 a0, a1, u0, u1, y0, y1;
#pragma unroll
                for (int e = 0; e < 4; ++e) { a0[e] = (float)acc[ai][0][m][0][e] * rs * sa0[e] + ba0[e]; a1[e] = (float)acc[ai][0][m][1][e] * rs * sa1[e] + ba1[e];
                    u0[e] = (float)acc[ai][1][m][0][e] * rs * su0[e] + bu0[e]; u1[e] = (float)acc[ai][1][m][1][e] * rs * su1[e] + bu1[e]; }
#pragma unroll
                for (int e = 0; e < 4; ++e) {
                    float a = fminf(a0[e], 7.0f), uu = fminf(fmaxf(u0[e], -7.0f), 7.0f); y0[e] = a * sigmoidf_(1.702f * a) * (uu + 1.0f);
                    a = fminf(a1[e], 7.0f); uu = fminf(fmaxf(u1[e], -7.0f), 7.0f); y1[e] = a * sigmoidf_(1.702f * a) * (uu + 1.0f);
                }
                { u32x2 w; w.x = pk4_fp8(y0[0], y0[1], y0[2], y0[3]); w.y = pk4_fp8(y1[0], y1[1], y1[2], y1[3]); *(u32x2*)(ACT + row * 1024 + j0) = w; } }
    }
};
struct MoeDnProb {
    static constexpr bool PERM = true, GATHER_A = false, I8 = false, F8 = true; typedef f32x4 Acc;
    struct U { int e, rt, pn; };
    const unsigned char* ACT; const unsigned char* W; const float* bdn; bf16_t* YE;
    const volatile LAS int* tstart; int R, G, c;
    __device__ __forceinline__ bool get(int i, U& u) const {
        const int L = i * G + c; if (L >= R * 4) return false;
        int rt, pn; g8::order2d(L, R, 4, rt, pn);
        const int e = ((const volatile LAS unsigned char*)tstart)[(1024 - 64) + rt];
        u.e = __builtin_amdgcn_readfirstlane(e); u.rt = __builtin_amdgcn_readfirstlane(rt); u.pn = __builtin_amdgcn_readfirstlane(pn); return true;
    }
    __device__ __forceinline__ void setup(const U& u, unsigned (&oa)[4], unsigned& ob, unsigned (&dA)[4], unsigned (&dB)[4], const char*& pA, const char*& pB, int& nt) const {
        int R0, Rb0, C0; g8::lane_geom(threadIdx.x, R0, Rb0, C0);
        nt = 8; pA = (const char*)ACT; pB = (const char*)W;
#pragma unroll
        for (int j = 0; j < 4; ++j) { dA[j] = (unsigned)(64 * j * 1024); dB[j] = dA[j]; }
        oa[0] = (unsigned)((256 * u.rt + R0) * 1024 + C0 * 2); ob = (unsigned)((u.e * 1024 + 256 * u.pn + Rb0) * 1024 + C0 * 2);
    }
    __device__ __forceinline__ void epi(const f32x4 (&acc)[2][2][4][2], const U& u, int wr, int wc, int fr, int fq) const {
#pragma unroll
        for (int bj = 0; bj < 2; ++bj) { const int col = 256 * u.pn + G8_COL0(bj);
            const float* bp = bdn + (size_t)u.e * 1024 + col; const f32x4 b0 = *(const f32x4*)bp, b1 = *(const f32x4*)(bp + 4);
#pragma unroll
            for (int ai = 0; ai < 2; ++ai)
#pragma unroll
                for (int m = 0; m < 4; ++m) { const size_t row = (size_t)256 * u.rt + G8_ROWS(ai, m);
                    *(u32x4*)(YE + row * 1024 + col) = pack8(acc[ai][bj][m][0] * (1.0f / 32.0f) + b0, acc[ai][bj][m][1] * (1.0f / 32.0f) + b1); } }
    }
};

__device__ __forceinline__ int rope_perm(int d) { return (d & 32) | ((d & 15) << 1) | ((d >> 4) & 1); }
template <class RM>
__device__ __forceinline__ void transpose_tile(const Fr& F, const float* src, int N, int k0, int n0, bf16_t* dst, int Kd, RM rm) {
    LAS unsigned char* lds = F.lds;
    const int tid = F.tid;
    { const int kq = tid >> 4, c4 = (tid & 15) * 4; f32x4 v[4];
#pragma unroll
      for (int r = 0; r < 4; ++r) v[r] = *(const f32x4*)(src + (size_t)(k0 + 4 * kq + r) * N + n0 + c4);
#pragma unroll
      for (int e = 0; e < 4; ++e) { u32x2 w; w.x = cvt_pk_bf16(v[0][e], v[1][e]); w.y = cvt_pk_bf16(v[2][e], v[3][e]); *(LAS u32x2*)(lds + (c4 + e) * 272 + kq * 8) = w; } }
    __syncthreads();
    { const int n = tid >> 3, ch = tid & 7; const u32x4 w0 = *(const LAS u32x4*)(lds + n * 272 + ch * 32), w1 = *(const LAS u32x4*)(lds + n * 272 + ch * 32 + 16);
      bf16_t* dp = dst + (size_t)rm(n0 + n) * Kd + k0 + ch * 16; *(u32x4*)dp = w0; *(u32x4*)(dp + 8) = w1; }
    __syncthreads();
}
__device__ __forceinline__ void transpose_tile_fp8(const Fr& F, const float* src, int k0, int n0, unsigned char* dst) {
    LAS unsigned char* lds = F.lds;
    const int tid = F.tid;
    { const int kq = tid >> 4, c4 = (tid & 15) * 4; f32x4 v[4];
#pragma unroll
      for (int r = 0; r < 4; ++r) v[r] = *(const f32x4*)(src + (size_t)(k0 + 4 * kq + r) * 1024 + n0 + c4) * 32.0f;
#pragma unroll
      for (int e = 0; e < 4; ++e) *(LAS unsigned*)(lds + (c4 + e) * 144 + kq * 4) = pk4_fp8(v[0][e], v[1][e], v[2][e], v[3][e]); }
    __syncthreads();
    { const int n = tid >> 3, ch = tid & 7; const u32x4 w = *(const LAS u32x4*)(lds + n * 144 + ch * 16);
      *(u32x4*)(dst + (size_t)(n0 + n) * 1024 + k0 + ch * 16) = w; }
    __syncthreads();
}
struct RmGu { __device__ int operator()(int n) const { const int bj = n >> 10, j = n & 1023; return 256 * (j >> 7) + 128 * bj + (j & 127); } };
template <int MODE, int KT, class RM>
__device__ __forceinline__ void strip_convert(const Fr& F, const float* src, int N, int n0, void* dstv, int Kd, float* sdst, RM rm) {
    LAS unsigned char* lds = F.lds;
    LAS float* red = (LAS float*)(lds + 32768);
    LAS float* inv = (LAS float*)(lds + 32768 + 8192);
    const int tid = F.tid, kq = tid >> 4, c4 = (tid & 15) * 4;
    f32x4 v[KT][4];
#pragma unroll
    for (int kt = 0; kt < KT; ++kt)
#pragma unroll
        for (int r = 0; r < 4; ++r) v[kt][r] = *(const f32x4*)(src + (size_t)(kt * 128 + 4 * kq + r) * N + n0 + c4);
    f32x4 iv = {32.0f, 32.0f, 32.0f, 32.0f};
    if (MODE == 0) {
        f32x4 mx = {0.f, 0.f, 0.f, 0.f};
#pragma unroll
        for (int kt = 0; kt < KT; ++kt)
#pragma unroll
            for (int r = 0; r < 4; ++r)
#pragma unroll
                for (int e = 0; e < 4; ++e) mx[e] = fmaxf(mx[e], fabsf(v[kt][r][e]));
#pragma unroll
        for (int e = 0; e < 4; ++e) red[kq * 64 + c4 + e] = mx[e];
        __syncthreads();
        if (tid < 64) { float m = 0.f;
#pragma unroll
            for (int r = 0; r < 32; ++r) m = fmaxf(m, red[r * 64 + tid]);
            sdst[rm(n0 + tid)] = m * (1.0f / 127.0f); inv[tid] = m > 0.f ? 127.0f / m : 0.f; }
        __syncthreads();
        iv = *(const LAS f32x4*)(inv + c4);
    }
#pragma unroll
    for (int kt = 0; kt < KT; ++kt) {
        if (MODE == 0) {
#pragma unroll
            for (int e = 0; e < 4; ++e) { const int q0 = __float2int_rn(v[kt][0][e] * iv[e]), q1 = __float2int_rn(v[kt][1][e] * iv[e]), q2 = __float2int_rn(v[kt][2][e] * iv[e]), q3 = __float2int_rn(v[kt][3][e] * iv[e]);
                *(LAS unsigned*)(lds + (c4 + e) * 144 + kq * 4) = (unsigned)(q0 & 255) | ((unsigned)(q1 & 255) << 8) | ((unsigned)(q2 & 255) << 16) | ((unsigned)(q3 & 255) << 24); }
        } else if (MODE == 1) {
#pragma unroll
            for (int e = 0; e < 4; ++e) *(LAS unsigned*)(lds + (c4 + e) * 144 + kq * 4) = pk4_fp8(v[kt][0][e] * 32.0f, v[kt][1][e] * 32.0f, v[kt][2][e] * 32.0f, v[kt][3][e] * 32.0f);
        } else {
#pragma unroll
            for (int e = 0; e < 4; ++e) { u32x2 w; w.x = cvt_pk_bf16(v[kt][0][e], v[kt][1][e]); w.y = cvt_pk_bf16(v[kt][2][e], v[kt][3][e]); *(LAS u32x2*)(lds + (c4 + e) * 272 + kq * 8) = w; }
        }
        __syncthreads();
        { const int nl = tid >> 3, ch = tid & 7; const int row = rm(n0 + nl);
          if (MODE == 2) { const u32x4 w0 = *(const LAS u32x4*)(lds + nl * 272 + ch * 32), w1 = *(const LAS u32x4*)(lds + nl * 272 + ch * 32 + 16);
              bf16_t* dp = (bf16_t*)dstv + (size_t)row * Kd + kt * 128 + ch * 16; *(u32x4*)dp = w0; *(u32x4*)(dp + 8) = w1; }
          else { const u32x4 w = *(const LAS u32x4*)(lds + nl * 144 + ch * 16); *(u32x4*)((unsigned char*)dstv + (size_t)row * Kd + kt * 128 + ch * 16) = w; } }
        __syncthreads();
    }
}
struct RmId { __device__ int operator()(int n) const { return n; } };
struct RmWin { __device__ int operator()(int n) const { return (n >= 512 && n < 1152) ? ((n & ~63) | rope_perm(n & 63)) : n; } };

__device__ __forceinline__ void prologue_phase(const Fr& F) {
    const int tid = F.tid, G = F.G, bid = F.bid;
    const float PI2 = 6.283185307179586f;
    const size_t gtid = (size_t)bid * 512 + tid, gsz = (size_t)G * 512;
    { float* rope = WSP(float, WS_ROPE);
      for (size_t i = gtid; i < 2048; i += gsz) { const int pos = (int)(i >> 4), f = (int)(i & 15); const float inv = powf(10000.0f, -(float)f / 16.0f); const float a = (float)pos * inv; rope[i] = cosf(a); rope[2048 + i] = sinf(a); } }
    { bf16_t* W1 = WSP(bf16_t, WS_W1);
      for (size_t i = gtid; i < 256 * 128; i += gsz) { const int r = (int)(i >> 7), n1 = (int)(i & 127); float v = 0.f;
          if (r < 128) { const int k1p = r >> 1, part = r & 1;
              if (part == 0) v = cospif((float)((k1p * n1) & 127) / 64.0f);
              else if (k1p == 0) v = (n1 & 1) ? -1.0f : 1.0f;
              else v = -sinpif((float)((k1p * n1) & 127) / 64.0f); }
          W1[i] = f2bf(v); } }
    { bf16_t* MT = WSP(bf16_t, WS_MT);
      for (size_t i = gtid; i < (size_t)64 * 256 * 128; i += gsz) {
          const int kk = (int)(i & 127), r = (int)((i >> 7) & 255), k1p = (int)(i >> 15);
          const int part = kk >> 6, n2 = kk & 63, s = r >> 7, k2 = (r & 127) >> 1, reim = r & 1;
          float v;
          if (k1p == 0) { const int k = 64 * s + 128 * k2; const int mm = (n2 * k) & 8191; const float cm = cospif((float)mm / 4096.0f), sm = sinpif((float)mm / 4096.0f);
              v = (part == s) ? (reim ? -sm : cm) : 0.0f; }
          else { const int k = (s ? 128 - k1p : k1p) + 128 * k2; const int mm = (n2 * k) & 8191; const float cm = cospif((float)mm / 4096.0f), sm = sinpif((float)mm / 4096.0f);
              if (s == 0) v = reim ? (part ? cm : -sm) : (part ? sm : cm);
              else        v = reim ? (part ? -cm : -sm) : (part ? -sm : cm); }
          MT[i] = f2bf(v); } }
    { bf16_t* WC = WSP(bf16_t, WS_WC);
      const float sc = 5.656854249492381f;
      for (size_t i = gtid; i < 512 * 256; i += gsz) { const int n = (int)(i & 255), r = (int)(i >> 8), k = r >> 1, reim = r & 1; const int mm = (k * n) & 255;
          WC[i] = f2bf(sc * (reim ? -sinpif((float)mm / 128.0f) : cospif((float)mm / 128.0f))); } }
    { bf16_t* RWT = WSP(bf16_t, WS_RWT); const float* rw = INP(13);
      for (size_t i = gtid; i < (size_t)DEPTH * 32 * 1024; i += gsz) { const int k = (int)(i & 1023), e = (int)((i >> 10) & 31), l = (int)(i >> 15); RWT[i] = f2bf(rw[((size_t)l * 1024 + k) * 32 + e]); } }
    { bf16_t* H = WSP(bf16_t, WS_H); for (size_t i = gtid; i < 256 * 1024; i += gsz) H[(size_t)TT * 1024 + i] = 0;
      unsigned* H8z = (unsigned*)(WSP(signed char, WS_H8) + (size_t)TT * 1024); for (size_t i = gtid; i < 256 * 256; i += gsz) H8z[i] = 0u; }
    (void)PI2;
    {
        LAS float* sil = (LAS float*)(F.lds + 65536);
        LAS float* red = (LAS float*)(F.lds + 65536 + 20480);
        for (int i = tid; i < 5 * 1024; i += 512) { const int v = i >> 10, k = i & 1023; const float x = (v < 4) ? INP(1)[v * 1024 + k] : INP(3)[k]; sil[i] = x * sigmoidf_(x); }
        __syncthreads();
        float* MOD = WSP(float, WS_MOD);
        for (int u = bid; u < DEPTH * 96; u += G) {
            const int l = u / 96, j0 = (u % 96) * 64;
            const float* aw = INP(4) + (size_t)l * 1024 * 6144 + j0 + F.lane;
            float a0 = 0.f, a1 = 0.f, a2 = 0.f, a3 = 0.f, a4 = 0.f;
            for (int kk = 0; kk < 128; ++kk) { const int k = F.wave * 128 + kk; const float w = aw[(size_t)k * 6144];
                a0 += sil[k] * w; a1 += sil[1024 + k] * w; a2 += sil[2048 + k] * w; a3 += sil[3072 + k] * w; a4 += sil[4096 + k] * w; }
            red[(F.wave * 5 + 0) * 64 + F.lane] = a0; red[(F.wave * 5 + 1) * 64 + F.lane] = a1; red[(F.wave * 5 + 2) * 64 + F.lane] = a2; red[(F.wave * 5 + 3) * 64 + F.lane] = a3; red[(F.wave * 5 + 4) * 64 + F.lane] = a4;
            __syncthreads();
            if (tid < 320) { const int v = tid >> 6, jl = tid & 63; float s = INP(5)[(size_t)l * 6144 + j0 + jl];
#pragma unroll
                for (int w = 0; w < 8; ++w) s += red[(w * 5 + v) * 64 + jl];
                MOD[((size_t)l * 5 + v) * 6144 + j0 + jl] = s; }
            __syncthreads();
        }
    }
    {
        LAS float* tab = (LAS float*)(F.lds + 65536);
        if (tid < 128) { tab[tid] = cospif((float)tid / 64.0f); tab[128 + tid] = sinpif((float)tid / 64.0f); }
        __syncthreads();
        bf16_t* WFO = WSP(bf16_t, WS_WFO);
        for (int u = bid; u < DEPTH * 4 * 2 * 16; u += G) {
            const int dc = u & 15, reim = (u >> 4) & 1, g = (u >> 5) & 3, l = u >> 7;
            const float* wf = INP(10) + ((size_t)l * 512 + g * 128) * 1024;
#pragma unroll 1
            for (int oh = 0; oh < 2; ++oh) { const int o = tid + 512 * oh;
                float a[8] = {0.f, 0.f, 0.f, 0.f, 0.f, 0.f, 0.f, 0.f};
                for (int j = 0; j < 128; ++j) { const float w = wf[(size_t)j * 1024 + o];
#pragma unroll
                    for (int q = 0; q < 8; ++q) a[q] += tab[reim * 128 + ((j * (dc * 8 + q)) & 127)] * w; }
                u32x4 w4; w4.x = cvt_pk_bf16(a[0] * (1.f / 1024.f), a[1] * (1.f / 1024.f)); w4.y = cvt_pk_bf16(a[2] * (1.f / 1024.f), a[3] * (1.f / 1024.f));
                w4.z = cvt_pk_bf16(a[4] * (1.f / 1024.f), a[5] * (1.f / 1024.f)); w4.w = cvt_pk_bf16(a[6] * (1.f / 1024.f), a[7] * (1.f / 1024.f));
                *(u32x4*)(WFO + ((size_t)l * 1024 + o) * 1024 + g * 256 + reim * 128 + dc * 8) = w4; }
        }
        __syncthreads();
    }
    {
        constexpr int T_GU = DEPTH * 32 * 32, T_DN = DEPTH * 32 * 16, T_WIN = DEPTH * 52, T_WAO = DEPTH * 16, T_WOUT = DEPTH * 16;
#pragma unroll 1
        for (int q = bid; q < T_GU; q += G) { const int le = q >> 5, ns = q & 31;
            strip_convert<0, 8>(F, INP(15) + (size_t)le * 1024 * 2048, 2048, ns * 64, WSP(signed char, WS_WGU) + (size_t)le * 2048 * 1024, 1024, WSP(float, WS_SWGU) + (size_t)le * 2048, RmGu()); }
#pragma unroll 1
        for (int q = bid; q < T_DN; q += G) { const int le = q >> 4, ns = q & 15;
            strip_convert<1, 8>(F, INP(17) + (size_t)le * 1024 * 1024, 1024, ns * 64, WSP(unsigned char, WS_WDN) + (size_t)le * 1024 * 1024, 1024, nullptr, RmId()); }
#pragma unroll 1
        for (int q = bid; q < T_WIN; q += G) { const int l = q / 52, ns = q % 52;
            strip_convert<0, 8>(F, INP(8) + (size_t)l * 1024 * IN_DIM, IN_DIM, ns * 64, WSP(signed char, WS_WIN) + (size_t)l * IN_DIM * 1024, 1024, WSP(float, WS_SWIN) + (size_t)l * IN_DIM, RmWin()); }
#pragma unroll 1
        for (int q = (bid + 208) % G; q < T_WAO; q += G) { const int l = q >> 4, ns = q & 15;
            strip_convert<2, 4>(F, INP(11) + (size_t)l * 512 * 1024, 1024, ns * 64, WSP(bf16_t, WS_WAO) + (size_t)l * 1024 * 512, 512, nullptr, RmId()); }
#pragma unroll 1
        for (int q = (bid + 144) % G; q < T_WOUT; q += G) { const int l = q >> 4, ns = q & 15;
            strip_convert<2, 8>(F, INP(12) + (size_t)l * 1024 * 1024, 1024, ns * 64, WSP(bf16_t, WS_WOUT) + (size_t)l * 1024 * 1024, 1024, nullptr, RmId()); }
    }
}

__device__ __forceinline__ void moe_combine(const Fr& F, int tok, int lprev, const volatile LAS int* tstart, f32x4 (&m)[4]) {
    const int* slot = WSP(int, WS_SLOT); const float* gate = WSP(float, WS_GATE); const bf16_t* YE = WSP(bf16_t, WS_YE);
#pragma unroll
    for (int j = 0; j < 4; ++j) m[j] = (f32x4){0.f, 0.f, 0.f, 0.f};
#pragma unroll
    for (int k = 0; k < 4; ++k) {
        const int sl = slot[tok * 4 + k]; const float gk = gate[tok * 4 + k];
        const int e = sl >> 20, pos = sl & 0xfffff;
        const size_t row = (size_t)256 * tstart[e] + pos;
        const bf16_t* yp = YE + row * 1024 + 4 * F.lane;
#pragma unroll
        for (int j = 0; j < 4; ++j) { const u32x2 w = *(const u32x2*)(yp + 256 * j); m[j][0] += gk * bf_lo(w.x); m[j][1] += gk * bf_hi(w.x); m[j][2] += gk * bf_lo(w.y); m[j][3] += gk * bf_hi(w.y); }
    }
    (void)lprev;
}
__device__ __forceinline__ int fill_tstart(const Fr& F, int l) {
    volatile LAS int* ts = (volatile LAS int*)(F.lds + LDS_MISC + 64);
    __syncthreads();
    if (F.tid == 0) { const int* cnt = (const int*)(F.ws + WS_CTL + CTL_CNT) + l * 32; int s = 0; for (int e = 0; e < 32; ++e) { ts[e] = s; s += (cnt[e] + 255) >> 8; } ts[32] = s; }
    __syncthreads();
    { volatile LAS unsigned char* r2e = (volatile LAS unsigned char*)(F.lds + LDS_MISC + 1024);
      const int R = ts[32];
      for (int rt = F.tid; rt < R; rt += 512) { int e = 0;
#pragma unroll 1
          for (int q = 1; q < 32; ++q) e = (ts[q] <= rt) ? q : e;
          r2e[rt] = (unsigned char)e; } }
    __syncthreads();
    return ts[32];
}

__device__ __forceinline__ void norm1_phase(const Fr& F, int l) {
    const volatile LAS int* tstart = (const volatile LAS int*)(F.lds + LDS_MISC + 64);
    if (l > 0) fill_tstart(F, l - 1);
    const float* MOD = WSP(float, WS_MOD);
    const bool fin = (l == DEPTH);
    const int ntok = fin ? TX : TT;
    const bool tmo = fin && (xb_ld((unsigned*)(F.ws + WS_CTL) + XB_TMO) != 0u);
    const float* gvec = fin ? INP(19) : INP(6) + (size_t)l * 1024;
    float* XW = WSP(float, WS_XW); float* CW = WSP(float, WS_CW); signed char* H8 = WSP(signed char, WS_H8); float* SHv = WSP(float, WS_SH);
    for (int tok = F.bid * 8 + F.wave; tok < ntok; tok += F.G * 8) {
        const bool isx = tok < TX; const int v = isx ? (tok >> 13) : 4;
        const float* src = (l == 0) ? (isx ? INP(0) + (size_t)tok * 1024 : INP(2) + (size_t)(tok - TX) * 1024) : (isx ? XW + (size_t)tok * 1024 : CW + (size_t)(tok - TX) * 1024);
        f32x4 x[4];
#pragma unroll
        for (int j = 0; j < 4; ++j) x[j] = *(const f32x4*)(src + 256 * j + 4 * F.lane);
        if (l > 0) {
            f32x4 mm[4]; moe_combine(F, tok, l - 1, tstart, mm);
            const float* g2 = MOD + ((size_t)(l - 1) * 5 + v) * 6144 + 5 * 1024;
            float* dst = isx ? XW + (size_t)tok * 1024 : CW + (size_t)(tok - TX) * 1024;
#pragma unroll
            for (int j = 0; j < 4; ++j) { x[j] += *(const f32x4*)(g2 + 256 * j + 4 * F.lane) * mm[j]; if (!fin) *(f32x4*)(dst + 256 * j + 4 * F.lane) = x[j]; }
        }
        float ss = 0.f;
#pragma unroll
        for (int j = 0; j < 4; ++j) ss += x[j][0] * x[j][0] + x[j][1] * x[j][1] + x[j][2] * x[j][2] + x[j][3] * x[j][3];
        ss = wave_sum(ss);
        const float rstd = rsqrtf(ss * (1.0f / 1024.0f) + EPS);
        if (fin) {
#pragma unroll
            for (int j = 0; j < 4; ++j) { const f32x4 g = *(const f32x4*)(gvec + 256 * j + 4 * F.lane); *(f32x4*)(F.out + (size_t)tok * 1024 + 256 * j + 4 * F.lane) = tmo ? (f32x4){__builtin_nanf(""), __builtin_nanf(""), __builtin_nanf(""), __builtin_nanf("")} : x[j] * rstd * g; }
        } else {
            const float* md = MOD + ((size_t)l * 5 + v) * 6144;
            float amax = 0.f;
#pragma unroll
            for (int j = 0; j < 4; ++j) { const int c = 256 * j + 4 * F.lane; const f32x4 g = *(const f32x4*)(gvec + c), sh = *(const f32x4*)(md + c), sc = *(const f32x4*)(md + 1024 + c);
                x[j] = x[j] * rstd * g * (sc + 1.0f) + sh;
                amax = fmaxf(amax, fmaxf(fmaxf(fabsf(x[j][0]), fabsf(x[j][1])), fmaxf(fabsf(x[j][2]), fabsf(x[j][3])))); }
#pragma unroll
            for (int o = 32; o >= 1; o >>= 1) amax = fmaxf(amax, __shfl_xor(amax, o));
            const float inv = amax > 0.f ? 127.0f / amax : 0.f;
#pragma unroll
            for (int j = 0; j < 4; ++j) { const int c = 256 * j + 4 * F.lane;
                const int q0 = __float2int_rn(x[j][0] * inv), q1 = __float2int_rn(x[j][1] * inv), q2 = __float2int_rn(x[j][2] * inv), q3 = __float2int_rn(x[j][3] * inv);
                *(unsigned*)(H8 + (size_t)tok * 1024 + c) = (unsigned)(q0 & 255) | ((unsigned)(q1 & 255) << 8) | ((unsigned)(q2 & 255) << 16) | ((unsigned)(q3 & 255) << 24); }
            if (F.lane == 0) SHv[tok] = amax * (1.0f / 127.0f);
        }
    }
}

__device__ __forceinline__ void norm2_router_phase(const Fr& F, int l, bool fake = false) {
    const int ntok = (l == DEPTH - 1) ? TX : TT;
    const float* MOD = WSP(float, WS_MOD); const float* gvec = INP(7) + (size_t)l * 1024;
    const float* XW = WSP(float, WS_XW); const float* CW = WSP(float, WS_CW); bf16_t* H = WSP(bf16_t, WS_H);
    const bf16_t* RWT = WSP(bf16_t, WS_RWT) + (size_t)l * 32 * 1024; const float* rb = INP(14) + l * 32;
    int* cntg = (int*)(F.ws + WS_CTL + CTL_CNT) + l * 32; int* list = WSP(int, WS_LIST); int* slot = WSP(int, WS_SLOT); float* gate = WSP(float, WS_GATE);
    LAS unsigned char* hs = F.lds;
    LAS float* part = (LAS float*)(F.lds + 69632);
    LAS float* logit = (LAS float*)(F.lds + 69632 + 36864);
    LAS int* lcnt = (LAS int*)(F.lds + 69632 + 36864 + 4608);
    LAS int* lbase = lcnt + 32;
    LAS float* tsc = (LAS float*)(lbase + 32);
    signed char* H8 = WSP(signed char, WS_H8); float* lscg = WSP(float, WS_LSC);
    const int lane = F.lane, w = F.wave, l32 = lane & 31, hh = lane >> 5;
    for (int tl = F.bid; tl < ntok / 32; tl += F.G) {
        const int t0 = tl * 32;
        if (F.tid < 32) lcnt[F.tid] = 0;
#pragma unroll 1
        for (int q = 0; q < 4; ++q) {
            const int tloc = 4 * w + q, tok = t0 + tloc; const bool isx = tok < TX; const int v = isx ? (tok >> 13) : 4;
            const float* src = isx ? XW + (size_t)tok * 1024 : CW + (size_t)(tok - TX) * 1024;
            f32x4 x[4]; float ss = 0.f;
#pragma unroll
            for (int j = 0; j < 4; ++j) { x[j] = *(const f32x4*)(src + 256 * j + 4 * lane); ss += x[j][0] * x[j][0] + x[j][1] * x[j][1] + x[j][2] * x[j][2] + x[j][3] * x[j][3]; }
            ss = wave_sum(ss); const float rstd = rsqrtf(ss * (1.0f / 1024.0f) + EPS);
            const float* md = MOD + ((size_t)l * 5 + v) * 6144;
            float amax = 0.f;
#pragma unroll
            for (int j = 0; j < 4; ++j) { const int c = 256 * j + 4 * lane; const f32x4 g = *(const f32x4*)(gvec + c), sh = *(const f32x4*)(md + 3072 + c), sc = *(const f32x4*)(md + 4096 + c);
                x[j] = x[j] * rstd * g * (sc + 1.0f) + sh;
                amax = fmaxf(amax, fmaxf(fmaxf(fabsf(x[j][0]), fabsf(x[j][1])), fmaxf(fabsf(x[j][2]), fabsf(x[j][3]))));
                u32x2 wv; wv.x = cvt_pk_bf16(x[j][0], x[j][1]); wv.y = cvt_pk_bf16(x[j][2], x[j][3]);
                *(LAS u32x2*)(hs + tloc * 2064 + c * 2) = wv; }
#pragma unroll
            for (int o = 32; o >= 1; o >>= 1) amax = fmaxf(amax, __shfl_xor(amax, o));
            const float inv = amax > 0.f ? 127.0f / amax : 0.f;
#pragma unroll
            for (int j = 0; j < 4; ++j) { const int c = 256 * j + 4 * lane;
                const int q0 = __float2int_rn(x[j][0] * inv), q1 = __float2int_rn(x[j][1] * inv), q2 = __float2int_rn(x[j][2] * inv), q3 = __float2int_rn(x[j][3] * inv);
                *(unsigned*)(H8 + (size_t)tok * 1024 + c) = (unsigned)(q0 & 255) | ((unsigned)(q1 & 255) << 8) | ((unsigned)(q2 & 255) << 16) | ((unsigned)(q3 & 255) << 24); }
            if (lane == 0) tsc[tloc] = amax * (1.0f / 127.0f);
        }
        __syncthreads();
        {
            f32x16 acc;
#pragma unroll
            for (int e = 0; e < 16; ++e) acc[e] = 0.f;
#pragma unroll
            for (int s = 0; s < 8; ++s) { const int k = 128 * w + 16 * s + 8 * hh;
                const bf16x8 a = *(const LAS bf16x8*)(hs + l32 * 2064 + k * 2);
                const bf16x8 b = *(const bf16x8*)(RWT + (size_t)l32 * 1024 + k);
                acc = __builtin_amdgcn_mfma_f32_32x32x16_bf16(a, b, acc, 0, 0, 0); }
#pragma unroll
            for (int e = 0; e < 16; ++e) { const int trow = 8 * (e >> 2) + 4 * hh + (e & 3); part[(w * 32 + trow) * 33 + l32] = acc[e]; }
        }
        __syncthreads();
        { const int tr = F.tid >> 4, e0 = (F.tid & 15) * 2;
#pragma unroll
          for (int q = 0; q < 2; ++q) { float s = rb[e0 + q];
#pragma unroll
              for (int ww = 0; ww < 8; ++ww) s += part[(ww * 32 + tr) * 33 + e0 + q];
              logit[tr * 33 + e0 + q] = s; } }
        __syncthreads();
        int es[4], rk[4]; float gs[4];
        if (fake) { __syncthreads(); continue; }
        if (F.tid < 32) {
            float lv[4]; unsigned used = 0u;
#pragma unroll
            for (int k = 0; k < 4; ++k) { float best = -3.0e38f; int bi = 0;
#pragma unroll 1
                for (int e = 0; e < 32; ++e) { const float vv = logit[F.tid * 33 + e]; if (!((used >> e) & 1u) && vv > best) { best = vv; bi = e; } }
                used |= 1u << bi; es[k] = bi; lv[k] = best; }
            const float mx = lv[0]; float sum = 0.f;
#pragma unroll
            for (int k = 0; k < 4; ++k) { gs[k] = __expf(lv[k] - mx); sum += gs[k]; }
#pragma unroll
            for (int k = 0; k < 4; ++k) { gs[k] /= sum; rk[k] = __hip_atomic_fetch_add(&lcnt[es[k]], 1, __ATOMIC_RELAXED, __HIP_MEMORY_SCOPE_WORKGROUP); }
        }
        __syncthreads();
        if (F.tid < 32) { const int n = lcnt[F.tid]; lbase[F.tid] = n ? atomicAdd(&cntg[F.tid], n) : 0; }
        __syncthreads();
        if (F.tid < 32) { const int tok = t0 + F.tid;
#pragma unroll
            for (int k = 0; k < 4; ++k) { const int pos = lbase[es[k]] + rk[k]; list[(size_t)es[k] * TT + pos] = tok; lscg[(size_t)es[k] * TT + pos] = tsc[F.tid]; slot[tok * 4 + k] = (es[k] << 20) | pos; gate[tok * 4 + k] = gs[k]; } }
        __syncthreads();
    }
}

template <int OFF> __device__ __forceinline__ s16x4 tr_read(unsigned vb) { s16x4 r; asm volatile("ds_read_b64_tr_b16 %0, %1 offset:%2" : "=&v"(r) : "v"(vb), "i"(OFF) : "memory"); return r; }

__device__ __forceinline__ void attn_phase(const Fr& F, int l, bool with_ctx) {
    LAS unsigned char* lds = F.lds;
    const unsigned ldsb = (unsigned)(uintptr_t)lds;
    const bf16_t* Q = WSP(bf16_t, WS_Q); const bf16_t* Kb = WSP(bf16_t, WS_K); const bf16_t* Vb = WSP(bf16_t, WS_V); bf16_t* AO = WSP(bf16_t, WS_AO);
    const int tid = F.tid, lane = F.lane, w = F.wave, l32 = lane & 31, hh = lane >> 5;
    const int g = w >> 1, rhalf = w & 1;
    const int nunits = 512 + (with_ctx ? 16 : 0);
    const int skey = tid >> 3, sch = tid & 7;
    const unsigned k_st = (unsigned)(skey * 128 + ((sch ^ ((skey >> 1) & 7)) * 16));
    const unsigned v_st = (unsigned)(8192 + skey * 128 + ((((sch >> 1) ^ (((skey >> 1) & 1) << 1)) * 32) + (sch & 1) * 16));
    unsigned vbase[2];
    { const int li = lane & 15, q = li >> 2, p = li & 3, g16 = l32 >> 4; const int key = 4 * hh + q;
#pragma unroll
      for (int db = 0; db < 2; ++db) { const int c32 = 2 * db + g16; vbase[db] = ldsb + 8192u + (unsigned)(key * 128 + ((c32 ^ (((key >> 1) & 1) << 1)) * 32) + 8 * p); } }
    for (int u = F.bid; u < nunits; u += F.G) {
        int b, qb, kvh; bool isctx;
        if (u < 512) { b = u >> 7; qb = (u >> 1) & 63; kvh = u & 1; isctx = false; }
        else { const int uu = u - 512; b = uu >> 2; qb = (uu >> 1) & 1; kvh = uu & 1; isctx = true; }
        const int head = kvh * 4 + g;
        const int qtok0 = isctx ? (TX + b * LC + qb * 128) : (b * SEQ + qb * 128);
        bf16x8 qf[2][4];
#pragma unroll
        for (int qk = 0; qk < 2; ++qk)
#pragma unroll
            for (int s = 0; s < 4; ++s) qf[qk][s] = *(const bf16x8*)(Q + (size_t)(qtok0 + rhalf * 64 + qk * 32 + l32) * 512 + head * 64 + 16 * s + 8 * hh);
        const float sink2 = INP(9)[l * 8 + head] * LOG2E;
        float m_run[2] = {sink2, sink2}, l_run[2] = {hh ? 0.f : 1.f, hh ? 0.f : 1.f};
        f32x16 O[2][2];
#pragma unroll
        for (int a = 0; a < 2; ++a)
#pragma unroll
            for (int c = 0; c < 2; ++c)
#pragma unroll
                for (int e = 0; e < 16; ++e) O[a][c][e] = 0.f;
        int t = isctx ? 6 : (qb == 0 ? 2 : 0);
        u32x4 kreg, vreg;
        { const int tok0 = (t < 6) ? (b * SEQ + (qb - 1) * 128 + 64 * t) : (TX + b * LC + 64 * (t - 6));
          kreg = *(const u32x4*)(Kb + (size_t)(tok0 + skey) * 128 + kvh * 64 + sch * 8); vreg = *(const u32x4*)(Vb + (size_t)(tok0 + skey) * 128 + kvh * 64 + sch * 8); }
        for (;;) {
            __syncthreads();
            *(LAS u32x4*)(lds + k_st) = kreg; *(LAS u32x4*)(lds + v_st) = vreg;
            int tn = t + 1; if (!isctx && qb == 63 && (tn == 4 || tn == 5)) tn = 6;
            const bool more = tn < 10;
            if (more) { const int tok0 = (tn < 6) ? (b * SEQ + (qb - 1) * 128 + 64 * tn) : (TX + b * LC + 64 * (tn - 6));
                kreg = *(const u32x4*)(Kb + (size_t)(tok0 + skey) * 128 + kvh * 64 + sch * 8); vreg = *(const u32x4*)(Vb + (size_t)(tok0 + skey) * 128 + kvh * 64 + sch * 8); }
            __syncthreads();
            const bool local = (!isctx) && (t < 6);
            const bool skip = local && ((rhalf == 0 && t == 5) || (rhalf == 1 && t == 0));
            if (!skip) {
                f32x16 S[2][2];
#pragma unroll
                for (int kb = 0; kb < 2; ++kb)
#pragma unroll
                    for (int qk = 0; qk < 2; ++qk)
#pragma unroll
                        for (int e = 0; e < 16; ++e) S[kb][qk][e] = 0.f;
#pragma unroll
                for (int kb = 0; kb < 2; ++kb)
#pragma unroll
                    for (int s = 0; s < 4; ++s) { const int key = 32 * kb + l32, ch = 2 * s + hh;
                        const bf16x8 kf = *(const LAS bf16x8*)(lds + key * 128 + ((ch ^ ((key >> 1) & 7)) * 16));
#pragma unroll
                        for (int qk = 0; qk < 2; ++qk) S[kb][qk] = __builtin_amdgcn_mfma_f32_32x32x16_bf16(kf, qf[qk][s], S[kb][qk], 0, 0, 0); }
                bf16x8 pf[2][2][2];
#pragma unroll
                for (int qk = 0; qk < 2; ++qk) {
                    if (local) { const int rq = rhalf * 64 + qk * 32 + l32;
#pragma unroll
                        for (int kb = 0; kb < 2; ++kb)
#pragma unroll
                            for (int e = 0; e < 16; ++e) { const int kk = 64 * t + 32 * kb + 8 * (e >> 2) + 4 * hh + (e & 3); const int rel = kk - 128 - rq; if (rel < -128 || rel > 128) S[kb][qk][e] = -__builtin_inff(); } }
                    float mx = -__builtin_inff();
#pragma unroll
                    for (int kb = 0; kb < 2; ++kb)
#pragma unroll
                        for (int e = 0; e < 16; ++e) mx = fmaxf(mx, S[kb][qk][e]);
                    mx = fmaxf(mx, __shfl_xor(mx, 32));
                    const float mn = fmaxf(m_run[qk], mx); const float alpha = __builtin_amdgcn_exp2f(m_run[qk] - mn); m_run[qk] = mn;
                    float rs = 0.f;
#pragma unroll
                    for (int kb = 0; kb < 2; ++kb)
#pragma unroll
                        for (int e = 0; e < 16; ++e) { const float p = __builtin_amdgcn_exp2f(S[kb][qk][e] - mn); S[kb][qk][e] = p; rs += p; }
                    l_run[qk] = l_run[qk] * alpha + rs;
#pragma unroll
                    for (int db = 0; db < 2; ++db)
#pragma unroll
                        for (int e = 0; e < 16; ++e) O[db][qk][e] *= alpha;
#pragma unroll
                    for (int kb = 0; kb < 2; ++kb)
#pragma unroll
                        for (int sp = 0; sp < 2; ++sp) { u32x4 pw;
                            pw.x = cvt_pk_bf16(S[kb][qk][8 * sp + 0], S[kb][qk][8 * sp + 1]); pw.y = cvt_pk_bf16(S[kb][qk][8 * sp + 2], S[kb][qk][8 * sp + 3]);
                            pw.z = cvt_pk_bf16(S[kb][qk][8 * sp + 4], S[kb][qk][8 * sp + 5]); pw.w = cvt_pk_bf16(S[kb][qk][8 * sp + 6], S[kb][qk][8 * sp + 7]);
                            pf[kb][sp][qk] = __builtin_bit_cast(bf16x8, pw); }
                }
#define PV_STEP(KB, SP) do { \
                    const s16x4 a0 = tr_read<((32 * (KB) + 16 * (SP)) * 128)>(vbase[0]), a1 = tr_read<((32 * (KB) + 16 * (SP) + 8) * 128)>(vbase[0]); \
                    const s16x4 c0 = tr_read<((32 * (KB) + 16 * (SP)) * 128)>(vbase[1]), c1 = tr_read<((32 * (KB) + 16 * (SP) + 8) * 128)>(vbase[1]); \
                    asm volatile("s_waitcnt lgkmcnt(0)" ::: "memory"); __builtin_amdgcn_sched_barrier(0); \
                    const bf16x8 vf0 = (bf16x8){a0[0], a0[1], a0[2], a0[3], a1[0], a1[1], a1[2], a1[3]}, vf1 = (bf16x8){c0[0], c0[1], c0[2], c0[3], c1[0], c1[1], c1[2], c1[3]}; \
                    O[0][0] = __builtin_amdgcn_mfma_f32_32x32x16_bf16(vf0, pf[KB][SP][0], O[0][0], 0, 0, 0); O[0][1] = __builtin_amdgcn_mfma_f32_32x32x16_bf16(vf0, pf[KB][SP][1], O[0][1], 0, 0, 0); \
                    O[1][0] = __builtin_amdgcn_mfma_f32_32x32x16_bf16(vf1, pf[KB][SP][0], O[1][0], 0, 0, 0); O[1][1] = __builtin_amdgcn_mfma_f32_32x32x16_bf16(vf1, pf[KB][SP][1], O[1][1], 0, 0, 0); } while (0)
                PV_STEP(0, 0); PV_STEP(0, 1); PV_STEP(1, 0); PV_STEP(1, 1);
#undef PV_STEP
            }
            if (!more) break;
            t = tn;
        }
#pragma unroll
        for (int qk = 0; qk < 2; ++qk) {
            const float lt = l_run[qk] + __shfl_xor(l_run[qk], 32); const float inv = 1.0f / lt;
            const size_t tok = (size_t)(qtok0 + rhalf * 64 + qk * 32 + l32);
#pragma unroll
            for (int db = 0; db < 2; ++db)
#pragma unroll
                for (int vq = 0; vq < 4; ++vq) { u32x2 wv; wv.x = cvt_pk_bf16(O[db][qk][4 * vq] * inv, O[db][qk][4 * vq + 1] * inv); wv.y = cvt_pk_bf16(O[db][qk][4 * vq + 2] * inv, O[db][qk][4 * vq + 3] * inv);
                    *(u32x2*)(AO + tok * 512 + head * 64 + 32 * db + 8 * vq + 4 * hh) = wv; }
        }
    }
    __syncthreads();
}

struct Args { const float* in[20]; float* out; unsigned char* ws; int ph_lo, ph_hi; };

constexpr int PH_PER_LAYER = 9;
constexpr int PH_FINAL = 1 + DEPTH * PH_PER_LAYER;
constexpr int PH_COUNT = PH_FINAL + 1;

__global__ void __launch_bounds__(512, 2) fwd_kernel(Args args) {
    extern __shared__ __attribute__((aligned(16))) unsigned char lds_raw[];
    Fr F;
    F.lds = (LAS unsigned char*)lds_raw; F.ws = args.ws; F.out = args.out;
    F.tid = threadIdx.x; F.lane = F.tid & 63; F.wave = __builtin_amdgcn_readfirstlane(F.tid >> 6); F.G = gridDim.x; F.bid = blockIdx.x;
    volatile LAS unsigned* misc = (volatile LAS unsigned*)(F.lds + LDS_MISC);
    if (F.tid < 64) misc[F.tid] = 0u;
    if (F.tid < 20) { const unsigned long long pv = (unsigned long long)args.in[F.tid]; misc[128 + 2 * F.tid] = (unsigned)pv; misc[128 + 2 * F.tid + 1] = (unsigned)(pv >> 32); }
    __syncthreads();
    XcdBarrier bar; bar.bar = (unsigned*)(F.ws + WS_CTL); bar.x = 0; bar.st = misc;
    const bool one = (args.ph_hi - args.ph_lo) > 1;
    if (one) bar = xcd_barrier_post((unsigned*)(F.ws + WS_CTL), misc);
    const int lo = args.ph_lo, hi = args.ph_hi;
#ifdef STOP_PH
#define IN(k) (lo <= (k) && (k) < hi && ((k) < STOP_PH || (k) == PH_FINAL))
#else
#define IN(k) (lo <= (k) && (k) < hi)
#endif
#ifndef DUP_PH
#define DUP_PH -1
#endif
#define NREP(b) ((DUP_PH == (b)) ? 2 : 1)
#define SEAM(k) do { if (lo <= (k) + 1 && (k) + 1 < hi) xcd_barrier(bar); } while (0)

#ifndef PHM
#define PHM 0xFFFF
#endif
#define PHON(b) ((PHM >> (b)) & 1)
    if (PHON(0) && IN(0)) { for (int rep = 0; rep < NREP(0); ++rep) { LAUNDER(F); prologue_phase(F); SEAM(0); } }

#pragma unroll 1
    for (int l = 0; l < NLAYERS_RUN; ++l) {
        const int pb = 1 + l * PH_PER_LAYER;
        const bool lastl = (l == DEPTH - 1);
        if (PHON(1) && IN(pb + 0)) { LAUNDER(F); norm1_phase(F, l); SEAM(pb + 0); }
        if (PHON(2) && IN(pb + 1)) for (int rep = 0; rep < NREP(2); ++rep) { LAUNDER(F);
            { InProjProb<0> P; P.H = WSP(signed char, WS_H8); P.W = WSP(signed char, WS_WIN) + (size_t)l * IN_DIM * 1024; P.sH = WSP(float, WS_SH); P.sW = WSP(float, WS_SWIN) + (size_t)l * IN_DIM;
              P.FT = WSP(bf16_t, WS_FT); P.FCT = WSP(bf16_t, WS_FCT); P.Q = WSP(bf16_t, WS_Q); P.Kb = WSP(bf16_t, WS_K); P.Vb = WSP(bf16_t, WS_V); P.GF = WSP(bf16_t, WS_GF); P.GA = WSP(bf16_t, WS_GA);
              P.rope = (const LAS float*)(F.lds + LDS_ROPE);
              { const float* rg = WSP(float, WS_ROPE); LAS float* rl = (LAS float*)(F.lds + LDS_ROPE); for (int i = F.tid; i < 4096; i += 512) rl[i] = rg[i]; __syncthreads(); }
              P.nM = lastl ? 128 : 132; P.n_nat = P.nM * 11; P.n_fx = 256; P.n_fc = lastl ? 0 : 8; P.n_extra = lastl ? 4 : 0; P.G = F.G; P.c = F.bid;
              g8::gemm_run(F.lds, P); }
            { InProjProb<1> P; P.H = WSP(signed char, WS_H8); P.W = WSP(signed char, WS_WIN) + (size_t)l * IN_DIM * 1024; P.sH = WSP(float, WS_SH); P.sW = WSP(float, WS_SWIN) + (size_t)l * IN_DIM;
              P.FT = WSP(bf16_t, WS_FT); P.FCT = WSP(bf16_t, WS_FCT); P.Q = nullptr; P.Kb = nullptr; P.Vb = nullptr; P.GF = nullptr; P.GA = nullptr; P.rope = nullptr;
              P.nM = 0; P.n_nat = 0; P.n_fx = 256; P.n_fc = lastl ? 0 : 8; P.n_extra = 0; P.G = F.G; P.c = (F.bid + 84) % F.G;
              g8::gemm_run(F.lds, P); }
            SEAM(pb + 1);
        }
        if (PHON(3) && IN(pb + 2)) for (int rep = 0; rep < NREP(3); ++rep) { LAUNDER(F);
#ifndef NO_ATTN
            attn_phase(F, l, !lastl);
#endif
#ifndef NO_FFT1
            Fft1Prob P; P.W1 = WSP(bf16_t, WS_W1); P.FT = WSP(bf16_t, WS_FT); P.WC = WSP(bf16_t, WS_WC); P.FCT = WSP(bf16_t, WS_FCT); P.T1 = WSP(bf16_t, WS_T1); P.XS = WSP(bf16_t, WS_XS);
            P.n0 = 512; P.n1 = lastl ? 0 : 16; P.G = F.G; P.c = (F.bid + 128) % F.G;
            g8::gemm_run(F.lds, P);
#endif
            SEAM(pb + 2);
        }
        if (PHON(4) && IN(pb + 3)) for (int rep = 0; rep < NREP(4); ++rep) { LAUNDER(F);
            Fft2Prob P; P.MT = WSP(bf16_t, WS_MT); P.T1 = WSP(bf16_t, WS_T1); P.XS = WSP(bf16_t, WS_XS); P.G = F.G; P.c = F.bid;
            g8::gemm_run(F.lds, P); SEAM(pb + 3);
        }
        if (PHON(5) && IN(pb + 4)) for (int rep = 0; rep < NREP(5); ++rep) { LAUNDER(F);
            { MergeProb<0> P; P.A = WSP(bf16_t, WS_XS); P.W = WSP(bf16_t, WS_WFO) + (size_t)l * 1024 * 1024; P.lda = 1024; P.GATE = WSP(bf16_t, WS_GF); P.YB = WSP(bf16_t, WS_YB);
              P.xin = nullptr; P.cin = nullptr; P.XW = nullptr; P.CW = nullptr; P.g1x = nullptr; P.g1c = nullptr; P.nM = lastl ? 128 : 132; P.G = F.G; P.c = F.bid;
              g8::gemm_run(F.lds, P); }
            { MergeProb<1> P; P.A = WSP(bf16_t, WS_AO); P.W = WSP(bf16_t, WS_WAO) + (size_t)l * 1024 * 512; P.lda = 512; P.GATE = WSP(bf16_t, WS_GA); P.YB = WSP(bf16_t, WS_YB);
              P.xin = nullptr; P.cin = nullptr; P.XW = nullptr; P.CW = nullptr; P.g1x = nullptr; P.g1c = nullptr; P.nM = lastl ? 128 : 132; P.G = F.G; P.c = F.bid;
              g8::gemm_run(F.lds, P); }
            SEAM(pb + 4);
        }
        if (PHON(6) && IN(pb + 5)) { LAUNDER(F);
            MergeProb<2> P; P.A = WSP(bf16_t, WS_YB); P.W = WSP(bf16_t, WS_WOUT) + (size_t)l * 1024 * 1024; P.lda = 1024; P.GATE = nullptr; P.YB = nullptr;
            P.xin = (l == 0) ? INP(0) : WSP(float, WS_XW); P.cin = (l == 0) ? INP(2) : WSP(float, WS_CW); P.XW = WSP(float, WS_XW); P.CW = WSP(float, WS_CW);
            P.g1x = WSP(float, WS_MOD) + (size_t)l * 5 * 6144 + 2 * 1024; P.g1c = WSP(float, WS_MOD) + ((size_t)l * 5 + 4) * 6144 + 2 * 1024; P.nM = lastl ? 128 : 132; P.G = F.G; P.c = F.bid;
            g8::gemm_run(F.lds, P); SEAM(pb + 5);
        }
        if (PHON(7) && IN(pb + 6)) for (int rep = 0; rep < NREP(7); ++rep) { LAUNDER(F); norm2_router_phase(F, l, rep + 1 < NREP(7)); SEAM(pb + 6); }
        if (PHON(8) && IN(pb + 7)) for (int rep = 0; rep < NREP(8); ++rep) { LAUNDER(F);
            MoeGuProb P; P.R = fill_tstart(F, l);
            P.H8 = WSP(signed char, WS_H8); P.W8 = WSP(signed char, WS_WGU) + (size_t)l * 32 * 2048 * 1024; P.sW = WSP(float, WS_SWGU) + (size_t)l * 32 * 2048; P.lsc = WSP(float, WS_LSC);
            P.bgu = INP(16) + (size_t)l * 32 * 2048; P.ACT = WSP(unsigned char, WS_ACT);
            P.list = WSP(int, WS_LIST); P.cnt = (const int*)(F.ws + WS_CTL + CTL_CNT) + l * 32; P.tstart = (const volatile LAS int*)(F.lds + LDS_MISC + 64); P.G = F.G; P.c = F.bid;
            g8::gemm_run(F.lds, P); SEAM(pb + 7);
        }
        if (PHON(9) && IN(pb + 8)) for (int rep = 0; rep < NREP(9); ++rep) { LAUNDER(F);
            MoeDnProb P; P.R = fill_tstart(F, l);
            P.ACT = WSP(unsigned char, WS_ACT); P.W = WSP(unsigned char, WS_WDN) + (size_t)l * 32 * 1024 * 1024; P.bdn = INP(18) + (size_t)l * 32 * 1024; P.YE = WSP(bf16_t, WS_YE);
            P.tstart = (const volatile LAS int*)(F.lds + LDS_MISC + 64); P.G = F.G; P.c = F.bid;
            g8::gemm_run(F.lds, P); SEAM(pb + 8);
        }
    }
#ifdef STOP_PH
    if (IN(PH_FINAL)) { LAUNDER(F);
        const size_t n = (size_t)TX * 1024;
        for (size_t i = (size_t)F.bid * 512 + F.tid; i < n; i += (size_t)F.G * 512) {
            F.out[i] = DUMP_EXPR(i);
        } }
#else
    if (PHON(10) && IN(PH_FINAL)) for (int rep = 0; rep < NREP(10); ++rep) { LAUNDER(F); norm1_phase(F, DEPTH); if (rep + 1 < NREP(10)) xcd_barrier(bar); }
#endif
#undef IN
#undef SEAM
}

extern "C" void kernel_launch(void* const* d_in, const int* in_sizes, int n_in, void* d_out, int out_size, void* d_ws, size_t ws_size, hipStream_t stream) {
    static int grid = 0;
    if (grid == 0) {
        if (n_in != 20 || ws_size < WS_END) { fprintf(stderr, "kernel_launch: bad arguments (n_in %d, ws %zu < %zu)\n", n_in, ws_size, (size_t)WS_END); grid = -1; return; }
        int dev = 0, cus = 0, per_cu = 0;
        if (hipGetDevice(&dev) != hipSuccess || hipDeviceGetAttribute(&cus, hipDeviceAttributeMultiprocessorCount, dev) != hipSuccess) { grid = -1; return; }
        if (hipFuncSetAttribute((const void*)fwd_kernel, hipFuncAttributeMaxDynamicSharedMemorySize, LDS_BYTES) != hipSuccess) { fprintf(stderr, "kernel_launch: hipFuncSetAttribute failed\n"); grid = -1; return; }
        if (hipOccupancyMaxActiveBlocksPerMultiprocessor(&per_cu, (const void*)fwd_kernel, 512, LDS_BYTES) != hipSuccess || per_cu < 1) { fprintf(stderr, "kernel_launch: occupancy query says %d\n", per_cu); }
        (void)hipGetLastError();
        grid = cus;
    }
    if (grid < 0) return;
    (void)hipMemsetAsync((char*)d_ws + WS_CTL, 0, CTL_BYTES, stream);
    Args a{};
    for (int i = 0; i < 20; ++i) a.in[i] = (const float*)d_in[i];
    a.out = (float*)d_out; a.ws = (unsigned char*)d_ws;
#if N_LAUNCH_MODE == 1
    a.ph_lo = 0; a.ph_hi = PH_COUNT;
    hipLaunchKernelGGL(fwd_kernel, dim3(grid), dim3(512), LDS_BYTES, stream, a);
#else
    for (int p = 0; p < PH_COUNT; ++p) { a.ph_lo = p; a.ph_hi = p + 1; hipLaunchKernelGGL(fwd_kernel, dim3(grid), dim3(512), LDS_BYTES, stream, a); }
#endif
    (void)in_sizes; (void)out_size;
}
```

```cpp
#include <hip/hip_runtime.h>
#include <cstdio>
#include <cstdint>

#define LAS __attribute__((address_space(3)))
#define GAS __attribute__((address_space(1)))
typedef unsigned short bf16_t;
typedef short bf16x8 __attribute__((ext_vector_type(8)));
typedef short s16x4 __attribute__((ext_vector_type(4)));
typedef float f32x4 __attribute__((ext_vector_type(4)));
typedef float f32x16 __attribute__((ext_vector_type(16)));
typedef unsigned u32x4 __attribute__((ext_vector_type(4)));
typedef unsigned u32x2 __attribute__((ext_vector_type(2)));
typedef int i32x4 __attribute__((ext_vector_type(4)));
typedef int i32x8 __attribute__((ext_vector_type(8)));

#ifndef N_LAUNCH_MODE
#define N_LAUNCH_MODE 1
#endif
#ifndef DBG_CHECK
#define DBG_CHECK 0
#endif
#ifndef EMU8
#define EMU8 false
#endif
#ifndef STG_DN
#define STG_DN 0
#endif
#ifndef STG_GU
#define STG_GU 0
#endif
#ifndef STG_IN
#define STG_IN 0
#endif
#ifndef NLAYERS_RUN
#define NLAYERS_RUN 4
#endif

constexpr int D = 1024, NB = 4, SEQ = 8192, TX = NB * SEQ, LC = 256, TC = NB * LC, TT = TX + TC, DEPTH = 4;
constexpr int IN_DIM = 3328, NEXP = 32;
constexpr int ROWS_MAX = TT * 4 + NEXP * 256;
constexpr float LOG2E = 1.4426950408889634f;
constexpr float QSCALE = 0.125f * LOG2E;
constexpr float EPS = 1e-5f;
constexpr float SOFT_C = 16.0f;

constexpr size_t al256(size_t x) { return (x + 255) & ~(size_t)255; }
constexpr size_t WS_CTL = 0;
constexpr size_t CTL_BYTES = 65536;
constexpr size_t CTL_CNT = 16384;
constexpr size_t WS_MOD = WS_CTL + CTL_BYTES;
constexpr size_t WS_ROPE = WS_MOD + al256((size_t)DEPTH * 5 * 6144 * 4);
constexpr size_t WS_W1 = WS_ROPE + 16384;
constexpr size_t WS_MT = WS_W1 + 256 * 128 * 2;
constexpr size_t WS_WC = WS_MT + (size_t)64 * 256 * 128 * 2;
constexpr size_t WS_RWT = WS_WC + 512 * 256 * 2;
constexpr size_t WS_WIN = WS_RWT + (size_t)DEPTH * 32 * 1024 * 2;
constexpr size_t WS_SWIN = WS_WIN + (size_t)DEPTH * IN_DIM * 1024;
constexpr size_t WS_WFO = WS_SWIN + al256((size_t)DEPTH * IN_DIM * 4);
constexpr size_t WS_WAO = WS_WFO + (size_t)DEPTH * 1024 * 1024 * 2;
constexpr size_t WS_WOUT = WS_WAO + (size_t)DEPTH * 1024 * 512 * 2;
constexpr size_t WS_WGU = WS_WOUT + (size_t)DEPTH * 1024 * 1024 * 2;
constexpr size_t WS_SWGU = WS_WGU + (size_t)DEPTH * 32 * 2048 * 1024;
constexpr size_t WS_WDN = WS_SWGU + (size_t)DEPTH * 32 * 2048 * 4;
constexpr size_t WS_H = WS_WDN + (size_t)DEPTH * 32 * 1024 * 1024 * 2;
constexpr size_t WS_FT = WS_H + (size_t)(TT + 256) * 1024 * 2;
constexpr size_t WS_FCT = WS_FT + (size_t)131072 * 128 * 2;
constexpr size_t WS_Q = WS_FCT + (size_t)2048 * 256 * 2;
constexpr size_t WS_K = WS_Q + (size_t)TT * 512 * 2;
constexpr size_t WS_V = WS_K + (size_t)TT * 128 * 2;
constexpr size_t WS_GF = WS_V + (size_t)TT * 128 * 2;
constexpr size_t WS_GA = WS_GF + (size_t)TT * 1024 * 2;
constexpr size_t WS_T1 = WS_GA + (size_t)TT * 1024 * 2;
constexpr size_t WS_XS = WS_T1 + (size_t)64 * 2048 * 128 * 2;
constexpr size_t WS_AO = WS_XS + (size_t)TT * 1024 * 2;
constexpr size_t WS_YB = WS_AO + (size_t)TT * 512 * 2;
constexpr size_t WS_XW = WS_YB + (size_t)TT * 1024 * 2;
constexpr size_t WS_CW = WS_XW + (size_t)TX * 1024 * 4;
constexpr size_t WS_ACT = WS_CW + (size_t)TC * 1024 * 4;
constexpr size_t WS_YE = WS_ACT + (size_t)ROWS_MAX * 1024 * 2;
constexpr size_t WS_LIST = WS_YE + (size_t)ROWS_MAX * 1024 * 2;
constexpr size_t WS_SLOT = WS_LIST + (size_t)32 * TT * 4;
constexpr size_t WS_GATE = WS_SLOT + (size_t)TT * 4 * 4;
constexpr size_t WS_H8 = WS_GATE + (size_t)TT * 4 * 4;
constexpr size_t WS_LSC = WS_H8 + (size_t)(TT + 256) * 1024;
constexpr size_t WS_SH = WS_LSC + (size_t)32 * TT * 4;
constexpr size_t WS_END = WS_SH + (size_t)(TT + 256) * 4;

constexpr int LDS_STAGE = 131072;
constexpr int LDS_MISC = LDS_STAGE;
constexpr int LDS_ROPE = LDS_MISC + 4096;
constexpr int LDS_BYTES = 163840;

typedef __bf16 bf16v2_t __attribute__((ext_vector_type(2)));
typedef float f32x2_t __attribute__((ext_vector_type(2)));
__device__ __forceinline__ unsigned cvt_pk_bf16(float lo, float hi) { const f32x2_t v = {lo, hi}; const bf16v2_t b = __builtin_convertvector(v, bf16v2_t); return __builtin_bit_cast(unsigned, b); }
__device__ __forceinline__ float q8(float x) { const int p = __builtin_amdgcn_cvt_pk_fp8_f32(x, 0.f, 0, false); return __builtin_amdgcn_cvt_f32_fp8(p, 0); }
__device__ __forceinline__ unsigned pk4_fp8(float a, float b, float c, float d) { int p = __builtin_amdgcn_cvt_pk_fp8_f32(a, b, 0, false); p = __builtin_amdgcn_cvt_pk_fp8_f32(c, d, p, true); return (unsigned)p; }
__device__ __forceinline__ float clamp8(float x) { return __builtin_amdgcn_fmed3f(x, -448.0f, 448.0f); }
__device__ __forceinline__ u32x2 pack8_fp8(const f32x4& v0, const f32x4& v1, float sc) { u32x2 w; w.x = pk4_fp8(clamp8(v0[0] * sc), clamp8(v0[1] * sc), clamp8(v0[2] * sc), clamp8(v0[3] * sc)); w.y = pk4_fp8(clamp8(v1[0] * sc), clamp8(v1[1] * sc), clamp8(v1[2] * sc), clamp8(v1[3] * sc)); return w; }
__device__ __forceinline__ bf16_t f2bf(float f) { return (bf16_t)(cvt_pk_bf16(f, 0.f) & 0xffffu); }
__device__ __forceinline__ float bf_lo(unsigned u) { return __uint_as_float(u << 16); }
__device__ __forceinline__ float bf_hi(unsigned u) { return __uint_as_float(u & 0xffff0000u); }
__device__ __forceinline__ float bf2f(bf16_t b) { return __uint_as_float(((unsigned)b) << 16); }
__device__ __forceinline__ float sigmoidf_(float x) { return __builtin_amdgcn_rcpf(1.0f + __builtin_amdgcn_exp2f(-x * LOG2E)); }
__device__ __forceinline__ float wave_sum(float v) {
#pragma unroll
    for (int o = 32; o >= 1; o >>= 1) v += __shfl_xor(v, o);
    return v;
}

#define XB_TMO      128
#define XB_XCNT(j)  (256  + 64 * (j))
#define XB_XSUB(j)  (1280 + 64 * (j))
#define XB_XGEN(j)  (2304 + 64 * (j))
#define XB_TOP      3328
#define XB_TOPGEN   3392
#define XCD_BAR_WORDS 3456
#define XB_SPIN_CAP (1u << 22)

__device__ __forceinline__ unsigned xb_ld(unsigned* p)              { return __hip_atomic_load(p, __ATOMIC_RELAXED, __HIP_MEMORY_SCOPE_AGENT); }
__device__ __forceinline__ unsigned xb_add(unsigned* p, unsigned v) { return __hip_atomic_fetch_add(p, v, __ATOMIC_RELAXED, __HIP_MEMORY_SCOPE_AGENT); }
__device__ __forceinline__ unsigned xb_xcc_id() { return (unsigned)__builtin_amdgcn_s_getreg((3 << 11) | 20) & 0xFu; }
#define XB_SPIN(cond, bar) do { unsigned _sp = 0; while (cond) { __builtin_amdgcn_s_sleep(1); \
    if ((++_sp & 255u) == 0u) { if (xb_ld(&(bar)[XB_TMO])) break; if (_sp > XB_SPIN_CAP) { atomicAdd(&(bar)[XB_TMO], 1u); break; } } } } while (0)

struct XcdBarrier { unsigned* bar; unsigned x; volatile LAS unsigned* st; };

__device__ __forceinline__ XcdBarrier xcd_barrier_post(unsigned* bar, volatile LAS unsigned* st) {
    XcdBarrier b; b.bar = bar; b.x = xb_xcc_id(); b.st = st;
    if (threadIdx.x == 0) (void)xb_add(&bar[XB_XCNT(b.x)], 1u);
    return b;
}
__device__ __forceinline__ void xcd_barrier_complete(unsigned* bar, unsigned x, unsigned& nloc, unsigned& nx) {
    const unsigned G = gridDim.x * gridDim.y * gridDim.z;
    unsigned sum, cnt, mine, sp = 0u;
    for (;;) {
        sum = 0u; cnt = 0u; mine = 0u;
#pragma unroll
        for (unsigned j = 0; j < 16; ++j) { const unsigned c = xb_ld(&bar[XB_XCNT(j)]); sum += c; cnt += (c > 0u) ? 1u : 0u; mine = (j == x) ? c : mine; }
        if (sum == G) break;
        __builtin_amdgcn_s_sleep(1);
        if ((++sp & 255u) == 0u) { if (xb_ld(&bar[XB_TMO])) break; if (sp > XB_SPIN_CAP) { atomicAdd(&bar[XB_TMO], 1u); break; } }
    }
    nloc = mine > 0u ? mine : 1u; nx = cnt > 0u ? cnt : 1u;
}
__device__ __forceinline__ void xcd_barrier(const XcdBarrier& b) {
    asm volatile("s_waitcnt vmcnt(0)" ::: "memory");
    __syncthreads();
    if (threadIdx.x == 0) {
        unsigned* bar = b.bar;
        __builtin_amdgcn_s_waitcnt(0);
        unsigned nloc = b.st[0], nx = b.st[1];
        if (nloc == 0u) { xcd_barrier_complete(bar, b.x, nloc, nx); b.st[0] = nloc; b.st[1] = nx; }
        const unsigned old = xb_add(&bar[XB_XSUB(b.x)], 1u);
        const unsigned gen = old / nloc;
        if (old + 1u == (gen + 1u) * nloc) {
            __builtin_amdgcn_fence(__ATOMIC_RELEASE, "agent");
            asm volatile("s_waitcnt vmcnt(0)" ::: "memory");
            const unsigned og = xb_add(&bar[XB_TOP], 1u);
            const unsigned tg = og / nx;
            if (og + 1u == (tg + 1u) * nx) xb_add(&bar[XB_TOPGEN], 1u);
            else XB_SPIN(xb_ld(&bar[XB_TOPGEN]) == tg, bar);
            __builtin_amdgcn_fence(__ATOMIC_ACQUIRE, "agent");
            xb_add(&bar[XB_XGEN(b.x)], 1u);
            asm volatile("s_waitcnt vmcnt(0)" ::: "memory");
        } else {
            XB_SPIN(xb_ld(&bar[XB_XGEN(b.x)]) == gen, bar);
            __builtin_amdgcn_fence(__ATOMIC_ACQUIRE, "agent");
            asm volatile("s_waitcnt vmcnt(0)" ::: "memory");
        }
    }
    __syncthreads();
}

struct Fr {
    LAS unsigned char* lds;
    unsigned char* ws;
    float* out;
    int tid, lane, wave, G, bid;
};
__device__ __forceinline__ const float* in_ptr(const Fr& F, int i) {
    volatile LAS unsigned* p = (volatile LAS unsigned*)(F.lds + 131072 + 512) + 2 * i;
    const unsigned lo = __builtin_amdgcn_readfirstlane(p[0]), hi = __builtin_amdgcn_readfirstlane(p[1]);
    return (const float*)(GAS const float*)(((unsigned long long)hi << 32) | lo);
}
#define INP(i) in_ptr(F, (i))
#define LAUNDER(F) do { GAS unsigned char* _w = (GAS unsigned char*)(F).ws; asm volatile("" : "+s"(_w)); (F).ws = (unsigned char*)_w;     int _t = threadIdx.x; asm volatile("" : "+v"(_t)); (F).tid = _t; (F).lane = _t & 63; (F).wave = __builtin_amdgcn_readfirstlane(_t >> 6); } while (0)
#define WSP(T, off) ((T*)(F.ws + (off)))

namespace g8 {
constexpr int BM = 256, BK = 64, HALF = 128, HTB = HALF * BK * 2, NXCD = 8, WGM = 8;
__device__ __forceinline__ int lds_byte(int r, int c) { const int st = (r >> 4) * 2 + (c >> 5), rr = r & 15, cc = c & 31, ob = rr * 64 + cc * 2; return st * 1024 + (ob ^ (((ob >> 9) & 1) << 5)); }
__device__ __forceinline__ void stage_rc(int b, int& R, int& C) { const int st = b / 1024, sb = b % 1024, swz = sb ^ (((sb >> 9) & 1) << 5); R = (st >> 1) * 16 + swz / 64; C = (st & 1) * 32 + (swz % 64) / 2; }
__device__ __forceinline__ int perm32(int rho) { const int n = rho >> 4, i = rho & 15; return 8 * (i >> 2) + 4 * n + (i & 3); }
template <int NN>
__device__ __forceinline__ void order2d_c(int L, int nM, int& pm, int& pn) {
    const int nwg = nM * NN;
    int wgid = L; { const int q = nwg >> 3, r = nwg & 7, xcd = wgid & 7, off = wgid >> 3; wgid = (xcd < r ? xcd * (q + 1) : r * (q + 1) + (xcd - r) * q) + off; }
    constexpr int nig = WGM * NN; const int gid = wgid / nig, x = wgid - gid * nig, fm = gid * WGM, gsz = (nM - fm) < WGM ? (nM - fm) : WGM;
    if (gsz == WGM) { pm = fm + (x & 7); pn = x >> 3; } else { pm = fm + (x % gsz); pn = x / gsz; }
}
__device__ __forceinline__ void order2d(int L, int nM, int nN, int& pm, int& pn) {
    if (nN == 4) order2d_c<4>(L, nM, pm, pn); else if (nN == 8) order2d_c<8>(L, nM, pm, pn); else order2d_c<11>(L, nM, pm, pn);
}
__device__ __forceinline__ void lane_geom(int tid, int& R0, int& Rb0, int& C0) { asm volatile("" : "+v"(tid)); stage_rc(tid * 16, R0, C0); Rb0 = (R0 & ~31) + perm32(R0 & 31); }

__device__ __forceinline__ void lane_geom_w(int tid, int& R0, int& Rbw, int& C0) { asm volatile("" : "+v"(tid)); stage_rc(tid * 16, R0, C0); const int i = R0 & 31; Rbw = 64 * (R0 >> 5) + 16 * ((i >> 2) & 3) + 4 * (i >> 4) + (i & 3); }
#define G8_DBW(j) (128 * ((j) & 1) + 8 * ((j) >> 1))
#define G8_COLW(bj) (64 * wc + 16 * fq + 8 * (bj))
#define G8_ROWS(ai, m) (128 * (ai) + 64 * wr + 16 * (m) + fr)
#define G8_COL0(bj) (128 * (bj) + 32 * wc + 8 * fq)
#define G8_GOFF(pm, pn4, ai, m) (((size_t)((pm) * 4 + (pn4)) * 8 + (wr * 4 + wc)) * 8192 + ((ai) * 4 + (m)) * 1024 + (fq * 16 + fr) * 16)

template <bool I8> __device__ __forceinline__ f32x4 mma1(const bf16x8& b, const bf16x8& a, const f32x4& c) { return __builtin_amdgcn_mfma_f32_16x16x32_bf16(b, a, c, 0, 0, 0); }
template <bool I8> __device__ __forceinline__ i32x4 mma1(const bf16x8& b, const bf16x8& a, const i32x4& c) { return __builtin_amdgcn_mfma_i32_16x16x64_i8(__builtin_bit_cast(i32x4, b), __builtin_bit_cast(i32x4, a), c, 0, 0, 0); }
__device__ __forceinline__ f32x4 mma8(const bf16x8& b0, const bf16x8& b1, const bf16x8& a0, const bf16x8& a1, const f32x4& c) {
    const i32x4 B0 = __builtin_bit_cast(i32x4, b0), B1 = __builtin_bit_cast(i32x4, b1), A0 = __builtin_bit_cast(i32x4, a0), A1 = __builtin_bit_cast(i32x4, a1);
    const i32x8 B = {B0[0], B0[1], B0[2], B0[3], B1[0], B1[1], B1[2], B1[3]}, A = {A0[0], A0[1], A0[2], A0[3], A1[0], A1[1], A1[2], A1[3]};
    return __builtin_amdgcn_mfma_scale_f32_16x16x128_f8f6f4(B, A, c, 0, 0, 0, 0x7F7F7F7F, 0, 0x7F7F7F7F);
}
template <class P>
__device__ __forceinline__ void gemm_run(LAS unsigned char* lds, P& prob, int stagger = 0) {
    if (stagger > 0) { const unsigned long long t0 = __builtin_amdgcn_s_memrealtime(); while ((int)(__builtin_amdgcn_s_memrealtime() - t0) < stagger) __builtin_amdgcn_s_sleep(16); }
    int tid = threadIdx.x; asm volatile("" : "+v"(tid));
    const int wid = __builtin_amdgcn_readfirstlane(tid >> 6), lane = tid & 63, wr = wid >> 2, wc = wid & 3, fr = lane & 15, fq = lane >> 4;
    const size_t kstep = (size_t)(BK * 2);
    const unsigned ldsw = (unsigned)wid * 1024u;
    const int aoff = lds_byte(wr * 64 + fr, fq * 8), boff = lds_byte(wc * 32 + fr, fq * 8);
#define G8_SA(b, h) (((b) * 2 + (h)) * HTB)
#define G8_SB(b, h) ((4 + (b) * 2 + (h)) * HTB)
#define G8_STAGE_(bufoff, g0, o0, g1, o1) do { \
        __builtin_amdgcn_global_load_lds((const unsigned*)((const char*)(g0) + (o0)), (LAS unsigned*)(lds + (bufoff) + ldsw), 16, 0, 0); \
        __builtin_amdgcn_global_load_lds((const unsigned*)((const char*)(g1) + (o1)), (LAS unsigned*)(lds + (bufoff) + ldsw + 8192), 16, 0, 0); } while (0)
#define G8_OA(j) (P::GATHER_A ? oa[j] : oa[0])
#define G8_STA(bufoff, gbase, h) G8_STAGE_(bufoff, (gbase) + dA[2 * (h)], G8_OA(2 * (h)), (gbase) + dA[2 * (h) + 1], G8_OA(2 * (h) + 1))
#define G8_STB(bufoff, gbase, h) G8_STAGE_(bufoff, (gbase) + dB[2 * (h)], ob, (gbase) + dB[2 * (h) + 1], ob)
#define G8_LDA(dst, b, h) do { _Pragma("unroll") for (int m = 0; m < 4; ++m) _Pragma("unroll") for (int k = 0; k < 2; ++k) dst[m][k] = *(const LAS bf16x8*)(lds + G8_SA(b, h) + aoff + m * 2048 + k * 1024); } while (0)
#define G8_LDB(dst, b, h) do { _Pragma("unroll") for (int n = 0; n < 2; ++n) _Pragma("unroll") for (int k = 0; k < 2; ++k) dst[n][k] = *(const LAS bf16x8*)(lds + G8_SB(b, h) + boff + n * 2048 + k * 1024); } while (0)
#define G8_MMA(ai, bj, At, Bt) do { __builtin_amdgcn_s_setprio(1); \
        if constexpr (P::F8) { _Pragma("unroll") for (int m = 0; m < 4; ++m) _Pragma("unroll") for (int n = 0; n < 2; ++n) acc[ai][bj][m][n] = mma8(Bt[n][0], Bt[n][1], At[m][0], At[m][1], acc[ai][bj][m][n]); } \
        else { _Pragma("unroll") for (int m = 0; m < 4; ++m) _Pragma("unroll") for (int n = 0; n < 2; ++n) _Pragma("unroll") for (int k = 0; k < 2; ++k) \
        acc[ai][bj][m][n] = mma1<P::I8>(Bt[n][k], At[m][k], acc[ai][bj][m][n]); } __builtin_amdgcn_s_setprio(0); } while (0)
#define G8_WAIT_V(n) asm volatile("s_waitcnt vmcnt(" #n ")" ::: "memory")
#define G8_WAIT_L(n) asm volatile("s_waitcnt lgkmcnt(" #n ")" ::: "memory")
#define G8_BAR __builtin_amdgcn_s_barrier()
#define G8_SCHED __builtin_amdgcn_sched_barrier(0)
    typename P::U cur, nxt; int ui = 0;
    if (!prob.get(0, cur)) return;
    typedef typename P::Acc Acc;
    Acc acc[2][2][4][2];
#pragma unroll
    for (int a = 0; a < 2; ++a)
#pragma unroll
        for (int b = 0; b < 2; ++b)
#pragma unroll
            for (int m = 0; m < 4; ++m)
#pragma unroll
                for (int n = 0; n < 2; ++n) acc[a][b][m][n] = (Acc){0, 0, 0, 0};
    bf16x8 At[4][2], B0[2][2], B1[2][2];
    unsigned oa[4], ob, dA[4], dB[4]; const char* cA; const char* cB; int nt;
    prob.setup(cur, oa, ob, dA, dB, cA, cB, nt);
    G8_STB(G8_SB(0, 0), cB, 0); G8_STA(G8_SA(0, 0), cA, 0); G8_STB(G8_SB(0, 1), cB, 1); G8_STA(G8_SA(0, 1), cA, 1);
    if (wr == 1) G8_BAR;
    G8_WAIT_V(4); G8_BAR;
    G8_STB(G8_SB(1, 0), cB + kstep, 0); G8_STA(G8_SA(1, 0), cA + kstep, 0); G8_STB(G8_SB(1, 1), cB + kstep, 1);
    G8_WAIT_V(6); G8_BAR;
    for (;;) {
        const bool has_next = prob.get(ui + 1, nxt);
        int nnt = nt;
#pragma unroll 1
        for (int t = 0; t < nt; t += 2) {
            const bool last = (t == nt - 2);
            G8_LDB(B0, 0, 0); G8_SCHED; G8_LDA(At, 0, 0); G8_STA(G8_SA(1, 1), cA + (size_t)(t + 1) * kstep, 1);
            G8_WAIT_L(8); G8_BAR; G8_WAIT_L(0); G8_MMA(0, 0, At, B0); G8_BAR; G8_SCHED;
            const char* a2; const char* b2;
            if (last) { if (has_next) { prob.setup(nxt, oa, ob, dA, dB, cA, cB, nnt); } a2 = cA; b2 = cB; }
            else { a2 = cA + (size_t)(t + 2) * kstep; b2 = cB + (size_t)(t + 2) * kstep; }
            const char* a3 = a2 + kstep; const char* b3 = b2 + kstep;
            G8_LDB(B1, 0, 1); G8_STB(G8_SB(0, 0), b2, 0);
            G8_BAR; G8_WAIT_L(0); G8_MMA(0, 1, At, B1); G8_BAR;
            G8_LDA(At, 0, 1); G8_STA(G8_SA(0, 0), a2, 0);
            G8_BAR; G8_WAIT_L(0); G8_MMA(1, 0, At, B0); G8_BAR; G8_SCHED;
            G8_STB(G8_SB(0, 1), b2, 1);
            G8_WAIT_V(6); G8_BAR; G8_MMA(1, 1, At, B1); G8_BAR;
            G8_LDB(B0, 1, 0); G8_SCHED; G8_LDA(At, 1, 0); G8_STA(G8_SA(0, 1), a2, 1);
            G8_WAIT_L(8); G8_BAR; G8_WAIT_L(0); G8_MMA(0, 0, At, B0); G8_BAR; G8_SCHED;
            G8_LDB(B1, 1, 1); G8_STB(G8_SB(1, 0), b3, 0);
            G8_BAR; G8_WAIT_L(0); G8_MMA(0, 1, At, B1); G8_BAR;
            G8_LDA(At, 1, 1); G8_STA(G8_SA(1, 0), a3, 0);
            G8_BAR; G8_WAIT_L(0); G8_MMA(1, 0, At, B0); G8_BAR; G8_SCHED;
            G8_STB(G8_SB(1, 1), b3, 1);
            G8_WAIT_V(6); G8_BAR; G8_MMA(1, 1, At, B1); G8_BAR;
            if (last) break;
        }
        bool keep = false;
        { int t2 = threadIdx.x; asm volatile("" : "+v"(t2)); const int l2 = t2 & 63;
          if constexpr (P::HAS_MID) { if (prob.is_mid(cur)) { prob.mid(acc, cur, wr, wc, l2 & 15, l2 >> 4); keep = true; } else prob.epi(acc, cur, wr, wc, l2 & 15, l2 >> 4); }
          else prob.epi(acc, cur, wr, wc, l2 & 15, l2 >> 4); }
        if (!has_next) break;
        if (!keep)
#pragma unroll
        for (int a = 0; a < 2; ++a)
#pragma unroll
            for (int b = 0; b < 2; ++b)
#pragma unroll
                for (int m = 0; m < 4; ++m)
#pragma unroll
                    for (int n = 0; n < 2; ++n) acc[a][b][m][n] = (Acc){0, 0, 0, 0};
        cur = nxt; nt = nnt; ++ui;
    }
    G8_WAIT_V(0);
    if (wr == 0) G8_BAR;
    G8_BAR;
}
}

__device__ __forceinline__ u32x4 pack8(const f32x4& v0, const f32x4& v1) {
    u32x4 w; w.x = cvt_pk_bf16(v0[0], v0[1]); w.y = cvt_pk_bf16(v0[2], v0[3]); w.z = cvt_pk_bf16(v1[0], v1[1]); w.w = cvt_pk_bf16(v1[2], v1[3]); return w;
}
__device__ __forceinline__ void unpack8(const u32x4& w, f32x4& v0, f32x4& v1) {
    v0 = (f32x4){bf_lo(w.x), bf_hi(w.x), bf_lo(w.y), bf_hi(w.y)}; v1 = (f32x4){bf_lo(w.z), bf_hi(w.z), bf_lo(w.w), bf_hi(w.w)};
}

__device__ __forceinline__ void unpack8u(const u32x2& w, f32x4& v0, f32x4& v1) {
    const float k = 1.0f / 255.0f;
    v0 = (f32x4){(float)(w.x & 255u) * k, (float)((w.x >> 8) & 255u) * k, (float)((w.x >> 16) & 255u) * k, (float)(w.x >> 24) * k};
    v1 = (f32x4){(float)(w.y & 255u) * k, (float)((w.y >> 8) & 255u) * k, (float)((w.y >> 16) & 255u) * k, (float)(w.y >> 24) * k};
}
template <int WHICH> struct InProjProb {
    static constexpr bool PERM = true, GATHER_A = false, I8 = true, F8 = false, HAS_MID = false; typedef i32x4 Acc;
    struct U { int kind, pm, pn, b, j; };
    const signed char* H; const signed char* W; const float* sH; const float* sW;
    bf16_t *FT, *FCT, *Q, *Kb, *Vb, *GF, *GA; const LAS float* rope;
    int nM, n_nat, n_fx, n_fc, n_extra, G, c;
    __device__ __forceinline__ bool get(int i, U& u) const {
        const int L = i * G + c;
        if (WHICH == 0) {
            if (L >= n_nat + n_extra) return false;
            const bool nat = L < n_nat;
            int pm, pn; g8::order2d(nat ? L : 0, nM, 11, pm, pn);
            u.kind = 2; u.pm = __builtin_amdgcn_readfirstlane(nat ? pm : (128 + L - n_nat)); u.pn = __builtin_amdgcn_readfirstlane(nat ? (pn + 2) : 4); u.b = 0; u.j = 0;
            return true;
        } else {
            if (L >= n_fx + n_fc) return false;
            const bool fx = L < n_fx; const int L2 = L - n_fx;
            u.kind = __builtin_amdgcn_readfirstlane(fx ? 0 : 1); u.b = __builtin_amdgcn_readfirstlane(fx ? (L >> 6) : (L2 >> 1)); u.j = __builtin_amdgcn_readfirstlane(fx ? ((L & 63) >> 1) : 0); u.pn = __builtin_amdgcn_readfirstlane(fx ? (L & 1) : (L2 & 1)); u.pm = 0;
            return true;
        }
    }
    __device__ __forceinline__ void setup(const U& u, unsigned (&oa)[4], unsigned& ob, unsigned (&dA)[4], unsigned (&dB)[4], const char*& pA, const char*& pB, int& nt) const {
        int R0, Rb0, C0; g8::lane_geom(threadIdx.x, R0, Rb0, C0);
        nt = 8;
#pragma unroll
        for (int j = 0; j < 4; ++j) { dA[j] = (unsigned)(64 * j * 1024); dB[j] = dA[j]; }
        if (WHICH == 0) {
            pA = (const char*)H; pB = (const char*)W;
            oa[0] = (unsigned)((256 * u.pm + R0) * 1024 + C0 * 2); ob = (unsigned)((256 * u.pn + Rb0) * 1024 + C0 * 2);
        } else {
            pA = (const char*)W; pB = (const char*)H;
            oa[0] = (unsigned)((256 * u.pn + R0) * 1024 + C0 * 2);
            if (u.kind == 0) { ob = (unsigned)((u.b * SEQ + 64 * Rb0 + 2 * u.j) * 1024 + C0 * 2);
                dB[1] = (unsigned)(64 * 64 * 1024); dB[2] = 1024u; dB[3] = dB[1] + 1024u; }
            else ob = (unsigned)((TX + u.b * LC + Rb0) * 1024 + C0 * 2);
        }
    }
    __device__ __forceinline__ void epi(const i32x4 (&acc)[2][2][4][2], const U& u, int wr, int wc, int fr, int fq) const {
        if (WHICH == 0) {
            f32x4 sw[2][2];
#pragma unroll
            for (int bj = 0; bj < 2; ++bj) { const float* sp = sW + 256 * u.pn + G8_COL0(bj); sw[bj][0] = *(const f32x4*)sp; sw[bj][1] = *(const f32x4*)(sp + 4); }
            float rsv[2][4];
#pragma unroll
            for (int ai = 0; ai < 2; ++ai)
#pragma unroll
                for (int m = 0; m < 4; ++m) rsv[ai][m] = sH[256 * u.pm + G8_ROWS(ai, m)];
            if (u.pn >= 5) {
                unsigned char* dst = (unsigned char*)((u.pn >= 9) ? GA : GF); const int cb = (u.pn >= 9) ? u.pn - 9 : u.pn - 5;
                f32x2_t fc[2][4];
#pragma unroll
                for (int bj = 0; bj < 2; ++bj)
#pragma unroll
                    for (int q = 0; q < 4; ++q) fc[bj][q] = (f32x2_t){sw[bj][q >> 1][2 * (q & 1)], sw[bj][q >> 1][2 * (q & 1) + 1]} * (-LOG2E);
#pragma unroll
                for (int ai = 0; ai < 2; ++ai)
#pragma unroll
                    for (int m = 0; m < 4; ++m) { const f32x2_t rs2 = {rsv[ai][m], rsv[ai][m]}; u32x4 w4;
#pragma unroll
                        for (int bj = 0; bj < 2; ++bj) { u32x2 w = {0u, 0u};
#pragma unroll
                            for (int q = 0; q < 4; ++q) { const int n = q >> 1, e0 = 2 * (q & 1);
                                const f32x2_t a = {(float)acc[ai][bj][m][n][e0], (float)acc[ai][bj][m][n][e0 + 1]};
                                const f32x2_t t = a * (rs2 * fc[bj][q]);
                                const f32x2_t d = (f32x2_t){__builtin_amdgcn_exp2f(t[0]), __builtin_amdgcn_exp2f(t[1])} + 1.0f;
                                const f32x2_t g = (f32x2_t){__builtin_amdgcn_rcpf(d[0]), __builtin_amdgcn_rcpf(d[1])} * 255.0f;
                                if (n == 0) { w.x = __builtin_amdgcn_cvt_pk_u8_f32(g[0], e0, w.x); w.x = __builtin_amdgcn_cvt_pk_u8_f32(g[1], e0 + 1, w.x); }
                                else        { w.y = __builtin_amdgcn_cvt_pk_u8_f32(g[0], e0, w.y); w.y = __builtin_amdgcn_cvt_pk_u8_f32(g[1], e0 + 1, w.y); } }
                            if (bj == 0) { w4.x = w.x; w4.y = w.y; } else { w4.z = w.x; w4.w = w.y; } }
                        *(u32x4*)(dst + G8_GOFF(u.pm, cb, ai, m)) = w4; }
            } else {
#pragma unroll
                for (int ai = 0; ai < 2; ++ai)
#pragma unroll
                    for (int m = 0; m < 4; ++m) { const int tok = 256 * u.pm + G8_ROWS(ai, m); const float rs = rsv[ai][m];
                        const bool isx = tok < TX; const int n = tok & (SEQ - 1); const int prow = n >> 6, pcol = n & 63;
#pragma unroll
                        for (int bj = 0; bj < 2; ++bj) { f32x4 v0, v1;
#pragma unroll
                            for (int e = 0; e < 4; ++e) { v0[e] = (float)acc[ai][bj][m][0][e] * rs * sw[bj][0][e]; v1[e] = (float)acc[ai][bj][m][1][e] * rs * sw[bj][1][e]; }
                            const int c0 = G8_COL0(bj);
                            const bool isv = (u.pn == 4) && (bj == 1);
                            if (!isv) {
                                const int dp = c0 & 63; const int axis = dp >> 5, f0 = (dp & 31) >> 1;
                                if (isx) {
                                    const int pos = axis ? pcol : prow;
                                    const f32x4 cs = *(const LAS f32x4*)(rope + pos * 16 + f0), sn = *(const LAS f32x4*)(rope + 2048 + pos * 16 + f0);
                                    f32x4 r0, r1;
                                    r0[0] = v0[0] * cs[0] - v0[1] * sn[0]; r0[1] = v0[1] * cs[0] + v0[0] * sn[0];
                                    r0[2] = v0[2] * cs[1] - v0[3] * sn[1]; r0[3] = v0[3] * cs[1] + v0[2] * sn[1];
                                    r1[0] = v1[0] * cs[2] - v1[1] * sn[2]; r1[1] = v1[1] * cs[2] + v1[0] * sn[2];
                                    r1[2] = v1[2] * cs[3] - v1[3] * sn[3]; r1[3] = v1[3] * cs[3] + v1[2] * sn[3];
                                    v0 = r0; v1 = r1;
                                }
                            }
                            if (u.pn < 4) { v0 *= QSCALE; v1 *= QSCALE; *(u32x4*)(Q + (size_t)tok * 512 + 256 * (u.pn - 2) + c0) = pack8(v0, v1); }
                            else if (!isv) { *(u32x4*)(Kb + (size_t)tok * 128 + c0) = pack8(v0, v1); }
                            else { *(u32x4*)(Vb + (size_t)tok * 128 + (c0 - 128)) = pack8(v0, v1); }
                        } }
            }
        } else {
            f32x4 st[2][2];
#pragma unroll
            for (int bj = 0; bj < 2; ++bj) { const int c0 = G8_COL0(bj);
                if (u.kind == 0) { const float* tp = sH + (size_t)u.b * SEQ + 64 * (c0 & 127) + 2 * u.j + (c0 >> 7);
#pragma unroll
                    for (int e = 0; e < 4; ++e) { st[bj][0][e] = tp[64 * e]; st[bj][1][e] = tp[64 * (4 + e)]; } }
                else { const float* tp = sH + TX + u.b * LC + c0; st[bj][0] = *(const f32x4*)tp; st[bj][1] = *(const f32x4*)(tp + 4); } }
            float rsw[2][4];
#pragma unroll
            for (int ai = 0; ai < 2; ++ai)
#pragma unroll
                for (int m = 0; m < 4; ++m) rsw[ai][m] = sW[256 * u.pn + G8_ROWS(ai, m)];
#pragma unroll
            for (int ai = 0; ai < 2; ++ai)
#pragma unroll
                for (int m = 0; m < 4; ++m) { const int ch = 256 * u.pn + G8_ROWS(ai, m); const float rs = rsw[ai][m];
#pragma unroll
                    for (int bj = 0; bj < 2; ++bj) { const int c0 = G8_COL0(bj); f32x4 v0, v1;
#pragma unroll
                        for (int e = 0; e < 4; ++e) { v0[e] = (float)acc[ai][bj][m][0][e] * rs * st[bj][0][e]; v1[e] = (float)acc[ai][bj][m][1][e] * rs * st[bj][1][e]; }
                        const u32x4 w = pack8(v0, v1);
                        if (u.kind == 0) { const int n2 = 2 * u.j + (c0 >> 7), n1 = c0 & 127; *(u32x4*)(FT + ((size_t)(u.b * 512 + ch) * 64 + n2) * 128 + n1) = w; }
                        else *(u32x4*)(FCT + (size_t)(u.b * 512 + ch) * 256 + c0) = w;
                    } }
        }
    }
};

struct Fft1Prob {
    static constexpr bool PERM = true, GATHER_A = false, I8 = false, F8 = false, HAS_MID = false; typedef f32x4 Acc;
    struct U { int kind, pm, pn; };
    const bf16_t *W1, *FT, *WC, *FCT; bf16_t* T1; unsigned char* XS;
    int n0, n1, G, c;
    __device__ __forceinline__ bool get(int i, U& u) const {
        const int L = i * G + c;
        if (L >= n0 + n1) return false;
        const bool k0 = L < n0; const int L2 = L - n0;
        u.kind = __builtin_amdgcn_readfirstlane(k0 ? 0 : 1); u.pm = __builtin_amdgcn_readfirstlane(k0 ? 0 : (L2 & 1)); u.pn = __builtin_amdgcn_readfirstlane(k0 ? L : (L2 >> 1));
        return true;
    }
    __device__ __forceinline__ void setup(const U& u, unsigned (&oa)[4], unsigned& ob, unsigned (&dA)[4], unsigned (&dB)[4], const char*& pA, const char*& pB, int& nt) const {
        int R0, Rb0, C0; g8::lane_geom(threadIdx.x, R0, Rb0, C0);
        if (u.kind == 0) { nt = 2; pA = (const char*)W1; pB = (const char*)FT;
#pragma unroll
            for (int j = 0; j < 4; ++j) { dA[j] = (unsigned)(64 * j * 128) * 2u; dB[j] = dA[j]; }
            oa[0] = (unsigned)(R0 * 128 + C0) * 2u; ob = (unsigned)((256 * u.pn + Rb0) * 128 + C0) * 2u;
        } else { nt = 4; pA = (const char*)WC; pB = (const char*)FCT;
#pragma unroll
            for (int j = 0; j < 4; ++j) { dA[j] = (unsigned)(64 * j * 256) * 2u; dB[j] = dA[j]; }
            oa[0] = (unsigned)((256 * u.pm + R0) * 256 + C0) * 2u; ob = (unsigned)((256 * u.pn + Rb0) * 256 + C0) * 2u;
        }
    }
    __device__ __forceinline__ void epi(const f32x4 (&acc)[2][2][4][2], const U& u, int wr, int wc, int fr, int fq) const {
        if (u.kind == 0) {
#pragma unroll
            for (int m = 0; m < 4; ++m) { const int r = G8_ROWS(0, m); const int k1p = r >> 1, part = r & 1;
#pragma unroll
                for (int bj = 0; bj < 2; ++bj) { const int col = 256 * u.pn + G8_COL0(bj); const int bc = col >> 6, n2 = col & 63;
                    *(u32x4*)(T1 + (((size_t)k1p * 2048 + bc) * 2 + part) * 64 + n2) = pack8(acc[0][bj][m][0], acc[0][bj][m][1]); } }
        } else {
#pragma unroll
            for (int ai = 0; ai < 2; ++ai)
#pragma unroll
                for (int m = 0; m < 4; ++m) { const int r = 256 * u.pm + G8_ROWS(ai, m); const int k = r >> 1, reim = r & 1;
#pragma unroll
                    for (int bj = 0; bj < 2; ++bj) { const int bc = 256 * u.pn + G8_COL0(bj); const int b = bc >> 9, ch = bc & 511, g = ch >> 7, d = ch & 127;
                        *(u32x2*)(XS + (size_t)(TX + b * LC + k) * 1024 + g * 256 + reim * 128 + d) = pack8_fp8(acc[ai][bj][m][0], acc[ai][bj][m][1], 0.0625f); } }
        }
    }
};

struct Fft2Prob {
    static constexpr bool PERM = true, GATHER_A = false, I8 = false, F8 = false, HAS_MID = false; typedef f32x4 Acc;
    struct U { int k1p, pn; };
    const bf16_t *MT, *T1; unsigned char* XS; int G, c;
    __device__ __forceinline__ bool get(int i, U& u) const { const int L = i * G + c; if (c < 0 || L >= 512) return false; u.k1p = __builtin_amdgcn_readfirstlane(L >> 3); u.pn = __builtin_amdgcn_readfirstlane(L & 7); return true; }
    __device__ __forceinline__ void setup(const U& u, unsigned (&oa)[4], unsigned& ob, unsigned (&dA)[4], unsigned (&dB)[4], const char*& pA, const char*& pB, int& nt) const {
        int R0, Rb0, C0; g8::lane_geom_w(threadIdx.x, R0, Rb0, C0);
        nt = 2; pA = (const char*)MT; pB = (const char*)T1;
#pragma unroll
        for (int j = 0; j < 4; ++j) { dA[j] = (unsigned)(64 * j * 128) * 2u; dB[j] = (unsigned)(G8_DBW(j) * 128) * 2u; }
        oa[0] = (unsigned)((u.k1p * 256 + R0) * 128 + C0) * 2u; ob = (unsigned)((u.k1p * 2048 + 256 * u.pn + Rb0) * 128 + C0) * 2u;
    }
    __device__ __forceinline__ void epi(const f32x4 (&acc)[2][2][4][2], const U& u, int wr, int wc, int fr, int fq) const {
#pragma unroll
        for (int ai = 0; ai < 2; ++ai)
#pragma unroll
            for (int m = 0; m < 4; ++m) { const int r = G8_ROWS(ai, m); const int s = r >> 7, k2 = (r & 127) >> 1, reim = r & 1;
                const int kb = (u.k1p == 0) ? 64 * s : (s ? 128 - u.k1p : u.k1p); const int k = kb + 128 * k2;
                const int bc = 256 * u.pn + G8_COLW(0); const int b = bc >> 9, ch = bc & 511, g = ch >> 7, d = ch & 127;
                const u32x2 w0 = pack8_fp8(acc[ai][0][m][0], acc[ai][0][m][1], 0.0625f), w1 = pack8_fp8(acc[ai][1][m][0], acc[ai][1][m][1], 0.0625f);
                *(u32x4*)(XS + (size_t)(b * SEQ + k) * 1024 + g * 256 + reim * 128 + d) = (u32x4){w0.x, w0.y, w1.x, w1.y}; }
    }
};

template <int MODE> struct MergeProb {
    static constexpr bool PERM = true, GATHER_A = false, I8 = false, F8 = true, HAS_MID = false; typedef f32x4 Acc;
    struct U { int pm, pn; };
    const unsigned char* A; const unsigned char* W; int lda;
    const unsigned char* GATE; bf16_t* T; unsigned char* Y8;
    const float* xin; const float* cin; bf16_t* XWb; bf16_t* CWb; const float* g1x; const float* g1c; bool in32;
    int nM, G, c;
    __device__ __forceinline__ bool get(int i, U& u) const { const int L = i * G + c; if (L >= nM * 4) return false; int pm, pn; g8::order2d(L, nM, 4, pm, pn); u.pm = __builtin_amdgcn_readfirstlane(pm); u.pn = __builtin_amdgcn_readfirstlane(pn); return true; }
    __device__ __forceinline__ void setup(const U& u, unsigned (&oa)[4], unsigned& ob, unsigned (&dA)[4], unsigned (&dB)[4], const char*& pA, const char*& pB, int& nt) const {
        int R0, Rb0, C0; g8::lane_geom(threadIdx.x, R0, Rb0, C0);
        nt = lda >> 7; pA = (const char*)A; pB = (const char*)W;
#pragma unroll
        for (int j = 0; j < 4; ++j) { dA[j] = (unsigned)(64 * j * lda); dB[j] = dA[j]; }
        oa[0] = (unsigned)((256 * u.pm + R0) * lda + C0 * 2); ob = (unsigned)((256 * u.pn + Rb0) * lda + C0 * 2);
    }
    __device__ __forceinline__ void epi(const f32x4 (&acc)[2][2][4][2], const U& u, int wr, int wc, int fr, int fq) const {
        if (MODE == 0) {
#pragma unroll
            for (int ai = 0; ai < 2; ++ai) {
                u32x2 gt[4][2];
#pragma unroll
                for (int m = 0; m < 4; ++m)
#pragma unroll
                    for (int bj = 0; bj < 2; ++bj) gt[m][bj] = *(const u32x2*)(GATE + (size_t)(256 * u.pm + G8_ROWS(ai, m)) * 1024 + 256 * u.pn + G8_COL0(bj));
#pragma unroll
                for (int m = 0; m < 4; ++m)
#pragma unroll
                    for (int bj = 0; bj < 2; ++bj) { f32x4 g0, g1; unpack8u(gt[m][bj], g0, g1);
                        *(u32x4*)(T + (size_t)(256 * u.pm + G8_ROWS(ai, m)) * 1024 + 256 * u.pn + G8_COL0(bj)) = pack8(acc[ai][bj][m][0] * g0 * (1.0f / 512.0f), acc[ai][bj][m][1] * g1 * (1.0f / 512.0f)); }
            }
        } else if (MODE == 1) {
#pragma unroll
            for (int ai = 0; ai < 2; ++ai)
#pragma unroll
                for (int m = 0; m < 4; ++m) {
                    u32x2 gt[2]; u32x4 tt[2];
#pragma unroll
                    for (int bj = 0; bj < 2; ++bj) { const size_t o = (size_t)(256 * u.pm + G8_ROWS(ai, m)) * 1024 + 256 * u.pn + G8_COL0(bj); gt[bj] = *(const u32x2*)(GATE + o); tt[bj] = *(const u32x4*)(T + o); }
#pragma unroll
                    for (int bj = 0; bj < 2; ++bj) { const size_t o = (size_t)(256 * u.pm + G8_ROWS(ai, m)) * 1024 + 256 * u.pn + G8_COL0(bj);
                        f32x4 g0, g1, t0, t1; unpack8u(gt[bj], g0, g1); unpack8(tt[bj], t0, t1);
                        *(u32x2*)(Y8 + o) = pack8_fp8(acc[ai][bj][m][0] * g0 * (1.0f / 512.0f) + t0, acc[ai][bj][m][1] * g1 * (1.0f / 512.0f) + t1, 2.0f); }
                }
        } else {
            f32x4 gv[2][2];
            const bool isx = (256 * u.pm) < TX;
            { const float* gp = isx ? (g1x + ((256 * u.pm) >> 13) * 6144) : g1c;
#pragma unroll
              for (int bj = 0; bj < 2; ++bj) { gv[bj][0] = *(const f32x4*)(gp + 256 * u.pn + G8_COL0(bj)) * (1.0f / 64.0f); gv[bj][1] = *(const f32x4*)(gp + 256 * u.pn + G8_COL0(bj) + 4) * (1.0f / 64.0f); } }
            const size_t rbase = isx ? 0 : (size_t)TX;
            bf16_t* ob = isx ? XWb : CWb;
            if (in32) {
                const float* xb = isx ? xin : cin;
#pragma unroll
                for (int ai = 0; ai < 2; ++ai) {
                    f32x4 xv[4][2][2];
#pragma unroll
                    for (int m = 0; m < 4; ++m)
#pragma unroll
                        for (int bj = 0; bj < 2; ++bj) { const float* xp = xb + ((size_t)(256 * u.pm + G8_ROWS(ai, m)) - rbase) * 1024 + 256 * u.pn + G8_COL0(bj); xv[m][bj][0] = *(const f32x4*)xp; xv[m][bj][1] = *(const f32x4*)(xp + 4); }
#pragma unroll
                    for (int m = 0; m < 4; ++m)
#pragma unroll
                        for (int bj = 0; bj < 2; ++bj) { bf16_t* op = ob + ((size_t)(256 * u.pm + G8_ROWS(ai, m)) - rbase) * 1024 + 256 * u.pn + G8_COL0(bj);
                            *(u32x4*)op = pack8(xv[m][bj][0] + gv[bj][0] * acc[ai][bj][m][0], xv[m][bj][1] + gv[bj][1] * acc[ai][bj][m][1]); }
                }
            } else {
                u32x4 xw2[2][4][2];
#pragma unroll
                for (int ai = 0; ai < 2; ++ai)
#pragma unroll
                    for (int m = 0; m < 4; ++m)
#pragma unroll
                        for (int bj = 0; bj < 2; ++bj) xw2[ai][m][bj] = *(const u32x4*)(ob + ((size_t)(256 * u.pm + G8_ROWS(ai, m)) - rbase) * 1024 + 256 * u.pn + G8_COL0(bj));
#pragma unroll
                for (int ai = 0; ai < 2; ++ai)
#pragma unroll
                    for (int m = 0; m < 4; ++m)
#pragma unroll
                        for (int bj = 0; bj < 2; ++bj) { bf16_t* op = ob + ((size_t)(256 * u.pm + G8_ROWS(ai, m)) - rbase) * 1024 + 256 * u.pn + G8_COL0(bj);
                            f32x4 x0, x1; unpack8(xw2[ai][m][bj], x0, x1);
                            *(u32x4*)op = pack8(x0 + gv[bj][0] * acc[ai][bj][m][0], x1 + gv[bj][1] * acc[ai][bj][m][1]); }
            }
        }
    }
};

struct Merge1Prob {
    static constexpr bool PERM = true, GATHER_A = false, I8 = false, F8 = true, HAS_MID = true; typedef f32x4 Acc;
    struct U { int pm, pn, seg; };
    const unsigned char *XS, *AO, *WFO, *WAO, *GF, *GA; unsigned char* Y8; int nM, pm0, G, c;
    __device__ __forceinline__ bool get(int i, U& u) const { const int L = (i >> 1) * G + c; if (c < 0 || L >= nM * 4) return false; int pm, pn; g8::order2d(L, nM, 4, pm, pn);
        u.pm = __builtin_amdgcn_readfirstlane(pm + pm0); u.pn = __builtin_amdgcn_readfirstlane(pn); u.seg = i & 1; return true; }
    __device__ __forceinline__ bool is_mid(const U& u) const { return u.seg == 0; }
    __device__ __forceinline__ void setup(const U& u, unsigned (&oa)[4], unsigned& ob, unsigned (&dA)[4], unsigned (&dB)[4], const char*& pA, const char*& pB, int& nt) const {
        int R0, Rb0, C0; g8::lane_geom(threadIdx.x, R0, Rb0, C0);
        const int lda = u.seg ? 1024 : 512;
        nt = lda >> 7; pA = (const char*)(u.seg ? XS : AO); pB = (const char*)(u.seg ? WFO : WAO);
#pragma unroll
        for (int j = 0; j < 4; ++j) { dA[j] = (unsigned)(64 * j * lda); dB[j] = dA[j]; }
        oa[0] = (unsigned)((256 * u.pm + R0) * lda + C0 * 2); ob = (unsigned)((256 * u.pn + Rb0) * lda + C0 * 2);
    }
    __device__ __forceinline__ void mid(f32x4 (&acc)[2][2][4][2], const U& u, int wr, int wc, int fr, int fq) const {
#pragma unroll
        for (int ai = 0; ai < 2; ++ai) {
            u32x2 qf[4][2], qa[4][2];
#pragma unroll
            for (int m = 0; m < 4; ++m) { const size_t o = G8_GOFF(u.pm, u.pn, ai, m); const u32x4 f4 = *(const u32x4*)(GF + o), a4 = *(const u32x4*)(GA + o);
                qf[m][0] = (u32x2){f4.x, f4.y}; qf[m][1] = (u32x2){f4.z, f4.w}; qa[m][0] = (u32x2){a4.x, a4.y}; qa[m][1] = (u32x2){a4.z, a4.w}; }
#pragma unroll
            for (int m = 0; m < 4; ++m)
#pragma unroll
                for (int bj = 0; bj < 2; ++bj)
#pragma unroll
                    for (int n = 0; n < 2; ++n) { const unsigned wf = n ? qf[m][bj].y : qf[m][bj].x, wa = n ? qa[m][bj].y : qa[m][bj].x;
#pragma unroll
                        for (int e = 0; e < 4; ++e) { const float f = fmaxf((float)((wf >> (8 * e)) & 255u), 1.0f), a = (float)((wa >> (8 * e)) & 255u);
                            acc[ai][bj][m][n][e] *= a * __builtin_amdgcn_rcpf(f); } }
        }
    }
    __device__ __forceinline__ void epi(const f32x4 (&acc)[2][2][4][2], const U& u, int wr, int wc, int fr, int fq) const {
        u32x2 qf[2][4][2];
#pragma unroll
        for (int ai = 0; ai < 2; ++ai)
#pragma unroll
            for (int m = 0; m < 4; ++m) { const u32x4 f4 = *(const u32x4*)(GF + G8_GOFF(u.pm, u.pn, ai, m)); qf[ai][m][0] = (u32x2){f4.x, f4.y}; qf[ai][m][1] = (u32x2){f4.z, f4.w}; }
#pragma unroll
        for (int ai = 0; ai < 2; ++ai) {
#pragma unroll
            for (int m = 0; m < 4; ++m)
#pragma unroll
                for (int bj = 0; bj < 2; ++bj) { f32x4 v[2];
#pragma unroll
                    for (int n = 0; n < 2; ++n) { const unsigned wf = n ? qf[ai][m][bj].y : qf[ai][m][bj].x;
#pragma unroll
                        for (int e = 0; e < 4; ++e) v[n][e] = acc[ai][bj][m][n][e] * (fmaxf((float)((wf >> (8 * e)) & 255u), 1.0f) * (1.0f / (255.0f * 512.0f))); }
                    *(u32x2*)(Y8 + (size_t)(256 * u.pm + G8_ROWS(ai, m)) * 1024 + 256 * u.pn + G8_COL0(bj)) = pack8_fp8(v[0], v[1], 2.0f); }
        }
    }
};

struct MoeGuProb {
    static constexpr bool PERM = true, GATHER_A = true, I8 = true, F8 = false, HAS_MID = false; typedef i32x4 Acc;
    struct U { int e, rt, pn, base, par; int tok[4]; };
    const signed char* H8; const signed char* W8; const float* sW; const float* lsc; const float* bgu; unsigned char* ACT; const int* list; const int* cnt;
    __device__ __forceinline__ LAS unsigned char* parp(int off) const { return (LAS unsigned char*)tstart + (20480 - 64) + off; }
    const volatile LAS int* tstart;
    int R, G, c;
    __device__ __forceinline__ bool get(int i, U& u) const {
        const int L = i * G + c; if (L >= R * 8) return false;
        int rt, pn; g8::order2d(L, R, 8, rt, pn);
        const int e = ((const volatile LAS unsigned char*)tstart)[(1024 - 64) + rt];
        u.e = __builtin_amdgcn_readfirstlane(e); u.rt = __builtin_amdgcn_readfirstlane(rt); u.pn = __builtin_amdgcn_readfirstlane(pn); u.base = __builtin_amdgcn_readfirstlane((rt - tstart[e]) * 256); const int ucnt = __builtin_amdgcn_readfirstlane(cnt[e]);
        int R0, Rb0, C0; g8::lane_geom(threadIdx.x, R0, Rb0, C0);
#pragma unroll
        for (int j = 0; j < 4; ++j) { const int p = u.base + R0 + 64 * j; u.tok[j] = (p < ucnt) ? list[(size_t)e * TT + p] : TT; }
        u.par = __builtin_amdgcn_readfirstlane((i % 3) * 3072);
        { int t2 = threadIdx.x; asm volatile("" : "+v"(t2)); const int wv = __builtin_amdgcn_readfirstlane(t2 >> 6), ln = t2 & 63;
          if (wv < 3) { const float* gb = (wv == 0) ? bgu + (size_t)u.e * 2048 + 128 * u.pn : (wv == 1) ? sW + (size_t)u.e * 2048 + 256 * u.pn : lsc + (size_t)u.e * TT + u.base;
              const unsigned off = (wv == 0 && ln >= 32) ? (unsigned)(4096 + 16 * (ln - 32)) : (unsigned)(16 * ln);
              __builtin_amdgcn_global_load_lds((const unsigned*)((const char*)gb + off), (LAS unsigned*)parp(u.par + 1024 * wv), 16, 0, 0); } }
        return true;
    }
    __device__ __forceinline__ void setup(const U& u, unsigned (&oa)[4], unsigned& ob, unsigned (&dA)[4], unsigned (&dB)[4], const char*& pA, const char*& pB, int& nt) const {
        int R0, Rb0, C0; g8::lane_geom(threadIdx.x, R0, Rb0, C0);
        nt = 8; pA = (const char*)H8; pB = (const char*)W8;
#pragma unroll
        for (int j = 0; j < 4; ++j) { dA[j] = 0u; dB[j] = (unsigned)(64 * j * 1024); oa[j] = (unsigned)(u.tok[j] * 1024 + C0 * 2); }
        ob = (unsigned)((u.e * 2048 + 256 * u.pn + Rb0) * 1024 + C0 * 2);
    }
    __device__ __forceinline__ void epi(const i32x4 (&acc)[2][2][4][2], const U& u, int wr, int wc, int fr, int fq) const {
        const int j0 = 128 * u.pn + 32 * wc + 8 * fq;
        const LAS float* pl = (const LAS float*)parp(u.par);
        const LAS float* bp = pl + 32 * wc + 8 * fq;
        const f32x4 ba0 = *(const LAS f32x4*)bp, ba1 = *(const LAS f32x4*)(bp + 4), bu0 = *(const LAS f32x4*)(bp + 128), bu1 = *(const LAS f32x4*)(bp + 132);
        const LAS float* sp = pl + 256 + 32 * wc + 8 * fq;
        const f32x4 sa0 = *(const LAS f32x4*)sp, sa1 = *(const LAS f32x4*)(sp + 4), su0 = *(const LAS f32x4*)(sp + 128), su1 = *(const LAS f32x4*)(sp + 132);
        float rsv[2][4];
#pragma unroll
        for (int ai = 0; ai < 2; ++ai)
#pragma unroll
            for (int m = 0; m < 4; ++m) rsv[ai][m] = pl[512 + G8_ROWS(ai, m)];
        f32x2_t sA[4], sU[4], bA[4], bU[4];
#pragma unroll
        for (int q = 0; q < 2; ++q) { sA[q] = (f32x2_t){sa0[2 * q], sa0[2 * q + 1]}; sA[2 + q] = (f32x2_t){sa1[2 * q], sa1[2 * q + 1]}; sU[q] = (f32x2_t){su0[2 * q], su0[2 * q + 1]}; sU[2 + q] = (f32x2_t){su1[2 * q], su1[2 * q + 1]};
            bA[q] = (f32x2_t){ba0[2 * q], ba0[2 * q + 1]}; bA[2 + q] = (f32x2_t){ba1[2 * q], ba1[2 * q + 1]}; bU[q] = (f32x2_t){bu0[2 * q], bu0[2 * q + 1]}; bU[2 + q] = (f32x2_t){bu1[2 * q], bu1[2 * q + 1]}; }
#pragma unroll
        for (int ai = 0; ai < 2; ++ai)
#pragma unroll
            for (int m = 0; m < 4; ++m) { const int rr = G8_ROWS(ai, m); const size_t row = (size_t)256 * u.rt + rr;
                const f32x2_t rs2 = {rsv[ai][m], rsv[ai][m]};
                f32x2_t y[4];
#pragma unroll
                for (int q = 0; q < 4; ++q) { const int n = q >> 1, e0 = 2 * (q & 1);
                    const f32x2_t ai2 = {(float)acc[ai][0][m][n][e0], (float)acc[ai][0][m][n][e0 + 1]}, ui2 = {(float)acc[ai][1][m][n][e0], (float)acc[ai][1][m][n][e0 + 1]};
                    f32x2_t a = ai2 * (rs2 * sA[q]) + bA[q], uu = ui2 * (rs2 * sU[q]) + bU[q];
                    a = (f32x2_t){fminf(a[0], 7.0f), fminf(a[1], 7.0f)};
                    uu = (f32x2_t){__builtin_amdgcn_fmed3f(uu[0], -7.0f, 7.0f), __builtin_amdgcn_fmed3f(uu[1], -7.0f, 7.0f)};
                    const f32x2_t t = a * (-1.702f * LOG2E);
                    const f32x2_t den = (f32x2_t){__builtin_amdgcn_exp2f(t[0]), __builtin_amdgcn_exp2f(t[1])} + 1.0f;
                    const f32x2_t r = {__builtin_amdgcn_rcpf(den[0]), __builtin_amdgcn_rcpf(den[1])};
                    y[q] = (a * r) * (uu + 1.0f); }
                { u32x2 w; w.x = pk4_fp8(y[0][0], y[0][1], y[1][0], y[1][1]); w.y = pk4_fp8(y[2][0], y[2][1], y[3][0], y[3][1]); *(u32x2*)(ACT + row * 1024 + j0) = w; } }
    }
};
struct MoeDnProb {
    static constexpr bool PERM = true, GATHER_A = false, I8 = false, F8 = true, HAS_MID = false; typedef f32x4 Acc;
    struct U { int e, rt, pn; f32x4 bias[2][2]; };
    const unsigned char* ACT; const unsigned char* W; const float* bdn; unsigned char* YE;
    const volatile LAS int* tstart; int R, G, c;
    __device__ __forceinline__ bool get(int i, U& u) const {
        const int L = i * G + c; if (L >= R * 4) return false;
        int rt, pn; g8::order2d(L, R, 4, rt, pn);
        const int e = ((const volatile LAS unsigned char*)tstart)[(1024 - 64) + rt];
        u.e = __builtin_amdgcn_readfirstlane(e); u.rt = __builtin_amdgcn_readfirstlane(rt); u.pn = __builtin_amdgcn_readfirstlane(pn);
        { int t2 = threadIdx.x; asm volatile("" : "+v"(t2)); const int wc = (t2 >> 6) & 3, fq = (t2 & 63) >> 4;
#pragma unroll
          for (int bj = 0; bj < 2; ++bj) { const float* bp = bdn + (size_t)u.e * 1024 + 256 * u.pn + G8_COLW(bj); u.bias[bj][0] = *(const f32x4*)bp; u.bias[bj][1] = *(const f32x4*)(bp + 4); } }
        return true;
    }
    __device__ __forceinline__ void setup(const U& u, unsigned (&oa)[4], unsigned& ob, unsigned (&dA)[4], unsigned (&dB)[4], const char*& pA, const char*& pB, int& nt) const {
        int R0, Rb0, C0; g8::lane_geom_w(threadIdx.x, R0, Rb0, C0);
        nt = 8; pA = (const char*)ACT; pB = (const char*)W;
#pragma unroll
        for (int j = 0; j < 4; ++j) { dA[j] = (unsigned)(64 * j * 1024); dB[j] = (unsigned)(G8_DBW(j) * 1024); }
        oa[0] = (unsigned)((256 * u.rt + R0) * 1024 + C0 * 2); ob = (unsigned)((u.e * 1024 + 256 * u.pn + Rb0) * 1024 + C0 * 2);
    }
    __device__ __forceinline__ void epi(const f32x4 (&acc)[2][2][4][2], const U& u, int wr, int wc, int fr, int fq) const {
        const int col = 256 * u.pn + G8_COLW(0);
#pragma unroll
        for (int ai = 0; ai < 2; ++ai)
#pragma unroll
            for (int m = 0; m < 4; ++m) { const size_t row = (size_t)256 * u.rt + G8_ROWS(ai, m);
                const u32x2 w0 = pack8_fp8(acc[ai][0][m][0] * (1.0f / 32.0f) + u.bias[0][0], acc[ai][0][m][1] * (1.0f / 32.0f) + u.bias[0][1], 1.0f);
                const u32x2 w1 = pack8_fp8(acc[ai][1][m][0] * (1.0f / 32.0f) + u.bias[1][0], acc[ai][1][m][1] * (1.0f / 32.0f) + u.bias[1][1], 1.0f);
                *(u32x4*)(YE + row * 1024 + col) = (u32x4){w0.x, w0.y, w1.x, w1.y}; }
    }
};

__device__ __forceinline__ int rope_perm(int d) { return (d & 32) | ((d & 15) << 1) | ((d >> 4) & 1); }
template <class RM>
__device__ __forceinline__ void transpose_tile(const Fr& F, const float* src, int N, int k0, int n0, bf16_t* dst, int Kd, RM rm) {
    LAS unsigned char* lds = F.lds;
    const int tid = F.tid;
    { const int kq = tid >> 4, c4 = (tid & 15) * 4; f32x4 v[4];
#pragma unroll
      for (int r = 0; r < 4; ++r) v[r] = *(const f32x4*)(src + (size_t)(k0 + 4 * kq + r) * N + n0 + c4);
#pragma unroll
      for (int e = 0; e < 4; ++e) { u32x2 w; w.x = cvt_pk_bf16(v[0][e], v[1][e]); w.y = cvt_pk_bf16(v[2][e], v[3][e]); *(LAS u32x2*)(lds + (c4 + e) * 272 + kq * 8) = w; } }
    __syncthreads();
    { const int n = tid >> 3, ch = tid & 7; const u32x4 w0 = *(const LAS u32x4*)(lds + n * 272 + ch * 32), w1 = *(const LAS u32x4*)(lds + n * 272 + ch * 32 + 16);
      bf16_t* dp = dst + (size_t)rm(n0 + n) * Kd + k0 + ch * 16; *(u32x4*)dp = w0; *(u32x4*)(dp + 8) = w1; }
    __syncthreads();
}
__device__ __forceinline__ void transpose_tile_fp8(const Fr& F, const float* src, int k0, int n0, unsigned char* dst) {
    LAS unsigned char* lds = F.lds;
    const int tid = F.tid;
    { const int kq = tid >> 4, c4 = (tid & 15) * 4; f32x4 v[4];
#pragma unroll
      for (int r = 0; r < 4; ++r) v[r] = *(const f32x4*)(src + (size_t)(k0 + 4 * kq + r) * 1024 + n0 + c4) * 32.0f;
#pragma unroll
      for (int e = 0; e < 4; ++e) *(LAS unsigned*)(lds + (c4 + e) * 144 + kq * 4) = pk4_fp8(v[0][e], v[1][e], v[2][e], v[3][e]); }
    __syncthreads();
    { const int n = tid >> 3, ch = tid & 7; const u32x4 w = *(const LAS u32x4*)(lds + n * 144 + ch * 16);
      *(u32x4*)(dst + (size_t)(n0 + n) * 1024 + k0 + ch * 16) = w; }
    __syncthreads();
}
struct RmGu { __device__ int operator()(int n) const { const int bj = n >> 10, j = n & 1023; return 256 * (j >> 7) + 128 * bj + (j & 127); } };
template <int MODE, int KT, class RM>
__device__ __forceinline__ void strip_convert(const Fr& F, const float* src, int N, int n0, void* dstv, int Kd, float* sdst, RM rm) {
    LAS unsigned char* lds = F.lds;
    LAS float* red = (LAS float*)(lds + 32768);
    LAS float* inv = (LAS float*)(lds + 32768 + 8192);
    const int tid = F.tid, kq = tid >> 4, c4 = (tid & 15) * 4;
    f32x4 v[KT][4];
#pragma unroll
    for (int kt = 0; kt < KT; ++kt)
#pragma unroll
        for (int r = 0; r < 4; ++r) v[kt][r] = __builtin_nontemporal_load((const f32x4*)(src + (size_t)(kt * 128 + 4 * kq + r) * N + n0 + c4));
    f32x4 iv = {32.0f, 32.0f, 32.0f, 32.0f};
    if (MODE == 0) {
        f32x4 mx = {0.f, 0.f, 0.f, 0.f};
#pragma unroll
        for (int kt = 0; kt < KT; ++kt)
#pragma unroll
            for (int r = 0; r < 4; ++r)
#pragma unroll
                for (int e = 0; e < 4; ++e) mx[e] = fmaxf(mx[e], fabsf(v[kt][r][e]));
#pragma unroll
        for (int e = 0; e < 4; ++e) red[kq * 64 + c4 + e] = mx[e];
        __syncthreads();
        if (tid < 64) { float m = 0.f;
#pragma unroll
            for (int r = 0; r < 32; ++r) m = fmaxf(m, red[r * 64 + tid]);
            sdst[rm(n0 + tid)] = m * (1.0f / 127.0f); inv[tid] = m > 0.f ? 127.0f / m : 0.f; }
        __syncthreads();
        iv = *(const LAS f32x4*)(inv + c4);
    }
#pragma unroll
    for (int kt = 0; kt < KT; ++kt) {
        if (MODE == 0) {
#pragma unroll
            for (int e = 0; e < 4; ++e) { const int q0 = __float2int_rn(v[kt][0][e] * iv[e]), q1 = __float2int_rn(v[kt][1][e] * iv[e]), q2 = __float2int_rn(v[kt][2][e] * iv[e]), q3 = __float2int_rn(v[kt][3][e] * iv[e]);
                *(LAS unsigned*)(lds + (c4 + e) * 144 + kq * 4) = (unsigned)(q0 & 255) | ((unsigned)(q1 & 255) << 8) | ((unsigned)(q2 & 255) << 16) | ((unsigned)(q3 & 255) << 24); }
        } else if (MODE == 1) {
#pragma unroll
            for (int e = 0; e < 4; ++e) *(LAS unsigned*)(lds + (c4 + e) * 144 + kq * 4) = pk4_fp8(v[kt][0][e] * 32.0f, v[kt][1][e] * 32.0f, v[kt][2][e] * 32.0f, v[kt][3][e] * 32.0f);
        } else {
#pragma unroll
            for (int e = 0; e < 4; ++e) { u32x2 w; w.x = cvt_pk_bf16(v[kt][0][e], v[kt][1][e]); w.y = cvt_pk_bf16(v[kt][2][e], v[kt][3][e]); *(LAS u32x2*)(lds + (c4 + e) * 272 + kq * 8) = w; }
        }
        __syncthreads();
        { const int nl = tid >> 3, ch = tid & 7; const int row = rm(n0 + nl);
          if (MODE == 2) { const u32x4 w0 = *(const LAS u32x4*)(lds + nl * 272 + ch * 32), w1 = *(const LAS u32x4*)(lds + nl * 272 + ch * 32 + 16);
              bf16_t* dp = (bf16_t*)dstv + (size_t)row * Kd + kt * 128 + ch * 16; *(u32x4*)dp = w0; *(u32x4*)(dp + 8) = w1; }
          else { const u32x4 w = *(const LAS u32x4*)(lds + nl * 144 + ch * 16); *(u32x4*)((unsigned char*)dstv + (size_t)row * Kd + kt * 128 + ch * 16) = w; } }
        __syncthreads();
    }
}
__device__ __forceinline__ void strip128_fp8(const Fr& F, const float* src, int N, int k0, int n0, unsigned char* dst, int Kd) {
    LAS unsigned char* lds = F.lds;
    const int tid = F.tid, kq = tid >> 5, c4 = (tid & 31) * 4;
    f32x4 v[8][4];
#pragma unroll
    for (int kt = 0; kt < 8; ++kt)
#pragma unroll
        for (int r = 0; r < 4; ++r) v[kt][r] = __builtin_nontemporal_load((const f32x4*)(src + (size_t)(k0 + kt * 64 + 4 * kq + r) * N + n0 + c4));
#pragma unroll
    for (int kt = 0; kt < 8; ++kt)
#pragma unroll
        for (int e = 0; e < 4; ++e) *(LAS unsigned*)(lds + (c4 + e) * 528 + kt * 64 + kq * 4) = pk4_fp8(v[kt][0][e] * 32.0f, v[kt][1][e] * 32.0f, v[kt][2][e] * 32.0f, v[kt][3][e] * 32.0f);
    __syncthreads();
#pragma unroll
    for (int it = 0; it < 8; ++it) { const int n = it * 16 + (tid >> 5), ch = tid & 31; const u32x4 w = *(const LAS u32x4*)(lds + n * 528 + ch * 16);
        *(u32x4*)(dst + (size_t)(n0 + n) * Kd + k0 + ch * 16) = w; }
    __syncthreads();
}
struct RmId { __device__ int operator()(int n) const { return n; } };
struct RmWin { __device__ int operator()(int n) const { return (n >= 512 && n < 1152) ? ((n & ~63) | rope_perm(n & 63)) : n; } };

__device__ __forceinline__ void prologue_phase(const Fr& F) {
    const int tid = F.tid, G = F.G, bid = F.bid;
    const float PI2 = 6.283185307179586f;
    const size_t gtid = (size_t)bid * 512 + tid, gsz = (size_t)G * 512;
    { float* rope = WSP(float, WS_ROPE);
      for (size_t i = gtid; i < 2048; i += gsz) { const int pos = (int)(i >> 4), f = (int)(i & 15); const float inv = powf(10000.0f, -(float)f / 16.0f); const float a = (float)pos * inv; rope[i] = cosf(a); rope[2048 + i] = sinf(a); } }
    { bf16_t* W1 = WSP(bf16_t, WS_W1);
      for (size_t i = gtid; i < 256 * 128; i += gsz) { const int r = (int)(i >> 7), n1 = (int)(i & 127); float v = 0.f;
          if (r < 128) { const int k1p = r >> 1, part = r & 1;
              if (part == 0) v = cospif((float)((k1p * n1) & 127) / 64.0f);
              else if (k1p == 0) v = (n1 & 1) ? -1.0f : 1.0f;
              else v = -sinpif((float)((k1p * n1) & 127) / 64.0f); }
          W1[i] = f2bf(v); } }
    { bf16_t* MT = WSP(bf16_t, WS_MT);
      for (size_t i = gtid; i < (size_t)64 * 256 * 128; i += gsz) {
          const int kk = (int)(i & 127), r = (int)((i >> 7) & 255), k1p = (int)(i >> 15);
          const int part = kk >> 6, n2 = kk & 63, s = r >> 7, k2 = (r & 127) >> 1, reim = r & 1;
          float v;
          if (k1p == 0) { const int k = 64 * s + 128 * k2; const int mm = (n2 * k) & 8191; const float cm = cospif((float)mm / 4096.0f), sm = sinpif((float)mm / 4096.0f);
              v = (part == s) ? (reim ? -sm : cm) : 0.0f; }
          else { const int k = (s ? 128 - k1p : k1p) + 128 * k2; const int mm = (n2 * k) & 8191; const float cm = cospif((float)mm / 4096.0f), sm = sinpif((float)mm / 4096.0f);
              if (s == 0) v = reim ? (part ? cm : -sm) : (part ? sm : cm);
              else        v = reim ? (part ? -cm : -sm) : (part ? -sm : cm); }
          MT[i] = f2bf(v); } }
    { bf16_t* WC = WSP(bf16_t, WS_WC);
      const float sc = 5.656854249492381f;
      for (size_t i = gtid; i < 512 * 256; i += gsz) { const int n = (int)(i & 255), r = (int)(i >> 8), k = r >> 1, reim = r & 1; const int mm = (k * n) & 255;
          WC[i] = f2bf(sc * (reim ? -sinpif((float)mm / 128.0f) : cospif((float)mm / 128.0f))); } }
    { bf16_t* RWT = WSP(bf16_t, WS_RWT); const float* rw = INP(13);
      for (size_t i = gtid; i < (size_t)DEPTH * 32 * 1024; i += gsz) { const int k = (int)(i & 1023), e = (int)((i >> 10) & 31), l = (int)(i >> 15); RWT[i] = f2bf(rw[((size_t)l * 1024 + k) * 32 + e]); } }
    { bf16_t* H = WSP(bf16_t, WS_H); for (size_t i = gtid; i < 256 * 1024; i += gsz) H[(size_t)TT * 1024 + i] = 0;
      unsigned* H8z = (unsigned*)(WSP(signed char, WS_H8) + (size_t)TT * 1024); for (size_t i = gtid; i < 256 * 256; i += gsz) H8z[i] = 0u; }
    (void)PI2;
    {
        LAS float* sil = (LAS float*)(F.lds + 65536);
        LAS float* red = (LAS float*)(F.lds + 65536 + 20480);
        for (int i = tid; i < 5 * 1024; i += 512) { const int v = i >> 10, k = i & 1023; const float x = (v < 4) ? INP(1)[v * 1024 + k] : INP(3)[k]; sil[i] = x * sigmoidf_(x); }
        __syncthreads();
        float* MOD = WSP(float, WS_MOD);
        for (int u = bid; u < DEPTH * 96; u += G) {
            const int l = u / 96, j0 = (u % 96) * 64;
            const float* aw = INP(4) + (size_t)l * 1024 * 6144 + j0 + F.lane;
            float a0 = 0.f, a1 = 0.f, a2 = 0.f, a3 = 0.f, a4 = 0.f;
            for (int kk = 0; kk < 128; ++kk) { const int k = F.wave * 128 + kk; const float w = aw[(size_t)k * 6144];
                a0 += sil[k] * w; a1 += sil[1024 + k] * w; a2 += sil[2048 + k] * w; a3 += sil[3072 + k] * w; a4 += sil[4096 + k] * w; }
            red[(F.wave * 5 + 0) * 64 + F.lane] = a0; red[(F.wave * 5 + 1) * 64 + F.lane] = a1; red[(F.wave * 5 + 2) * 64 + F.lane] = a2; red[(F.wave * 5 + 3) * 64 + F.lane] = a3; red[(F.wave * 5 + 4) * 64 + F.lane] = a4;
            __syncthreads();
            if (tid < 320) { const int v = tid >> 6, jl = tid & 63; float s = INP(5)[(size_t)l * 6144 + j0 + jl];
#pragma unroll
                for (int w = 0; w < 8; ++w) s += red[(w * 5 + v) * 64 + jl];
                MOD[((size_t)l * 5 + v) * 6144 + j0 + jl] = s; }
            __syncthreads();
        }
    }
    {
        LAS float* tab = (LAS float*)(F.lds + 65536);
        if (tid < 128) { tab[tid] = cospif((float)tid / 64.0f); tab[128 + tid] = sinpif((float)tid / 64.0f); }
        __syncthreads();
        unsigned char* WFO = WSP(unsigned char, WS_WFO);
        for (int u = bid; u < DEPTH * 4 * 2 * 8; u += G) {
            const int dp = u & 7, reim = (u >> 3) & 1, g = (u >> 4) & 3, l = u >> 6;
            const int dc = 2 * dp + (tid >> 8), o4 = (tid & 255) * 4;
            const float* wf = INP(10) + ((size_t)l * 512 + g * 128) * 1024 + o4;
            f32x4 a[8];
#pragma unroll
            for (int q = 0; q < 8; ++q) a[q] = (f32x4){0.f, 0.f, 0.f, 0.f};
#pragma unroll 4
            for (int j = 0; j < 128; ++j) { const f32x4 w = *(const f32x4*)(wf + (size_t)j * 1024);
#pragma unroll
                for (int q = 0; q < 8; ++q) a[q] += w * tab[reim * 128 + ((j * (dc * 8 + q)) & 127)]; }
#pragma unroll
            for (int e = 0; e < 4; ++e) { u32x2 w2; w2.x = pk4_fp8(a[0][e] * 8.0f, a[1][e] * 8.0f, a[2][e] * 8.0f, a[3][e] * 8.0f); w2.y = pk4_fp8(a[4][e] * 8.0f, a[5][e] * 8.0f, a[6][e] * 8.0f, a[7][e] * 8.0f);
                *(u32x2*)(WFO + ((size_t)l * 1024 + o4 + e) * 1024 + g * 256 + reim * 128 + dc * 8) = w2; }
        }
        __syncthreads();
    }
    {
        constexpr int T_GU = DEPTH * 32 * 32, T_DN = DEPTH * 32 * 16, T_WIN = DEPTH * 52, T_WAO = DEPTH * 16, T_WOUT = DEPTH * 16;
#pragma unroll 1
        for (int q = bid; q < T_GU; q += G) { const int le = q >> 5, ns = q & 31;
            strip_convert<0, 8>(F, INP(15) + (size_t)le * 1024 * 2048, 2048, ns * 64, WSP(signed char, WS_WGU) + (size_t)le * 2048 * 1024, 1024, WSP(float, WS_SWGU) + (size_t)le * 2048, RmGu()); }
#pragma unroll 1
        for (int q = bid; q < T_DN; q += G) { const int le = q >> 4, ns = (q >> 1) & 7, kh = q & 1;
            strip128_fp8(F, INP(17) + (size_t)le * 1024 * 1024, 1024, kh * 512, ns * 128, WSP(unsigned char, WS_WDN) + (size_t)le * 1024 * 1024, 1024); }
#pragma unroll 1
        for (int q = bid; q < T_WIN; q += G) { const int l = q / 52, ns = q % 52;
            strip_convert<0, 8>(F, INP(8) + (size_t)l * 1024 * IN_DIM, IN_DIM, ns * 64, WSP(signed char, WS_WIN) + (size_t)l * IN_DIM * 1024, 1024, WSP(float, WS_SWIN) + (size_t)l * IN_DIM, RmWin()); }
#pragma unroll 1
        for (int q = (bid + 208) % G; q < DEPTH * 8; q += G) { const int l = q >> 3, ns = q & 7;
            strip128_fp8(F, INP(11) + (size_t)l * 512 * 1024, 1024, 0, ns * 128, WSP(unsigned char, WS_WAO) + (size_t)l * 1024 * 512, 512); }
#pragma unroll 1
        for (int q = (bid + 144) % G; q < DEPTH * 16; q += G) { const int l = q >> 4, ns = (q >> 1) & 7, kh = q & 1;
            strip128_fp8(F, INP(12) + (size_t)l * 1024 * 1024, 1024, kh * 512, ns * 128, WSP(unsigned char, WS_WOUT) + (size_t)l * 1024 * 1024, 1024); }
    }
}

template <bool WIDE>
__device__ __forceinline__ void moe_combine(const Fr& F, int tok, int lprev, const volatile LAS int* tstart, f32x4 (&m)[4]) {
    const int* slot = WSP(int, WS_SLOT); const float* gate = WSP(float, WS_GATE); const unsigned char* YE = WSP(unsigned char, WS_YE);
#pragma unroll
    for (int j = 0; j < 4; ++j) m[j] = (f32x4){0.f, 0.f, 0.f, 0.f};
    const i32x4 sl4 = *(const i32x4*)(slot + tok * 4); const f32x4 gk4 = *(const f32x4*)(gate + tok * 4);
#pragma unroll
    for (int k = 0; k < 4; ++k) {
        const int sl = sl4[k]; const float gk = gk4[k];
        const int e = sl >> 20, pos = sl & 0xfffff;
        const size_t row = (size_t)256 * tstart[e] + pos;
        i32x4 w4;
        if (WIDE) w4 = *(const i32x4*)(YE + row * 1024 + 16 * F.lane);
        else { const unsigned char* yp = YE + row * 1024 + 4 * F.lane;
#pragma unroll
            for (int j = 0; j < 4; ++j) w4[j] = *(const int*)(yp + 256 * j); }
#pragma unroll
        for (int j = 0; j < 4; ++j) { const int w = w4[j];
            m[j][0] += gk * __builtin_amdgcn_cvt_f32_fp8(w, 0); m[j][1] += gk * __builtin_amdgcn_cvt_f32_fp8(w, 1); m[j][2] += gk * __builtin_amdgcn_cvt_f32_fp8(w, 2); m[j][3] += gk * __builtin_amdgcn_cvt_f32_fp8(w, 3); }
    }
    (void)lprev;
}
__device__ __forceinline__ int fill_tstart(const Fr& F, int l) {
    volatile LAS int* ts = (volatile LAS int*)(F.lds + LDS_MISC + 64);
    volatile LAS unsigned char* r2e = (volatile LAS unsigned char*)(F.lds + LDS_MISC + 1024);
    __syncthreads();
    if (F.tid < 64) {
        const int e = F.tid & 31; const int* cnt = (const int*)(F.ws + WS_CTL + CTL_CNT) + l * 32;
        const int nt_e = (cnt[e] + 255) >> 8; int inc = nt_e;
#pragma unroll
        for (int o = 1; o < 32; o <<= 1) { const int y = __shfl_up(inc, o, 32); if (e >= o) inc += y; }
        const int start = inc - nt_e;
        if (F.tid < 32) { ts[e] = start; if (e == 31) ts[32] = inc;
            for (int rt = start; rt < inc; ++rt) r2e[rt] = (unsigned char)e; }
    }
    __syncthreads();
    return ts[32];
}

__device__ __forceinline__ void norm1_phase(const Fr& F, int l) {
    const volatile LAS int* tstart = (const volatile LAS int*)(F.lds + LDS_MISC + 64);
    if (l > 0) fill_tstart(F, l - 1);
    const float* MOD = WSP(float, WS_MOD);
    const bool fin = (l == DEPTH);
    const int ntok = fin ? TX : TT;
    const bool tmo = fin && (xb_ld((unsigned*)(F.ws + WS_CTL) + XB_TMO) != 0u);
    const float* gvec = fin ? INP(19) : INP(6) + (size_t)l * 1024;
    bf16_t* XW = WSP(bf16_t, WS_XW); bf16_t* CW = WSP(bf16_t, WS_CW); signed char* H8 = WSP(signed char, WS_H8); float* SHv = WSP(float, WS_SH);
    const bool wide = (l > 0) && !fin;
#define N1_COL(j) (wide ? (16 * F.lane + 4 * (j)) : (256 * (j) + 4 * F.lane))
    int vcur = -1; f32x4 g2v[4], mulv[4], addv[4];
    for (int tok = F.bid * 8 + F.wave; tok < ntok; tok += F.G * 8) {
        const bool isx = tok < TX; const int v = isx ? (tok >> 13) : 4;
        if (v != vcur) { vcur = v;
            const float* g2 = MOD + ((size_t)(l > 0 ? l - 1 : 0) * 5 + v) * 6144 + 5 * 1024; const float* md = MOD + ((size_t)(fin ? 0 : l) * 5 + v) * 6144;
#pragma unroll
            for (int j = 0; j < 4; ++j) { const int c = N1_COL(j); g2v[j] = *(const f32x4*)(g2 + c); const f32x4 g = *(const f32x4*)(gvec + c);
                if (fin) { mulv[j] = g; addv[j] = (f32x4){0.f, 0.f, 0.f, 0.f}; } else { mulv[j] = g * (*(const f32x4*)(md + 1024 + c) + 1.0f); addv[j] = *(const f32x4*)(md + c); } } }
        f32x4 x[4];
        if (l == 0) { const float* src = isx ? INP(0) + (size_t)tok * 1024 : INP(2) + (size_t)(tok - TX) * 1024;
#pragma unroll
            for (int j = 0; j < 4; ++j) x[j] = *(const f32x4*)(src + 256 * j + 4 * F.lane);
        } else { const bf16_t* src = isx ? XW + (size_t)tok * 1024 : CW + (size_t)(tok - TX) * 1024; u32x2 xw[4];
            if (wide) { const u32x4 a = *(const u32x4*)(src + 16 * F.lane), bq = *(const u32x4*)(src + 16 * F.lane + 8);
                xw[0] = (u32x2){a.x, a.y}; xw[1] = (u32x2){a.z, a.w}; xw[2] = (u32x2){bq.x, bq.y}; xw[3] = (u32x2){bq.z, bq.w}; }
            else {
#pragma unroll
                for (int j = 0; j < 4; ++j) xw[j] = *(const u32x2*)(src + 256 * j + 4 * F.lane); }
#pragma unroll
            for (int j = 0; j < 4; ++j) x[j] = (f32x4){bf_lo(xw[j].x), bf_hi(xw[j].x), bf_lo(xw[j].y), bf_hi(xw[j].y)};
        }
        if (l > 0) {
            f32x4 mm[4]; if (wide) moe_combine<true>(F, tok, l - 1, tstart, mm); else moe_combine<false>(F, tok, l - 1, tstart, mm);
            bf16_t* dst = isx ? XW + (size_t)tok * 1024 : CW + (size_t)(tok - TX) * 1024;
#pragma unroll
            for (int j = 0; j < 4; ++j) x[j] += g2v[j] * mm[j];
            if (wide) { u32x4 a, bq; a.x = cvt_pk_bf16(x[0][0], x[0][1]); a.y = cvt_pk_bf16(x[0][2], x[0][3]); a.z = cvt_pk_bf16(x[1][0], x[1][1]); a.w = cvt_pk_bf16(x[1][2], x[1][3]);
                bq.x = cvt_pk_bf16(x[2][0], x[2][1]); bq.y = cvt_pk_bf16(x[2][2], x[2][3]); bq.z = cvt_pk_bf16(x[3][0], x[3][1]); bq.w = cvt_pk_bf16(x[3][2], x[3][3]);
                *(u32x4*)(dst + 16 * F.lane) = a; *(u32x4*)(dst + 16 * F.lane + 8) = bq; }
        }
        float ss = 0.f;
#pragma unroll
        for (int j = 0; j < 4; ++j) ss += x[j][0] * x[j][0] + x[j][1] * x[j][1] + x[j][2] * x[j][2] + x[j][3] * x[j][3];
        ss = wave_sum(ss);
        const float rstd = rsqrtf(ss * (1.0f / 1024.0f) + EPS);
        if (fin) {
#pragma unroll
            for (int j = 0; j < 4; ++j) *(f32x4*)(F.out + (size_t)tok * 1024 + 256 * j + 4 * F.lane) = tmo ? (f32x4){__builtin_nanf(""), __builtin_nanf(""), __builtin_nanf(""), __builtin_nanf("")} : x[j] * rstd * mulv[j];
        } else {
            float amax = 0.f;
#pragma unroll
            for (int j = 0; j < 4; ++j) { x[j] = x[j] * rstd * mulv[j] + addv[j];
                amax = fmaxf(amax, fmaxf(fmaxf(fabsf(x[j][0]), fabsf(x[j][1])), fmaxf(fabsf(x[j][2]), fabsf(x[j][3])))); }
#pragma unroll
            for (int o = 32; o >= 1; o >>= 1) amax = fmaxf(amax, __shfl_xor(amax, o));
            const float inv = amax > 0.f ? 127.0f / amax : 0.f;
            u32x4 hq;
#pragma unroll
            for (int j = 0; j < 4; ++j) {
                const int q0 = __float2int_rn(x[j][0] * inv), q1 = __float2int_rn(x[j][1] * inv), q2 = __float2int_rn(x[j][2] * inv), q3 = __float2int_rn(x[j][3] * inv);
                hq[j] = (unsigned)(q0 & 255) | ((unsigned)(q1 & 255) << 8) | ((unsigned)(q2 & 255) << 16) | ((unsigned)(q3 & 255) << 24); }
            if (wide) *(u32x4*)(H8 + (size_t)tok * 1024 + 16 * F.lane) = hq;
            else {
#pragma unroll
                for (int j = 0; j < 4; ++j) *(unsigned*)(H8 + (size_t)tok * 1024 + 256 * j + 4 * F.lane) = hq[j]; }
            if (F.lane == 0) SHv[tok] = amax * (1.0f / 127.0f);
        }
    }
#undef N1_COL
}

__device__ __forceinline__ void norm2_router_phase(const Fr& F, int l, bool fake = false) {
    const int ntok = (l == DEPTH - 1) ? TX : TT;
    const float* MOD = WSP(float, WS_MOD); const float* gvec = INP(7) + (size_t)l * 1024;
    const bf16_t* XW = WSP(bf16_t, WS_XW); const bf16_t* CW = WSP(bf16_t, WS_CW);
    const bf16_t* RWT = WSP(bf16_t, WS_RWT) + (size_t)l * 32 * 1024; const float* rb = INP(14) + l * 32;
    int* cntg = (int*)(F.ws + WS_CTL + CTL_CNT) + l * 32; int* list = WSP(int, WS_LIST); int* slot = WSP(int, WS_SLOT); float* gate = WSP(float, WS_GATE);
    LAS unsigned char* hs = F.lds;
    LAS float* part = (LAS float*)(F.lds + 69632);
    LAS float* logit = (LAS float*)(F.lds + 69632 + 36864);
    LAS int* lcnt = (LAS int*)(F.lds + 69632 + 36864 + 4608);
    LAS int* lbase = lcnt + 32;
    LAS float* tsc = (LAS float*)(lbase + 32);
    LAS int* tokE = (LAS int*)(tsc + 32); LAS float* tokG = (LAS float*)(tokE + 128);
    signed char* H8 = WSP(signed char, WS_H8); float* lscg = WSP(float, WS_LSC);
    const int lane = F.lane, w = F.wave, l32 = lane & 31, hh = lane >> 5;
    for (int tl = F.bid; tl < ntok / 32; tl += F.G) {
        const int t0 = tl * 32;
        if (F.tid < 32) lcnt[F.tid] = 0;
        f32x4 mulv[4], addv[4];
        { const int v0 = (t0 < TX) ? (t0 >> 13) : 4; const float* md0 = MOD + ((size_t)l * 5 + v0) * 6144;
#pragma unroll
          for (int j = 0; j < 4; ++j) { const int c = 256 * j + 4 * lane; mulv[j] = *(const f32x4*)(gvec + c) * (*(const f32x4*)(md0 + 4096 + c) + 1.0f); addv[j] = *(const f32x4*)(md0 + 3072 + c); } }
#pragma unroll 1
        for (int q = 0; q < 4; ++q) {
            const int tloc = 4 * w + q, tok = t0 + tloc; const bool isx = tok < TX; const int v = isx ? (tok >> 13) : 4;
            const bf16_t* src = isx ? XW + (size_t)tok * 1024 : CW + (size_t)(tok - TX) * 1024;
            f32x4 x[4]; float ss = 0.f; u32x2 xw[4];
#pragma unroll
            for (int j = 0; j < 4; ++j) xw[j] = *(const u32x2*)(src + 256 * j + 4 * lane);
#pragma unroll
            for (int j = 0; j < 4; ++j) { x[j] = (f32x4){bf_lo(xw[j].x), bf_hi(xw[j].x), bf_lo(xw[j].y), bf_hi(xw[j].y)}; ss += x[j][0] * x[j][0] + x[j][1] * x[j][1] + x[j][2] * x[j][2] + x[j][3] * x[j][3]; }
            ss = wave_sum(ss); const float rstd = rsqrtf(ss * (1.0f / 1024.0f) + EPS); (void)v;
            float amax = 0.f;
#pragma unroll
            for (int j = 0; j < 4; ++j) { const int c = 256 * j + 4 * lane;
                x[j] = x[j] * rstd * mulv[j] + addv[j];
                amax = fmaxf(amax, fmaxf(fmaxf(fabsf(x[j][0]), fabsf(x[j][1])), fmaxf(fabsf(x[j][2]), fabsf(x[j][3]))));
                u32x2 wv; wv.x = cvt_pk_bf16(x[j][0], x[j][1]); wv.y = cvt_pk_bf16(x[j][2], x[j][3]);
                *(LAS u32x2*)(hs + tloc * 2064 + c * 2) = wv; }
#pragma unroll
            for (int o = 32; o >= 1; o >>= 1) amax = fmaxf(amax, __shfl_xor(amax, o));
            const float inv = amax > 0.f ? 127.0f / amax : 0.f;
#pragma unroll
            for (int j = 0; j < 4; ++j) { const int c = 256 * j + 4 * lane;
                const int q0 = __float2int_rn(x[j][0] * inv), q1 = __float2int_rn(x[j][1] * inv), q2 = __float2int_rn(x[j][2] * inv), q3 = __float2int_rn(x[j][3] * inv);
                *(unsigned*)(H8 + (size_t)tok * 1024 + c) = (unsigned)(q0 & 255) | ((unsigned)(q1 & 255) << 8) | ((unsigned)(q2 & 255) << 16) | ((unsigned)(q3 & 255) << 24); }
            if (lane == 0) tsc[tloc] = amax * (1.0f / 127.0f);
        }
        __syncthreads();
        {
            f32x16 acc;
#pragma unroll
            for (int e = 0; e < 16; ++e) acc[e] = 0.f;
#pragma unroll
            for (int s = 0; s < 8; ++s) { const int k = 128 * w + 16 * s + 8 * hh;
                const bf16x8 a = *(const LAS bf16x8*)(hs + l32 * 2064 + k * 2);
                const bf16x8 b = *(const bf16x8*)(RWT + (size_t)l32 * 1024 + k);
                acc = __builtin_amdgcn_mfma_f32_32x32x16_bf16(a, b, acc, 0, 0, 0); }
#pragma unroll
            for (int e = 0; e < 16; ++e) { const int trow = 8 * (e >> 2) + 4 * hh + (e & 3); part[(w * 32 + trow) * 33 + l32] = acc[e]; }
        }
        __syncthreads();
        int es[4], rk[4]; float gs[4];
        {
            const int tr = F.tid >> 4, e0 = (F.tid & 15) * 2;
            float v0 = rb[e0], v1 = rb[e0 + 1];
#pragma unroll
            for (int ww = 0; ww < 8; ++ww) { v0 += part[(ww * 32 + tr) * 33 + e0]; v1 += part[(ww * 32 + tr) * 33 + e0 + 1]; }
            float lv[4];
#pragma unroll
            for (int k = 0; k < 4; ++k) {
                float bv = v0; int bi = e0; if (v1 > bv) { bv = v1; bi = e0 + 1; }
#pragma unroll
                for (int o = 1; o < 16; o <<= 1) { const float ov = __shfl_xor(bv, o, 16); const int oi = __shfl_xor(bi, o, 16); if (ov > bv || (ov == bv && oi < bi)) { bv = ov; bi = oi; } }
                es[k] = bi; lv[k] = bv;
                if (bi == e0) v0 = -3.0e38f; if (bi == e0 + 1) v1 = -3.0e38f; }
            if (fake) { __syncthreads(); continue; }
            if ((F.tid & 15) == 0) {
                const float mx = lv[0]; float sum = 0.f;
#pragma unroll
                for (int k = 0; k < 4; ++k) { gs[k] = __expf(lv[k] - mx); sum += gs[k]; }
                const float isum = 1.0f / sum;
#pragma unroll
                for (int k = 0; k < 4; ++k) { tokE[tr * 4 + k] = es[k]; tokG[tr * 4 + k] = gs[k] * isum; }
            }
        }
        __syncthreads();
        if (F.tid < 32) {
#pragma unroll
            for (int k = 0; k < 4; ++k) { es[k] = tokE[F.tid * 4 + k]; gs[k] = tokG[F.tid * 4 + k]; rk[k] = __hip_atomic_fetch_add(&lcnt[es[k]], 1, __ATOMIC_RELAXED, __HIP_MEMORY_SCOPE_WORKGROUP); }
        }
        __syncthreads();
        if (F.tid < 32) { const int n = lcnt[F.tid]; lbase[F.tid] = n ? atomicAdd(&cntg[F.tid], n) : 0; }
        __syncthreads();
        if (F.tid < 32) { const int tok = t0 + F.tid;
#pragma unroll
            for (int k = 0; k < 4; ++k) { const int pos = lbase[es[k]] + rk[k]; list[(size_t)es[k] * TT + pos] = tok; lscg[(size_t)es[k] * TT + pos] = tsc[F.tid]; slot[tok * 4 + k] = (es[k] << 20) | pos; gate[tok * 4 + k] = gs[k]; } }
        __syncthreads();
    }
}

template <int OFF> __device__ __forceinline__ s16x4 tr_read(unsigned vb) { s16x4 r; asm volatile("ds_read_b64_tr_b16 %0, %1 offset:%2" : "=&v"(r) : "v"(vb), "i"(OFF) : "memory"); return r; }

__device__ __forceinline__ void attn_phase(const Fr& F, int l, bool with_ctx) {
    LAS unsigned char* lds = F.lds;
    const unsigned ldsb = (unsigned)(uintptr_t)lds;
    const bf16_t* Q = WSP(bf16_t, WS_Q); const bf16_t* Kb = WSP(bf16_t, WS_K); const bf16_t* Vb = WSP(bf16_t, WS_V); unsigned char* AO = WSP(unsigned char, WS_AO);
    const int tid = F.tid, lane = F.lane, w = F.wave, l32 = lane & 31, hh = lane >> 5;
    const int g = w >> 1, rhalf = w & 1;
    const int nunits = 512 + (with_ctx ? 16 : 0);
    const int skey = tid >> 3, sch = tid & 7;
    const unsigned k_st = (unsigned)(skey * 128 + ((sch ^ ((skey >> 1) & 7)) * 16));
    const unsigned v_st = (unsigned)(8192 + skey * 128 + ((((sch >> 1) ^ (((skey >> 1) & 1) << 1)) * 32) + (sch & 1) * 16));
    unsigned vbase[2];
    { const int li = lane & 15, q = li >> 2, p = li & 3, g16 = l32 >> 4; const int key = 4 * hh + q;
#pragma unroll
      for (int db = 0; db < 2; ++db) { const int c32 = 2 * db + g16; vbase[db] = ldsb + 8192u + (unsigned)(key * 128 + ((c32 ^ (((key >> 1) & 1) << 1)) * 32) + 8 * p); } }
    for (int u = F.bid; u < nunits; u += F.G) {
        int b, qb, kvh; bool isctx;
        if (u < 512) { b = u >> 7; qb = (u >> 1) & 63; kvh = u & 1; isctx = false; }
        else { const int uu = u - 512; b = uu >> 2; qb = (uu >> 1) & 1; kvh = uu & 1; isctx = true; }
        const int head = kvh * 4 + g;
        const int qtok0 = isctx ? (TX + b * LC + qb * 128) : (b * SEQ + qb * 128);
        LAS unsigned char* ql = lds + 49152 + w * 8192;
        { u32x4 qv[8];
#pragma unroll
          for (int i = 0; i < 8; ++i) { const int row = i * 8 + (lane >> 3), ch = lane & 7; qv[i] = *(const u32x4*)(Q + (size_t)(qtok0 + rhalf * 64 + row) * 512 + head * 64 + ch * 8); }
#pragma unroll
          for (int i = 0; i < 8; ++i) { const int row = i * 8 + (lane >> 3), ch = lane & 7; *(LAS u32x4*)(ql + row * 128 + ((ch ^ ((row >> 1) & 7)) * 16)) = qv[i]; } }
        const float sink2 = INP(9)[l * 8 + head] * LOG2E;
        const float sk = __builtin_amdgcn_exp2f(sink2 - SOFT_C);
        float l_run[2] = {hh ? 0.f : sk, hh ? 0.f : sk};
        f32x16 O[2][2];
#pragma unroll
        for (int a = 0; a < 2; ++a)
#pragma unroll
            for (int c = 0; c < 2; ++c)
#pragma unroll
                for (int e = 0; e < 16; ++e) O[a][c][e] = 0.f;
#define ATT_TOK0(tt) (((tt) < 6) ? (b * SEQ + (qb - 1) * 128 + 64 * (tt)) : (TX + b * LC + 64 * ((tt) - 6)))
#define ATT_NEXT(tt) ((!isctx && qb == 63 && ((tt) + 1 == 4 || (tt) + 1 == 5)) ? 6 : (tt) + 1)
#define ATT_PV(SLOTB) do { const unsigned vb0 = vbase[0] + (SLOTB), vb1 = vbase[1] + (SLOTB); \
            ATT_PV_STEP(0, 0); ATT_PV_STEP(0, 1); ATT_PV_STEP(1, 0); ATT_PV_STEP(1, 1); } while (0)
#define ATT_PV_STEP(KB, SP) do { \
            const s16x4 a0 = tr_read<((32 * (KB) + 16 * (SP)) * 128)>(vb0), a1 = tr_read<((32 * (KB) + 16 * (SP) + 8) * 128)>(vb0); \
            const s16x4 c0 = tr_read<((32 * (KB) + 16 * (SP)) * 128)>(vb1), c1 = tr_read<((32 * (KB) + 16 * (SP) + 8) * 128)>(vb1); \
            asm volatile("s_waitcnt lgkmcnt(0)" ::: "memory"); __builtin_amdgcn_sched_barrier(0); \
            const bf16x8 vf0 = (bf16x8){a0[0], a0[1], a0[2], a0[3], a1[0], a1[1], a1[2], a1[3]}, vf1 = (bf16x8){c0[0], c0[1], c0[2], c0[3], c1[0], c1[1], c1[2], c1[3]}; \
            O[0][0] = __builtin_amdgcn_mfma_f32_32x32x16_bf16(vf0, pf[KB][SP][0], O[0][0], 0, 0, 0); O[0][1] = __builtin_amdgcn_mfma_f32_32x32x16_bf16(vf0, pf[KB][SP][1], O[0][1], 0, 0, 0); \
            O[1][0] = __builtin_amdgcn_mfma_f32_32x32x16_bf16(vf1, pf[KB][SP][0], O[1][0], 0, 0, 0); O[1][1] = __builtin_amdgcn_mfma_f32_32x32x16_bf16(vf1, pf[KB][SP][1], O[1][1], 0, 0, 0); } while (0)
        const bool late = (w >= 4);
        int t = isctx ? 6 : (qb == 0 ? 2 : 0);
        int tn = ATT_NEXT(t);
        u32x4 kreg, vreg;
        { const int tok0 = ATT_TOK0(t);
          kreg = *(const u32x4*)(Kb + (size_t)(tok0 + skey) * 128 + kvh * 64 + sch * 8); vreg = *(const u32x4*)(Vb + (size_t)(tok0 + skey) * 128 + kvh * 64 + sch * 8); }
        __syncthreads();
        *(LAS u32x4*)(lds + k_st) = kreg; *(LAS u32x4*)(lds + v_st) = vreg;
        if (tn < 10) { const int tok0 = ATT_TOK0(tn);
            kreg = *(const u32x4*)(Kb + (size_t)(tok0 + skey) * 128 + kvh * 64 + sch * 8); vreg = *(const u32x4*)(Vb + (size_t)(tok0 + skey) * 128 + kvh * 64 + sch * 8); }
        __syncthreads();
        int idx = 0, pidx = 0; bool pvpend = false;
        bf16x8 pf[2][2][2];
        for (;;) {
            const bool more = tn < 10;
            const int nidx = (idx == 2) ? 0 : idx + 1;
            int tnn = 10;
            if (more) {
                *(LAS u32x4*)(lds + nidx * 16384 + k_st) = kreg; *(LAS u32x4*)(lds + nidx * 16384 + v_st) = vreg;
                tnn = ATT_NEXT(tn);
                if (tnn < 10) { const int tok0 = ATT_TOK0(tnn);
                    kreg = *(const u32x4*)(Kb + (size_t)(tok0 + skey) * 128 + kvh * 64 + sch * 8); vreg = *(const u32x4*)(Vb + (size_t)(tok0 + skey) * 128 + kvh * 64 + sch * 8); }
            }
            if (late && pvpend) { ATT_PV((unsigned)(pidx * 16384)); pvpend = false; }
            const bool local = (!isctx) && (t < 6);
            const bool skip = local && ((rhalf == 0 && t == 5) || (rhalf == 1 && t == 0));
            const bool needmask = local && ((rhalf == 0 && (t == 0 || t == 4)) || (rhalf == 1 && (t == 1 || t == 5)));
            if (!skip) {
                LAS unsigned char* kl = lds + idx * 16384;
                f32x16 S[2][2];
#pragma unroll
                for (int kb = 0; kb < 2; ++kb)
#pragma unroll
                    for (int qk = 0; qk < 2; ++qk)
#pragma unroll
                        for (int e = 0; e < 16; ++e) S[kb][qk][e] = -SOFT_C;
#pragma unroll
                for (int kb = 0; kb < 2; ++kb)
#pragma unroll
                    for (int s = 0; s < 4; ++s) { const int key = 32 * kb + l32, ch = 2 * s + hh;
                        const bf16x8 kf = *(const LAS bf16x8*)(kl + key * 128 + ((ch ^ ((key >> 1) & 7)) * 16));
#pragma unroll
                        for (int qk = 0; qk < 2; ++qk) { const int qrow = 32 * qk + l32; const bf16x8 qfr = *(const LAS bf16x8*)(ql + qrow * 128 + ((ch ^ ((qrow >> 1) & 7)) * 16));
                            S[kb][qk] = __builtin_amdgcn_mfma_f32_32x32x16_bf16(kf, qfr, S[kb][qk], 0, 0, 0); } }
#pragma unroll
                for (int qk = 0; qk < 2; ++qk) {
                    if (needmask) { const int rq = rhalf * 64 + qk * 32 + l32;
#pragma unroll
                        for (int kb = 0; kb < 2; ++kb)
#pragma unroll
                            for (int e = 0; e < 16; ++e) { const int kk = 64 * t + 32 * kb + 8 * (e >> 2) + 4 * hh + (e & 3); const int rel = kk - 128 - rq; if (rel < -128 || rel > 128) S[kb][qk][e] = -__builtin_inff(); } }
                    float rs = 0.f;
#pragma unroll
                    for (int kb = 0; kb < 2; ++kb)
#pragma unroll
                        for (int e = 0; e < 16; ++e) { const float p = __builtin_amdgcn_exp2f(S[kb][qk][e]); S[kb][qk][e] = p; rs += p; }
                    l_run[qk] += rs;
#pragma unroll
                    for (int kb = 0; kb < 2; ++kb)
#pragma unroll
                        for (int sp = 0; sp < 2; ++sp) { u32x4 pw;
                            pw.x = cvt_pk_bf16(S[kb][qk][8 * sp + 0], S[kb][qk][8 * sp + 1]); pw.y = cvt_pk_bf16(S[kb][qk][8 * sp + 2], S[kb][qk][8 * sp + 3]);
                            pw.z = cvt_pk_bf16(S[kb][qk][8 * sp + 4], S[kb][qk][8 * sp + 5]); pw.w = cvt_pk_bf16(S[kb][qk][8 * sp + 6], S[kb][qk][8 * sp + 7]);
                            pf[kb][sp][qk] = __builtin_bit_cast(bf16x8, pw); }
                }
                if (late) pvpend = true; else ATT_PV((unsigned)(idx * 16384));
            }
            __syncthreads();
            if (!more) break;
            pidx = idx; idx = nidx; t = tn; tn = tnn;
        }
        if (late && pvpend) ATT_PV((unsigned)(idx * 16384));
#undef ATT_PV
#undef ATT_PV_STEP
#undef ATT_TOK0
#undef ATT_NEXT
#pragma unroll
        for (int qk = 0; qk < 2; ++qk) {
            const float lt = l_run[qk] + __shfl_xor(l_run[qk], 32); const float inv = 1.0f / lt;
            const size_t tok = (size_t)(qtok0 + rhalf * 64 + qk * 32 + l32);
#pragma unroll
            for (int db = 0; db < 2; ++db) { const float i16 = inv * 16.0f; unsigned pq[4];
#pragma unroll
                for (int vq = 0; vq < 4; ++vq) pq[vq] = pk4_fp8(clamp8(O[db][qk][4 * vq] * i16), clamp8(O[db][qk][4 * vq + 1] * i16), clamp8(O[db][qk][4 * vq + 2] * i16), clamp8(O[db][qk][4 * vq + 3] * i16));
                const auto r01 = __builtin_amdgcn_permlane32_swap(pq[0], pq[1], false, false), r23 = __builtin_amdgcn_permlane32_swap(pq[2], pq[3], false, false);
                const auto s0 = __builtin_amdgcn_permlane32_swap(r01[0], r23[0], false, false), s1 = __builtin_amdgcn_permlane32_swap(r01[1], r23[1], false, false);
                *(u32x4*)(AO + tok * 512 + head * 64 + 32 * db + 16 * hh) = (u32x4){s0[0], s1[0], s0[1], s1[1]}; }
        }
    }
    __syncthreads();
}

struct Args { const float* in[20]; float* out; unsigned char* ws; int ph_lo, ph_hi; };

constexpr int PH_PER_LAYER = 9;
constexpr int PH_FINAL = 1 + DEPTH * PH_PER_LAYER;
constexpr int PH_COUNT = PH_FINAL + 1;

__global__ void __launch_bounds__(512, 2) fwd_kernel(Args args) {
    extern __shared__ __attribute__((aligned(16))) unsigned char lds_raw[];
    Fr F;
    F.lds = (LAS unsigned char*)lds_raw; F.ws = args.ws; F.out = args.out;
    F.tid = threadIdx.x; F.lane = F.tid & 63; F.wave = __builtin_amdgcn_readfirstlane(F.tid >> 6); F.G = gridDim.x; F.bid = blockIdx.x;
    volatile LAS unsigned* misc = (volatile LAS unsigned*)(F.lds + LDS_MISC);
    if (F.tid < 64) misc[F.tid] = 0u;
    if (F.tid < 20) { const unsigned long long pv = (unsigned long long)args.in[F.tid]; misc[128 + 2 * F.tid] = (unsigned)pv; misc[128 + 2 * F.tid + 1] = (unsigned)(pv >> 32); }
    __syncthreads();
    XcdBarrier bar; bar.bar = (unsigned*)(F.ws + WS_CTL); bar.x = 0; bar.st = misc;
    const bool one = (args.ph_hi - args.ph_lo) > 1;
    if (one) bar = xcd_barrier_post((unsigned*)(F.ws + WS_CTL), misc);
    const int lo = args.ph_lo, hi = args.ph_hi;
#ifdef STOP_PH
#define IN(k) (lo <= (k) && (k) < hi && ((k) < STOP_PH || (k) == PH_FINAL))
#else
#define IN(k) (lo <= (k) && (k) < hi)
#endif
#ifndef DUP_PH
#define DUP_PH -1
#endif
#define NREP(b) ((DUP_PH == (b)) ? 2 : 1)
#define SEAM(k) do { if (lo <= (k) + 1 && (k) + 1 < hi) xcd_barrier(bar); } while (0)

#ifndef PHM
#define PHM 0xFFFF
#endif
#define PHON(b) ((PHM >> (b)) & 1)
    if (PHON(0) && IN(0)) { for (int rep = 0; rep < NREP(0); ++rep) { LAUNDER(F); prologue_phase(F); SEAM(0); } }

#pragma unroll 1
    for (int l = 0; l < NLAYERS_RUN; ++l) {
        const int pb = 1 + l * PH_PER_LAYER;
        const bool lastl = (l == DEPTH - 1);
        if (PHON(1) && IN(pb + 0)) { LAUNDER(F); norm1_phase(F, l); SEAM(pb + 0); }
        if (PHON(2) && IN(pb + 1)) for (int rep = 0; rep < NREP(2); ++rep) { LAUNDER(F);
            { InProjProb<0> P; P.H = WSP(signed char, WS_H8); P.W = WSP(signed char, WS_WIN) + (size_t)l * IN_DIM * 1024; P.sH = WSP(float, WS_SH); P.sW = WSP(float, WS_SWIN) + (size_t)l * IN_DIM;
              P.FT = WSP(bf16_t, WS_FT); P.FCT = WSP(bf16_t, WS_FCT); P.Q = WSP(bf16_t, WS_Q); P.Kb = WSP(bf16_t, WS_K); P.Vb = WSP(bf16_t, WS_V); P.GF = WSP(bf16_t, WS_GF); P.GA = WSP(bf16_t, WS_GA);
              P.rope = (const LAS float*)(F.lds + LDS_ROPE);
              { const float* rg = WSP(float, WS_ROPE); LAS float* rl = (LAS float*)(F.lds + LDS_ROPE); for (int i = F.tid; i < 4096; i += 512) rl[i] = rg[i]; __syncthreads(); }
              P.nM = lastl ? 128 : 132; P.n_nat = P.nM * 11; P.n_fx = 256; P.n_fc = lastl ? 0 : 8; P.n_extra = lastl ? 4 : 0; P.G = F.G; P.c = F.bid;
              g8::gemm_run(F.lds, P); }
            { InProjProb<1> P; P.H = WSP(signed char, WS_H8); P.W = WSP(signed char, WS_WIN) + (size_t)l * IN_DIM * 1024; P.sH = WSP(float, WS_SH); P.sW = WSP(float, WS_SWIN) + (size_t)l * IN_DIM;
              P.FT = WSP(bf16_t, WS_FT); P.FCT = WSP(bf16_t, WS_FCT); P.Q = nullptr; P.Kb = nullptr; P.Vb = nullptr; P.GF = nullptr; P.GA = nullptr; P.rope = nullptr;
              P.nM = 0; P.n_nat = 0; P.n_fx = 256; P.n_fc = lastl ? 0 : 8; P.n_extra = 0; P.G = F.G; P.c = (F.bid + 84) % F.G;
              g8::gemm_run(F.lds, P); }
            SEAM(pb + 1);
        }
        if (PHON(3) && IN(pb + 2)) for (int rep = 0; rep < NREP(3); ++rep) { LAUNDER(F);
#ifndef NO_ATTN
            attn_phase(F, l, !lastl);
#endif
#ifndef NO_FFT1
            Fft1Prob P; P.W1 = WSP(bf16_t, WS_W1); P.FT = WSP(bf16_t, WS_FT); P.WC = WSP(bf16_t, WS_WC); P.FCT = WSP(bf16_t, WS_FCT); P.T1 = WSP(bf16_t, WS_T1); P.XS = WSP(unsigned char, WS_XS);
            P.n0 = 512; P.n1 = lastl ? 0 : 16; P.G = F.G; P.c = (F.bid + 128) % F.G;
            g8::gemm_run(F.lds, P);
#endif
            SEAM(pb + 2);
        }
        if (PHON(4) && IN(pb + 3)) for (int rep = 0; rep < NREP(4); ++rep) { LAUNDER(F);
            const int nctx = lastl ? 0 : 16;
            { Fft2Prob P; P.MT = WSP(bf16_t, WS_MT); P.T1 = WSP(bf16_t, WS_T1); P.XS = WSP(unsigned char, WS_XS); P.G = F.G - nctx; P.c = F.bid - nctx;
              g8::gemm_run(F.lds, P); }
            if (nctx) { Merge1Prob P; P.XS = WSP(unsigned char, WS_XS); P.AO = WSP(unsigned char, WS_AO); P.WFO = WSP(unsigned char, WS_WFO) + (size_t)l * 1024 * 1024; P.WAO = WSP(unsigned char, WS_WAO) + (size_t)l * 1024 * 512;
              P.GF = WSP(unsigned char, WS_GF); P.GA = WSP(unsigned char, WS_GA); P.Y8 = WSP(unsigned char, WS_YB); P.nM = 4; P.pm0 = 128; P.G = 16; P.c = (F.bid < 16) ? F.bid : -1;
              g8::gemm_run(F.lds, P); }
            SEAM(pb + 3);
        }
        if (PHON(5) && IN(pb + 4)) for (int rep = 0; rep < NREP(5); ++rep) { LAUNDER(F);
            { Merge1Prob P; P.XS = WSP(unsigned char, WS_XS); P.AO = WSP(unsigned char, WS_AO); P.WFO = WSP(unsigned char, WS_WFO) + (size_t)l * 1024 * 1024; P.WAO = WSP(unsigned char, WS_WAO) + (size_t)l * 1024 * 512;
              P.GF = WSP(unsigned char, WS_GF); P.GA = WSP(unsigned char, WS_GA); P.Y8 = WSP(unsigned char, WS_YB); P.nM = 128; P.pm0 = 0; P.G = F.G; P.c = F.bid;
              g8::gemm_run(F.lds, P); }
            SEAM(pb + 4);
        }
        if (PHON(6) && IN(pb + 5)) { LAUNDER(F);
            MergeProb<2> P; P.A = WSP(unsigned char, WS_YB); P.W = WSP(unsigned char, WS_WOUT) + (size_t)l * 1024 * 1024; P.lda = 1024; P.GATE = nullptr; P.T = nullptr; P.Y8 = nullptr;
            P.xin = INP(0); P.cin = INP(2); P.XWb = WSP(bf16_t, WS_XW); P.CWb = WSP(bf16_t, WS_CW); P.in32 = (l == 0);
            P.g1x = WSP(float, WS_MOD) + (size_t)l * 5 * 6144 + 2 * 1024; P.g1c = WSP(float, WS_MOD) + ((size_t)l * 5 + 4) * 6144 + 2 * 1024; P.nM = lastl ? 128 : 132; P.G = F.G; P.c = F.bid;
            g8::gemm_run(F.lds, P); SEAM(pb + 5);
        }
        if (PHON(7) && IN(pb + 6)) for (int rep = 0; rep < NREP(7); ++rep) { LAUNDER(F); norm2_router_phase(F, l, rep + 1 < NREP(7)); SEAM(pb + 6); }
        if (PHON(8) && IN(pb + 7)) for (int rep = 0; rep < NREP(8); ++rep) { LAUNDER(F);
            MoeGuProb P; P.R = fill_tstart(F, l);
            P.H8 = WSP(signed char, WS_H8); P.W8 = WSP(signed char, WS_WGU) + (size_t)l * 32 * 2048 * 1024; P.sW = WSP(float, WS_SWGU) + (size_t)l * 32 * 2048; P.lsc = WSP(float, WS_LSC);
            P.bgu = INP(16) + (size_t)l * 32 * 2048; P.ACT = WSP(unsigned char, WS_ACT);
            P.list = WSP(int, WS_LIST); P.cnt = (const int*)(F.ws + WS_CTL + CTL_CNT) + l * 32; P.tstart = (const volatile LAS int*)(F.lds + LDS_MISC + 64); P.G = F.G; P.c = F.bid;
            g8::gemm_run(F.lds, P); SEAM(pb + 7);
        }
        if (PHON(9) && IN(pb + 8)) for (int rep = 0; rep < NREP(9); ++rep) { LAUNDER(F);
            MoeDnProb P; P.R = fill_tstart(F, l);
            P.ACT = WSP(unsigned char, WS_ACT); P.W = WSP(unsigned char, WS_WDN) + (size_t)l * 32 * 1024 * 1024; P.bdn = INP(18) + (size_t)l * 32 * 1024; P.YE = WSP(unsigned char, WS_YE);
            P.tstart = (const volatile LAS int*)(F.lds + LDS_MISC + 64); P.G = F.G; P.c = F.bid;
            g8::gemm_run(F.lds, P, ((F.bid >> 3) & 3) * STG_DN); SEAM(pb + 8);
        }
    }
#ifdef STOP_PH
    if (IN(PH_FINAL)) { LAUNDER(F);
        const size_t n = (size_t)TX * 1024;
        for (size_t i = (size_t)F.bid * 512 + F.tid; i < n; i += (size_t)F.G * 512) {
            F.out[i] = DUMP_EXPR(i);
        } }
#else
    if (PHON(10) && IN(PH_FINAL)) for (int rep = 0; rep < NREP(10); ++rep) { LAUNDER(F); norm1_phase(F, DEPTH); if (rep + 1 < NREP(10)) xcd_barrier(bar); }
#endif
#undef IN
#undef SEAM
}

extern "C" void kernel_launch(void* const* d_in, const int* in_sizes, int n_in, void* d_out, int out_size, void* d_ws, size_t ws_size, hipStream_t stream) {
    static int grid = 0;
    if (grid == 0) {
        if (n_in != 20 || ws_size < WS_END) { fprintf(stderr, "kernel_launch: bad arguments (n_in %d, ws %zu < %zu)\n", n_in, ws_size, (size_t)WS_END); grid = -1; return; }
        int dev = 0, cus = 0, per_cu = 0;
        if (hipGetDevice(&dev) != hipSuccess || hipDeviceGetAttribute(&cus, hipDeviceAttributeMultiprocessorCount, dev) != hipSuccess) { grid = -1; return; }
        if (hipFuncSetAttribute((const void*)fwd_kernel, hipFuncAttributeMaxDynamicSharedMemorySize, LDS_BYTES) != hipSuccess) { fprintf(stderr, "kernel_launch: hipFuncSetAttribute failed\n"); grid = -1; return; }
        if (hipOccupancyMaxActiveBlocksPerMultiprocessor(&per_cu, (const void*)fwd_kernel, 512, LDS_BYTES) != hipSuccess || per_cu < 1) { fprintf(stderr, "kernel_launch: occupancy query says %d\n", per_cu); }
        (void)hipGetLastError();
        grid = cus;
    }
    if (grid < 0) return;
    (void)hipMemsetAsync((char*)d_ws + WS_CTL, 0, CTL_BYTES, stream);
    Args a{};
    for (int i = 0; i < 20; ++i) a.in[i] = (const float*)d_in[i];
    a.out = (float*)d_out; a.ws = (unsigned char*)d_ws;
#if N_LAUNCH_MODE == 1
    a.ph_lo = 0; a.ph_hi = PH_COUNT;
    hipLaunchKernelGGL(fwd_kernel, dim3(grid), dim3(512), LDS_BYTES, stream, a);
#else
    for (int p = 0; p < PH_COUNT; ++p) { a.ph_lo = p; a.ph_hi = p + 1; hipLaunchKernelGGL(fwd_kernel, dim3(grid), dim3(512), LDS_BYTES, stream, a); }
#endif
    (void)in_sizes; (void)out_size;
}
```

```cpp
#include <hip/hip_runtime.h>
#include <cstdio>
#include <cstdint>

#define LAS __attribute__((address_space(3)))
#define GAS __attribute__((address_space(1)))
typedef unsigned short bf16_t;
typedef short bf16x8 __attribute__((ext_vector_type(8)));
typedef short s16x4 __attribute__((ext_vector_type(4)));
typedef float f32x4 __attribute__((ext_vector_type(4)));
typedef float f32x16 __attribute__((ext_vector_type(16)));
typedef unsigned u32x4 __attribute__((ext_vector_type(4)));
typedef unsigned u32x2 __attribute__((ext_vector_type(2)));
typedef int i32x4 __attribute__((ext_vector_type(4)));
typedef int i32x8 __attribute__((ext_vector_type(8)));

#ifndef N_LAUNCH_MODE
#define N_LAUNCH_MODE 1
#endif
#ifndef DBG_CHECK
#define DBG_CHECK 0
#endif
#ifndef EMU8
#define EMU8 false
#endif
#ifndef STG_DN
#define STG_DN 0
#endif
#ifndef STG_GU
#define STG_GU 0
#endif
#ifndef STG_IN
#define STG_IN 0
#endif
#ifndef NLAYERS_RUN
#define NLAYERS_RUN 4
#endif

constexpr int D = 1024, NB = 4, SEQ = 8192, TX = NB * SEQ, LC = 256, TC = NB * LC, TT = TX + TC, DEPTH = 4;
constexpr int IN_DIM = 3328, NEXP = 32;
constexpr int ROWS_MAX = TT * 4 + NEXP * 256;
constexpr float LOG2E = 1.4426950408889634f;
constexpr float QSCALE = 0.125f * LOG2E;
constexpr float EPS = 1e-5f;
constexpr float SOFT_C = 16.0f;

constexpr size_t al256(size_t x) { return (x + 255) & ~(size_t)255; }
constexpr size_t WS_CTL = 0;
constexpr size_t CTL_BYTES = 65536;
constexpr size_t CTL_CNT = 16384;
constexpr size_t WS_MOD = WS_CTL + CTL_BYTES;
constexpr size_t WS_ROPE = WS_MOD + al256((size_t)DEPTH * 5 * 6144 * 4);
constexpr size_t WS_W1 = WS_ROPE + 16384;
constexpr size_t WS_MT = WS_W1 + 256 * 128 * 2;
constexpr size_t WS_WC = WS_MT + (size_t)64 * 256 * 128 * 2;
constexpr size_t WS_RWT = WS_WC + 512 * 256 * 2;
constexpr size_t WS_WIN = WS_RWT + (size_t)DEPTH * 32 * 1024 * 2;
constexpr size_t WS_SWIN = WS_WIN + (size_t)DEPTH * IN_DIM * 1024;
constexpr size_t WS_WFO = WS_SWIN + al256((size_t)DEPTH * IN_DIM * 4);
constexpr size_t WS_WAO = WS_WFO + (size_t)DEPTH * 1024 * 1024 * 2;
constexpr size_t WS_WOUT = WS_WAO + (size_t)DEPTH * 1024 * 512 * 2;
constexpr size_t WS_WGU = WS_WOUT + (size_t)DEPTH * 1024 * 1024 * 2;
constexpr size_t WS_SWGU = WS_WGU + (size_t)DEPTH * 32 * 2048 * 1024;
constexpr size_t WS_WDN = WS_SWGU + (size_t)DEPTH * 32 * 2048 * 4;
constexpr size_t WS_H = WS_WDN + (size_t)DEPTH * 32 * 1024 * 1024 * 2;
constexpr size_t WS_FT = WS_H + (size_t)(TT + 256) * 1024 * 2;
constexpr size_t WS_FCT = WS_FT + (size_t)131072 * 128 * 2;
constexpr size_t WS_Q = WS_FCT + (size_t)2048 * 256 * 2;
constexpr size_t WS_K = WS_Q + (size_t)TT * 512 * 2;
constexpr size_t WS_V = WS_K + (size_t)TT * 128 * 2;
constexpr size_t WS_GF = WS_V + (size_t)TT * 128 * 2;
constexpr size_t WS_GA = WS_GF + (size_t)TT * 1024 * 2;
constexpr size_t WS_T1 = WS_GA + (size_t)TT * 1024 * 2;
constexpr size_t WS_XS = WS_T1 + (size_t)64 * 2048 * 128 * 2;
constexpr size_t WS_AO = WS_XS + (size_t)TT * 1024 * 2;
constexpr size_t WS_YB = WS_AO + (size_t)TT * 512 * 2;
constexpr size_t WS_XW = WS_YB + (size_t)TT * 1024 * 2;
constexpr size_t WS_CW = WS_XW + (size_t)TX * 1024 * 4;
constexpr size_t WS_ACT = WS_CW + (size_t)TC * 1024 * 4;
constexpr size_t WS_YE = WS_ACT + (size_t)ROWS_MAX * 1024 * 2;
constexpr size_t WS_LIST = WS_YE + (size_t)ROWS_MAX * 1024 * 2;
constexpr size_t WS_SLOT = WS_LIST + (size_t)32 * TT * 4;
constexpr size_t WS_GATE = WS_SLOT + (size_t)TT * 4 * 4;
constexpr size_t WS_H8 = WS_GATE + (size_t)TT * 4 * 4;
constexpr size_t WS_LSC = WS_H8 + (size_t)(TT + 256) * 1024;
constexpr size_t WS_SH = WS_LSC + (size_t)32 * TT * 4;
constexpr size_t WS_END = WS_SH + (size_t)(TT + 256) * 4;

constexpr int LDS_STAGE = 131072;
constexpr int LDS_MISC = LDS_STAGE;
constexpr int LDS_ROPE = LDS_MISC + 4096;
constexpr int LDS_BYTES = 163840;

typedef __bf16 bf16v2_t __attribute__((ext_vector_type(2)));
typedef float f32x2_t __attribute__((ext_vector_type(2)));
__device__ __forceinline__ unsigned cvt_pk_bf16(float lo, float hi) { const f32x2_t v = {lo, hi}; const bf16v2_t b = __builtin_convertvector(v, bf16v2_t); return __builtin_bit_cast(unsigned, b); }
__device__ __forceinline__ float q8(float x) { const int p = __builtin_amdgcn_cvt_pk_fp8_f32(x, 0.f, 0, false); return __builtin_amdgcn_cvt_f32_fp8(p, 0); }
__device__ __forceinline__ unsigned pk4_fp8(float a, float b, float c, float d) { int p = __builtin_amdgcn_cvt_pk_fp8_f32(a, b, 0, false); p = __builtin_amdgcn_cvt_pk_fp8_f32(c, d, p, true); return (unsigned)p; }
__device__ __forceinline__ float clamp8(float x) { return __builtin_amdgcn_fmed3f(x, -448.0f, 448.0f); }
__device__ __forceinline__ u32x2 pack8_fp8(const f32x4& v0, const f32x4& v1, float sc) { u32x2 w; w.x = pk4_fp8(clamp8(v0[0] * sc), clamp8(v0[1] * sc), clamp8(v0[2] * sc), clamp8(v0[3] * sc)); w.y = pk4_fp8(clamp8(v1[0] * sc), clamp8(v1[1] * sc), clamp8(v1[2] * sc), clamp8(v1[3] * sc)); return w; }
__device__ __forceinline__ bf16_t f2bf(float f) { return (bf16_t)(cvt_pk_bf16(f, 0.f) & 0xffffu); }
__device__ __forceinline__ float bf_lo(unsigned u) { return __uint_as_float(u << 16); }
__device__ __forceinline__ float bf_hi(unsigned u) { return __uint_as_float(u & 0xffff0000u); }
__device__ __forceinline__ float bf2f(bf16_t b) { return __uint_as_float(((unsigned)b) << 16); }
__device__ __forceinline__ float sigmoidf_(float x) { return __builtin_amdgcn_rcpf(1.0f + __builtin_amdgcn_exp2f(-x * LOG2E)); }
__device__ __forceinline__ float wave_sum(float v) {
#pragma unroll
    for (int o = 32; o >= 1; o >>= 1) v += __shfl_xor(v, o);
    return v;
}

#define XB_TMO      128
#define XB_XCNT(j)  (256  + 64 * (j))
#define XB_XSUB(j)  (1280 + 64 * (j))
#define XB_XGEN(j)  (2304 + 64 * (j))
#define XB_TOP      3328
#define XB_TOPGEN   3392
#define XCD_BAR_WORDS 3456
#define XB_SPIN_CAP (1u << 22)

__device__ __forceinline__ unsigned xb_ld(unsigned* p)              { return __hip_atomic_load(p, __ATOMIC_RELAXED, __HIP_MEMORY_SCOPE_AGENT); }
__device__ __forceinline__ unsigned xb_add(unsigned* p, unsigned v) { return __hip_atomic_fetch_add(p, v, __ATOMIC_RELAXED, __HIP_MEMORY_SCOPE_AGENT); }
__device__ __forceinline__ unsigned xb_xcc_id() { return (unsigned)__builtin_amdgcn_s_getreg((3 << 11) | 20) & 0xFu; }
#define XB_SPIN(cond, bar) do { unsigned _sp = 0; while (cond) { __builtin_amdgcn_s_sleep(1); \
    if ((++_sp & 255u) == 0u) { if (xb_ld(&(bar)[XB_TMO])) break; if (_sp > XB_SPIN_CAP) { atomicAdd(&(bar)[XB_TMO], 1u); break; } } } } while (0)

struct XcdBarrier { unsigned* bar; unsigned x; volatile LAS unsigned* st; };

__device__ __forceinline__ XcdBarrier xcd_barrier_post(unsigned* bar, volatile LAS unsigned* st) {
    XcdBarrier b; b.bar = bar; b.x = xb_xcc_id(); b.st = st;
    if (threadIdx.x == 0) (void)xb_add(&bar[XB_XCNT(b.x)], 1u);
    return b;
}
__device__ __forceinline__ void xcd_barrier_complete(unsigned* bar, unsigned x, unsigned& nloc, unsigned& nx) {
    const unsigned G = gridDim.x * gridDim.y * gridDim.z;
    unsigned sum, cnt, mine, sp = 0u;
    for (;;) {
        sum = 0u; cnt = 0u; mine = 0u;
#pragma unroll
        for (unsigned j = 0; j < 16; ++j) { const unsigned c = xb_ld(&bar[XB_XCNT(j)]); sum += c; cnt += (c > 0u) ? 1u : 0u; mine = (j == x) ? c : mine; }
        if (sum == G) break;
        __builtin_amdgcn_s_sleep(1);
        if ((++sp & 255u) == 0u) { if (xb_ld(&bar[XB_TMO])) break; if (sp > XB_SPIN_CAP) { atomicAdd(&bar[XB_TMO], 1u); break; } }
    }
    nloc = mine > 0u ? mine : 1u; nx = cnt > 0u ? cnt : 1u;
}
__device__ __forceinline__ void xcd_barrier(const XcdBarrier& b) {
    asm volatile("s_waitcnt vmcnt(0)" ::: "memory");
    __syncthreads();
    if (threadIdx.x == 0) {
        unsigned* bar = b.bar;
        __builtin_amdgcn_s_waitcnt(0);
        unsigned nloc = b.st[0], nx = b.st[1];
        if (nloc == 0u) { xcd_barrier_complete(bar, b.x, nloc, nx); b.st[0] = nloc; b.st[1] = nx; }
        const unsigned old = xb_add(&bar[XB_XSUB(b.x)], 1u);
        const unsigned gen = old / nloc;
        if (old + 1u == (gen + 1u) * nloc) {
            __builtin_amdgcn_fence(__ATOMIC_RELEASE, "agent");
            asm volatile("s_waitcnt vmcnt(0)" ::: "memory");
            const unsigned og = xb_add(&bar[XB_TOP], 1u);
            const unsigned tg = og / nx;
            if (og + 1u == (tg + 1u) * nx) xb_add(&bar[XB_TOPGEN], 1u);
            else XB_SPIN(xb_ld(&bar[XB_TOPGEN]) == tg, bar);
            __builtin_amdgcn_fence(__ATOMIC_ACQUIRE, "agent");
            xb_add(&bar[XB_XGEN(b.x)], 1u);
            asm volatile("s_waitcnt vmcnt(0)" ::: "memory");
        } else {
            XB_SPIN(xb_ld(&bar[XB_XGEN(b.x)]) == gen, bar);
            __builtin_amdgcn_fence(__ATOMIC_ACQUIRE, "agent");
            asm volatile("s_waitcnt vmcnt(0)" ::: "memory");
        }
    }
    __syncthreads();
}

struct Fr {
    LAS unsigned char* lds;
    unsigned char* ws;
    float* out;
    int tid, lane, wave, G, bid;
};
__device__ __forceinline__ const float* in_ptr(const Fr& F, int i) {
    volatile LAS unsigned* p = (volatile LAS unsigned*)(F.lds + 131072 + 512) + 2 * i;
    const unsigned lo = __builtin_amdgcn_readfirstlane(p[0]), hi = __builtin_amdgcn_readfirstlane(p[1]);
    return (const float*)(GAS const float*)(((unsigned long long)hi << 32) | lo);
}
#define INP(i) in_ptr(F, (i))
#define LAUNDER(F) do { GAS unsigned char* _w = (GAS unsigned char*)(F).ws; asm volatile("" : "+s"(_w)); (F).ws = (unsigned char*)_w;     int _t = threadIdx.x; asm volatile("" : "+v"(_t)); (F).tid = _t; (F).lane = _t & 63; (F).wave = __builtin_amdgcn_readfirstlane(_t >> 6); } while (0)
#define WSP(T, off) ((T*)(F.ws + (off)))

namespace g8 {
constexpr int BM = 256, BK = 64, HALF = 128, HTB = HALF * BK * 2, NXCD = 8, WGM = 8;
__device__ __forceinline__ int lds_byte(int r, int c) { const int st = (r >> 4) * 2 + (c >> 5), rr = r & 15, cc = c & 31, ob = rr * 64 + cc * 2; return st * 1024 + (ob ^ (((ob >> 9) & 1) << 5)); }
__device__ __forceinline__ void stage_rc(int b, int& R, int& C) { const int st = b / 1024, sb = b % 1024, swz = sb ^ (((sb >> 9) & 1) << 5); R = (st >> 1) * 16 + swz / 64; C = (st & 1) * 32 + (swz % 64) / 2; }
__device__ __forceinline__ int perm32(int rho) { const int n = rho >> 4, i = rho & 15; return 8 * (i >> 2) + 4 * n + (i & 3); }
template <int NN>
__device__ __forceinline__ void order2d_c(int L, int nM, int& pm, int& pn) {
    const int nwg = nM * NN;
    int wgid = L; { const int q = nwg >> 3, r = nwg & 7, xcd = wgid & 7, off = wgid >> 3; wgid = (xcd < r ? xcd * (q + 1) : r * (q + 1) + (xcd - r) * q) + off; }
    constexpr int nig = WGM * NN; const int gid = wgid / nig, x = wgid - gid * nig, fm = gid * WGM, gsz = (nM - fm) < WGM ? (nM - fm) : WGM;
    if (gsz == WGM) { pm = fm + (x & 7); pn = x >> 3; } else { pm = fm + (x % gsz); pn = x / gsz; }
}
__device__ __forceinline__ void order2d(int L, int nM, int nN, int& pm, int& pn) {
    if (nN == 4) order2d_c<4>(L, nM, pm, pn); else if (nN == 8) order2d_c<8>(L, nM, pm, pn); else order2d_c<11>(L, nM, pm, pn);
}
__device__ __forceinline__ void lane_geom(int tid, int& R0, int& Rb0, int& C0) { asm volatile("" : "+v"(tid)); stage_rc(tid * 16, R0, C0); Rb0 = (R0 & ~31) + perm32(R0 & 31); }

__device__ __forceinline__ void lane_geom_w(int tid, int& R0, int& Rbw, int& C0) { asm volatile("" : "+v"(tid)); stage_rc(tid * 16, R0, C0); const int i = R0 & 31; Rbw = 64 * (R0 >> 5) + 16 * ((i >> 2) & 3) + 4 * (i >> 4) + (i & 3); }
#define G8_DBW(j) (128 * ((j) & 1) + 8 * ((j) >> 1))
#define G8_COLW(bj) (64 * wc + 16 * fq + 8 * (bj))
#define G8_ROWS(ai, m) (128 * (ai) + 64 * wr + 16 * (m) + fr)
#define G8_COL0(bj) (128 * (bj) + 32 * wc + 8 * fq)
#define G8_GOFF(pm, pn4, ai, m) (((size_t)((pm) * 4 + (pn4)) * 8 + (wr * 4 + wc)) * 8192 + ((ai) * 4 + (m)) * 1024 + (fq * 16 + fr) * 16)

template <bool I8> __device__ __forceinline__ f32x4 mma1(const bf16x8& b, const bf16x8& a, const f32x4& c) { return __builtin_amdgcn_mfma_f32_16x16x32_bf16(b, a, c, 0, 0, 0); }
template <bool I8> __device__ __forceinline__ i32x4 mma1(const bf16x8& b, const bf16x8& a, const i32x4& c) { return __builtin_amdgcn_mfma_i32_16x16x64_i8(__builtin_bit_cast(i32x4, b), __builtin_bit_cast(i32x4, a), c, 0, 0, 0); }
__device__ __forceinline__ f32x4 mma8(const bf16x8& b0, const bf16x8& b1, const bf16x8& a0, const bf16x8& a1, const f32x4& c) {
    const i32x4 B0 = __builtin_bit_cast(i32x4, b0), B1 = __builtin_bit_cast(i32x4, b1), A0 = __builtin_bit_cast(i32x4, a0), A1 = __builtin_bit_cast(i32x4, a1);
    const i32x8 B = {B0[0], B0[1], B0[2], B0[3], B1[0], B1[1], B1[2], B1[3]}, A = {A0[0], A0[1], A0[2], A0[3], A1[0], A1[1], A1[2], A1[3]};
    return __builtin_amdgcn_mfma_scale_f32_16x16x128_f8f6f4(B, A, c, 0, 0, 0, 0x7F7F7F7F, 0, 0x7F7F7F7F);
}
template <class P>
__device__ __forceinline__ void gemm_run(LAS unsigned char* lds, P& prob, int stagger = 0) {
    if (stagger > 0) { const unsigned long long t0 = __builtin_amdgcn_s_memrealtime(); while ((int)(__builtin_amdgcn_s_memrealtime() - t0) < stagger) __builtin_amdgcn_s_sleep(16); }
    int tid = threadIdx.x; asm volatile("" : "+v"(tid));
    const int wid = __builtin_amdgcn_readfirstlane(tid >> 6), lane = tid & 63, wr = wid >> 2, wc = wid & 3, fr = lane & 15, fq = lane >> 4;
    const size_t kstep = (size_t)(BK * 2);
    const unsigned ldsw = (unsigned)wid * 1024u;
    const int aoff = lds_byte(wr * 64 + fr, fq * 8), boff = lds_byte(wc * 32 + fr, fq * 8);
#define G8_SA(b, h) (((b) * 2 + (h)) * HTB)
#define G8_SB(b, h) ((4 + (b) * 2 + (h)) * HTB)
#define G8_STAGE_(bufoff, g0, o0, g1, o1) do { \
        __builtin_amdgcn_global_load_lds((const unsigned*)((const char*)(g0) + (o0)), (LAS unsigned*)(lds + (bufoff) + ldsw), 16, 0, 0); \
        __builtin_amdgcn_global_load_lds((const unsigned*)((const char*)(g1) + (o1)), (LAS unsigned*)(lds + (bufoff) + ldsw + 8192), 16, 0, 0); } while (0)
#define G8_OA(j) (P::GATHER_A ? oa[j] : oa[0])
#define G8_STA(bufoff, gbase, h) G8_STAGE_(bufoff, (gbase) + dA[2 * (h)], G8_OA(2 * (h)), (gbase) + dA[2 * (h) + 1], G8_OA(2 * (h) + 1))
#define G8_STB(bufoff, gbase, h) G8_STAGE_(bufoff, (gbase) + dB[2 * (h)], ob, (gbase) + dB[2 * (h) + 1], ob)
#define G8_LDA(dst, b, h) do { _Pragma("unroll") for (int m = 0; m < 4; ++m) _Pragma("unroll") for (int k = 0; k < 2; ++k) dst[m][k] = *(const LAS bf16x8*)(lds + G8_SA(b, h) + aoff + m * 2048 + k * 1024); } while (0)
#define G8_LDB(dst, b, h) do { _Pragma("unroll") for (int n = 0; n < 2; ++n) _Pragma("unroll") for (int k = 0; k < 2; ++k) dst[n][k] = *(const LAS bf16x8*)(lds + G8_SB(b, h) + boff + n * 2048 + k * 1024); } while (0)
#define G8_MMA(ai, bj, At, Bt) do { __builtin_amdgcn_s_setprio(1); \
        if constexpr (P::F8) { _Pragma("unroll") for (int m = 0; m < 4; ++m) _Pragma("unroll") for (int n = 0; n < 2; ++n) acc[ai][bj][m][n] = mma8(Bt[n][0], Bt[n][1], At[m][0], At[m][1], acc[ai][bj][m][n]); } \
        else { _Pragma("unroll") for (int m = 0; m < 4; ++m) _Pragma("unroll") for (int n = 0; n < 2; ++n) _Pragma("unroll") for (int k = 0; k < 2; ++k) \
        acc[ai][bj][m][n] = mma1<P::I8>(Bt[n][k], At[m][k], acc[ai][bj][m][n]); } __builtin_amdgcn_s_setprio(0); } while (0)
#define G8_WAIT_V(n) asm volatile("s_waitcnt vmcnt(" #n ")" ::: "memory")
#define G8_WAIT_L(n) asm volatile("s_waitcnt lgkmcnt(" #n ")" ::: "memory")
#define G8_BAR __builtin_amdgcn_s_barrier()
#define G8_SCHED __builtin_amdgcn_sched_barrier(0)
    typename P::U cur, nxt; int ui = 0;
    if (!prob.get(0, cur)) return;
    typedef typename P::Acc Acc;
    Acc acc[2][2][4][2];
#pragma unroll
    for (int a = 0; a < 2; ++a)
#pragma unroll
        for (int b = 0; b < 2; ++b)
#pragma unroll
            for (int m = 0; m < 4; ++m)
#pragma unroll
                for (int n = 0; n < 2; ++n) acc[a][b][m][n] = (Acc){0, 0, 0, 0};
    bf16x8 At[4][2], B0[2][2], B1[2][2];
    unsigned oa[4], ob, dA[4], dB[4]; const char* cA; const char* cB; int nt;
    prob.setup(cur, oa, ob, dA, dB, cA, cB, nt);
    G8_STB(G8_SB(0, 0), cB, 0); G8_STA(G8_SA(0, 0), cA, 0); G8_STB(G8_SB(0, 1), cB, 1); G8_STA(G8_SA(0, 1), cA, 1);
    if (wr == 1) G8_BAR;
    G8_WAIT_V(4); G8_BAR;
    G8_STB(G8_SB(1, 0), cB + kstep, 0); G8_STA(G8_SA(1, 0), cA + kstep, 0); G8_STB(G8_SB(1, 1), cB + kstep, 1);
    G8_WAIT_V(6); G8_BAR;
    for (;;) {
        const bool has_next = prob.get(ui + 1, nxt);
        int nnt = nt;
#pragma unroll 1
        for (int t = 0; t < nt; t += 2) {
            const bool last = (t == nt - 2);
            G8_LDB(B0, 0, 0); G8_SCHED; G8_LDA(At, 0, 0); G8_STA(G8_SA(1, 1), cA + (size_t)(t + 1) * kstep, 1);
            G8_WAIT_L(8); G8_BAR; G8_WAIT_L(0); G8_MMA(0, 0, At, B0); G8_BAR; G8_SCHED;
            const char* a2; const char* b2;
            if (last) { if (has_next) { prob.setup(nxt, oa, ob, dA, dB, cA, cB, nnt); } a2 = cA; b2 = cB; }
            else { a2 = cA + (size_t)(t + 2) * kstep; b2 = cB + (size_t)(t + 2) * kstep; }
            const char* a3 = a2 + kstep; const char* b3 = b2 + kstep;
            G8_LDB(B1, 0, 1); G8_STB(G8_SB(0, 0), b2, 0);
            G8_BAR; G8_WAIT_L(0); G8_MMA(0, 1, At, B1); G8_BAR;
            G8_LDA(At, 0, 1); G8_STA(G8_SA(0, 0), a2, 0);
            G8_BAR; G8_WAIT_L(0); G8_MMA(1, 0, At, B0); G8_BAR; G8_SCHED;
            G8_STB(G8_SB(0, 1), b2, 1);
            G8_WAIT_V(6); G8_BAR; G8_MMA(1, 1, At, B1); G8_BAR;
            G8_LDB(B0, 1, 0); G8_SCHED; G8_LDA(At, 1, 0); G8_STA(G8_SA(0, 1), a2, 1);
            G8_WAIT_L(8); G8_BAR; G8_WAIT_L(0); G8_MMA(0, 0, At, B0); G8_BAR; G8_SCHED;
            G8_LDB(B1, 1, 1); G8_STB(G8_SB(1, 0), b3, 0);
            G8_BAR; G8_WAIT_L(0); G8_MMA(0, 1, At, B1); G8_BAR;
            G8_LDA(At, 1, 1); G8_STA(G8_SA(1, 0), a3, 0);
            G8_BAR; G8_WAIT_L(0); G8_MMA(1, 0, At, B0); G8_BAR; G8_SCHED;
            G8_STB(G8_SB(1, 1), b3, 1);
            G8_WAIT_V(6); G8_BAR; G8_MMA(1, 1, At, B1); G8_BAR;
            if (last) break;
        }
        bool keep = false;
        { int t2 = threadIdx.x; asm volatile("" : "+v"(t2)); const int l2 = t2 & 63;
          if constexpr (P::HAS_MID) { if (prob.is_mid(cur)) { prob.mid(acc, cur, wr, wc, l2 & 15, l2 >> 4); keep = true; } else prob.epi(acc, cur, wr, wc, l2 & 15, l2 >> 4); }
          else prob.epi(acc, cur, wr, wc, l2 & 15, l2 >> 4); }
        if (!has_next) break;
        if (!keep)
#pragma unroll
        for (int a = 0; a < 2; ++a)
#pragma unroll
            for (int b = 0; b < 2; ++b)
#pragma unroll
                for (int m = 0; m < 4; ++m)
#pragma unroll
                    for (int n = 0; n < 2; ++n) acc[a][b][m][n] = (Acc){0, 0, 0, 0};
        cur = nxt; nt = nnt; ++ui;
    }
    G8_WAIT_V(0);
    if (wr == 0) G8_BAR;
    G8_BAR;
}
}

__device__ __forceinline__ u32x4 pack8(const f32x4& v0, const f32x4& v1) {
    u32x4 w; w.x = cvt_pk_bf16(v0[0], v0[1]); w.y = cvt_pk_bf16(v0[2], v0[3]); w.z = cvt_pk_bf16(v1[0], v1[1]); w.w = cvt_pk_bf16(v1[2], v1[3]); return w;
}
__device__ __forceinline__ void unpack8(const u32x4& w, f32x4& v0, f32x4& v1) {
    v0 = (f32x4){bf_lo(w.x), bf_hi(w.x), bf_lo(w.y), bf_hi(w.y)}; v1 = (f32x4){bf_lo(w.z), bf_hi(w.z), bf_lo(w.w), bf_hi(w.w)};
}

__device__ __forceinline__ void unpack8u(const u32x2& w, f32x4& v0, f32x4& v1) {
    const float k = 1.0f / 255.0f;
    v0 = (f32x4){(float)(w.x & 255u) * k, (float)((w.x >> 8) & 255u) * k, (float)((w.x >> 16) & 255u) * k, (float)(w.x >> 24) * k};
    v1 = (f32x4){(float)(w.y & 255u) * k, (float)((w.y >> 8) & 255u) * k, (float)((w.y >> 16) & 255u) * k, (float)(w.y >> 24) * k};
}
template <int WHICH> struct InProjProb {
    static constexpr bool PERM = true, GATHER_A = false, I8 = true, F8 = false, HAS_MID = false; typedef i32x4 Acc;
    struct U { int kind, pm, pn, b, j; };
    const signed char* H; const signed char* W; const float* sH; const float* sW;
    bf16_t *FT, *FCT, *Q, *Kb, *Vb, *GF, *GA; const LAS float* rope;
    int nM, n_nat, n_fx, n_fc, n_extra, G, c;
    __device__ __forceinline__ bool get(int i, U& u) const {
        const int L = i * G + c;
        if (WHICH == 0) {
            if (L >= n_nat + n_extra) return false;
            const bool nat = L < n_nat;
            int pm, pn; g8::order2d(nat ? L : 0, nM, 11, pm, pn);
            u.kind = 2; u.pm = __builtin_amdgcn_readfirstlane(nat ? pm : (128 + L - n_nat)); u.pn = __builtin_amdgcn_readfirstlane(nat ? (pn + 2) : 4); u.b = 0; u.j = 0;
            return true;
        } else {
            if (L >= n_fx + n_fc) return false;
            const bool fx = L < n_fx; const int L2 = L - n_fx;
            u.kind = __builtin_amdgcn_readfirstlane(fx ? 0 : 1); u.b = __builtin_amdgcn_readfirstlane(fx ? (L >> 6) : (L2 >> 1)); u.j = __builtin_amdgcn_readfirstlane(fx ? ((L & 63) >> 1) : 0); u.pn = __builtin_amdgcn_readfirstlane(fx ? (L & 1) : (L2 & 1)); u.pm = 0;
            return true;
        }
    }
    __device__ __forceinline__ void setup(const U& u, unsigned (&oa)[4], unsigned& ob, unsigned (&dA)[4], unsigned (&dB)[4], const char*& pA, const char*& pB, int& nt) const {
        int R0, Rb0, C0; g8::lane_geom(threadIdx.x, R0, Rb0, C0);
        nt = 8;
#pragma unroll
        for (int j = 0; j < 4; ++j) { dA[j] = (unsigned)(64 * j * 1024); dB[j] = dA[j]; }
        if (WHICH == 0) {
            pA = (const char*)H; pB = (const char*)W;
            oa[0] = (unsigned)((256 * u.pm + R0) * 1024 + C0 * 2); ob = (unsigned)((256 * u.pn + Rb0) * 1024 + C0 * 2);
        } else {
            pA = (const char*)W; pB = (const char*)H;
            oa[0] = (unsigned)((256 * u.pn + R0) * 1024 + C0 * 2);
            if (u.kind == 0) { ob = (unsigned)((u.b * SEQ + 64 * Rb0 + 2 * u.j) * 1024 + C0 * 2);
                dB[1] = (unsigned)(64 * 64 * 1024); dB[2] = 1024u; dB[3] = dB[1] + 1024u; }
            else ob = (unsigned)((TX + u.b * LC + Rb0) * 1024 + C0 * 2);
        }
    }
    __device__ __forceinline__ void epi(const i32x4 (&acc)[2][2][4][2], const U& u, int wr, int wc, int fr, int fq) const {
        if (WHICH == 0) {
            f32x4 sw[2][2];
#pragma unroll
            for (int bj = 0; bj < 2; ++bj) { const float* sp = sW + 256 * u.pn + G8_COL0(bj); sw[bj][0] = *(const f32x4*)sp; sw[bj][1] = *(const f32x4*)(sp + 4); }
            float rsv[2][4];
#pragma unroll
            for (int ai = 0; ai < 2; ++ai)
#pragma unroll
                for (int m = 0; m < 4; ++m) rsv[ai][m] = sH[256 * u.pm + G8_ROWS(ai, m)];
            if (u.pn >= 5) {
                unsigned char* dst = (unsigned char*)((u.pn >= 9) ? GA : GF); const int cb = (u.pn >= 9) ? u.pn - 9 : u.pn - 5;
                f32x2_t fc[2][4];
#pragma unroll
                for (int bj = 0; bj < 2; ++bj)
#pragma unroll
                    for (int q = 0; q < 4; ++q) fc[bj][q] = (f32x2_t){sw[bj][q >> 1][2 * (q & 1)], sw[bj][q >> 1][2 * (q & 1) + 1]} * (-LOG2E);
#pragma unroll
                for (int ai = 0; ai < 2; ++ai)
#pragma unroll
                    for (int m = 0; m < 4; ++m) { const f32x2_t rs2 = {rsv[ai][m], rsv[ai][m]}; u32x4 w4;
#pragma unroll
                        for (int bj = 0; bj < 2; ++bj) { u32x2 w = {0u, 0u};
#pragma unroll
                            for (int q = 0; q < 4; ++q) { const int n = q >> 1, e0 = 2 * (q & 1);
                                const f32x2_t a = {(float)acc[ai][bj][m][n][e0], (float)acc[ai][bj][m][n][e0 + 1]};
                                const f32x2_t t = a * (rs2 * fc[bj][q]);
                                const f32x2_t d = (f32x2_t){__builtin_amdgcn_exp2f(t[0]), __builtin_amdgcn_exp2f(t[1])} + 1.0f;
                                const f32x2_t g = (f32x2_t){__builtin_amdgcn_rcpf(d[0]), __builtin_amdgcn_rcpf(d[1])} * 255.0f;
                                if (n == 0) { w.x = __builtin_amdgcn_cvt_pk_u8_f32(g[0], e0, w.x); w.x = __builtin_amdgcn_cvt_pk_u8_f32(g[1], e0 + 1, w.x); }
                                else        { w.y = __builtin_amdgcn_cvt_pk_u8_f32(g[0], e0, w.y); w.y = __builtin_amdgcn_cvt_pk_u8_f32(g[1], e0 + 1, w.y); } }
                            if (bj == 0) { w4.x = w.x; w4.y = w.y; } else { w4.z = w.x; w4.w = w.y; } }
                        *(u32x4*)(dst + G8_GOFF(u.pm, cb, ai, m)) = w4; }
            } else {
#pragma unroll
                for (int ai = 0; ai < 2; ++ai)
#pragma unroll
                    for (int m = 0; m < 4; ++m) { const int tok = 256 * u.pm + G8_ROWS(ai, m); const float rs = rsv[ai][m];
                        const bool isx = tok < TX; const int n = tok & (SEQ - 1); const int prow = n >> 6, pcol = n & 63;
#pragma unroll
                        for (int bj = 0; bj < 2; ++bj) { f32x4 v0, v1;
#pragma unroll
                            for (int e = 0; e < 4; ++e) { v0[e] = (float)acc[ai][bj][m][0][e] * rs * sw[bj][0][e]; v1[e] = (float)acc[ai][bj][m][1][e] * rs * sw[bj][1][e]; }
                            const int c0 = G8_COL0(bj);
                            const bool isv = (u.pn == 4) && (bj == 1);
                            if (!isv) {
                                const int dp = c0 & 63; const int axis = dp >> 5, f0 = (dp & 31) >> 1;
                                if (isx) {
                                    const int pos = axis ? pcol : prow;
                                    const f32x4 cs = *(const LAS f32x4*)(rope + pos * 16 + f0), sn = *(const LAS f32x4*)(rope + 2048 + pos * 16 + f0);
                                    f32x4 r0, r1;
                                    r0[0] = v0[0] * cs[0] - v0[1] * sn[0]; r0[1] = v0[1] * cs[0] + v0[0] * sn[0];
                                    r0[2] = v0[2] * cs[1] - v0[3] * sn[1]; r0[3] = v0[3] * cs[1] + v0[2] * sn[1];
                                    r1[0] = v1[0] * cs[2] - v1[1] * sn[2]; r1[1] = v1[1] * cs[2] + v1[0] * sn[2];
                                    r1[2] = v1[2] * cs[3] - v1[3] * sn[3]; r1[3] = v1[3] * cs[3] + v1[2] * sn[3];
                                    v0 = r0; v1 = r1;
                                }
                            }
                            if (u.pn < 4) { v0 *= QSCALE; v1 *= QSCALE; *(u32x4*)(Q + (size_t)tok * 512 + 256 * (u.pn - 2) + c0) = pack8(v0, v1); }
                            else if (!isv) { *(u32x4*)(Kb + (size_t)tok * 128 + c0) = pack8(v0, v1); }
                            else { *(u32x4*)(Vb + (size_t)tok * 128 + (c0 - 128)) = pack8(v0, v1); }
                        } }
            }
        } else {
            f32x4 st[2][2];
#pragma unroll
            for (int bj = 0; bj < 2; ++bj) { const int c0 = G8_COL0(bj);
                if (u.kind == 0) { const float* tp = sH + (size_t)u.b * SEQ + 64 * (c0 & 127) + 2 * u.j + (c0 >> 7);
#pragma unroll
                    for (int e = 0; e < 4; ++e) { st[bj][0][e] = tp[64 * e]; st[bj][1][e] = tp[64 * (4 + e)]; } }
                else { const float* tp = sH + TX + u.b * LC + c0; st[bj][0] = *(const f32x4*)tp; st[bj][1] = *(const f32x4*)(tp + 4); } }
            float rsw[2][4];
#pragma unroll
            for (int ai = 0; ai < 2; ++ai)
#pragma unroll
                for (int m = 0; m < 4; ++m) rsw[ai][m] = sW[256 * u.pn + G8_ROWS(ai, m)];
#pragma unroll
            for (int ai = 0; ai < 2; ++ai)
#pragma unroll
                for (int m = 0; m < 4; ++m) { const int ch = 256 * u.pn + G8_ROWS(ai, m); const float rs = rsw[ai][m];
#pragma unroll
                    for (int bj = 0; bj < 2; ++bj) { const int c0 = G8_COL0(bj); f32x4 v0, v1;
#pragma unroll
                        for (int e = 0; e < 4; ++e) { v0[e] = (float)acc[ai][bj][m][0][e] * rs * st[bj][0][e]; v1[e] = (float)acc[ai][bj][m][1][e] * rs * st[bj][1][e]; }
                        const u32x4 w = pack8(v0, v1);
                        if (u.kind == 0) { const int n2 = 2 * u.j + (c0 >> 7), n1 = c0 & 127; *(u32x4*)(FT + ((size_t)(u.b * 512 + ch) * 64 + n2) * 128 + n1) = w; }
                        else *(u32x4*)(FCT + (size_t)(u.b * 512 + ch) * 256 + c0) = w;
                    } }
        }
    }
};

struct Fft1Prob {
    static constexpr bool PERM = true, GATHER_A = false, I8 = false, F8 = false, HAS_MID = false; typedef f32x4 Acc;
    struct U { int kind, pm, pn; };
    const bf16_t *W1, *FT, *WC, *FCT; bf16_t* T1; unsigned char* XS;
    int n0, n1, G, c;
    __device__ __forceinline__ bool get(int i, U& u) const {
        const int L = i * G + c;
        if (L >= n0 + n1) return false;
        const bool k0 = L < n0; const int L2 = L - n0;
        u.kind = __builtin_amdgcn_readfirstlane(k0 ? 0 : 1); u.pm = __builtin_amdgcn_readfirstlane(k0 ? 0 : (L2 & 1)); u.pn = __builtin_amdgcn_readfirstlane(k0 ? L : (L2 >> 1));
        return true;
    }
    __device__ __forceinline__ void setup(const U& u, unsigned (&oa)[4], unsigned& ob, unsigned (&dA)[4], unsigned (&dB)[4], const char*& pA, const char*& pB, int& nt) const {
        int R0, Rb0, C0; g8::lane_geom(threadIdx.x, R0, Rb0, C0);
        if (u.kind == 0) { nt = 2; pA = (const char*)W1; pB = (const char*)FT;
#pragma unroll
            for (int j = 0; j < 4; ++j) { dA[j] = (unsigned)(64 * j * 128) * 2u; dB[j] = dA[j]; }
            oa[0] = (unsigned)(R0 * 128 + C0) * 2u; ob = (unsigned)((256 * u.pn + Rb0) * 128 + C0) * 2u;
        } else { nt = 4; pA = (const char*)WC; pB = (const char*)FCT;
#pragma unroll
            for (int j = 0; j < 4; ++j) { dA[j] = (unsigned)(64 * j * 256) * 2u; dB[j] = dA[j]; }
            oa[0] = (unsigned)((256 * u.pm + R0) * 256 + C0) * 2u; ob = (unsigned)((256 * u.pn + Rb0) * 256 + C0) * 2u;
        }
    }
    __device__ __forceinline__ void epi(const f32x4 (&acc)[2][2][4][2], const U& u, int wr, int wc, int fr, int fq) const {
        if (u.kind == 0) {
#pragma unroll
            for (int m = 0; m < 4; ++m) { const int r = G8_ROWS(0, m); const int k1p = r >> 1, part = r & 1;
#pragma unroll
                for (int bj = 0; bj < 2; ++bj) { const int col = 256 * u.pn + G8_COL0(bj); const int bc = col >> 6, n2 = col & 63;
                    *(u32x4*)(T1 + (((size_t)k1p * 2048 + bc) * 2 + part) * 64 + n2) = pack8(acc[0][bj][m][0], acc[0][bj][m][1]); } }
        } else {
#pragma unroll
            for (int ai = 0; ai < 2; ++ai)
#pragma unroll
                for (int m = 0; m < 4; ++m) { const int r = 256 * u.pm + G8_ROWS(ai, m); const int k = r >> 1, reim = r & 1;
#pragma unroll
                    for (int bj = 0; bj < 2; ++bj) { const int bc = 256 * u.pn + G8_COL0(bj); const int b = bc >> 9, ch = bc & 511, g = ch >> 7, d = ch & 127;
                        *(u32x2*)(XS + (size_t)(TX + b * LC + k) * 1024 + g * 256 + reim * 128 + d) = pack8_fp8(acc[ai][bj][m][0], acc[ai][bj][m][1], 0.0625f); } }
        }
    }
};

struct Fft2Prob {
    static constexpr bool PERM = true, GATHER_A = false, I8 = false, F8 = false, HAS_MID = false; typedef f32x4 Acc;
    struct U { int k1p, pn; };
    const bf16_t *MT, *T1; unsigned char* XS; int G, c;
    __device__ __forceinline__ bool get(int i, U& u) const { const int L = i * G + c; if (c < 0 || L >= 512) return false; u.k1p = __builtin_amdgcn_readfirstlane(L >> 3); u.pn = __builtin_amdgcn_readfirstlane(L & 7); return true; }
    __device__ __forceinline__ void setup(const U& u, unsigned (&oa)[4], unsigned& ob, unsigned (&dA)[4], unsigned (&dB)[4], const char*& pA, const char*& pB, int& nt) const {
        int R0, Rb0, C0; g8::lane_geom_w(threadIdx.x, R0, Rb0, C0);
        nt = 2; pA = (const char*)MT; pB = (const char*)T1;
#pragma unroll
        for (int j = 0; j < 4; ++j) { dA[j] = (unsigned)(64 * j * 128) * 2u; dB[j] = (unsigned)(G8_DBW(j) * 128) * 2u; }
        oa[0] = (unsigned)((u.k1p * 256 + R0) * 128 + C0) * 2u; ob = (unsigned)((u.k1p * 2048 + 256 * u.pn + Rb0) * 128 + C0) * 2u;
    }
    __device__ __forceinline__ void epi(const f32x4 (&acc)[2][2][4][2], const U& u, int wr, int wc, int fr, int fq) const {
#pragma unroll
        for (int ai = 0; ai < 2; ++ai)
#pragma unroll
            for (int m = 0; m < 4; ++m) { const int r = G8_ROWS(ai, m); const int s = r >> 7, k2 = (r & 127) >> 1, reim = r & 1;
                const int kb = (u.k1p == 0) ? 64 * s : (s ? 128 - u.k1p : u.k1p); const int k = kb + 128 * k2;
                const int bc = 256 * u.pn + G8_COLW(0); const int b = bc >> 9, ch = bc & 511, g = ch >> 7, d = ch & 127;
                const u32x2 w0 = pack8_fp8(acc[ai][0][m][0], acc[ai][0][m][1], 0.0625f), w1 = pack8_fp8(acc[ai][1][m][0], acc[ai][1][m][1], 0.0625f);
                *(u32x4*)(XS + (size_t)(b * SEQ + k) * 1024 + g * 256 + reim * 128 + d) = (u32x4){w0.x, w0.y, w1.x, w1.y}; }
    }
};

template <int MODE> struct MergeProb {
    static constexpr bool PERM = true, GATHER_A = false, I8 = false, F8 = true, HAS_MID = false; typedef f32x4 Acc;
    struct U { int pm, pn; };
    const unsigned char* A; const unsigned char* W; int lda;
    const unsigned char* GATE; bf16_t* T; unsigned char* Y8;
    const float* xin; const float* cin; bf16_t* XWb; bf16_t* CWb; const float* g1x; const float* g1c; bool in32;
    int nM, G, c;
    __device__ __forceinline__ bool get(int i, U& u) const { const int L = i * G + c; if (L >= nM * 4) return false; int pm, pn; g8::order2d(L, nM, 4, pm, pn); u.pm = __builtin_amdgcn_readfirstlane(pm); u.pn = __builtin_amdgcn_readfirstlane(pn); return true; }
    __device__ __forceinline__ void setup(const U& u, unsigned (&oa)[4], unsigned& ob, unsigned (&dA)[4], unsigned (&dB)[4], const char*& pA, const char*& pB, int& nt) const {
        int R0, Rb0, C0; g8::lane_geom(threadIdx.x, R0, Rb0, C0);
        nt = lda >> 7; pA = (const char*)A; pB = (const char*)W;
#pragma unroll
        for (int j = 0; j < 4; ++j) { dA[j] = (unsigned)(64 * j * lda); dB[j] = dA[j]; }
        oa[0] = (unsigned)((256 * u.pm + R0) * lda + C0 * 2); ob = (unsigned)((256 * u.pn + Rb0) * lda + C0 * 2);
    }
    __device__ __forceinline__ void epi(const f32x4 (&acc)[2][2][4][2], const U& u, int wr, int wc, int fr, int fq) const {
        if (MODE == 0) {
#pragma unroll
            for (int ai = 0; ai < 2; ++ai) {
                u32x2 gt[4][2];
#pragma unroll
                for (int m = 0; m < 4; ++m)
#pragma unroll
                    for (int bj = 0; bj < 2; ++bj) gt[m][bj] = *(const u32x2*)(GATE + (size_t)(256 * u.pm + G8_ROWS(ai, m)) * 1024 + 256 * u.pn + G8_COL0(bj));
#pragma unroll
                for (int m = 0; m < 4; ++m)
#pragma unroll
                    for (int bj = 0; bj < 2; ++bj) { f32x4 g0, g1; unpack8u(gt[m][bj], g0, g1);
                        *(u32x4*)(T + (size_t)(256 * u.pm + G8_ROWS(ai, m)) * 1024 + 256 * u.pn + G8_COL0(bj)) = pack8(acc[ai][bj][m][0] * g0 * (1.0f / 512.0f), acc[ai][bj][m][1] * g1 * (1.0f / 512.0f)); }
            }
        } else if (MODE == 1) {
#pragma unroll
            for (int ai = 0; ai < 2; ++ai)
#pragma unroll
                for (int m = 0; m < 4; ++m) {
                    u32x2 gt[2]; u32x4 tt[2];
#pragma unroll
                    for (int bj = 0; bj < 2; ++bj) { const size_t o = (size_t)(256 * u.pm + G8_ROWS(ai, m)) * 1024 + 256 * u.pn + G8_COL0(bj); gt[bj] = *(const u32x2*)(GATE + o); tt[bj] = *(const u32x4*)(T + o); }
#pragma unroll
                    for (int bj = 0; bj < 2; ++bj) { const size_t o = (size_t)(256 * u.pm + G8_ROWS(ai, m)) * 1024 + 256 * u.pn + G8_COL0(bj);
                        f32x4 g0, g1, t0, t1; unpack8u(gt[bj], g0, g1); unpack8(tt[bj], t0, t1);
                        *(u32x2*)(Y8 + o) = pack8_fp8(acc[ai][bj][m][0] * g0 * (1.0f / 512.0f) + t0, acc[ai][bj][m][1] * g1 * (1.0f / 512.0f) + t1, 2.0f); }
                }
        } else {
            f32x4 gv[2][2];
            const bool isx = (256 * u.pm) < TX;
            { const float* gp = isx ? (g1x + ((256 * u.pm) >> 13) * 6144) : g1c;
#pragma unroll
              for (int bj = 0; bj < 2; ++bj) { gv[bj][0] = *(const f32x4*)(gp + 256 * u.pn + G8_COL0(bj)) * (1.0f / 64.0f); gv[bj][1] = *(const f32x4*)(gp + 256 * u.pn + G8_COL0(bj) + 4) * (1.0f / 64.0f); } }
            const size_t rbase = isx ? 0 : (size_t)TX;
            bf16_t* ob = isx ? XWb : CWb;
            if (in32) {
                const float* xb = isx ? xin : cin;
#pragma unroll
                for (int ai = 0; ai < 2; ++ai) {
                    f32x4 xv[4][2][2];
#pragma unroll
                    for (int m = 0; m < 4; ++m)
#pragma unroll
                        for (int bj = 0; bj < 2; ++bj) { const float* xp = xb + ((size_t)(256 * u.pm + G8_ROWS(ai, m)) - rbase) * 1024 + 256 * u.pn + G8_COL0(bj); xv[m][bj][0] = *(const f32x4*)xp; xv[m][bj][1] = *(const f32x4*)(xp + 4); }
#pragma unroll
                    for (int m = 0; m < 4; ++m)
#pragma unroll
                        for (int bj = 0; bj < 2; ++bj) { bf16_t* op = ob + ((size_t)(256 * u.pm + G8_ROWS(ai, m)) - rbase) * 1024 + 256 * u.pn + G8_COL0(bj);
                            *(u32x4*)op = pack8(xv[m][bj][0] + gv[bj][0] * acc[ai][bj][m][0], xv[m][bj][1] + gv[bj][1] * acc[ai][bj][m][1]); }
                }
            } else {
                u32x4 xw2[2][4][2];
#pragma unroll
                for (int ai = 0; ai < 2; ++ai)
#pragma unroll
                    for (int m = 0; m < 4; ++m)
#pragma unroll
                        for (int bj = 0; bj < 2; ++bj) xw2[ai][m][bj] = *(const u32x4*)(ob + ((size_t)(256 * u.pm + G8_ROWS(ai, m)) - rbase) * 1024 + 256 * u.pn + G8_COL0(bj));
#pragma unroll
                for (int ai = 0; ai < 2; ++ai)
#pragma unroll
                    for (int m = 0; m < 4; ++m)
#pragma unroll
                        for (int bj = 0; bj < 2; ++bj) { bf16_t* op = ob + ((size_t)(256 * u.pm + G8_ROWS(ai, m)) - rbase) * 1024 + 256 * u.pn + G8_COL0(bj);
                            f32x4 x0, x1; unpack8(xw2[ai][m][bj], x0, x1);
                            *(u32x4*)op = pack8(x0 + gv[bj][0] * acc[ai][bj][m][0], x1 + gv[bj][1] * acc[ai][bj][m][1]); }
            }
        }
    }
};

struct Merge1Prob {
    static constexpr bool PERM = true, GATHER_A = false, I8 = false, F8 = true, HAS_MID = true; typedef f32x4 Acc;
    struct U { int pm, pn, seg; };
    const unsigned char *XS, *AO, *WFO, *WAO, *GF, *GA; unsigned char* Y8; int nM, pm0, G, c;
    __device__ __forceinline__ bool get(int i, U& u) const { const int L = (i >> 1) * G + c; if (c < 0 || L >= nM * 4) return false; int pm, pn; g8::order2d(L, nM, 4, pm, pn);
        u.pm = __builtin_amdgcn_readfirstlane(pm + pm0); u.pn = __builtin_amdgcn_readfirstlane(pn); u.seg = i & 1; return true; }
    __device__ __forceinline__ bool is_mid(const U& u) const { return u.seg == 0; }
    __device__ __forceinline__ void setup(const U& u, unsigned (&oa)[4], unsigned& ob, unsigned (&dA)[4], unsigned (&dB)[4], const char*& pA, const char*& pB, int& nt) const {
        int R0, Rb0, C0; g8::lane_geom(threadIdx.x, R0, Rb0, C0);
        const int lda = u.seg ? 1024 : 512;
        nt = lda >> 7; pA = (const char*)(u.seg ? XS : AO); pB = (const char*)(u.seg ? WFO : WAO);
#pragma unroll
        for (int j = 0; j < 4; ++j) { dA[j] = (unsigned)(64 * j * lda); dB[j] = dA[j]; }
        oa[0] = (unsigned)((256 * u.pm + R0) * lda + C0 * 2); ob = (unsigned)((256 * u.pn + Rb0) * lda + C0 * 2);
    }
    __device__ __forceinline__ void mid(f32x4 (&acc)[2][2][4][2], const U& u, int wr, int wc, int fr, int fq) const {
#pragma unroll
        for (int ai = 0; ai < 2; ++ai) {
            u32x2 qf[4][2], qa[4][2];
#pragma unroll
            for (int m = 0; m < 4; ++m) { const size_t o = G8_GOFF(u.pm, u.pn, ai, m); const u32x4 f4 = *(const u32x4*)(GF + o), a4 = *(const u32x4*)(GA + o);
                qf[m][0] = (u32x2){f4.x, f4.y}; qf[m][1] = (u32x2){f4.z, f4.w}; qa[m][0] = (u32x2){a4.x, a4.y}; qa[m][1] = (u32x2){a4.z, a4.w}; }
#pragma unroll
            for (int m = 0; m < 4; ++m)
#pragma unroll
                for (int bj = 0; bj < 2; ++bj)
#pragma unroll
                    for (int n = 0; n < 2; ++n) { const unsigned wf = n ? qf[m][bj].y : qf[m][bj].x, wa = n ? qa[m][bj].y : qa[m][bj].x;
#pragma unroll
                        for (int e = 0; e < 4; ++e) { const float f = fmaxf((float)((wf >> (8 * e)) & 255u), 1.0f), a = (float)((wa >> (8 * e)) & 255u);
                            acc[ai][bj][m][n][e] *= a * __builtin_amdgcn_rcpf(f); } }
        }
    }
    __device__ __forceinline__ void epi(const f32x4 (&acc)[2][2][4][2], const U& u, int wr, int wc, int fr, int fq) const {
        u32x2 qf[2][4][2];
#pragma unroll
        for (int ai = 0; ai < 2; ++ai)
#pragma unroll
            for (int m = 0; m < 4; ++m) { const u32x4 f4 = *(const u32x4*)(GF + G8_GOFF(u.pm, u.pn, ai, m)); qf[ai][m][0] = (u32x2){f4.x, f4.y}; qf[ai][m][1] = (u32x2){f4.z, f4.w}; }
#pragma unroll
        for (int ai = 0; ai < 2; ++ai) {
#pragma unroll
            for (int m = 0; m < 4; ++m)
#pragma unroll
                for (int bj = 0; bj < 2; ++bj) { f32x4 v[2];
#pragma unroll
                    for (int n = 0; n < 2; ++n) { const unsigned wf = n ? qf[ai][m][bj].y : qf[ai][m][bj].x;
#pragma unroll
                        for (int e = 0; e < 4; ++e) v[n][e] = acc[ai][bj][m][n][e] * (fmaxf((float)((wf >> (8 * e)) & 255u), 1.0f) * (1.0f / (255.0f * 512.0f))); }
                    *(u32x2*)(Y8 + (size_t)(256 * u.pm + G8_ROWS(ai, m)) * 1024 + 256 * u.pn + G8_COL0(bj)) = pack8_fp8(v[0], v[1], 2.0f); }
        }
    }
};

struct MoeGuProb {
    static constexpr bool PERM = true, GATHER_A = true, I8 = true, F8 = false, HAS_MID = false; typedef i32x4 Acc;
    struct U { int e, rt, pn, base, par; int tok[4]; };
    const signed char* H8; const signed char* W8; const float* sW; const float* lsc; const float* bgu; unsigned char* ACT; const int* list; const int* cnt;
    __device__ __forceinline__ LAS unsigned char* parp(int off) const { return (LAS unsigned char*)tstart + (20480 - 64) + off; }
    const volatile LAS int* tstart;
    int R, G, c;
    __device__ __forceinline__ bool get(int i, U& u) const {
        const int L = i * G + c; if (L >= R * 8) return false;
        int rt, pn; g8::order2d(L, R, 8, rt, pn);
        const int e = ((const volatile LAS unsigned char*)tstart)[(1024 - 64) + rt];
        u.e = __builtin_amdgcn_readfirstlane(e); u.rt = __builtin_amdgcn_readfirstlane(rt); u.pn = __builtin_amdgcn_readfirstlane(pn); u.base = __builtin_amdgcn_readfirstlane((rt - tstart[e]) * 256); const int ucnt = __builtin_amdgcn_readfirstlane(cnt[e]);
        int R0, Rb0, C0; g8::lane_geom(threadIdx.x, R0, Rb0, C0);
#pragma unroll
        for (int j = 0; j < 4; ++j) { const int p = u.base + R0 + 64 * j; u.tok[j] = (p < ucnt) ? list[(size_t)e * TT + p] : TT; }
        u.par = __builtin_amdgcn_readfirstlane((i % 3) * 3072);
        { int t2 = threadIdx.x; asm volatile("" : "+v"(t2)); const int wv = __builtin_amdgcn_readfirstlane(t2 >> 6), ln = t2 & 63;
          if (wv < 3) { const float* gb = (wv == 0) ? bgu + (size_t)u.e * 2048 + 128 * u.pn : (wv == 1) ? sW + (size_t)u.e * 2048 + 256 * u.pn : lsc + (size_t)u.e * TT + u.base;
              const unsigned off = (wv == 0 && ln >= 32) ? (unsigned)(4096 + 16 * (ln - 32)) : (unsigned)(16 * ln);
              __builtin_amdgcn_global_load_lds((const unsigned*)((const char*)gb + off), (LAS unsigned*)parp(u.par + 1024 * wv), 16, 0, 0); } }
        return true;
    }
    __device__ __forceinline__ void setup(const U& u, unsigned (&oa)[4], unsigned& ob, unsigned (&dA)[4], unsigned (&dB)[4], const char*& pA, const char*& pB, int& nt) const {
        int R0, Rb0, C0; g8::lane_geom(threadIdx.x, R0, Rb0, C0);
        nt = 8; pA = (const char*)H8; pB = (const char*)W8;
#pragma unroll
        for (int j = 0; j < 4; ++j) { dA[j] = 0u; dB[j] = (unsigned)(64 * j * 1024); oa[j] = (unsigned)(u.tok[j] * 1024 + C0 * 2); }
        ob = (unsigned)((u.e * 2048 + 256 * u.pn + Rb0) * 1024 + C0 * 2);
    }
    __device__ __forceinline__ void epi(const i32x4 (&acc)[2][2][4][2], const U& u, int wr, int wc, int fr, int fq) const {
        const int j0 = 128 * u.pn + 32 * wc + 8 * fq;
        const LAS float* pl = (const LAS float*)parp(u.par);
        const LAS float* bp = pl + 32 * wc + 8 * fq;
        const f32x4 ba0 = *(const LAS f32x4*)bp, ba1 = *(const LAS f32x4*)(bp + 4), bu0 = *(const LAS f32x4*)(bp + 128), bu1 = *(const LAS f32x4*)(bp + 132);
        const LAS float* sp = pl + 256 + 32 * wc + 8 * fq;
        const f32x4 sa0 = *(const LAS f32x4*)sp, sa1 = *(const LAS f32x4*)(sp + 4), su0 = *(const LAS f32x4*)(sp + 128), su1 = *(const LAS f32x4*)(sp + 132);
        float rsv[2][4];
#pragma unroll
        for (int ai = 0; ai < 2; ++ai)
#pragma unroll
            for (int m = 0; m < 4; ++m) rsv[ai][m] = pl[512 + G8_ROWS(ai, m)];
        f32x2_t sA[4], sU[4], bA[4], bU[4];
#pragma unroll
        for (int q = 0; q < 2; ++q) { sA[q] = (f32x2_t){sa0[2 * q], sa0[2 * q + 1]}; sA[2 + q] = (f32x2_t){sa1[2 * q], sa1[2 * q + 1]}; sU[q] = (f32x2_t){su0[2 * q], su0[2 * q + 1]}; sU[2 + q] = (f32x2_t){su1[2 * q], su1[2 * q + 1]};
            bA[q] = (f32x2_t){ba0[2 * q], ba0[2 * q + 1]}; bA[2 + q] = (f32x2_t){ba1[2 * q], ba1[2 * q + 1]}; bU[q] = (f32x2_t){bu0[2 * q], bu0[2 * q + 1]}; bU[2 + q] = (f32x2_t){bu1[2 * q], bu1[2 * q + 1]}; }
#pragma unroll
        for (int ai = 0; ai < 2; ++ai)
#pragma unroll
            for (int m = 0; m < 4; ++m) { const int rr = G8_ROWS(ai, m); const size_t row = (size_t)256 * u.rt + rr;
                const f32x2_t rs2 = {rsv[ai][m], rsv[ai][m]};
                f32x2_t y[4];
#pragma unroll
                for (int q = 0; q < 4; ++q) { const int n = q >> 1, e0 = 2 * (q & 1);
                    const f32x2_t ai2 = {(float)acc[ai][0][m][n][e0], (float)acc[ai][0][m][n][e0 + 1]}, ui2 = {(float)acc[ai][1][m][n][e0], (float)acc[ai][1][m][n][e0 + 1]};
                    f32x2_t a = ai2 * (rs2 * sA[q]) + bA[q], uu = ui2 * (rs2 * sU[q]) + bU[q];
                    a = (f32x2_t){fminf(a[0], 7.0f), fminf(a[1], 7.0f)};
                    uu = (f32x2_t){__builtin_amdgcn_fmed3f(uu[0], -7.0f, 7.0f), __builtin_amdgcn_fmed3f(uu[1], -7.0f, 7.0f)};
                    const f32x2_t t = a * (-1.702f * LOG2E);
                    const f32x2_t den = (f32x2_t){__builtin_amdgcn_exp2f(t[0]), __builtin_amdgcn_exp2f(t[1])} + 1.0f;
                    const f32x2_t r = {__builtin_amdgcn_rcpf(den[0]), __builtin_amdgcn_rcpf(den[1])};
                    y[q] = (a * r) * (uu + 1.0f); }
                { u32x2 w; w.x = pk4_fp8(y[0][0], y[0][1], y[1][0], y[1][1]); w.y = pk4_fp8(y[2][0], y[2][1], y[3][0], y[3][1]); *(u32x2*)(ACT + row * 1024 + j0) = w; } }
    }
};
struct MoeDnProb {
    static constexpr bool PERM = true, GATHER_A = false, I8 = false, F8 = true, HAS_MID = false; typedef f32x4 Acc;
    struct U { int e, rt, pn; f32x4 bias[2][2]; };
    const unsigned char* ACT; const unsigned char* W; const float* bdn; unsigned char* YE;
    const volatile LAS int* tstart; int R, G, c;
    __device__ __forceinline__ bool get(int i, U& u) const {
        const int L = i * G + c; if (L >= R * 4) return false;
        int rt, pn; g8::order2d(L, R, 4, rt, pn);
        const int e = ((const volatile LAS unsigned char*)tstart)[(1024 - 64) + rt];
        u.e = __builtin_amdgcn_readfirstlane(e); u.rt = __builtin_amdgcn_readfirstlane(rt); u.pn = __builtin_amdgcn_readfirstlane(pn);
        { int t2 = threadIdx.x; asm volatile("" : "+v"(t2)); const int wc = (t2 >> 6) & 3, fq = (t2 & 63) >> 4;
#pragma unroll
          for (int bj = 0; bj < 2; ++bj) { const float* bp = bdn + (size_t)u.e * 1024 + 256 * u.pn + G8_COLW(bj); u.bias[bj][0] = *(const f32x4*)bp; u.bias[bj][1] = *(const f32x4*)(bp + 4); } }
        return true;
    }
    __device__ __forceinline__ void setup(const U& u, unsigned (&oa)[4], unsigned& ob, unsigned (&dA)[4], unsigned (&dB)[4], const char*& pA, const char*& pB, int& nt) const {
        int R0, Rb0, C0; g8::lane_geom_w(threadIdx.x, R0, Rb0, C0);
        nt = 8; pA = (const char*)ACT; pB = (const char*)W;
#pragma unroll
        for (int j = 0; j < 4; ++j) { dA[j] = (unsigned)(64 * j * 1024); dB[j] = (unsigned)(G8_DBW(j) * 1024); }
        oa[0] = (unsigned)((256 * u.rt + R0) * 1024 + C0 * 2); ob = (unsigned)((u.e * 1024 + 256 * u.pn + Rb0) * 1024 + C0 * 2);
    }
    __device__ __forceinline__ void epi(const f32x4 (&acc)[2][2][4][2], const U& u, int wr, int wc, int fr, int fq) const {
        const int col = 256 * u.pn + G8_COLW(0);
#pragma unroll
        for (int ai = 0; ai < 2; ++ai)
#pragma unroll
            for (int m = 0; m < 4; ++m) { const size_t row = (size_t)256 * u.rt + G8_ROWS(ai, m);
                const u32x2 w0 = pack8_fp8(acc[ai][0][m][0] * (1.0f / 32.0f) + u.bias[0][0], acc[ai][0][m][1] * (1.0f / 32.0f) + u.bias[0][1], 1.0f);
                const u32x2 w1 = pack8_fp8(acc[ai][1][m][0] * (1.0f / 32.0f) + u.bias[1][0], acc[ai][1][m][1] * (1.0f / 32.0f) + u.bias[1][1], 1.0f);
                *(u32x4*)(YE + row * 1024 + col) = (u32x4){w0.x, w0.y, w1.x, w1.y}; }
    }
};

__device__ __forceinline__ int rope_perm(int d) { return (d & 32) | ((d & 15) << 1) | ((d >> 4) & 1); }
template <class RM>
__device__ __forceinline__ void transpose_tile(const Fr& F, const float* src, int N, int k0, int n0, bf16_t* dst, int Kd, RM rm) {
    LAS unsigned char* lds = F.lds;
    const int tid = F.tid;
    { const int kq = tid >> 4, c4 = (tid & 15) * 4; f32x4 v[4];
#pragma unroll
      for (int r = 0; r < 4; ++r) v[r] = *(const f32x4*)(src + (size_t)(k0 + 4 * kq + r) * N + n0 + c4);
#pragma unroll
      for (int e = 0; e < 4; ++e) { u32x2 w; w.x = cvt_pk_bf16(v[0][e], v[1][e]); w.y = cvt_pk_bf16(v[2][e], v[3][e]); *(LAS u32x2*)(lds + (c4 + e) * 272 + kq * 8) = w; } }
    __syncthreads();
    { const int n = tid >> 3, ch = tid & 7; const u32x4 w0 = *(const LAS u32x4*)(lds + n * 272 + ch * 32), w1 = *(const LAS u32x4*)(lds + n * 272 + ch * 32 + 16);
      bf16_t* dp = dst + (size_t)rm(n0 + n) * Kd + k0 + ch * 16; *(u32x4*)dp = w0; *(u32x4*)(dp + 8) = w1; }
    __syncthreads();
}
__device__ __forceinline__ void transpose_tile_fp8(const Fr& F, const float* src, int k0, int n0, unsigned char* dst) {
    LAS unsigned char* lds = F.lds;
    const int tid = F.tid;
    { const int kq = tid >> 4, c4 = (tid & 15) * 4; f32x4 v[4];
#pragma unroll
      for (int r = 0; r < 4; ++r) v[r] = *(const f32x4*)(src + (size_t)(k0 + 4 * kq + r) * 1024 + n0 + c4) * 32.0f;
#pragma unroll
      for (int e = 0; e < 4; ++e) *(LAS unsigned*)(lds + (c4 + e) * 144 + kq * 4) = pk4_fp8(v[0][e], v[1][e], v[2][e], v[3][e]); }
    __syncthreads();
    { const int n = tid >> 3, ch = tid & 7; const u32x4 w = *(const LAS u32x4*)(lds + n * 144 + ch * 16);
      *(u32x4*)(dst + (size_t)(n0 + n) * 1024 + k0 + ch * 16) = w; }
    __syncthreads();
}
struct RmGu { __device__ int operator()(int n) const { const int bj = n >> 10, j = n & 1023; return 256 * (j >> 7) + 128 * bj + (j & 127); } };
template <int MODE, int KT, class RM>
__device__ __forceinline__ void strip_convert(const Fr& F, const float* src, int N, int n0, void* dstv, int Kd, float* sdst, RM rm) {
    LAS unsigned char* lds = F.lds;
    LAS float* red = (LAS float*)(lds + 32768);
    LAS float* inv = (LAS float*)(lds + 32768 + 8192);
    const int tid = F.tid, kq = tid >> 4, c4 = (tid & 15) * 4;
    f32x4 v[KT][4];
#pragma unroll
    for (int kt = 0; kt < KT; ++kt)
#pragma unroll
        for (int r = 0; r < 4; ++r) v[kt][r] = __builtin_nontemporal_load((const f32x4*)(src + (size_t)(kt * 128 + 4 * kq + r) * N + n0 + c4));
    f32x4 iv = {32.0f, 32.0f, 32.0f, 32.0f};
    if (MODE == 0) {
        f32x4 mx = {0.f, 0.f, 0.f, 0.f};
#pragma unroll
        for (int kt = 0; kt < KT; ++kt)
#pragma unroll
            for (int r = 0; r < 4; ++r)
#pragma unroll
                for (int e = 0; e < 4; ++e) mx[e] = fmaxf(mx[e], fabsf(v[kt][r][e]));
#pragma unroll
        for (int e = 0; e < 4; ++e) red[kq * 64 + c4 + e] = mx[e];
        __syncthreads();
        if (tid < 64) { float m = 0.f;
#pragma unroll
            for (int r = 0; r < 32; ++r) m = fmaxf(m, red[r * 64 + tid]);
            sdst[rm(n0 + tid)] = m * (1.0f / 127.0f); inv[tid] = m > 0.f ? 127.0f / m : 0.f; }
        __syncthreads();
        iv = *(const LAS f32x4*)(inv + c4);
    }
#pragma unroll
    for (int kt = 0; kt < KT; ++kt) {
        if (MODE == 0) {
#pragma unroll
            for (int e = 0; e < 4; ++e) { const int q0 = __float2int_rn(v[kt][0][e] * iv[e]), q1 = __float2int_rn(v[kt][1][e] * iv[e]), q2 = __float2int_rn(v[kt][2][e] * iv[e]), q3 = __float2int_rn(v[kt][3][e] * iv[e]);
                *(LAS unsigned*)(lds + (c4 + e) * 144 + kq * 4) = (unsigned)(q0 & 255) | ((unsigned)(q1 & 255) << 8) | ((unsigned)(q2 & 255) << 16) | ((unsigned)(q3 & 255) << 24); }
        } else if (MODE == 1) {
#pragma unroll
            for (int e = 0; e < 4; ++e) *(LAS unsigned*)(lds + (c4 + e) * 144 + kq * 4) = pk4_fp8(v[kt][0][e] * 32.0f, v[kt][1][e] * 32.0f, v[kt][2][e] * 32.0f, v[kt][3][e] * 32.0f);
        } else {
#pragma unroll
            for (int e = 0; e < 4; ++e) { u32x2 w; w.x = cvt_pk_bf16(v[kt][0][e], v[kt][1][e]); w.y = cvt_pk_bf16(v[kt][2][e], v[kt][3][e]); *(LAS u32x2*)(lds + (c4 + e) * 272 + kq * 8) = w; }
        }
        __syncthreads();
        { const int nl = tid >> 3, ch = tid & 7; const int row = rm(n0 + nl);
          if (MODE == 2) { const u32x4 w0 = *(const LAS u32x4*)(lds + nl * 272 + ch * 32), w1 = *(const LAS u32x4*)(lds + nl * 272 + ch * 32 + 16);
              bf16_t* dp = (bf16_t*)dstv + (size_t)row * Kd + kt * 128 + ch * 16; *(u32x4*)dp = w0; *(u32x4*)(dp + 8) = w1; }
          else { const u32x4 w = *(const LAS u32x4*)(lds + nl * 144 + ch * 16); *(u32x4*)((unsigned char*)dstv + (size_t)row * Kd + kt * 128 + ch * 16) = w; } }
        __syncthreads();
    }
}
__device__ __forceinline__ void strip128_fp8(const Fr& F, const float* src, int N, int k0, int n0, unsigned char* dst, int Kd) {
    LAS unsigned char* lds = F.lds;
    const int tid = F.tid, kq = tid >> 5, c4 = (tid & 31) * 4;
    f32x4 v[8][4];
#pragma unroll
    for (int kt = 0; kt < 8; ++kt)
#pragma unroll
        for (int r = 0; r < 4; ++r) v[kt][r] = __builtin_nontemporal_load((const f32x4*)(src + (size_t)(k0 + kt * 64 + 4 * kq + r) * N + n0 + c4));
#pragma unroll
    for (int kt = 0; kt < 8; ++kt)
#pragma unroll
        for (int e = 0; e < 4; ++e) *(LAS unsigned*)(lds + (c4 + e) * 528 + kt * 64 + kq * 4) = pk4_fp8(v[kt][0][e] * 32.0f, v[kt][1][e] * 32.0f, v[kt][2][e] * 32.0f, v[kt][3][e] * 32.0f);
    __syncthreads();
#pragma unroll
    for (int it = 0; it < 8; ++it) { const int n = it * 16 + (tid >> 5), ch = tid & 31; const u32x4 w = *(const LAS u32x4*)(lds + n * 528 + ch * 16);
        *(u32x4*)(dst + (size_t)(n0 + n) * Kd + k0 + ch * 16) = w; }
    __syncthreads();
}
struct RmId { __device__ int operator()(int n) const { return n; } };
struct RmWin { __device__ int operator()(int n) const { return (n >= 512 && n < 1152) ? ((n & ~63) | rope_perm(n & 63)) : n; } };

__device__ __forceinline__ void prologue_phase(const Fr& F) {
    const int tid = F.tid, G = F.G, bid = F.bid;
    const float PI2 = 6.283185307179586f;
    const size_t gtid = (size_t)bid * 512 + tid, gsz = (size_t)G * 512;
    { float* rope = WSP(float, WS_ROPE);
      for (size_t i = gtid; i < 2048; i += gsz) { const int pos = (int)(i >> 4), f = (int)(i & 15); const float inv = powf(10000.0f, -(float)f / 16.0f); const float a = (float)pos * inv; rope[i] = cosf(a); rope[2048 + i] = sinf(a); } }
    { bf16_t* W1 = WSP(bf16_t, WS_W1);
      for (size_t i = gtid; i < 256 * 128; i += gsz) { const int r = (int)(i >> 7), n1 = (int)(i & 127); float v = 0.f;
          if (r < 128) { const int k1p = r >> 1, part = r & 1;
              if (part == 0) v = cospif((float)((k1p * n1) & 127) / 64.0f);
              else if (k1p == 0) v = (n1 & 1) ? -1.0f : 1.0f;
              else v = -sinpif((float)((k1p * n1) & 127) / 64.0f); }
          W1[i] = f2bf(v); } }
    { bf16_t* MT = WSP(bf16_t, WS_MT);
      for (size_t i = gtid; i < (size_t)64 * 256 * 128; i += gsz) {
          const int kk = (int)(i & 127), r = (int)((i >> 7) & 255), k1p = (int)(i >> 15);
          const int part = kk >> 6, n2 = kk & 63, s = r >> 7, k2 = (r & 127) >> 1, reim = r & 1;
          float v;
          if (k1p == 0) { const int k = 64 * s + 128 * k2; const int mm = (n2 * k) & 8191; const float cm = cospif((float)mm / 4096.0f), sm = sinpif((float)mm / 4096.0f);
              v = (part == s) ? (reim ? -sm : cm) : 0.0f; }
          else { const int k = (s ? 128 - k1p : k1p) + 128 * k2; const int mm = (n2 * k) & 8191; const float cm = cospif((float)mm / 4096.0f), sm = sinpif((float)mm / 4096.0f);
              if (s == 0) v = reim ? (part ? cm : -sm) : (part ? sm : cm);
              else        v = reim ? (part ? -cm : -sm) : (part ? -sm : cm); }
          MT[i] = f2bf(v); } }
    { bf16_t* WC = WSP(bf16_t, WS_WC);
      const float sc = 5.656854249492381f;
      for (size_t i = gtid; i < 512 * 256; i += gsz) { const int n = (int)(i & 255), r = (int)(i >> 8), k = r >> 1, reim = r & 1; const int mm = (k * n) & 255;
          WC[i] = f2bf(sc * (reim ? -sinpif((float)mm / 128.0f) : cospif((float)mm / 128.0f))); } }
    { bf16_t* RWT = WSP(bf16_t, WS_RWT); const float* rw = INP(13);
      for (size_t i = gtid; i < (size_t)DEPTH * 32 * 1024; i += gsz) { const int k = (int)(i & 1023), e = (int)((i >> 10) & 31), l = (int)(i >> 15); RWT[i] = f2bf(rw[((size_t)l * 1024 + k) * 32 + e]); } }
    { bf16_t* H = WSP(bf16_t, WS_H); for (size_t i = gtid; i < 256 * 1024; i += gsz) H[(size_t)TT * 1024 + i] = 0;
      unsigned* H8z = (unsigned*)(WSP(signed char, WS_H8) + (size_t)TT * 1024); for (size_t i = gtid; i < 256 * 256; i += gsz) H8z[i] = 0u; }
    (void)PI2;
    {
        LAS float* sil = (LAS float*)(F.lds + 65536);
        LAS float* red = (LAS float*)(F.lds + 65536 + 20480);
        for (int i = tid; i < 5 * 1024; i += 512) { const int v = i >> 10, k = i & 1023; const float x = (v < 4) ? INP(1)[v * 1024 + k] : INP(3)[k]; sil[i] = x * sigmoidf_(x); }
        __syncthreads();
        float* MOD = WSP(float, WS_MOD);
        for (int u = bid; u < DEPTH * 96; u += G) {
            const int l = u / 96, j0 = (u % 96) * 64;
            const float* aw = INP(4) + (size_t)l * 1024 * 6144 + j0 + F.lane;
            float a0 = 0.f, a1 = 0.f, a2 = 0.f, a3 = 0.f, a4 = 0.f;
            for (int kk = 0; kk < 128; ++kk) { const int k = F.wave * 128 + kk; const float w = aw[(size_t)k * 6144];
                a0 += sil[k] * w; a1 += sil[1024 + k] * w; a2 += sil[2048 + k] * w; a3 += sil[3072 + k] * w; a4 += sil[4096 + k] * w; }
            red[(F.wave * 5 + 0) * 64 + F.lane] = a0; red[(F.wave * 5 + 1) * 64 + F.lane] = a1; red[(F.wave * 5 + 2) * 64 + F.lane] = a2; red[(F.wave * 5 + 3) * 64 + F.lane] = a3; red[(F.wave * 5 + 4) * 64 + F.lane] = a4;
            __syncthreads();
            if (tid < 320) { const int v = tid >> 6, jl = tid & 63; float s = INP(5)[(size_t)l * 6144 + j0 + jl];
#pragma unroll
                for (int w = 0; w < 8; ++w) s += red[(w * 5 + v) * 64 + jl];
                MOD[((size_t)l * 5 + v) * 6144 + j0 + jl] = s; }
            __syncthreads();
        }
    }
    {
        LAS float* tab = (LAS float*)(F.lds + 65536);
        if (tid < 128) { tab[tid] = cospif((float)tid / 64.0f); tab[128 + tid] = sinpif((float)tid / 64.0f); }
        __syncthreads();
        unsigned char* WFO = WSP(unsigned char, WS_WFO);
        for (int u = bid; u < DEPTH * 4 * 2 * 8; u += G) {
            const int dp = u & 7, reim = (u >> 3) & 1, g = (u >> 4) & 3, l = u >> 6;
            const int dc = 2 * dp + (tid >> 8), o4 = (tid & 255) * 4;
            const float* wf = INP(10) + ((size_t)l * 512 + g * 128) * 1024 + o4;
            f32x4 a[8];
#pragma unroll
            for (int q = 0; q < 8; ++q) a[q] = (f32x4){0.f, 0.f, 0.f, 0.f};
#pragma unroll 4
            for (int j = 0; j < 128; ++j) { const f32x4 w = *(const f32x4*)(wf + (size_t)j * 1024);
#pragma unroll
                for (int q = 0; q < 8; ++q) a[q] += w * tab[reim * 128 + ((j * (dc * 8 + q)) & 127)]; }
#pragma unroll
            for (int e = 0; e < 4; ++e) { u32x2 w2; w2.x = pk4_fp8(a[0][e] * 8.0f, a[1][e] * 8.0f, a[2][e] * 8.0f, a[3][e] * 8.0f); w2.y = pk4_fp8(a[4][e] * 8.0f, a[5][e] * 8.0f, a[6][e] * 8.0f, a[7][e] * 8.0f);
                *(u32x2*)(WFO + ((size_t)l * 1024 + o4 + e) * 1024 + g * 256 + reim * 128 + dc * 8) = w2; }
        }
        __syncthreads();
    }
    {
        constexpr int T_GU = DEPTH * 32 * 32, T_DN = DEPTH * 32 * 16, T_WIN = DEPTH * 52, T_WAO = DEPTH * 16, T_WOUT = DEPTH * 16;
#pragma unroll 1
        for (int q = bid; q < T_GU; q += G) { const int le = q >> 5, ns = q & 31;
            strip_convert<0, 8>(F, INP(15) + (size_t)le * 1024 * 2048, 2048, ns * 64, WSP(signed char, WS_WGU) + (size_t)le * 2048 * 1024, 1024, WSP(float, WS_SWGU) + (size_t)le * 2048, RmGu()); }
#pragma unroll 1
        for (int q = bid; q < T_DN; q += G) { const int le = q >> 4, ns = (q >> 1) & 7, kh = q & 1;
            strip128_fp8(F, INP(17) + (size_t)le * 1024 * 1024, 1024, kh * 512, ns * 128, WSP(unsigned char, WS_WDN) + (size_t)le * 1024 * 1024, 1024); }
#pragma unroll 1
        for (int q = bid; q < T_WIN; q += G) { const int l = q / 52, ns = q % 52;
            strip_convert<0, 8>(F, INP(8) + (size_t)l * 1024 * IN_DIM, IN_DIM, ns * 64, WSP(signed char, WS_WIN) + (size_t)l * IN_DIM * 1024, 1024, WSP(float, WS_SWIN) + (size_t)l * IN_DIM, RmWin()); }
#pragma unroll 1
        for (int q = (bid + 208) % G; q < DEPTH * 8; q += G) { const int l = q >> 3, ns = q & 7;
            strip128_fp8(F, INP(11) + (size_t)l * 512 * 1024, 1024, 0, ns * 128, WSP(unsigned char, WS_WAO) + (size_t)l * 1024 * 512, 512); }
#pragma unroll 1
        for (int q = (bid + 144) % G; q < DEPTH * 16; q += G) { const int l = q >> 4, ns = (q >> 1) & 7, kh = q & 1;
            strip128_fp8(F, INP(12) + (size_t)l * 1024 * 1024, 1024, kh * 512, ns * 128, WSP(unsigned char, WS_WOUT) + (size_t)l * 1024 * 1024, 1024); }
    }
}

template <bool WIDE>
__device__ __forceinline__ void moe_combine(const Fr& F, int tok, int lprev, const volatile LAS int* tstart, f32x4 (&m)[4]) {
    const int* slot = WSP(int, WS_SLOT); const float* gate = WSP(float, WS_GATE); const unsigned char* YE = WSP(unsigned char, WS_YE);
#pragma unroll
    for (int j = 0; j < 4; ++j) m[j] = (f32x4){0.f, 0.f, 0.f, 0.f};
    const i32x4 sl4 = *(const i32x4*)(slot + tok * 4); const f32x4 gk4 = *(const f32x4*)(gate + tok * 4);
#pragma unroll
    for (int k = 0; k < 4; ++k) {
        const int sl = sl4[k]; const float gk = gk4[k];
        const int e = sl >> 20, pos = sl & 0xfffff;
        const size_t row = (size_t)256 * tstart[e] + pos;
        i32x4 w4;
        if (WIDE) w4 = *(const i32x4*)(YE + row * 1024 + 16 * F.lane);
        else { const unsigned char* yp = YE + row * 1024 + 4 * F.lane;
#pragma unroll
            for (int j = 0; j < 4; ++j) w4[j] = *(const int*)(yp + 256 * j); }
#pragma unroll
        for (int j = 0; j < 4; ++j) { const int w = w4[j];
            m[j][0] += gk * __builtin_amdgcn_cvt_f32_fp8(w, 0); m[j][1] += gk * __builtin_amdgcn_cvt_f32_fp8(w, 1); m[j][2] += gk * __builtin_amdgcn_cvt_f32_fp8(w, 2); m[j][3] += gk * __builtin_amdgcn_cvt_f32_fp8(w, 3); }
    }
    (void)lprev;
}
__device__ __forceinline__ int fill_tstart(const Fr& F, int l) {
    volatile LAS int* ts = (volatile LAS int*)(F.lds + LDS_MISC + 64);
    volatile LAS unsigned char* r2e = (volatile LAS unsigned char*)(F.lds + LDS_MISC + 1024);
    __syncthreads();
    if (F.tid < 64) {
        const int e = F.tid & 31; const int* cnt = (const int*)(F.ws + WS_CTL + CTL_CNT) + l * 32;
        const int nt_e = (cnt[e] + 255) >> 8; int inc = nt_e;
#pragma unroll
        for (int o = 1; o < 32; o <<= 1) { const int y = __shfl_up(inc, o, 32); if (e >= o) inc += y; }
        const int start = inc - nt_e;
        if (F.tid < 32) { ts[e] = start; if (e == 31) ts[32] = inc;
            for (int rt = start; rt < inc; ++rt) r2e[rt] = (unsigned char)e; }
    }
    __syncthreads();
    return ts[32];
}

__device__ __forceinline__ void norm1_phase(const Fr& F, int l) {
    const volatile LAS int* tstart = (const volatile LAS int*)(F.lds + LDS_MISC + 64);
    if (l > 0) fill_tstart(F, l - 1);
    const float* MOD = WSP(float, WS_MOD);
    const bool fin = (l == DEPTH);
    const int ntok = fin ? TX : TT;
    const bool tmo = fin && (xb_ld((unsigned*)(F.ws + WS_CTL) + XB_TMO) != 0u);
    const float* gvec = fin ? INP(19) : INP(6) + (size_t)l * 1024;
    bf16_t* XW = WSP(bf16_t, WS_XW); bf16_t* CW = WSP(bf16_t, WS_CW); signed char* H8 = WSP(signed char, WS_H8); float* SHv = WSP(float, WS_SH);
    const bool wide = (l > 0) && !fin;
#define N1_COL(j) (wide ? (16 * F.lane + 4 * (j)) : (256 * (j) + 4 * F.lane))
    int vcur = -1; f32x4 g2v[4], mulv[4], addv[4];
    for (int tok = F.bid * 8 + F.wave; tok < ntok; tok += F.G * 8) {
        const bool isx = tok < TX; const int v = isx ? (tok >> 13) : 4;
        if (v != vcur) { vcur = v;
            const float* g2 = MOD + ((size_t)(l > 0 ? l - 1 : 0) * 5 + v) * 6144 + 5 * 1024; const float* md = MOD + ((size_t)(fin ? 0 : l) * 5 + v) * 6144;
#pragma unroll
            for (int j = 0; j < 4; ++j) { const int c = N1_COL(j); g2v[j] = *(const f32x4*)(g2 + c); const f32x4 g = *(const f32x4*)(gvec + c);
                if (fin) { mulv[j] = g; addv[j] = (f32x4){0.f, 0.f, 0.f, 0.f}; } else { mulv[j] = g * (*(const f32x4*)(md + 1024 + c) + 1.0f); addv[j] = *(const f32x4*)(md + c); } } }
        f32x4 x[4];
        if (l == 0) { const float* src = isx ? INP(0) + (size_t)tok * 1024 : INP(2) + (size_t)(tok - TX) * 1024;
#pragma unroll
            for (int j = 0; j < 4; ++j) x[j] = *(const f32x4*)(src + 256 * j + 4 * F.lane);
        } else { const bf16_t* src = isx ? XW + (size_t)tok * 1024 : CW + (size_t)(tok - TX) * 1024; u32x2 xw[4];
            if (wide) { const u32x4 a = *(const u32x4*)(src + 16 * F.lane), bq = *(const u32x4*)(src + 16 * F.lane + 8);
                xw[0] = (u32x2){a.x, a.y}; xw[1] = (u32x2){a.z, a.w}; xw[2] = (u32x2){bq.x, bq.y}; xw[3] = (u32x2){bq.z, bq.w}; }
            else {
#pragma unroll
                for (int j = 0; j < 4; ++j) xw[j] = *(const u32x2*)(src + 256 * j + 4 * F.lane); }
#pragma unroll
            for (int j = 0; j < 4; ++j) x[j] = (f32x4){bf_lo(xw[j].x), bf_hi(xw[j].x), bf_lo(xw[j].y), bf_hi(xw[j].y)};
        }
        if (l > 0) {
            f32x4 mm[4]; if (wide) moe_combine<true>(F, tok, l - 1, tstart, mm); else moe_combine<false>(F, tok, l - 1, tstart, mm);
            bf16_t* dst = isx ? XW + (size_t)tok * 1024 : CW + (size_t)(tok - TX) * 1024;
#pragma unroll
            for (int j = 0; j < 4; ++j) x[j] += g2v[j] * mm[j];
            if (wide) { u32x4 a, bq; a.x = cvt_pk_bf16(x[0][0], x[0][1]); a.y = cvt_pk_bf16(x[0][2], x[0][3]); a.z = cvt_pk_bf16(x[1][0], x[1][1]); a.w = cvt_pk_bf16(x[1][2], x[1][3]);
                bq.x = cvt_pk_bf16(x[2][0], x[2][1]); bq.y = cvt_pk_bf16(x[2][2], x[2][3]); bq.z = cvt_pk_bf16(x[3][0], x[3][1]); bq.w = cvt_pk_bf16(x[3][2], x[3][3]);
                *(u32x4*)(dst + 16 * F.lane) = a; *(u32x4*)(dst + 16 * F.lane + 8) = bq; }
        }
        float ss = 0.f;
#pragma unroll
        for (int j = 0; j < 4; ++j) ss += x[j][0] * x[j][0] + x[j][1] * x[j][1] + x[j][2] * x[j][2] + x[j][3] * x[j][3];
        ss = wave_sum(ss);
        const float rstd = rsqrtf(ss * (1.0f / 1024.0f) + EPS);
        if (fin) {
#pragma unroll
            for (int j = 0; j < 4; ++j) *(f32x4*)(F.out + (size_t)tok * 1024 + 256 * j + 4 * F.lane) = tmo ? (f32x4){__builtin_nanf(""), __builtin_nanf(""), __builtin_nanf(""), __builtin_nanf("")} : x[j] * rstd * mulv[j];
        } else {
            float amax = 0.f;
#pragma unroll
            for (int j = 0; j < 4; ++j) { x[j] = x[j] * rstd * mulv[j] + addv[j];
                amax = fmaxf(amax, fmaxf(fmaxf(fabsf(x[j][0]), fabsf(x[j][1])), fmaxf(fabsf(x[j][2]), fabsf(x[j][3])))); }
#pragma unroll
            for (int o = 32; o >= 1; o >>= 1) amax = fmaxf(amax, __shfl_xor(amax, o));
            const float inv = amax > 0.f ? 127.0f / amax : 0.f;
            u32x4 hq;
#pragma unroll
            for (int j = 0; j < 4; ++j) {
                const int q0 = __float2int_rn(x[j][0] * inv), q1 = __float2int_rn(x[j][1] * inv), q2 = __float2int_rn(x[j][2] * inv), q3 = __float2int_rn(x[j][3] * inv);
                hq[j] = (unsigned)(q0 & 255) | ((unsigned)(q1 & 255) << 8) | ((unsigned)(q2 & 255) << 16) | ((unsigned)(q3 & 255) << 24); }
            if (wide) *(u32x4*)(H8 + (size_t)tok * 1024 + 16 * F.lane) = hq;
            else {
#pragma unroll
                for (int j = 0; j < 4; ++j) *(unsigned*)(H8 + (size_t)tok * 1024 + 256 * j + 4 * F.lane) = hq[j]; }
            if (F.lane == 0) SHv[tok] = amax * (1.0f / 127.0f);
        }
    }
#undef N1_COL
}

__device__ __forceinline__ void norm2_router_phase(const Fr& F, int l, bool fake = false) {
    const int ntok = (l == DEPTH - 1) ? TX : TT;
    const float* MOD = WSP(float, WS_MOD); const float* gvec = INP(7) + (size_t)l * 1024;
    const bf16_t* XW = WSP(bf16_t, WS_XW); const bf16_t* CW = WSP(bf16_t, WS_CW);
    const bf16_t* RWT = WSP(bf16_t, WS_RWT) + (size_t)l * 32 * 1024; const float* rb = INP(14) + l * 32;
    int* cntg = (int*)(F.ws + WS_CTL + CTL_CNT) + l * 32; int* list = WSP(int, WS_LIST); int* slot = WSP(int, WS_SLOT); float* gate = WSP(float, WS_GATE);
    LAS unsigned char* hs = F.lds;
    LAS float* part = (LAS float*)(F.lds + 69632);
    LAS float* logit = (LAS float*)(F.lds + 69632 + 36864);
    LAS int* lcnt = (LAS int*)(F.lds + 69632 + 36864 + 4608);
    LAS int* lbase = lcnt + 32;
    LAS float* tsc = (LAS float*)(lbase + 32);
    LAS int* tokE = (LAS int*)(tsc + 32); LAS float* tokG = (LAS float*)(tokE + 128);
    signed char* H8 = WSP(signed char, WS_H8); float* lscg = WSP(float, WS_LSC);
    const int lane = F.lane, w = F.wave, l32 = lane & 31, hh = lane >> 5;
    bf16x8 rwf[8];
#pragma unroll
    for (int s = 0; s < 8; ++s) rwf[s] = *(const bf16x8*)(RWT + (size_t)l32 * 1024 + 128 * w + 16 * s + 8 * hh);
    for (int tl = F.bid; tl < ntok / 32; tl += F.G) {
        const int t0 = tl * 32;
        if (F.tid < 32) lcnt[F.tid] = 0;
        f32x4 mulv[4], addv[4];
        { const int v0 = (t0 < TX) ? (t0 >> 13) : 4; const float* md0 = MOD + ((size_t)l * 5 + v0) * 6144;
#pragma unroll
          for (int j = 0; j < 4; ++j) { const int c = 256 * j + 4 * lane; mulv[j] = *(const f32x4*)(gvec + c) * (*(const f32x4*)(md0 + 4096 + c) + 1.0f); addv[j] = *(const f32x4*)(md0 + 3072 + c); } }
#pragma unroll 1
        for (int q = 0; q < 4; ++q) {
            const int tloc = 4 * w + q, tok = t0 + tloc; const bool isx = tok < TX; const int v = isx ? (tok >> 13) : 4;
            const bf16_t* src = isx ? XW + (size_t)tok * 1024 : CW + (size_t)(tok - TX) * 1024;
            f32x4 x[4]; float ss = 0.f; u32x2 xw[4];
#pragma unroll
            for (int j = 0; j < 4; ++j) xw[j] = *(const u32x2*)(src + 256 * j + 4 * lane);
#pragma unroll
            for (int j = 0; j < 4; ++j) { x[j] = (f32x4){bf_lo(xw[j].x), bf_hi(xw[j].x), bf_lo(xw[j].y), bf_hi(xw[j].y)}; ss += x[j][0] * x[j][0] + x[j][1] * x[j][1] + x[j][2] * x[j][2] + x[j][3] * x[j][3]; }
            ss = wave_sum(ss); const float rstd = rsqrtf(ss * (1.0f / 1024.0f) + EPS); (void)v;
            float amax = 0.f;
#pragma unroll
            for (int j = 0; j < 4; ++j) { const int c = 256 * j + 4 * lane;
                x[j] = x[j] * rstd * mulv[j] + addv[j];
                amax = fmaxf(amax, fmaxf(fmaxf(fabsf(x[j][0]), fabsf(x[j][1])), fmaxf(fabsf(x[j][2]), fabsf(x[j][3]))));
                u32x2 wv; wv.x = cvt_pk_bf16(x[j][0], x[j][1]); wv.y = cvt_pk_bf16(x[j][2], x[j][3]);
                *(LAS u32x2*)(hs + tloc * 2064 + c * 2) = wv; }
#pragma unroll
            for (int o = 32; o >= 1; o >>= 1) amax = fmaxf(amax, __shfl_xor(amax, o));
            const float inv = amax > 0.f ? 127.0f / amax : 0.f;
#pragma unroll
            for (int j = 0; j < 4; ++j) { const int c = 256 * j + 4 * lane;
                const int q0 = __float2int_rn(x[j][0] * inv), q1 = __float2int_rn(x[j][1] * inv), q2 = __float2int_rn(x[j][2] * inv), q3 = __float2int_rn(x[j][3] * inv);
                *(unsigned*)(H8 + (size_t)tok * 1024 + c) = (unsigned)(q0 & 255) | ((unsigned)(q1 & 255) << 8) | ((unsigned)(q2 & 255) << 16) | ((unsigned)(q3 & 255) << 24); }
            if (lane == 0) tsc[tloc] = amax * (1.0f / 127.0f);
        }
        __syncthreads();
        {
            f32x16 acc;
#pragma unroll
            for (int e = 0; e < 16; ++e) acc[e] = 0.f;
#pragma unroll
            for (int s = 0; s < 8; ++s) { const int k = 128 * w + 16 * s + 8 * hh;
                const bf16x8 a = *(const LAS bf16x8*)(hs + l32 * 2064 + k * 2);
                acc = __builtin_amdgcn_mfma_f32_32x32x16_bf16(a, rwf[s], acc, 0, 0, 0); }
#pragma unroll
            for (int e = 0; e < 16; ++e) { const int trow = 8 * (e >> 2) + 4 * hh + (e & 3); part[(w * 32 + trow) * 33 + l32] = acc[e]; }
        }
        __syncthreads();
        int es[4], rk[4]; float gs[4];
        {
            const int tr = F.tid >> 4, e0 = (F.tid & 15) * 2;
            float v0 = rb[e0], v1 = rb[e0 + 1];
#pragma unroll
            for (int ww = 0; ww < 8; ++ww) { v0 += part[(ww * 32 + tr) * 33 + e0]; v1 += part[(ww * 32 + tr) * 33 + e0 + 1]; }
            float lv[4];
#pragma unroll
            for (int k = 0; k < 4; ++k) {
                float bv = v0; int bi = e0; if (v1 > bv) { bv = v1; bi = e0 + 1; }
#pragma unroll
                for (int o = 1; o < 16; o <<= 1) { const float ov = __shfl_xor(bv, o, 16); const int oi = __shfl_xor(bi, o, 16); if (ov > bv || (ov == bv && oi < bi)) { bv = ov; bi = oi; } }
                es[k] = bi; lv[k] = bv;
                if (bi == e0) v0 = -3.0e38f; if (bi == e0 + 1) v1 = -3.0e38f; }
            if (fake) { __syncthreads(); continue; }
            if ((F.tid & 15) == 0) {
                const float mx = lv[0]; float sum = 0.f;
#pragma unroll
                for (int k = 0; k < 4; ++k) { gs[k] = __expf(lv[k] - mx); sum += gs[k]; }
                const float isum = 1.0f / sum;
#pragma unroll
                for (int k = 0; k < 4; ++k) { tokE[tr * 4 + k] = es[k]; tokG[tr * 4 + k] = gs[k] * isum; }
            }
        }
        __syncthreads();
        if (F.tid < 32) {
#pragma unroll
            for (int k = 0; k < 4; ++k) { es[k] = tokE[F.tid * 4 + k]; gs[k] = tokG[F.tid * 4 + k]; rk[k] = __hip_atomic_fetch_add(&lcnt[es[k]], 1, __ATOMIC_RELAXED, __HIP_MEMORY_SCOPE_WORKGROUP); }
        }
        __syncthreads();
        if (F.tid < 32) { const int n = lcnt[F.tid]; lbase[F.tid] = n ? atomicAdd(&cntg[F.tid], n) : 0; }
        __syncthreads();
        if (F.tid < 32) { const int tok = t0 + F.tid;
#pragma unroll
            for (int k = 0; k < 4; ++k) { const int pos = lbase[es[k]] + rk[k]; list[(size_t)es[k] * TT + pos] = tok; lscg[(size_t)es[k] * TT + pos] = tsc[F.tid]; slot[tok * 4 + k] = (es[k] << 20) | pos; gate[tok * 4 + k] = gs[k]; } }
        __syncthreads();
    }
}

template <int OFF> __device__ __forceinline__ s16x4 tr_read(unsigned vb) { s16x4 r; asm volatile("ds_read_b64_tr_b16 %0, %1 offset:%2" : "=&v"(r) : "v"(vb), "i"(OFF) : "memory"); return r; }

__device__ __forceinline__ void attn_phase(const Fr& F, int l, bool with_ctx) {
    LAS unsigned char* lds = F.lds;
    const unsigned ldsb = (unsigned)(uintptr_t)lds;
    const bf16_t* Q = WSP(bf16_t, WS_Q); const bf16_t* Kb = WSP(bf16_t, WS_K); const bf16_t* Vb = WSP(bf16_t, WS_V); unsigned char* AO = WSP(unsigned char, WS_AO);
    const int tid = F.tid, lane = F.lane, w = F.wave, l32 = lane & 31, hh = lane >> 5;
    const int g = w >> 1, rhalf = w & 1;
    const int nunits = 512 + (with_ctx ? 16 : 0);
    const int skey = tid >> 3, sch = tid & 7;
    const unsigned k_st = (unsigned)(skey * 128 + ((sch ^ ((skey >> 1) & 7)) * 16));
    const unsigned v_st = (unsigned)(8192 + skey * 128 + ((((sch >> 1) ^ (((skey >> 1) & 1) << 1)) * 32) + (sch & 1) * 16));
    unsigned vbase[2];
    { const int li = lane & 15, q = li >> 2, p = li & 3, g16 = l32 >> 4; const int key = 4 * hh + q;
#pragma unroll
      for (int db = 0; db < 2; ++db) { const int c32 = 2 * db + g16; vbase[db] = ldsb + 8192u + (unsigned)(key * 128 + ((c32 ^ (((key >> 1) & 1) << 1)) * 32) + 8 * p); } }
    for (int u = F.bid; u < nunits; u += F.G) {
        int b, qb, kvh; bool isctx;
        if (u < 512) { b = u >> 7; qb = (u >> 1) & 63; kvh = u & 1; isctx = false; }
        else { const int uu = u - 512; b = uu >> 2; qb = (uu >> 1) & 1; kvh = uu & 1; isctx = true; }
        const int head = kvh * 4 + g;
        const int qtok0 = isctx ? (TX + b * LC + qb * 128) : (b * SEQ + qb * 128);
        LAS unsigned char* ql = lds + 49152 + w * 8192;
        { u32x4 qv[8];
#pragma unroll
          for (int i = 0; i < 8; ++i) { const int row = i * 8 + (lane >> 3), ch = lane & 7; qv[i] = *(const u32x4*)(Q + (size_t)(qtok0 + rhalf * 64 + row) * 512 + head * 64 + ch * 8); }
#pragma unroll
          for (int i = 0; i < 8; ++i) { const int row = i * 8 + (lane >> 3), ch = lane & 7; *(LAS u32x4*)(ql + row * 128 + ((ch ^ ((row >> 1) & 7)) * 16)) = qv[i]; } }
        const float sink2 = INP(9)[l * 8 + head] * LOG2E;
        const float sk = __builtin_amdgcn_exp2f(sink2 - SOFT_C);
        float l_run[2] = {hh ? 0.f : sk, hh ? 0.f : sk};
        f32x16 O[2][2];
#pragma unroll
        for (int a = 0; a < 2; ++a)
#pragma unroll
            for (int c = 0; c < 2; ++c)
#pragma unroll
                for (int e = 0; e < 16; ++e) O[a][c][e] = 0.f;
#define ATT_TOK0(tt) (((tt) < 6) ? (b * SEQ + (qb - 1) * 128 + 64 * (tt)) : (TX + b * LC + 64 * ((tt) - 6)))
#define ATT_NEXT(tt) ((!isctx && qb == 63 && ((tt) + 1 == 4 || (tt) + 1 == 5)) ? 6 : (tt) + 1)
#define ATT_PV(SLOTB) do { const unsigned vb0 = vbase[0] + (SLOTB), vb1 = vbase[1] + (SLOTB); \
            ATT_PV_STEP(0, 0); ATT_PV_STEP(0, 1); ATT_PV_STEP(1, 0); ATT_PV_STEP(1, 1); } while (0)
#define ATT_PV_STEP(KB, SP) do { \
            const s16x4 a0 = tr_read<((32 * (KB) + 16 * (SP)) * 128)>(vb0), a1 = tr_read<((32 * (KB) + 16 * (SP) + 8) * 128)>(vb0); \
            const s16x4 c0 = tr_read<((32 * (KB) + 16 * (SP)) * 128)>(vb1), c1 = tr_read<((32 * (KB) + 16 * (SP) + 8) * 128)>(vb1); \
            asm volatile("s_waitcnt lgkmcnt(0)" ::: "memory"); __builtin_amdgcn_sched_barrier(0); \
            const bf16x8 vf0 = (bf16x8){a0[0], a0[1], a0[2], a0[3], a1[0], a1[1], a1[2], a1[3]}, vf1 = (bf16x8){c0[0], c0[1], c0[2], c0[3], c1[0], c1[1], c1[2], c1[3]}; \
            O[0][0] = __builtin_amdgcn_mfma_f32_32x32x16_bf16(vf0, pf[KB][SP][0], O[0][0], 0, 0, 0); O[0][1] = __builtin_amdgcn_mfma_f32_32x32x16_bf16(vf0, pf[KB][SP][1], O[0][1], 0, 0, 0); \
            O[1][0] = __builtin_amdgcn_mfma_f32_32x32x16_bf16(vf1, pf[KB][SP][0], O[1][0], 0, 0, 0); O[1][1] = __builtin_amdgcn_mfma_f32_32x32x16_bf16(vf1, pf[KB][SP][1], O[1][1], 0, 0, 0); } while (0)
        const bool late = (w >= 4);
        int t = isctx ? 6 : (qb == 0 ? 2 : 0);
        int tn = ATT_NEXT(t);
        u32x4 kreg, vreg;
        { const int tok0 = ATT_TOK0(t);
          kreg = *(const u32x4*)(Kb + (size_t)(tok0 + skey) * 128 + kvh * 64 + sch * 8); vreg = *(const u32x4*)(Vb + (size_t)(tok0 + skey) * 128 + kvh * 64 + sch * 8); }
        __syncthreads();
        *(LAS u32x4*)(lds + k_st) = kreg; *(LAS u32x4*)(lds + v_st) = vreg;
        if (tn < 10) { const int tok0 = ATT_TOK0(tn);
            kreg = *(const u32x4*)(Kb + (size_t)(tok0 + skey) * 128 + kvh * 64 + sch * 8); vreg = *(const u32x4*)(Vb + (size_t)(tok0 + skey) * 128 + kvh * 64 + sch * 8); }
        __syncthreads();
        int idx = 0, pidx = 0; bool pvpend = false;
        bf16x8 pf[2][2][2];
        for (;;) {
            const bool more = tn < 10;
            const int nidx = (idx == 2) ? 0 : idx + 1;
            int tnn = 10;
            if (more) {
                *(LAS u32x4*)(lds + nidx * 16384 + k_st) = kreg; *(LAS u32x4*)(lds + nidx * 16384 + v_st) = vreg;
                tnn = ATT_NEXT(tn);
                if (tnn < 10) { const int tok0 = ATT_TOK0(tnn);
                    kreg = *(const u32x4*)(Kb + (size_t)(tok0 + skey) * 128 + kvh * 64 + sch * 8); vreg = *(const u32x4*)(Vb + (size_t)(tok0 + skey) * 128 + kvh * 64 + sch * 8); }
            }
            if (late && pvpend) { ATT_PV((unsigned)(pidx * 16384)); pvpend = false; }
            const bool local = (!isctx) && (t < 6);
            const bool skip = local && ((rhalf == 0 && t == 5) || (rhalf == 1 && t == 0));
            const bool needmask = local && ((rhalf == 0 && (t == 0 || t == 4)) || (rhalf == 1 && (t == 1 || t == 5)));
            if (!skip) {
                LAS unsigned char* kl = lds + idx * 16384;
                f32x16 S[2][2];
#pragma unroll
                for (int kb = 0; kb < 2; ++kb)
#pragma unroll
                    for (int qk = 0; qk < 2; ++qk)
#pragma unroll
                        for (int e = 0; e < 16; ++e) S[kb][qk][e] = -SOFT_C;
#pragma unroll
                for (int kb = 0; kb < 2; ++kb)
#pragma unroll
                    for (int s = 0; s < 4; ++s) { const int key = 32 * kb + l32, ch = 2 * s + hh;
                        const bf16x8 kf = *(const LAS bf16x8*)(kl + key * 128 + ((ch ^ ((key >> 1) & 7)) * 16));
#pragma unroll
                        for (int qk = 0; qk < 2; ++qk) { const int qrow = 32 * qk + l32; const bf16x8 qfr = *(const LAS bf16x8*)(ql + qrow * 128 + ((ch ^ ((qrow >> 1) & 7)) * 16));
                            S[kb][qk] = __builtin_amdgcn_mfma_f32_32x32x16_bf16(kf, qfr, S[kb][qk], 0, 0, 0); } }
#pragma unroll
                for (int qk = 0; qk < 2; ++qk) {
                    if (needmask) { const int rq = rhalf * 64 + qk * 32 + l32;
#pragma unroll
                        for (int kb = 0; kb < 2; ++kb)
#pragma unroll
                            for (int e = 0; e < 16; ++e) { const int kk = 64 * t + 32 * kb + 8 * (e >> 2) + 4 * hh + (e & 3); const int rel = kk - 128 - rq; if (rel < -128 || rel > 128) S[kb][qk][e] = -__builtin_inff(); } }
                    float rs = 0.f;
#pragma unroll
                    for (int kb = 0; kb < 2; ++kb)
#pragma unroll
                        for (int e = 0; e < 16; ++e) { const float p = __builtin_amdgcn_exp2f(S[kb][qk][e]); S[kb][qk][e] = p; rs += p; }
                    l_run[qk] += rs;
#pragma unroll
                    for (int kb = 0; kb < 2; ++kb)
#pragma unroll
                        for (int sp = 0; sp < 2; ++sp) { u32x4 pw;
                            pw.x = cvt_pk_bf16(S[kb][qk][8 * sp + 0], S[kb][qk][8 * sp + 1]); pw.y = cvt_pk_bf16(S[kb][qk][8 * sp + 2], S[kb][qk][8 * sp + 3]);
                            pw.z = cvt_pk_bf16(S[kb][qk][8 * sp + 4], S[kb][qk][8 * sp + 5]); pw.w = cvt_pk_bf16(S[kb][qk][8 * sp + 6], S[kb][qk][8 * sp + 7]);
                            pf[kb][sp][qk] = __builtin_bit_cast(bf16x8, pw); }
                }
                if (late) pvpend = true; else ATT_PV((unsigned)(idx * 16384));
            }
            __syncthreads();
            if (!more) break;
            pidx = idx; idx = nidx; t = tn; tn = tnn;
        }
        if (late && pvpend) ATT_PV((unsigned)(idx * 16384));
#undef ATT_PV
#undef ATT_PV_STEP
#undef ATT_TOK0
#undef ATT_NEXT
#pragma unroll
        for (int qk = 0; qk < 2; ++qk) {
            const float lt = l_run[qk] + __shfl_xor(l_run[qk], 32); const float inv = 1.0f / lt;
            const size_t tok = (size_t)(qtok0 + rhalf * 64 + qk * 32 + l32);
#pragma unroll
            for (int db = 0; db < 2; ++db) { const float i16 = inv * 16.0f; unsigned pq[4];
#pragma unroll
                for (int vq = 0; vq < 4; ++vq) pq[vq] = pk4_fp8(clamp8(O[db][qk][4 * vq] * i16), clamp8(O[db][qk][4 * vq + 1] * i16), clamp8(O[db][qk][4 * vq + 2] * i16), clamp8(O[db][qk][4 * vq + 3] * i16));
                const auto r01 = __builtin_amdgcn_permlane32_swap(pq[0], pq[1], false, false), r23 = __builtin_amdgcn_permlane32_swap(pq[2], pq[3], false, false);
                const auto s0 = __builtin_amdgcn_permlane32_swap(r01[0], r23[0], false, false), s1 = __builtin_amdgcn_permlane32_swap(r01[1], r23[1], false, false);
                *(u32x4*)(AO + tok * 512 + head * 64 + 32 * db + 16 * hh) = (u32x4){s0[0], s1[0], s0[1], s1[1]}; }
        }
    }
    __syncthreads();
}

struct Args { const float* in[20]; float* out; unsigned char* ws; int ph_lo, ph_hi; };

constexpr int PH_PER_LAYER = 9;
constexpr int PH_FINAL = 1 + DEPTH * PH_PER_LAYER;
constexpr int PH_COUNT = PH_FINAL + 1;

__global__ void __launch_bounds__(512, 2) fwd_kernel(Args args) {
    extern __shared__ __attribute__((aligned(16))) unsigned char lds_raw[];
    Fr F;
    F.lds = (LAS unsigned char*)lds_raw; F.ws = args.ws; F.out = args.out;
    F.tid = threadIdx.x; F.lane = F.tid & 63; F.wave = __builtin_amdgcn_readfirstlane(F.tid >> 6); F.G = gridDim.x; F.bid = blockIdx.x;
    volatile LAS unsigned* misc = (volatile LAS unsigned*)(F.lds + LDS_MISC);
    if (F.tid < 64) misc[F.tid] = 0u;
    if (F.tid < 20) { const unsigned long long pv = (unsigned long long)args.in[F.tid]; misc[128 + 2 * F.tid] = (unsigned)pv; misc[128 + 2 * F.tid + 1] = (unsigned)(pv >> 32); }
    __syncthreads();
    XcdBarrier bar; bar.bar = (unsigned*)(F.ws + WS_CTL); bar.x = 0; bar.st = misc;
    const bool one = (args.ph_hi - args.ph_lo) > 1;
    if (one) bar = xcd_barrier_post((unsigned*)(F.ws + WS_CTL), misc);
    const int lo = args.ph_lo, hi = args.ph_hi;
#ifdef STOP_PH
#define IN(k) (lo <= (k) && (k) < hi && ((k) < STOP_PH || (k) == PH_FINAL))
#else
#define IN(k) (lo <= (k) && (k) < hi)
#endif
#ifndef DUP_PH
#define DUP_PH -1
#endif
#define NREP(b) ((DUP_PH == (b)) ? 2 : 1)
#define SEAM(k) do { if (lo <= (k) + 1 && (k) + 1 < hi) xcd_barrier(bar); } while (0)

#ifndef PHM
#define PHM 0xFFFF
#endif
#define PHON(b) ((PHM >> (b)) & 1)
    if (PHON(0) && IN(0)) { for (int rep = 0; rep < NREP(0); ++rep) { LAUNDER(F); prologue_phase(F); SEAM(0); } }

#pragma unroll 1
    for (int l = 0; l < NLAYERS_RUN; ++l) {
        const int pb = 1 + l * PH_PER_LAYER;
        const bool lastl = (l == DEPTH - 1);
        if (PHON(1) && IN(pb + 0)) { LAUNDER(F); norm1_phase(F, l); SEAM(pb + 0); }
        if (PHON(2) && IN(pb + 1)) for (int rep = 0; rep < NREP(2); ++rep) { LAUNDER(F);
            { InProjProb<0> P; P.H = WSP(signed char, WS_H8); P.W = WSP(signed char, WS_WIN) + (size_t)l * IN_DIM * 1024; P.sH = WSP(float, WS_SH); P.sW = WSP(float, WS_SWIN) + (size_t)l * IN_DIM;
              P.FT = WSP(bf16_t, WS_FT); P.FCT = WSP(bf16_t, WS_FCT); P.Q = WSP(bf16_t, WS_Q); P.Kb = WSP(bf16_t, WS_K); P.Vb = WSP(bf16_t, WS_V); P.GF = WSP(bf16_t, WS_GF); P.GA = WSP(bf16_t, WS_GA);
              P.rope = (const LAS float*)(F.lds + LDS_ROPE);
              { const float* rg = WSP(float, WS_ROPE); LAS float* rl = (LAS float*)(F.lds + LDS_ROPE); for (int i = F.tid; i < 4096; i += 512) rl[i] = rg[i]; __syncthreads(); }
              P.nM = lastl ? 128 : 132; P.n_nat = P.nM * 11; P.n_fx = 256; P.n_fc = lastl ? 0 : 8; P.n_extra = lastl ? 4 : 0; P.G = F.G; P.c = F.bid;
              g8::gemm_run(F.lds, P); }
            { InProjProb<1> P; P.H = WSP(signed char, WS_H8); P.W = WSP(signed char, WS_WIN) + (size_t)l * IN_DIM * 1024; P.sH = WSP(float, WS_SH); P.sW = WSP(float, WS_SWIN) + (size_t)l * IN_DIM;
              P.FT = WSP(bf16_t, WS_FT); P.FCT = WSP(bf16_t, WS_FCT); P.Q = nullptr; P.Kb = nullptr; P.Vb = nullptr; P.GF = nullptr; P.GA = nullptr; P.rope = nullptr;
              P.nM = 0; P.n_nat = 0; P.n_fx = 256; P.n_fc = lastl ? 0 : 8; P.n_extra = 0; P.G = F.G; P.c = (F.bid + 84) % F.G;
              g8::gemm_run(F.lds, P); }
            SEAM(pb + 1);
        }
        if (PHON(3) && IN(pb + 2)) for (int rep = 0; rep < NREP(3); ++rep) { LAUNDER(F);
#ifndef NO_ATTN
            attn_phase(F, l, !lastl);
#endif
#ifndef NO_FFT1
            Fft1Prob P; P.W1 = WSP(bf16_t, WS_W1); P.FT = WSP(bf16_t, WS_FT); P.WC = WSP(bf16_t, WS_WC); P.FCT = WSP(bf16_t, WS_FCT); P.T1 = WSP(bf16_t, WS_T1); P.XS = WSP(unsigned char, WS_XS);
            P.n0 = 512; P.n1 = lastl ? 0 : 16; P.G = F.G; P.c = (F.bid + 128) % F.G;
            g8::gemm_run(F.lds, P);
#endif
            SEAM(pb + 2);
        }
        if (PHON(4) && IN(pb + 3)) for (int rep = 0; rep < NREP(4); ++rep) { LAUNDER(F);
            const int nctx = lastl ? 0 : 16;
            { Fft2Prob P; P.MT = WSP(bf16_t, WS_MT); P.T1 = WSP(bf16_t, WS_T1); P.XS = WSP(unsigned char, WS_XS); P.G = F.G - nctx; P.c = F.bid - nctx;
              g8::gemm_run(F.lds, P); }
            if (nctx) { Merge1Prob P; P.XS = WSP(unsigned char, WS_XS); P.AO = WSP(unsigned char, WS_AO); P.WFO = WSP(unsigned char, WS_WFO) + (size_t)l * 1024 * 1024; P.WAO = WSP(unsigned char, WS_WAO) + (size_t)l * 1024 * 512;
              P.GF = WSP(unsigned char, WS_GF); P.GA = WSP(unsigned char, WS_GA); P.Y8 = WSP(unsigned char, WS_YB); P.nM = 4; P.pm0 = 128; P.G = 16; P.c = (F.bid < 16) ? F.bid : -1;
              g8::gemm_run(F.lds, P); }
            SEAM(pb + 3);
        }
        if (PHON(5) && IN(pb + 4)) for (int rep = 0; rep < NREP(5); ++rep) { LAUNDER(F);
            { Merge1Prob P; P.XS = WSP(unsigned char, WS_XS); P.AO = WSP(unsigned char, WS_AO); P.WFO = WSP(unsigned char, WS_WFO) + (size_t)l * 1024 * 1024; P.WAO = WSP(unsigned char, WS_WAO) + (size_t)l * 1024 * 512;
              P.GF = WSP(unsigned char, WS_GF); P.GA = WSP(unsigned char, WS_GA); P.Y8 = WSP(unsigned char, WS_YB); P.nM = 128; P.pm0 = 0; P.G = F.G; P.c = F.bid;
              g8::gemm_run(F.lds, P); }
            SEAM(pb + 4);
        }
        if (PHON(6) && IN(pb + 5)) { LAUNDER(F);
            MergeProb<2> P; P.A = WSP(unsigned char, WS_YB); P.W = WSP(unsigned char, WS_WOUT) + (size_t)l * 1024 * 1024; P.lda = 1024; P.GATE = nullptr; P.T = nullptr; P.Y8 = nullptr;
            P.xin = INP(0); P.cin = INP(2); P.XWb = WSP(bf16_t, WS_XW); P.CWb = WSP(bf16_t, WS_CW); P.in32 = (l == 0);
            P.g1x = WSP(float, WS_MOD) + (size_t)l * 5 * 6144 + 2 * 1024; P.g1c = WSP(float, WS_MOD) + ((size_t)l * 5 + 4) * 6144 + 2 * 1024; P.nM = lastl ? 128 : 132; P.G = F.G; P.c = F.bid;
            g8::gemm_run(F.lds, P); SEAM(pb + 5);
        }
        if (PHON(7) && IN(pb + 6)) for (int rep = 0; rep < NREP(7); ++rep) { LAUNDER(F); norm2_router_phase(F, l, rep + 1 < NREP(7)); SEAM(pb + 6); }
        if (PHON(8) && IN(pb + 7)) for (int rep = 0; rep < NREP(8); ++rep) { LAUNDER(F);
            MoeGuProb P; P.R = fill_tstart(F, l);
            P.H8 = WSP(signed char, WS_H8); P.W8 = WSP(signed char, WS_WGU) + (size_t)l * 32 * 2048 * 1024; P.sW = WSP(float, WS_SWGU) + (size_t)l * 32 * 2048; P.lsc = WSP(float, WS_LSC);
            P.bgu = INP(16) + (size_t)l * 32 * 2048; P.ACT = WSP(unsigned char, WS_ACT);
            P.list = WSP(int, WS_LIST); P.cnt = (const int*)(F.ws + WS_CTL + CTL_CNT) + l * 32; P.tstart = (const volatile LAS int*)(F.lds + LDS_MISC + 64); P.G = F.G; P.c = F.bid;
            g8::gemm_run(F.lds, P); SEAM(pb + 7);
        }
        if (PHON(9) && IN(pb + 8)) for (int rep = 0; rep < NREP(9); ++rep) { LAUNDER(F);
            MoeDnProb P; P.R = fill_tstart(F, l);
            P.ACT = WSP(unsigned char, WS_ACT); P.W = WSP(unsigned char, WS_WDN) + (size_t)l * 32 * 1024 * 1024; P.bdn = INP(18) + (size_t)l * 32 * 1024; P.YE = WSP(unsigned char, WS_YE);
            P.tstart = (const volatile LAS int*)(F.lds + LDS_MISC + 64); P.G = F.G; P.c = F.bid;
            g8::gemm_run(F.lds, P, ((F.bid >> 3) & 3) * STG_DN); SEAM(pb + 8);
        }
    }
#ifdef STOP_PH
    if (IN(PH_FINAL)) { LAUNDER(F);
        const size_t n = (size_t)TX * 1024;
        for (size_t i = (size_t)F.bid * 512 + F.tid; i < n; i += (size_t)F.G * 512) {
            F.out[i] = DUMP_EXPR(i);
        } }
#else
    if (PHON(10) && IN(PH_FINAL)) for (int rep = 0; rep < NREP(10); ++rep) { LAUNDER(F); norm1_phase(F, DEPTH); if (rep + 1 < NREP(10)) xcd_barrier(bar); }
#endif
#undef IN
#undef SEAM
}

extern "C" void kernel_launch(void* const* d_in, const int* in_sizes, int n_in, void* d_out, int out_size, void* d_ws, size_t ws_size, hipStream_t stream) {
    static int grid = 0;
    if (grid == 0) {
        if (n_in != 20 || ws_size < WS_END) { fprintf(stderr, "kernel_launch: bad arguments (n_in %d, ws %zu < %zu)\n", n_in, ws_size, (size_t)WS_END); grid = -1; return; }
        int dev = 0, cus = 0, per_cu = 0;
        if (hipGetDevice(&dev) != hipSuccess || hipDeviceGetAttribute(&cus, hipDeviceAttributeMultiprocessorCount, dev) != hipSuccess) { grid = -1; return; }
        if (hipFuncSetAttribute((const void*)fwd_kernel, hipFuncAttributeMaxDynamicSharedMemorySize, LDS_BYTES) != hipSuccess) { fprintf(stderr, "kernel_launch: hipFuncSetAttribute failed\n"); grid = -1; return; }
        if (hipOccupancyMaxActiveBlocksPerMultiprocessor(&per_cu, (const void*)fwd_kernel, 512, LDS_BYTES) != hipSuccess || per_cu < 1) { fprintf(stderr, "kernel_launch: occupancy query says %d\n", per_cu); }
        (void)hipGetLastError();
        grid = cus;
    }
    if (grid < 0) return;
    (void)hipMemsetAsync((char*)d_ws + WS_CTL, 0, CTL_BYTES, stream);
    Args a{};
    for (int i = 0; i < 20; ++i) a.in[i] = (const float*)d_in[i];
    a.out = (float*)d_out; a.ws = (unsigned char*)d_ws;
#if N_LAUNCH_MODE == 1
    a.ph_lo = 0; a.ph_hi = PH_COUNT;
    hipLaunchKernelGGL(fwd_kernel, dim3(grid), dim3(512), LDS_BYTES, stream, a);
#else
    for (int p = 0; p < PH_COUNT; ++p) { a.ph_lo = p; a.ph_hi = p + 1; hipLaunchKernelGGL(fwd_kernel, dim3(grid), dim3(512), LDS_BYTES, stream, a); }
#endif
    (void)in_sizes; (void)out_size;
}
```

```cpp
#include <hip/hip_runtime.h>
#include <cstdio>
#include <cstdint>

#define LAS __attribute__((address_space(3)))
#define GAS __attribute__((address_space(1)))
typedef unsigned short bf16_t;
typedef short bf16x8 __attribute__((ext_vector_type(8)));
typedef short s16x4 __attribute__((ext_vector_type(4)));
typedef float f32x4 __attribute__((ext_vector_type(4)));
typedef float f32x16 __attribute__((ext_vector_type(16)));
typedef unsigned u32x4 __attribute__((ext_vector_type(4)));
typedef unsigned u32x2 __attribute__((ext_vector_type(2)));
typedef int i32x4 __attribute__((ext_vector_type(4)));
typedef int i32x8 __attribute__((ext_vector_type(8)));

#ifndef N_LAUNCH_MODE
#define N_LAUNCH_MODE 1
#endif
#ifndef DBG_CHECK
#define DBG_CHECK 0
#endif
#ifndef EMU8
#define EMU8 false
#endif
#ifndef STG_DN
#define STG_DN 0
#endif
#ifndef STG_GU
#define STG_GU 0
#endif
#ifndef STG_IN
#define STG_IN 0
#endif
#ifndef NLAYERS_RUN
#define NLAYERS_RUN 4
#endif

constexpr int D = 1024, NB = 4, SEQ = 8192, TX = NB * SEQ, LC = 256, TC = NB * LC, TT = TX + TC, DEPTH = 4;
constexpr int IN_DIM = 3328, NEXP = 32;
constexpr int ROWS_MAX = TT * 4 + NEXP * 256;
constexpr float LOG2E = 1.4426950408889634f;
constexpr float QSCALE = 0.125f * LOG2E;
constexpr float EPS = 1e-5f;
constexpr float SOFT_C = 16.0f;

constexpr size_t al256(size_t x) { return (x + 255) & ~(size_t)255; }
constexpr size_t WS_CTL = 0;
constexpr size_t CTL_BYTES = 65536;
constexpr size_t CTL_CNT = 16384;
constexpr size_t WS_MOD = WS_CTL + CTL_BYTES;
constexpr size_t WS_ROPE = WS_MOD + al256((size_t)DEPTH * 5 * 6144 * 4);
constexpr size_t WS_W1 = WS_ROPE + 16384;
constexpr size_t WS_MT = WS_W1 + 256 * 128 * 2;
constexpr size_t WS_WC = WS_MT + (size_t)64 * 256 * 128 * 2;
constexpr size_t WS_RWT = WS_WC + 512 * 256 * 2;
constexpr size_t WS_WIN = WS_RWT + (size_t)DEPTH * 32 * 1024 * 2;
constexpr size_t WS_SWIN = WS_WIN + (size_t)DEPTH * IN_DIM * 1024;
constexpr size_t WS_WFO = WS_SWIN + al256((size_t)DEPTH * IN_DIM * 4);
constexpr size_t WS_WAO = WS_WFO + (size_t)DEPTH * 1024 * 1024 * 2;
constexpr size_t WS_WOUT = WS_WAO + (size_t)DEPTH * 1024 * 512 * 2;
constexpr size_t WS_WGU = WS_WOUT + (size_t)DEPTH * 1024 * 1024 * 2;
constexpr size_t WS_SWGU = WS_WGU + (size_t)DEPTH * 32 * 2048 * 1024;
constexpr size_t WS_WDN = WS_SWGU + (size_t)DEPTH * 32 * 2048 * 4;
constexpr size_t WS_H = WS_WDN + (size_t)DEPTH * 32 * 1024 * 1024 * 2;
constexpr size_t WS_FT = WS_H + (size_t)(TT + 256) * 1024 * 2;
constexpr size_t WS_FCT = WS_FT + (size_t)131072 * 128 * 2;
constexpr size_t WS_Q = WS_FCT + (size_t)2048 * 256 * 2;
constexpr size_t WS_K = WS_Q + (size_t)TT * 512 * 2;
constexpr size_t WS_V = WS_K + (size_t)TT * 128 * 2;
constexpr size_t WS_GF = WS_V + (size_t)TT * 128 * 2;
constexpr size_t WS_GA = WS_GF + (size_t)TT * 1024 * 2;
constexpr size_t WS_T1 = WS_GA + (size_t)TT * 1024 * 2;
constexpr size_t WS_XS = WS_T1 + (size_t)64 * 2048 * 128 * 2;
constexpr size_t WS_AO = WS_XS + (size_t)TT * 1024 * 2;
constexpr size_t WS_YB = WS_AO + (size_t)TT * 512 * 2;
constexpr size_t WS_XW = WS_YB + (size_t)TT * 1024 * 2;
constexpr size_t WS_CW = WS_XW + (size_t)TX * 1024 * 4;
constexpr size_t WS_ACT = WS_CW + (size_t)TC * 1024 * 4;
constexpr size_t WS_YE = WS_ACT + (size_t)ROWS_MAX * 1024 * 2;
constexpr size_t WS_LIST = WS_YE + (size_t)ROWS_MAX * 1024 * 2;
constexpr size_t WS_SLOT = WS_LIST + (size_t)32 * TT * 4;
constexpr size_t WS_GATE = WS_SLOT + (size_t)TT * 4 * 4;
constexpr size_t WS_H8 = WS_GATE + (size_t)TT * 4 * 4;
constexpr size_t WS_LSC = WS_H8 + (size_t)(TT + 256) * 1024;
constexpr size_t WS_SH = WS_LSC + (size_t)32 * TT * 4;
constexpr size_t WS_END = WS_SH + (size_t)(TT + 256) * 4;

constexpr int LDS_STAGE = 131072;
constexpr int LDS_MISC = LDS_STAGE;
constexpr int LDS_ROPE = LDS_MISC + 4096;
constexpr int LDS_BYTES = 163840;

typedef __bf16 bf16v2_t __attribute__((ext_vector_type(2)));
typedef float f32x2_t __attribute__((ext_vector_type(2)));
__device__ __forceinline__ unsigned cvt_pk_bf16(float lo, float hi) { const f32x2_t v = {lo, hi}; const bf16v2_t b = __builtin_convertvector(v, bf16v2_t); return __builtin_bit_cast(unsigned, b); }
__device__ __forceinline__ float q8(float x) { const int p = __builtin_amdgcn_cvt_pk_fp8_f32(x, 0.f, 0, false); return __builtin_amdgcn_cvt_f32_fp8(p, 0); }
__device__ __forceinline__ unsigned pk4_fp8(float a, float b, float c, float d) { int p = __builtin_amdgcn_cvt_pk_fp8_f32(a, b, 0, false); p = __builtin_amdgcn_cvt_pk_fp8_f32(c, d, p, true); return (unsigned)p; }
__device__ __forceinline__ float clamp8(float x) { return __builtin_amdgcn_fmed3f(x, -448.0f, 448.0f); }
__device__ __forceinline__ u32x2 pack8_fp8(const f32x4& v0, const f32x4& v1, float sc) { u32x2 w; w.x = pk4_fp8(clamp8(v0[0] * sc), clamp8(v0[1] * sc), clamp8(v0[2] * sc), clamp8(v0[3] * sc)); w.y = pk4_fp8(clamp8(v1[0] * sc), clamp8(v1[1] * sc), clamp8(v1[2] * sc), clamp8(v1[3] * sc)); return w; }
__device__ __forceinline__ bf16_t f2bf(float f) { return (bf16_t)(cvt_pk_bf16(f, 0.f) & 0xffffu); }
__device__ __forceinline__ float bf_lo(unsigned u) { return __uint_as_float(u << 16); }
__device__ __forceinline__ float bf_hi(unsigned u) { return __uint_as_float(u & 0xffff0000u); }
__device__ __forceinline__ float bf2f(bf16_t b) { return __uint_as_float(((unsigned)b) << 16); }
__device__ __forceinline__ float sigmoidf_(float x) { return __builtin_amdgcn_rcpf(1.0f + __builtin_amdgcn_exp2f(-x * LOG2E)); }
template <int CTRL> __device__ __forceinline__ float dpp_f(float v) { return __builtin_bit_cast(float, __builtin_amdgcn_update_dpp(0, __builtin_bit_cast(int, v), CTRL, 0xf, 0xf, true)); }
template <int CTRL> __device__ __forceinline__ int dpp_i(int v) { return __builtin_amdgcn_update_dpp(0, v, CTRL, 0xf, 0xf, true); }
__device__ __forceinline__ float lane_f(float v, int lane) { return __builtin_bit_cast(float, __builtin_amdgcn_readlane(__builtin_bit_cast(int, v), lane)); }
__device__ __forceinline__ float wave_sum(float v) {
    v += dpp_f<0xB1>(v); v += dpp_f<0x4E>(v); v += dpp_f<0x141>(v); v += dpp_f<0x140>(v);
    return (lane_f(v, 0) + lane_f(v, 16)) + (lane_f(v, 32) + lane_f(v, 48));
}
__device__ __forceinline__ float wave_max(float v) {
    v = fmaxf(v, dpp_f<0xB1>(v)); v = fmaxf(v, dpp_f<0x4E>(v)); v = fmaxf(v, dpp_f<0x141>(v)); v = fmaxf(v, dpp_f<0x140>(v));
    return fmaxf(fmaxf(lane_f(v, 0), lane_f(v, 16)), fmaxf(lane_f(v, 32), lane_f(v, 48)));
}

#define XB_TMO      128
#define XB_XCNT(j)  (256  + 64 * (j))
#define XB_XSUB(j)  (1280 + 64 * (j))
#define XB_XGEN(j)  (2304 + 64 * (j))
#define XB_TOP      3328
#define XB_TOPGEN   3392
#define XCD_BAR_WORDS 3456
#define XB_SPIN_CAP (1u << 22)

__device__ __forceinline__ unsigned xb_ld(unsigned* p)              { return __hip_atomic_load(p, __ATOMIC_RELAXED, __HIP_MEMORY_SCOPE_AGENT); }
__device__ __forceinline__ unsigned xb_add(unsigned* p, unsigned v) { return __hip_atomic_fetch_add(p, v, __ATOMIC_RELAXED, __HIP_MEMORY_SCOPE_AGENT); }
__device__ __forceinline__ unsigned xb_xcc_id() { return (unsigned)__builtin_amdgcn_s_getreg((3 << 11) | 20) & 0xFu; }
#define XB_SPIN(cond, bar) do { unsigned _sp = 0; while (cond) { __builtin_amdgcn_s_sleep(1); \
    if ((++_sp & 255u) == 0u) { if (xb_ld(&(bar)[XB_TMO])) break; if (_sp > XB_SPIN_CAP) { atomicAdd(&(bar)[XB_TMO], 1u); break; } } } } while (0)

struct XcdBarrier { unsigned* bar; unsigned x; volatile LAS unsigned* st; };

__device__ __forceinline__ XcdBarrier xcd_barrier_post(unsigned* bar, volatile LAS unsigned* st) {
    XcdBarrier b; b.bar = bar; b.x = xb_xcc_id(); b.st = st;
    if (threadIdx.x == 0) (void)xb_add(&bar[XB_XCNT(b.x)], 1u);
    return b;
}
__device__ __forceinline__ void xcd_barrier_complete(unsigned* bar, unsigned x, unsigned& nloc, unsigned& nx) {
    const unsigned G = gridDim.x * gridDim.y * gridDim.z;
    unsigned sum, cnt, mine, sp = 0u;
    for (;;) {
        sum = 0u; cnt = 0u; mine = 0u;
#pragma unroll
        for (unsigned j = 0; j < 16; ++j) { const unsigned c = xb_ld(&bar[XB_XCNT(j)]); sum += c; cnt += (c > 0u) ? 1u : 0u; mine = (j == x) ? c : mine; }
        if (sum == G) break;
        __builtin_amdgcn_s_sleep(1);
        if ((++sp & 255u) == 0u) { if (xb_ld(&bar[XB_TMO])) break; if (sp > XB_SPIN_CAP) { atomicAdd(&bar[XB_TMO], 1u); break; } }
    }
    nloc = mine > 0u ? mine : 1u; nx = cnt > 0u ? cnt : 1u;
}
__device__ __forceinline__ void xcd_barrier(const XcdBarrier& b) {
    asm volatile("s_waitcnt vmcnt(0)" ::: "memory");
    __syncthreads();
    if (threadIdx.x == 0) {
        unsigned* bar = b.bar;
        __builtin_amdgcn_s_waitcnt(0);
        unsigned nloc = b.st[0], nx = b.st[1];
        if (nloc == 0u) { xcd_barrier_complete(bar, b.x, nloc, nx); b.st[0] = nloc; b.st[1] = nx; }
        const unsigned old = xb_add(&bar[XB_XSUB(b.x)], 1u);
        const unsigned gen = old / nloc;
        if (old + 1u == (gen + 1u) * nloc) {
            __builtin_amdgcn_fence(__ATOMIC_RELEASE, "agent");
            asm volatile("s_waitcnt vmcnt(0)" ::: "memory");
            const unsigned og = xb_add(&bar[XB_TOP], 1u);
            const unsigned tg = og / nx;
            if (og + 1u == (tg + 1u) * nx) xb_add(&bar[XB_TOPGEN], 1u);
            else XB_SPIN(xb_ld(&bar[XB_TOPGEN]) == tg, bar);
            __builtin_amdgcn_fence(__ATOMIC_ACQUIRE, "agent");
            xb_add(&bar[XB_XGEN(b.x)], 1u);
            asm volatile("s_waitcnt vmcnt(0)" ::: "memory");
        } else {
            XB_SPIN(xb_ld(&bar[XB_XGEN(b.x)]) == gen, bar);
            __builtin_amdgcn_fence(__ATOMIC_ACQUIRE, "agent");
            asm volatile("s_waitcnt vmcnt(0)" ::: "memory");
        }
    }
    __syncthreads();
}

struct Fr {
    LAS unsigned char* lds;
    unsigned char* ws;
    float* out;
    int tid, lane, wave, G, bid;
};
__device__ __forceinline__ const float* in_ptr(const Fr& F, int i) {
    volatile LAS unsigned* p = (volatile LAS unsigned*)(F.lds + 131072 + 512) + 2 * i;
    const unsigned lo = __builtin_amdgcn_readfirstlane(p[0]), hi = __builtin_amdgcn_readfirstlane(p[1]);
    return (const float*)(GAS const float*)(((unsigned long long)hi << 32) | lo);
}
#define INP(i) in_ptr(F, (i))
#define LAUNDER(F) do { GAS unsigned char* _w = (GAS unsigned char*)(F).ws; asm volatile("" : "+s"(_w)); (F).ws = (unsigned char*)_w;     int _t = threadIdx.x; asm volatile("" : "+v"(_t)); (F).tid = _t; (F).lane = _t & 63; (F).wave = __builtin_amdgcn_readfirstlane(_t >> 6); } while (0)
#define WSP(T, off) ((T*)(F.ws + (off)))

namespace g8 {
constexpr int BM = 256, BK = 64, HALF = 128, HTB = HALF * BK * 2, NXCD = 8, WGM = 8;
__device__ __forceinline__ int lds_byte(int r, int c) { const int st = (r >> 4) * 2 + (c >> 5), rr = r & 15, cc = c & 31, ob = rr * 64 + cc * 2; return st * 1024 + (ob ^ (((ob >> 9) & 1) << 5)); }
__device__ __forceinline__ void stage_rc(int b, int& R, int& C) { const int st = b / 1024, sb = b % 1024, swz = sb ^ (((sb >> 9) & 1) << 5); R = (st >> 1) * 16 + swz / 64; C = (st & 1) * 32 + (swz % 64) / 2; }
__device__ __forceinline__ int perm32(int rho) { const int n = rho >> 4, i = rho & 15; return 8 * (i >> 2) + 4 * n + (i & 3); }
template <int NN>
__device__ __forceinline__ void order2d_c(int L, int nM, int& pm, int& pn) {
    const int nwg = nM * NN;
    int wgid = L; { const int q = nwg >> 3, r = nwg & 7, xcd = wgid & 7, off = wgid >> 3; wgid = (xcd < r ? xcd * (q + 1) : r * (q + 1) + (xcd - r) * q) + off; }
    constexpr int nig = WGM * NN; const int gid = wgid / nig, x = wgid - gid * nig, fm = gid * WGM, gsz = (nM - fm) < WGM ? (nM - fm) : WGM;
    if (gsz == WGM) { pm = fm + (x & 7); pn = x >> 3; } else { pm = fm + (x % gsz); pn = x / gsz; }
}
__device__ __forceinline__ void order2d(int L, int nM, int nN, int& pm, int& pn) {
    if (nN == 4) order2d_c<4>(L, nM, pm, pn); else if (nN == 8) order2d_c<8>(L, nM, pm, pn); else order2d_c<11>(L, nM, pm, pn);
}
__device__ __forceinline__ void lane_geom(int tid, int& R0, int& Rb0, int& C0) { asm volatile("" : "+v"(tid)); stage_rc(tid * 16, R0, C0); Rb0 = (R0 & ~31) + perm32(R0 & 31); }

__device__ __forceinline__ void lane_geom_w(int tid, int& R0, int& Rbw, int& C0) { asm volatile("" : "+v"(tid)); stage_rc(tid * 16, R0, C0); const int i = R0 & 31; Rbw = 64 * (R0 >> 5) + 16 * ((i >> 2) & 3) + 4 * (i >> 4) + (i & 3); }
#define G8_DBW(j) (128 * ((j) & 1) + 8 * ((j) >> 1))
#define G8_COLW(bj) (64 * wc + 16 * fq + 8 * (bj))
#define G8_ROWS(ai, m) (128 * (ai) + 64 * wr + 16 * (m) + fr)
#define G8_COL0(bj) (128 * (bj) + 32 * wc + 8 * fq)
#define G8_GOFF(pm, pn4, ai, m) (((size_t)((pm) * 4 + (pn4)) * 8 + (wr * 4 + wc)) * 8192 + ((ai) * 4 + (m)) * 1024 + (fq * 16 + fr) * 16)

template <bool I8> __device__ __forceinline__ f32x4 mma1(const bf16x8& b, const bf16x8& a, const f32x4& c) { return __builtin_amdgcn_mfma_f32_16x16x32_bf16(b, a, c, 0, 0, 0); }
template <bool I8> __device__ __forceinline__ i32x4 mma1(const bf16x8& b, const bf16x8& a, const i32x4& c) { return __builtin_amdgcn_mfma_i32_16x16x64_i8(__builtin_bit_cast(i32x4, b), __builtin_bit_cast(i32x4, a), c, 0, 0, 0); }
__device__ __forceinline__ f32x4 mma8(const bf16x8& b0, const bf16x8& b1, const bf16x8& a0, const bf16x8& a1, const f32x4& c) {
    const i32x4 B0 = __builtin_bit_cast(i32x4, b0), B1 = __builtin_bit_cast(i32x4, b1), A0 = __builtin_bit_cast(i32x4, a0), A1 = __builtin_bit_cast(i32x4, a1);
    const i32x8 B = {B0[0], B0[1], B0[2], B0[3], B1[0], B1[1], B1[2], B1[3]}, A = {A0[0], A0[1], A0[2], A0[3], A1[0], A1[1], A1[2], A1[3]};
    return __builtin_amdgcn_mfma_scale_f32_16x16x128_f8f6f4(B, A, c, 0, 0, 0, 0x7F7F7F7F, 0, 0x7F7F7F7F);
}
template <class P>
__device__ __forceinline__ void gemm_run(LAS unsigned char* lds, P& prob, int stagger = 0) {
    if (stagger > 0) { const unsigned long long t0 = __builtin_amdgcn_s_memrealtime(); while ((int)(__builtin_amdgcn_s_memrealtime() - t0) < stagger) __builtin_amdgcn_s_sleep(16); }
    int tid = threadIdx.x; asm volatile("" : "+v"(tid));
    const int wid = __builtin_amdgcn_readfirstlane(tid >> 6), lane = tid & 63, wr = wid >> 2, wc = wid & 3, fr = lane & 15, fq = lane >> 4;
    const size_t kstep = (size_t)(BK * 2);
    const unsigned ldsw = (unsigned)wid * 1024u;
    const int aoff = lds_byte(wr * 64 + fr, fq * 8), boff = lds_byte(wc * 32 + fr, fq * 8);
#define G8_SA(b, h) (((b) * 2 + (h)) * HTB)
#define G8_SB(b, h) ((4 + (b) * 2 + (h)) * HTB)
#define G8_STAGE_(bufoff, g0, o0, g1, o1) do { \
        __builtin_amdgcn_global_load_lds((const unsigned*)((const char*)(g0) + (o0)), (LAS unsigned*)(lds + (bufoff) + ldsw), 16, 0, 0); \
        __builtin_amdgcn_global_load_lds((const unsigned*)((const char*)(g1) + (o1)), (LAS unsigned*)(lds + (bufoff) + ldsw + 8192), 16, 0, 0); } while (0)
#define G8_OA(j) (P::GATHER_A ? oa[j] : oa[0])
#define G8_STA(bufoff, gbase, h) G8_STAGE_(bufoff, (gbase) + dA[2 * (h)], G8_OA(2 * (h)), (gbase) + dA[2 * (h) + 1], G8_OA(2 * (h) + 1))
#define G8_STB(bufoff, gbase, h) G8_STAGE_(bufoff, (gbase) + dB[2 * (h)], ob, (gbase) + dB[2 * (h) + 1], ob)
#define G8_LDA(dst, b, h) do { _Pragma("unroll") for (int m = 0; m < 4; ++m) _Pragma("unroll") for (int k = 0; k < 2; ++k) dst[m][k] = *(const LAS bf16x8*)(lds + G8_SA(b, h) + aoff + m * 2048 + k * 1024); } while (0)
#define G8_LDB(dst, b, h) do { _Pragma("unroll") for (int n = 0; n < 2; ++n) _Pragma("unroll") for (int k = 0; k < 2; ++k) dst[n][k] = *(const LAS bf16x8*)(lds + G8_SB(b, h) + boff + n * 2048 + k * 1024); } while (0)
#define G8_MMA(ai, bj, At, Bt) do { __builtin_amdgcn_s_setprio(1); \
        if constexpr (P::F8) { _Pragma("unroll") for (int m = 0; m < 4; ++m) _Pragma("unroll") for (int n = 0; n < 2; ++n) acc[ai][bj][m][n] = mma8(Bt[n][0], Bt[n][1], At[m][0], At[m][1], acc[ai][bj][m][n]); } \
        else { _Pragma("unroll") for (int m = 0; m < 4; ++m) _Pragma("unroll") for (int n = 0; n < 2; ++n) _Pragma("unroll") for (int k = 0; k < 2; ++k) \
        acc[ai][bj][m][n] = mma1<P::I8>(Bt[n][k], At[m][k], acc[ai][bj][m][n]); } __builtin_amdgcn_s_setprio(0); } while (0)
#define G8_WAIT_V(n) asm volatile("s_waitcnt vmcnt(" #n ")" ::: "memory")
#define G8_WAIT_L(n) asm volatile("s_waitcnt lgkmcnt(" #n ")" ::: "memory")
#define G8_BAR __builtin_amdgcn_s_barrier()
#define G8_SCHED __builtin_amdgcn_sched_barrier(0)
    typename P::U cur, nxt; int ui = 0;
    if (!prob.get(0, cur)) return;
    typedef typename P::Acc Acc;
    Acc acc[2][2][4][2];
#pragma unroll
    for (int a = 0; a < 2; ++a)
#pragma unroll
        for (int b = 0; b < 2; ++b)
#pragma unroll
            for (int m = 0; m < 4; ++m)
#pragma unroll
                for (int n = 0; n < 2; ++n) acc[a][b][m][n] = (Acc){0, 0, 0, 0};
    bf16x8 At[4][2], B0[2][2], B1[2][2];
    unsigned oa[4], ob, dA[4], dB[4]; const char* cA; const char* cB; int nt;
    prob.setup(cur, oa, ob, dA, dB, cA, cB, nt);
    G8_STB(G8_SB(0, 0), cB, 0); G8_STA(G8_SA(0, 0), cA, 0); G8_STB(G8_SB(0, 1), cB, 1); G8_STA(G8_SA(0, 1), cA, 1);
    if (wr == 1) G8_BAR;
    G8_WAIT_V(4); G8_BAR;
    G8_STB(G8_SB(1, 0), cB + kstep, 0); G8_STA(G8_SA(1, 0), cA + kstep, 0); G8_STB(G8_SB(1, 1), cB + kstep, 1);
    G8_WAIT_V(6); G8_BAR;
    for (;;) {
        const bool has_next = prob.get(ui + 1, nxt);
        int nnt = nt;
#pragma unroll 1
        for (int t = 0; t < nt; t += 2) {
            const bool last = (t == nt - 2);
            G8_LDB(B0, 0, 0); G8_SCHED; G8_LDA(At, 0, 0); G8_STA(G8_SA(1, 1), cA + (size_t)(t + 1) * kstep, 1);
            G8_WAIT_L(8); G8_BAR; G8_WAIT_L(0); G8_MMA(0, 0, At, B0); G8_BAR; G8_SCHED;
            const char* a2; const char* b2;
            if (last) { if (has_next) { prob.setup(nxt, oa, ob, dA, dB, cA, cB, nnt); } a2 = cA; b2 = cB; }
            else { a2 = cA + (size_t)(t + 2) * kstep; b2 = cB + (size_t)(t + 2) * kstep; }
            const char* a3 = a2 + kstep; const char* b3 = b2 + kstep;
            G8_LDB(B1, 0, 1); G8_STB(G8_SB(0, 0), b2, 0);
            G8_BAR; G8_WAIT_L(0); G8_MMA(0, 1, At, B1); G8_BAR;
            G8_LDA(At, 0, 1); G8_STA(G8_SA(0, 0), a2, 0);
            G8_BAR; G8_WAIT_L(0); G8_MMA(1, 0, At, B0); G8_BAR; G8_SCHED;
            G8_STB(G8_SB(0, 1), b2, 1);
            G8_WAIT_V(6); G8_BAR; G8_MMA(1, 1, At, B1); G8_BAR;
            G8_LDB(B0, 1, 0); G8_SCHED; G8_LDA(At, 1, 0); G8_STA(G8_SA(0, 1), a2, 1);
            G8_WAIT_L(8); G8_BAR; G8_WAIT_L(0); G8_MMA(0, 0, At, B0); G8_BAR; G8_SCHED;
            G8_LDB(B1, 1, 1); G8_STB(G8_SB(1, 0), b3, 0);
            G8_BAR; G8_WAIT_L(0); G8_MMA(0, 1, At, B1); G8_BAR;
            G8_LDA(At, 1, 1); G8_STA(G8_SA(1, 0), a3, 0);
            G8_BAR; G8_WAIT_L(0); G8_MMA(1, 0, At, B0); G8_BAR; G8_SCHED;
            G8_STB(G8_SB(1, 1), b3, 1);
            G8_WAIT_V(6); G8_BAR; G8_MMA(1, 1, At, B1); G8_BAR;
            if (last) break;
        }
        bool keep = false;
        { int t2 = threadIdx.x; asm volatile("" : "+v"(t2)); const int l2 = t2 & 63;
          if constexpr (P::HAS_MID) { if (prob.is_mid(cur)) { prob.mid(acc, cur, wr, wc, l2 & 15, l2 >> 4); keep = true; } else prob.epi(acc, cur, wr, wc, l2 & 15, l2 >> 4); }
          else prob.epi(acc, cur, wr, wc, l2 & 15, l2 >> 4); }
        if (!has_next) break;
        if (!keep)
#pragma unroll
        for (int a = 0; a < 2; ++a)
#pragma unroll
            for (int b = 0; b < 2; ++b)
#pragma unroll
                for (int m = 0; m < 4; ++m)
#pragma unroll
                    for (int n = 0; n < 2; ++n) acc[a][b][m][n] = (Acc){0, 0, 0, 0};
        cur = nxt; nt = nnt; ++ui;
    }
    G8_WAIT_V(0);
    if (wr == 0) G8_BAR;
    G8_BAR;
}
}

__device__ __forceinline__ u32x4 pack8(const f32x4& v0, const f32x4& v1) {
    u32x4 w; w.x = cvt_pk_bf16(v0[0], v0[1]); w.y = cvt_pk_bf16(v0[2], v0[3]); w.z = cvt_pk_bf16(v1[0], v1[1]); w.w = cvt_pk_bf16(v1[2], v1[3]); return w;
}
__device__ __forceinline__ void unpack8(const u32x4& w, f32x4& v0, f32x4& v1) {
    v0 = (f32x4){bf_lo(w.x), bf_hi(w.x), bf_lo(w.y), bf_hi(w.y)}; v1 = (f32x4){bf_lo(w.z), bf_hi(w.z), bf_lo(w.w), bf_hi(w.w)};
}

__device__ __forceinline__ void unpack8u(const u32x2& w, f32x4& v0, f32x4& v1) {
    const float k = 1.0f / 255.0f;
    v0 = (f32x4){(float)(w.x & 255u) * k, (float)((w.x >> 8) & 255u) * k, (float)((w.x >> 16) & 255u) * k, (float)(w.x >> 24) * k};
    v1 = (f32x4){(float)(w.y & 255u) * k, (float)((w.y >> 8) & 255u) * k, (float)((w.y >> 16) & 255u) * k, (float)(w.y >> 24) * k};
}
template <int WHICH> struct InProjProb {
    static constexpr bool PERM = true, GATHER_A = false, I8 = true, F8 = false, HAS_MID = false; typedef i32x4 Acc;
    struct U { int kind, pm, pn, b, j; };
    const signed char* H; const signed char* W; const float* sH; const float* sW;
    bf16_t *FT, *FCT, *Q, *Kb, *Vb, *GF, *GA; const LAS float* rope;
    int nM, n_nat, n_fx, n_fc, n_extra, G, c;
    __device__ __forceinline__ bool get(int i, U& u) const {
        const int L = i * G + c;
        if (WHICH == 0) {
            if (L >= n_nat + n_extra) return false;
            const bool nat = L < n_nat;
            int pm, pn; g8::order2d(nat ? L : 0, nM, 11, pm, pn);
            u.kind = 2; u.pm = __builtin_amdgcn_readfirstlane(nat ? pm : (128 + L - n_nat)); u.pn = __builtin_amdgcn_readfirstlane(nat ? (pn + 2) : 4); u.b = 0; u.j = 0;
            return true;
        } else {
            if (L >= n_fx + n_fc) return false;
            const bool fx = L < n_fx; const int L2 = L - n_fx;
            u.kind = __builtin_amdgcn_readfirstlane(fx ? 0 : 1); u.b = __builtin_amdgcn_readfirstlane(fx ? (L >> 6) : (L2 >> 1)); u.j = __builtin_amdgcn_readfirstlane(fx ? ((L & 63) >> 1) : 0); u.pn = __builtin_amdgcn_readfirstlane(fx ? (L & 1) : (L2 & 1)); u.pm = 0;
            return true;
        }
    }
    __device__ __forceinline__ void setup(const U& u, unsigned (&oa)[4], unsigned& ob, unsigned (&dA)[4], unsigned (&dB)[4], const char*& pA, const char*& pB, int& nt) const {
        int R0, Rb0, C0; g8::lane_geom(threadIdx.x, R0, Rb0, C0);
        nt = 8;
#pragma unroll
        for (int j = 0; j < 4; ++j) { dA[j] = (unsigned)(64 * j * 1024); dB[j] = dA[j]; }
        if (WHICH == 0) {
            pA = (const char*)H; pB = (const char*)W;
            oa[0] = (unsigned)((256 * u.pm + R0) * 1024 + C0 * 2); ob = (unsigned)((256 * u.pn + Rb0) * 1024 + C0 * 2);
        } else {
            pA = (const char*)W; pB = (const char*)H;
            oa[0] = (unsigned)((256 * u.pn + R0) * 1024 + C0 * 2);
            if (u.kind == 0) { ob = (unsigned)((u.b * SEQ + 64 * Rb0 + 2 * u.j) * 1024 + C0 * 2);
                dB[1] = (unsigned)(64 * 64 * 1024); dB[2] = 1024u; dB[3] = dB[1] + 1024u; }
            else ob = (unsigned)((TX + u.b * LC + Rb0) * 1024 + C0 * 2);
        }
    }
    __device__ __forceinline__ void epi(const i32x4 (&acc)[2][2][4][2], const U& u, int wr, int wc, int fr, int fq) const {
        if (WHICH == 0) {
            f32x4 sw[2][2];
#pragma unroll
            for (int bj = 0; bj < 2; ++bj) { const float* sp = sW + 256 * u.pn + G8_COL0(bj); sw[bj][0] = *(const f32x4*)sp; sw[bj][1] = *(const f32x4*)(sp + 4); }
            float rsv[2][4];
#pragma unroll
            for (int ai = 0; ai < 2; ++ai)
#pragma unroll
                for (int m = 0; m < 4; ++m) rsv[ai][m] = sH[256 * u.pm + G8_ROWS(ai, m)];
            if (u.pn >= 5) {
                unsigned char* dst = (unsigned char*)((u.pn >= 9) ? GA : GF); const int cb = (u.pn >= 9) ? u.pn - 9 : u.pn - 5;
                f32x2_t fc[2][4];
#pragma unroll
                for (int bj = 0; bj < 2; ++bj)
#pragma unroll
                    for (int q = 0; q < 4; ++q) fc[bj][q] = (f32x2_t){sw[bj][q >> 1][2 * (q & 1)], sw[bj][q >> 1][2 * (q & 1) + 1]} * (-LOG2E);
#pragma unroll
                for (int ai = 0; ai < 2; ++ai)
#pragma unroll
                    for (int m = 0; m < 4; ++m) { const f32x2_t rs2 = {rsv[ai][m], rsv[ai][m]}; u32x4 w4;
#pragma unroll
                        for (int bj = 0; bj < 2; ++bj) { u32x2 w = {0u, 0u};
#pragma unroll
                            for (int q = 0; q < 4; ++q) { const int n = q >> 1, e0 = 2 * (q & 1);
                                const f32x2_t a = {(float)acc[ai][bj][m][n][e0], (float)acc[ai][bj][m][n][e0 + 1]};
                                const f32x2_t t = a * (rs2 * fc[bj][q]);
                                const f32x2_t d = (f32x2_t){__builtin_amdgcn_exp2f(t[0]), __builtin_amdgcn_exp2f(t[1])} + 1.0f;
                                const f32x2_t g = (f32x2_t){__builtin_amdgcn_rcpf(d[0]), __builtin_amdgcn_rcpf(d[1])} * 255.0f;
                                if (n == 0) { w.x = __builtin_amdgcn_cvt_pk_u8_f32(g[0], e0, w.x); w.x = __builtin_amdgcn_cvt_pk_u8_f32(g[1], e0 + 1, w.x); }
                                else        { w.y = __builtin_amdgcn_cvt_pk_u8_f32(g[0], e0, w.y); w.y = __builtin_amdgcn_cvt_pk_u8_f32(g[1], e0 + 1, w.y); } }
                            if (bj == 0) { w4.x = w.x; w4.y = w.y; } else { w4.z = w.x; w4.w = w.y; } }
                        *(u32x4*)(dst + G8_GOFF(u.pm, cb, ai, m)) = w4; }
            } else {
#pragma unroll
                for (int ai = 0; ai < 2; ++ai)
#pragma unroll
                    for (int m = 0; m < 4; ++m) { const int tok = 256 * u.pm + G8_ROWS(ai, m); const float rs = rsv[ai][m];
                        const bool isx = tok < TX; const int n = tok & (SEQ - 1); const int prow = n >> 6, pcol = n & 63;
#pragma unroll
                        for (int bj = 0; bj < 2; ++bj) { f32x4 v0, v1;
#pragma unroll
                            for (int e = 0; e < 4; ++e) { v0[e] = (float)acc[ai][bj][m][0][e] * rs * sw[bj][0][e]; v1[e] = (float)acc[ai][bj][m][1][e] * rs * sw[bj][1][e]; }
                            const int c0 = G8_COL0(bj);
                            const bool isv = (u.pn == 4) && (bj == 1);
                            if (!isv) {
                                const int dp = c0 & 63; const int axis = dp >> 5, f0 = (dp & 31) >> 1;
                                if (isx) {
                                    const int pos = axis ? pcol : prow;
                                    const f32x4 cs = *(const LAS f32x4*)(rope + pos * 16 + f0), sn = *(const LAS f32x4*)(rope + 2048 + pos * 16 + f0);
                                    f32x4 r0, r1;
                                    r0[0] = v0[0] * cs[0] - v0[1] * sn[0]; r0[1] = v0[1] * cs[0] + v0[0] * sn[0];
                                    r0[2] = v0[2] * cs[1] - v0[3] * sn[1]; r0[3] = v0[3] * cs[1] + v0[2] * sn[1];
                                    r1[0] = v1[0] * cs[2] - v1[1] * sn[2]; r1[1] = v1[1] * cs[2] + v1[0] * sn[2];
                                    r1[2] = v1[2] * cs[3] - v1[3] * sn[3]; r1[3] = v1[3] * cs[3] + v1[2] * sn[3];
                                    v0 = r0; v1 = r1;
                                }
                            }
                            if (u.pn < 4) { v0 *= QSCALE; v1 *= QSCALE; *(u32x4*)(Q + (size_t)tok * 512 + 256 * (u.pn - 2) + c0) = pack8(v0, v1); }
                            else if (!isv) { *(u32x4*)(Kb + (size_t)tok * 128 + c0) = pack8(v0, v1); }
                            else { *(u32x4*)(Vb + (size_t)tok * 128 + (c0 - 128)) = pack8(v0, v1); }
                        } }
            }
        } else {
            f32x4 st[2][2];
#pragma unroll
            for (int bj = 0; bj < 2; ++bj) { const int c0 = G8_COL0(bj);
                if (u.kind == 0) { const float* tp = sH + (size_t)u.b * SEQ + 64 * (c0 & 127) + 2 * u.j + (c0 >> 7);
#pragma unroll
                    for (int e = 0; e < 4; ++e) { st[bj][0][e] = tp[64 * e]; st[bj][1][e] = tp[64 * (4 + e)]; } }
                else { const float* tp = sH + TX + u.b * LC + c0; st[bj][0] = *(const f32x4*)tp; st[bj][1] = *(const f32x4*)(tp + 4); } }
            float rsw[2][4];
#pragma unroll
            for (int ai = 0; ai < 2; ++ai)
#pragma unroll
                for (int m = 0; m < 4; ++m) rsw[ai][m] = sW[256 * u.pn + G8_ROWS(ai, m)];
#pragma unroll
            for (int ai = 0; ai < 2; ++ai)
#pragma unroll
                for (int m = 0; m < 4; ++m) { const int ch = 256 * u.pn + G8_ROWS(ai, m); const float rs = rsw[ai][m];
#pragma unroll
                    for (int bj = 0; bj < 2; ++bj) { const int c0 = G8_COL0(bj); f32x4 v0, v1;
#pragma unroll
                        for (int e = 0; e < 4; ++e) { v0[e] = (float)acc[ai][bj][m][0][e] * rs * st[bj][0][e]; v1[e] = (float)acc[ai][bj][m][1][e] * rs * st[bj][1][e]; }
                        const u32x4 w = pack8(v0, v1);
                        if (u.kind == 0) { const int n2 = 2 * u.j + (c0 >> 7), n1 = c0 & 127; *(u32x4*)(FT + ((size_t)(u.b * 512 + ch) * 64 + n2) * 128 + n1) = w; }
                        else *(u32x4*)(FCT + (size_t)(u.b * 512 + ch) * 256 + c0) = w;
                    } }
        }
    }
};

struct Fft1Prob {
    static constexpr bool PERM = true, GATHER_A = false, I8 = false, F8 = false, HAS_MID = false; typedef f32x4 Acc;
    struct U { int kind, pm, pn; };
    const bf16_t *W1, *FT, *WC, *FCT; bf16_t* T1; unsigned char* XS;
    int n0, n1, G, c;
    __device__ __forceinline__ bool get(int i, U& u) const {
        const int L = i * G + c;
        if (L >= n0 + n1) return false;
        const bool k0 = L < n0; const int L2 = L - n0;
        u.kind = __builtin_amdgcn_readfirstlane(k0 ? 0 : 1); u.pm = __builtin_amdgcn_readfirstlane(k0 ? 0 : (L2 & 1)); u.pn = __builtin_amdgcn_readfirstlane(k0 ? L : (L2 >> 1));
        return true;
    }
    __device__ __forceinline__ void setup(const U& u, unsigned (&oa)[4], unsigned& ob, unsigned (&dA)[4], unsigned (&dB)[4], const char*& pA, const char*& pB, int& nt) const {
        int R0, Rb0, C0; g8::lane_geom(threadIdx.x, R0, Rb0, C0);
        if (u.kind == 0) { nt = 2; pA = (const char*)W1; pB = (const char*)FT;
#pragma unroll
            for (int j = 0; j < 4; ++j) { dA[j] = (unsigned)(64 * j * 128) * 2u; dB[j] = dA[j]; }
            oa[0] = (unsigned)(R0 * 128 + C0) * 2u; ob = (unsigned)((256 * u.pn + Rb0) * 128 + C0) * 2u;
        } else { nt = 4; pA = (const char*)WC; pB = (const char*)FCT;
#pragma unroll
            for (int j = 0; j < 4; ++j) { dA[j] = (unsigned)(64 * j * 256) * 2u; dB[j] = dA[j]; }
            oa[0] = (unsigned)((256 * u.pm + R0) * 256 + C0) * 2u; ob = (unsigned)((256 * u.pn + Rb0) * 256 + C0) * 2u;
        }
    }
    __device__ __forceinline__ void epi(const f32x4 (&acc)[2][2][4][2], const U& u, int wr, int wc, int fr, int fq) const {
        if (u.kind == 0) {
#pragma unroll
            for (int m = 0; m < 4; ++m) { const int r = G8_ROWS(0, m); const int k1p = r >> 1, part = r & 1;
#pragma unroll
                for (int bj = 0; bj < 2; ++bj) { const int col = 256 * u.pn + G8_COL0(bj); const int bc = col >> 6, n2 = col & 63;
                    *(u32x4*)(T1 + (((size_t)k1p * 2048 + bc) * 2 + part) * 64 + n2) = pack8(acc[0][bj][m][0], acc[0][bj][m][1]); } }
        } else {
#pragma unroll
            for (int ai = 0; ai < 2; ++ai)
#pragma unroll
                for (int m = 0; m < 4; ++m) { const int r = 256 * u.pm + G8_ROWS(ai, m); const int k = r >> 1, reim = r & 1;
#pragma unroll
                    for (int bj = 0; bj < 2; ++bj) { const int bc = 256 * u.pn + G8_COL0(bj); const int b = bc >> 9, ch = bc & 511, g = ch >> 7, d = ch & 127;
                        *(u32x2*)(XS + (size_t)(TX + b * LC + k) * 1024 + g * 256 + reim * 128 + d) = pack8_fp8(acc[ai][bj][m][0], acc[ai][bj][m][1], 0.0625f); } }
        }
    }
};

struct Fft2Prob {
    static constexpr bool PERM = true, GATHER_A = false, I8 = false, F8 = false, HAS_MID = false; typedef f32x4 Acc;
    struct U { int k1p, pn; };
    const bf16_t *MT, *T1; unsigned char* XS; int G, c;
    __device__ __forceinline__ bool get(int i, U& u) const { const int L = i * G + c; if (c < 0 || L >= 512) return false; u.k1p = __builtin_amdgcn_readfirstlane(L >> 3); u.pn = __builtin_amdgcn_readfirstlane(L & 7); return true; }
    __device__ __forceinline__ void setup(const U& u, unsigned (&oa)[4], unsigned& ob, unsigned (&dA)[4], unsigned (&dB)[4], const char*& pA, const char*& pB, int& nt) const {
        int R0, Rb0, C0; g8::lane_geom_w(threadIdx.x, R0, Rb0, C0);
        nt = 2; pA = (const char*)MT; pB = (const char*)T1;
#pragma unroll
        for (int j = 0; j < 4; ++j) { dA[j] = (unsigned)(64 * j * 128) * 2u; dB[j] = (unsigned)(G8_DBW(j) * 128) * 2u; }
        oa[0] = (unsigned)((u.k1p * 256 + R0) * 128 + C0) * 2u; ob = (unsigned)((u.k1p * 2048 + 256 * u.pn + Rb0) * 128 + C0) * 2u;
    }
    __device__ __forceinline__ void epi(const f32x4 (&acc)[2][2][4][2], const U& u, int wr, int wc, int fr, int fq) const {
#pragma unroll
        for (int ai = 0; ai < 2; ++ai)
#pragma unroll
            for (int m = 0; m < 4; ++m) { const int r = G8_ROWS(ai, m); const int s = r >> 7, k2 = (r & 127) >> 1, reim = r & 1;
                const int kb = (u.k1p == 0) ? 64 * s : (s ? 128 - u.k1p : u.k1p); const int k = kb + 128 * k2;
                const int bc = 256 * u.pn + G8_COLW(0); const int b = bc >> 9, ch = bc & 511, g = ch >> 7, d = ch & 127;
                const u32x2 w0 = pack8_fp8(acc[ai][0][m][0], acc[ai][0][m][1], 0.0625f), w1 = pack8_fp8(acc[ai][1][m][0], acc[ai][1][m][1], 0.0625f);
                *(u32x4*)(XS + (size_t)(b * SEQ + k) * 1024 + g * 256 + reim * 128 + d) = (u32x4){w0.x, w0.y, w1.x, w1.y}; }
    }
};

template <int MODE> struct MergeProb {
    static constexpr bool PERM = true, GATHER_A = false, I8 = false, F8 = true, HAS_MID = false; typedef f32x4 Acc;
    struct U { int pm, pn; };
    const unsigned char* A; const unsigned char* W; int lda;
    const unsigned char* GATE; bf16_t* T; unsigned char* Y8;
    const float* xin; const float* cin; bf16_t* XWb; bf16_t* CWb; const float* g1x; const float* g1c; bool in32;
    int nM, G, c;
    __device__ __forceinline__ bool get(int i, U& u) const { const int L = i * G + c; if (L >= nM * 4) return false; int pm, pn; g8::order2d(L, nM, 4, pm, pn); u.pm = __builtin_amdgcn_readfirstlane(pm); u.pn = __builtin_amdgcn_readfirstlane(pn); return true; }
    __device__ __forceinline__ void setup(const U& u, unsigned (&oa)[4], unsigned& ob, unsigned (&dA)[4], unsigned (&dB)[4], const char*& pA, const char*& pB, int& nt) const {
        int R0, Rb0, C0; g8::lane_geom(threadIdx.x, R0, Rb0, C0);
        nt = lda >> 7; pA = (const char*)A; pB = (const char*)W;
#pragma unroll
        for (int j = 0; j < 4; ++j) { dA[j] = (unsigned)(64 * j * lda); dB[j] = dA[j]; }
        oa[0] = (unsigned)((256 * u.pm + R0) * lda + C0 * 2); ob = (unsigned)((256 * u.pn + Rb0) * lda + C0 * 2);
    }
    __device__ __forceinline__ void epi(const f32x4 (&acc)[2][2][4][2], const U& u, int wr, int wc, int fr, int fq) const {
        if (MODE == 0) {
#pragma unroll
            for (int ai = 0; ai < 2; ++ai) {
                u32x2 gt[4][2];
#pragma unroll
                for (int m = 0; m < 4; ++m)
#pragma unroll
                    for (int bj = 0; bj < 2; ++bj) gt[m][bj] = *(const u32x2*)(GATE + (size_t)(256 * u.pm + G8_ROWS(ai, m)) * 1024 + 256 * u.pn + G8_COL0(bj));
#pragma unroll
                for (int m = 0; m < 4; ++m)
#pragma unroll
                    for (int bj = 0; bj < 2; ++bj) { f32x4 g0, g1; unpack8u(gt[m][bj], g0, g1);
                        *(u32x4*)(T + (size_t)(256 * u.pm + G8_ROWS(ai, m)) * 1024 + 256 * u.pn + G8_COL0(bj)) = pack8(acc[ai][bj][m][0] * g0 * (1.0f / 512.0f), acc[ai][bj][m][1] * g1 * (1.0f / 512.0f)); }
            }
        } else if (MODE == 1) {
#pragma unroll
            for (int ai = 0; ai < 2; ++ai)
#pragma unroll
                for (int m = 0; m < 4; ++m) {
                    u32x2 gt[2]; u32x4 tt[2];
#pragma unroll
                    for (int bj = 0; bj < 2; ++bj) { const size_t o = (size_t)(256 * u.pm + G8_ROWS(ai, m)) * 1024 + 256 * u.pn + G8_COL0(bj); gt[bj] = *(const u32x2*)(GATE + o); tt[bj] = *(const u32x4*)(T + o); }
#pragma unroll
                    for (int bj = 0; bj < 2; ++bj) { const size_t o = (size_t)(256 * u.pm + G8_ROWS(ai, m)) * 1024 + 256 * u.pn + G8_COL0(bj);
                        f32x4 g0, g1, t0, t1; unpack8u(gt[bj], g0, g1); unpack8(tt[bj], t0, t1);
                        *(u32x2*)(Y8 + o) = pack8_fp8(acc[ai][bj][m][0] * g0 * (1.0f / 512.0f) + t0, acc[ai][bj][m][1] * g1 * (1.0f / 512.0f) + t1, 2.0f); }
                }
        } else {
            f32x4 gv[2][2];
            const bool isx = (256 * u.pm) < TX;
            { const float* gp = isx ? (g1x + ((256 * u.pm) >> 13) * 6144) : g1c;
#pragma unroll
              for (int bj = 0; bj < 2; ++bj) { gv[bj][0] = *(const f32x4*)(gp + 256 * u.pn + G8_COL0(bj)) * (1.0f / 64.0f); gv[bj][1] = *(const f32x4*)(gp + 256 * u.pn + G8_COL0(bj) + 4) * (1.0f / 64.0f); } }
            const size_t rbase = isx ? 0 : (size_t)TX;
            bf16_t* ob = isx ? XWb : CWb;
            if (in32) {
                const float* xb = isx ? xin : cin;
#pragma unroll
                for (int ai = 0; ai < 2; ++ai) {
                    f32x4 xv[4][2][2];
#pragma unroll
                    for (int m = 0; m < 4; ++m)
#pragma unroll
                        for (int bj = 0; bj < 2; ++bj) { const float* xp = xb + ((size_t)(256 * u.pm + G8_ROWS(ai, m)) - rbase) * 1024 + 256 * u.pn + G8_COL0(bj); xv[m][bj][0] = *(const f32x4*)xp; xv[m][bj][1] = *(const f32x4*)(xp + 4); }
#pragma unroll
                    for (int m = 0; m < 4; ++m)
#pragma unroll
                        for (int bj = 0; bj < 2; ++bj) { bf16_t* op = ob + ((size_t)(256 * u.pm + G8_ROWS(ai, m)) - rbase) * 1024 + 256 * u.pn + G8_COL0(bj);
                            *(u32x4*)op = pack8(xv[m][bj][0] + gv[bj][0] * acc[ai][bj][m][0], xv[m][bj][1] + gv[bj][1] * acc[ai][bj][m][1]); }
                }
            } else {
                u32x4 xw2[2][4][2];
#pragma unroll
                for (int ai = 0; ai < 2; ++ai)
#pragma unroll
                    for (int m = 0; m < 4; ++m)
#pragma unroll
                        for (int bj = 0; bj < 2; ++bj) xw2[ai][m][bj] = *(const u32x4*)(ob + ((size_t)(256 * u.pm + G8_ROWS(ai, m)) - rbase) * 1024 + 256 * u.pn + G8_COL0(bj));
#pragma unroll
                for (int ai = 0; ai < 2; ++ai)
#pragma unroll
                    for (int m = 0; m < 4; ++m)
#pragma unroll
                        for (int bj = 0; bj < 2; ++bj) { bf16_t* op = ob + ((size_t)(256 * u.pm + G8_ROWS(ai, m)) - rbase) * 1024 + 256 * u.pn + G8_COL0(bj);
                            f32x4 x0, x1; unpack8(xw2[ai][m][bj], x0, x1);
                            *(u32x4*)op = pack8(x0 + gv[bj][0] * acc[ai][bj][m][0], x1 + gv[bj][1] * acc[ai][bj][m][1]); }
            }
        }
    }
};

struct Merge1Prob {
    static constexpr bool PERM = true, GATHER_A = false, I8 = false, F8 = true, HAS_MID = true; typedef f32x4 Acc;
    struct U { int pm, pn, seg; };
    const unsigned char *XS, *AO, *WFO, *WAO, *GF, *GA; unsigned char* Y8; int nM, pm0, G, c;
    __device__ __forceinline__ bool get(int i, U& u) const { const int L = (i >> 1) * G + c; if (c < 0 || L >= nM * 4) return false; int pm, pn; g8::order2d(L, nM, 4, pm, pn);
        u.pm = __builtin_amdgcn_readfirstlane(pm + pm0); u.pn = __builtin_amdgcn_readfirstlane(pn); u.seg = i & 1; return true; }
    __device__ __forceinline__ bool is_mid(const U& u) const { return u.seg == 0; }
    __device__ __forceinline__ void setup(const U& u, unsigned (&oa)[4], unsigned& ob, unsigned (&dA)[4], unsigned (&dB)[4], const char*& pA, const char*& pB, int& nt) const {
        int R0, Rb0, C0; g8::lane_geom(threadIdx.x, R0, Rb0, C0);
        const int lda = u.seg ? 1024 : 512;
        nt = lda >> 7; pA = (const char*)(u.seg ? XS : AO); pB = (const char*)(u.seg ? WFO : WAO);
#pragma unroll
        for (int j = 0; j < 4; ++j) { dA[j] = (unsigned)(64 * j * lda); dB[j] = dA[j]; }
        oa[0] = (unsigned)((256 * u.pm + R0) * lda + C0 * 2); ob = (unsigned)((256 * u.pn + Rb0) * lda + C0 * 2);
    }
    __device__ __forceinline__ void mid(f32x4 (&acc)[2][2][4][2], const U& u, int wr, int wc, int fr, int fq) const {
#pragma unroll
        for (int ai = 0; ai < 2; ++ai) {
            u32x2 qf[4][2], qa[4][2];
#pragma unroll
            for (int m = 0; m < 4; ++m) { const size_t o = G8_GOFF(u.pm, u.pn, ai, m); const u32x4 f4 = *(const u32x4*)(GF + o), a4 = *(const u32x4*)(GA + o);
                qf[m][0] = (u32x2){f4.x, f4.y}; qf[m][1] = (u32x2){f4.z, f4.w}; qa[m][0] = (u32x2){a4.x, a4.y}; qa[m][1] = (u32x2){a4.z, a4.w}; }
#pragma unroll
            for (int m = 0; m < 4; ++m)
#pragma unroll
                for (int bj = 0; bj < 2; ++bj)
#pragma unroll
                    for (int n = 0; n < 2; ++n) { const unsigned wf = n ? qf[m][bj].y : qf[m][bj].x, wa = n ? qa[m][bj].y : qa[m][bj].x;
#pragma unroll
                        for (int e = 0; e < 4; ++e) { const float f = fmaxf((float)((wf >> (8 * e)) & 255u), 1.0f), a = (float)((wa >> (8 * e)) & 255u);
                            acc[ai][bj][m][n][e] *= a * __builtin_amdgcn_rcpf(f); } }
        }
    }
    __device__ __forceinline__ void epi(const f32x4 (&acc)[2][2][4][2], const U& u, int wr, int wc, int fr, int fq) const {
        u32x2 qf[2][4][2];
#pragma unroll
        for (int ai = 0; ai < 2; ++ai)
#pragma unroll
            for (int m = 0; m < 4; ++m) { const u32x4 f4 = *(const u32x4*)(GF + G8_GOFF(u.pm, u.pn, ai, m)); qf[ai][m][0] = (u32x2){f4.x, f4.y}; qf[ai][m][1] = (u32x2){f4.z, f4.w}; }
#pragma unroll
        for (int ai = 0; ai < 2; ++ai) {
#pragma unroll
            for (int m = 0; m < 4; ++m)
#pragma unroll
                for (int bj = 0; bj < 2; ++bj) { f32x4 v[2];
#pragma unroll
                    for (int n = 0; n < 2; ++n) { const unsigned wf = n ? qf[ai][m][bj].y : qf[ai][m][bj].x;
#pragma unroll
                        for (int e = 0; e < 4; ++e) v[n][e] = acc[ai][bj][m][n][e] * (fmaxf((float)((wf >> (8 * e)) & 255u), 1.0f) * (1.0f / (255.0f * 512.0f))); }
                    *(u32x2*)(Y8 + (size_t)(256 * u.pm + G8_ROWS(ai, m)) * 1024 + 256 * u.pn + G8_COL0(bj)) = pack8_fp8(v[0], v[1], 2.0f); }
        }
    }
};

struct MoeGuProb {
    static constexpr bool PERM = true, GATHER_A = true, I8 = true, F8 = false, HAS_MID = false; typedef i32x4 Acc;
    struct U { int e, rt, pn, base, par; int tok[4]; };
    const signed char* H8; const signed char* W8; const float* sW; const float* lsc; const float* bgu; unsigned char* ACT; const int* list; const int* cnt;
    __device__ __forceinline__ LAS unsigned char* parp(int off) const { return (LAS unsigned char*)tstart + (20480 - 64) + off; }
    const volatile LAS int* tstart;
    int R, G, c;
    __device__ __forceinline__ bool get(int i, U& u) const {
        const int L = i * G + c; if (L >= R * 8) return false;
        int rt, pn; g8::order2d(L, R, 8, rt, pn);
        const int e = ((const volatile LAS unsigned char*)tstart)[(1024 - 64) + rt];
        u.e = __builtin_amdgcn_readfirstlane(e); u.rt = __builtin_amdgcn_readfirstlane(rt); u.pn = __builtin_amdgcn_readfirstlane(pn); u.base = __builtin_amdgcn_readfirstlane((rt - tstart[e]) * 256); const int ucnt = __builtin_amdgcn_readfirstlane(cnt[e]);
        int R0, Rb0, C0; g8::lane_geom(threadIdx.x, R0, Rb0, C0);
#pragma unroll
        for (int j = 0; j < 4; ++j) { const int p = u.base + R0 + 64 * j; u.tok[j] = (p < ucnt) ? list[(size_t)e * TT + p] : TT; }
        u.par = __builtin_amdgcn_readfirstlane((i % 3) * 3072);
        { int t2 = threadIdx.x; asm volatile("" : "+v"(t2)); const int wv = __builtin_amdgcn_readfirstlane(t2 >> 6), ln = t2 & 63;
          if (wv < 3) { const float* gb = (wv == 0) ? bgu + (size_t)u.e * 2048 + 128 * u.pn : (wv == 1) ? sW + (size_t)u.e * 2048 + 256 * u.pn : lsc + (size_t)u.e * TT + u.base;
              const unsigned off = (wv == 0 && ln >= 32) ? (unsigned)(4096 + 16 * (ln - 32)) : (unsigned)(16 * ln);
              __builtin_amdgcn_global_load_lds((const unsigned*)((const char*)gb + off), (LAS unsigned*)parp(u.par + 1024 * wv), 16, 0, 0); } }
        return true;
    }
    __device__ __forceinline__ void setup(const U& u, unsigned (&oa)[4], unsigned& ob, unsigned (&dA)[4], unsigned (&dB)[4], const char*& pA, const char*& pB, int& nt) const {
        int R0, Rb0, C0; g8::lane_geom(threadIdx.x, R0, Rb0, C0);
        nt = 8; pA = (const char*)H8; pB = (const char*)W8;
#pragma unroll
        for (int j = 0; j < 4; ++j) { dA[j] = 0u; dB[j] = (unsigned)(64 * j * 1024); oa[j] = (unsigned)(u.tok[j] * 1024 + C0 * 2); }
        ob = (unsigned)((u.e * 2048 + 256 * u.pn + Rb0) * 1024 + C0 * 2);
    }
    __device__ __forceinline__ void epi(const i32x4 (&acc)[2][2][4][2], const U& u, int wr, int wc, int fr, int fq) const {
        const int j0 = 128 * u.pn + 32 * wc + 8 * fq;
        const LAS float* pl = (const LAS float*)parp(u.par);
        const LAS float* bp = pl + 32 * wc + 8 * fq;
        const f32x4 ba0 = *(const LAS f32x4*)bp, ba1 = *(const LAS f32x4*)(bp + 4), bu0 = *(const LAS f32x4*)(bp + 128), bu1 = *(const LAS f32x4*)(bp + 132);
        const LAS float* sp = pl + 256 + 32 * wc + 8 * fq;
        const f32x4 sa0 = *(const LAS f32x4*)sp, sa1 = *(const LAS f32x4*)(sp + 4), su0 = *(const LAS f32x4*)(sp + 128), su1 = *(const LAS f32x4*)(sp + 132);
        float rsv[2][4];
#pragma unroll
        for (int ai = 0; ai < 2; ++ai)
#pragma unroll
            for (int m = 0; m < 4; ++m) rsv[ai][m] = pl[512 + G8_ROWS(ai, m)];
        f32x2_t sA[4], sU[4], bA[4], bU[4];
#pragma unroll
        for (int q = 0; q < 2; ++q) { sA[q] = (f32x2_t){sa0[2 * q], sa0[2 * q + 1]}; sA[2 + q] = (f32x2_t){sa1[2 * q], sa1[2 * q + 1]}; sU[q] = (f32x2_t){su0[2 * q], su0[2 * q + 1]}; sU[2 + q] = (f32x2_t){su1[2 * q], su1[2 * q + 1]};
            bA[q] = (f32x2_t){ba0[2 * q], ba0[2 * q + 1]}; bA[2 + q] = (f32x2_t){ba1[2 * q], ba1[2 * q + 1]}; bU[q] = (f32x2_t){bu0[2 * q], bu0[2 * q + 1]}; bU[2 + q] = (f32x2_t){bu1[2 * q], bu1[2 * q + 1]}; }
#pragma unroll
        for (int ai = 0; ai < 2; ++ai)
#pragma unroll
            for (int m = 0; m < 4; ++m) { const int rr = G8_ROWS(ai, m); const size_t row = (size_t)256 * u.rt + rr;
                const f32x2_t rs2 = {rsv[ai][m], rsv[ai][m]};
                f32x2_t y[4];
#pragma unroll
                for (int q = 0; q < 4; ++q) { const int n = q >> 1, e0 = 2 * (q & 1);
                    const f32x2_t ai2 = {(float)acc[ai][0][m][n][e0], (float)acc[ai][0][m][n][e0 + 1]}, ui2 = {(float)acc[ai][1][m][n][e0], (float)acc[ai][1][m][n][e0 + 1]};
                    f32x2_t a = ai2 * (rs2 * sA[q]) + bA[q], uu = ui2 * (rs2 * sU[q]) + bU[q];
                    a = (f32x2_t){fminf(a[0], 7.0f), fminf(a[1], 7.0f)};
                    uu = (f32x2_t){__builtin_amdgcn_fmed3f(uu[0], -7.0f, 7.0f), __builtin_amdgcn_fmed3f(uu[1], -7.0f, 7.0f)};
                    const f32x2_t t = a * (-1.702f * LOG2E);
                    const f32x2_t den = (f32x2_t){__builtin_amdgcn_exp2f(t[0]), __builtin_amdgcn_exp2f(t[1])} + 1.0f;
                    const f32x2_t r = {__builtin_amdgcn_rcpf(den[0]), __builtin_amdgcn_rcpf(den[1])};
                    y[q] = (a * r) * (uu + 1.0f); }
                { u32x2 w; w.x = pk4_fp8(y[0][0], y[0][1], y[1][0], y[1][1]); w.y = pk4_fp8(y[2][0], y[2][1], y[3][0], y[3][1]); *(u32x2*)(ACT + row * 1024 + j0) = w; } }
    }
};
struct MoeDnProb {
    static constexpr bool PERM = true, GATHER_A = false, I8 = false, F8 = true, HAS_MID = false; typedef f32x4 Acc;
    struct U { int e, rt, pn; f32x4 bias[2][2]; };
    const unsigned char* ACT; const unsigned char* W; const float* bdn; unsigned char* YE;
    const volatile LAS int* tstart; int R, G, c;
    __device__ __forceinline__ bool get(int i, U& u) const {
        const int L = i * G + c; if (L >= R * 4) return false;
        int rt, pn; g8::order2d(L, R, 4, rt, pn);
        const int e = ((const volatile LAS unsigned char*)tstart)[(1024 - 64) + rt];
        u.e = __builtin_amdgcn_readfirstlane(e); u.rt = __builtin_amdgcn_readfirstlane(rt); u.pn = __builtin_amdgcn_readfirstlane(pn);
        { int t2 = threadIdx.x; asm volatile("" : "+v"(t2)); const int wc = (t2 >> 6) & 3, fq = (t2 & 63) >> 4;
#pragma unroll
          for (int bj = 0; bj < 2; ++bj) { const float* bp = bdn + (size_t)u.e * 1024 + 256 * u.pn + G8_COLW(bj); u.bias[bj][0] = *(const f32x4*)bp; u.bias[bj][1] = *(const f32x4*)(bp + 4); } }
        return true;
    }
    __device__ __forceinline__ void setup(const U& u, unsigned (&oa)[4], unsigned& ob, unsigned (&dA)[4], unsigned (&dB)[4], const char*& pA, const char*& pB, int& nt) const {
        int R0, Rb0, C0; g8::lane_geom_w(threadIdx.x, R0, Rb0, C0);
        nt = 8; pA = (const char*)ACT; pB = (const char*)W;
#pragma unroll
        for (int j = 0; j < 4; ++j) { dA[j] = (unsigned)(64 * j * 1024); dB[j] = (unsigned)(G8_DBW(j) * 1024); }
        oa[0] = (unsigned)((256 * u.rt + R0) * 1024 + C0 * 2); ob = (unsigned)((u.e * 1024 + 256 * u.pn + Rb0) * 1024 + C0 * 2);
    }
    __device__ __forceinline__ void epi(const f32x4 (&acc)[2][2][4][2], const U& u, int wr, int wc, int fr, int fq) const {
        const int col = 256 * u.pn + G8_COLW(0);
#pragma unroll
        for (int ai = 0; ai < 2; ++ai)
#pragma unroll
            for (int m = 0; m < 4; ++m) { const size_t row = (size_t)256 * u.rt + G8_ROWS(ai, m);
                const u32x2 w0 = pack8_fp8(acc[ai][0][m][0] * (1.0f / 32.0f) + u.bias[0][0], acc[ai][0][m][1] * (1.0f / 32.0f) + u.bias[0][1], 1.0f);
                const u32x2 w1 = pack8_fp8(acc[ai][1][m][0] * (1.0f / 32.0f) + u.bias[1][0], acc[ai][1][m][1] * (1.0f / 32.0f) + u.bias[1][1], 1.0f);
                *(u32x4*)(YE + row * 1024 + col) = (u32x4){w0.x, w0.y, w1.x, w1.y}; }
    }
};

__device__ __forceinline__ int rope_perm(int d) { return (d & 32) | ((d & 15) << 1) | ((d >> 4) & 1); }
template <class RM>
__device__ __forceinline__ void transpose_tile(const Fr& F, const float* src, int N, int k0, int n0, bf16_t* dst, int Kd, RM rm) {
    LAS unsigned char* lds = F.lds;
    const int tid = F.tid;
    { const int kq = tid >> 4, c4 = (tid & 15) * 4; f32x4 v[4];
#pragma unroll
      for (int r = 0; r < 4; ++r) v[r] = *(const f32x4*)(src + (size_t)(k0 + 4 * kq + r) * N + n0 + c4);
#pragma unroll
      for (int e = 0; e < 4; ++e) { u32x2 w; w.x = cvt_pk_bf16(v[0][e], v[1][e]); w.y = cvt_pk_bf16(v[2][e], v[3][e]); *(LAS u32x2*)(lds + (c4 + e) * 272 + kq * 8) = w; } }
    __syncthreads();
    { const int n = tid >> 3, ch = tid & 7; const u32x4 w0 = *(const LAS u32x4*)(lds + n * 272 + ch * 32), w1 = *(const LAS u32x4*)(lds + n * 272 + ch * 32 + 16);
      bf16_t* dp = dst + (size_t)rm(n0 + n) * Kd + k0 + ch * 16; *(u32x4*)dp = w0; *(u32x4*)(dp + 8) = w1; }
    __syncthreads();
}
__device__ __forceinline__ void transpose_tile_fp8(const Fr& F, const float* src, int k0, int n0, unsigned char* dst) {
    LAS unsigned char* lds = F.lds;
    const int tid = F.tid;
    { const int kq = tid >> 4, c4 = (tid & 15) * 4; f32x4 v[4];
#pragma unroll
      for (int r = 0; r < 4; ++r) v[r] = *(const f32x4*)(src + (size_t)(k0 + 4 * kq + r) * 1024 + n0 + c4) * 32.0f;
#pragma unroll
      for (int e = 0; e < 4; ++e) *(LAS unsigned*)(lds + (c4 + e) * 144 + kq * 4) = pk4_fp8(v[0][e], v[1][e], v[2][e], v[3][e]); }
    __syncthreads();
    { const int n = tid >> 3, ch = tid & 7; const u32x4 w = *(const LAS u32x4*)(lds + n * 144 + ch * 16);
      *(u32x4*)(dst + (size_t)(n0 + n) * 1024 + k0 + ch * 16) = w; }
    __syncthreads();
}
struct RmGu { __device__ int operator()(int n) const { const int bj = n >> 10, j = n & 1023; return 256 * (j >> 7) + 128 * bj + (j & 127); } };
template <int MODE, int KT, class RM>
__device__ __forceinline__ void strip_convert(const Fr& F, const float* src, int N, int n0, void* dstv, int Kd, float* sdst, RM rm) {
    LAS unsigned char* lds = F.lds;
    LAS float* red = (LAS float*)(lds + 32768);
    LAS float* inv = (LAS float*)(lds + 32768 + 8192);
    const int tid = F.tid, kq = tid >> 4, c4 = (tid & 15) * 4;
    f32x4 v[KT][4];
#pragma unroll
    for (int kt = 0; kt < KT; ++kt)
#pragma unroll
        for (int r = 0; r < 4; ++r) v[kt][r] = __builtin_nontemporal_load((const f32x4*)(src + (size_t)(kt * 128 + 4 * kq + r) * N + n0 + c4));
    f32x4 iv = {32.0f, 32.0f, 32.0f, 32.0f};
    if (MODE == 0) {
        f32x4 mx = {0.f, 0.f, 0.f, 0.f};
#pragma unroll
        for (int kt = 0; kt < KT; ++kt)
#pragma unroll
            for (int r = 0; r < 4; ++r)
#pragma unroll
                for (int e = 0; e < 4; ++e) mx[e] = fmaxf(mx[e], fabsf(v[kt][r][e]));
#pragma unroll
        for (int e = 0; e < 4; ++e) red[kq * 64 + c4 + e] = mx[e];
        __syncthreads();
        if (tid < 64) { float m = 0.f;
#pragma unroll
            for (int r = 0; r < 32; ++r) m = fmaxf(m, red[r * 64 + tid]);
            sdst[rm(n0 + tid)] = m * (1.0f / 127.0f); inv[tid] = m > 0.f ? 127.0f / m : 0.f; }
        __syncthreads();
        iv = *(const LAS f32x4*)(inv + c4);
    }
#pragma unroll
    for (int kt = 0; kt < KT; ++kt) {
        if (MODE == 0) {
#pragma unroll
            for (int e = 0; e < 4; ++e) { const int q0 = __float2int_rn(v[kt][0][e] * iv[e]), q1 = __float2int_rn(v[kt][1][e] * iv[e]), q2 = __float2int_rn(v[kt][2][e] * iv[e]), q3 = __float2int_rn(v[kt][3][e] * iv[e]);
                *(LAS unsigned*)(lds + (c4 + e) * 144 + kq * 4) = (unsigned)(q0 & 255) | ((unsigned)(q1 & 255) << 8) | ((unsigned)(q2 & 255) << 16) | ((unsigned)(q3 & 255) << 24); }
        } else if (MODE == 1) {
#pragma unroll
            for (int e = 0; e < 4; ++e) *(LAS unsigned*)(lds + (c4 + e) * 144 + kq * 4) = pk4_fp8(v[kt][0][e] * 32.0f, v[kt][1][e] * 32.0f, v[kt][2][e] * 32.0f, v[kt][3][e] * 32.0f);
        } else {
#pragma unroll
            for (int e = 0; e < 4; ++e) { u32x2 w; w.x = cvt_pk_bf16(v[kt][0][e], v[kt][1][e]); w.y = cvt_pk_bf16(v[kt][2][e], v[kt][3][e]); *(LAS u32x2*)(lds + (c4 + e) * 272 + kq * 8) = w; }
        }
        __syncthreads();
        { const int nl = tid >> 3, ch = tid & 7; const int row = rm(n0 + nl);
          if (MODE == 2) { const u32x4 w0 = *(const LAS u32x4*)(lds + nl * 272 + ch * 32), w1 = *(const LAS u32x4*)(lds + nl * 272 + ch * 32 + 16);
              bf16_t* dp = (bf16_t*)dstv + (size_t)row * Kd + kt * 128 + ch * 16; *(u32x4*)dp = w0; *(u32x4*)(dp + 8) = w1; }
          else { const u32x4 w = *(const LAS u32x4*)(lds + nl * 144 + ch * 16); *(u32x4*)((unsigned char*)dstv + (size_t)row * Kd + kt * 128 + ch * 16) = w; } }
        __syncthreads();
    }
}
__device__ __forceinline__ void strip128_fp8(const Fr& F, const float* src, int N, int k0, int n0, unsigned char* dst, int Kd) {
    LAS unsigned char* lds = F.lds;
    const int tid = F.tid, kq = tid >> 5, c4 = (tid & 31) * 4;
    f32x4 v[8][4];
#pragma unroll
    for (int kt = 0; kt < 8; ++kt)
#pragma unroll
        for (int r = 0; r < 4; ++r) v[kt][r] = __builtin_nontemporal_load((const f32x4*)(src + (size_t)(k0 + kt * 64 + 4 * kq + r) * N + n0 + c4));
#pragma unroll
    for (int kt = 0; kt < 8; ++kt)
#pragma unroll
        for (int e = 0; e < 4; ++e) *(LAS unsigned*)(lds + (c4 + e) * 528 + kt * 64 + kq * 4) = pk4_fp8(v[kt][0][e] * 32.0f, v[kt][1][e] * 32.0f, v[kt][2][e] * 32.0f, v[kt][3][e] * 32.0f);
    __syncthreads();
#pragma unroll
    for (int it = 0; it < 8; ++it) { const int n = it * 16 + (tid >> 5), ch = tid & 31; const u32x4 w = *(const LAS u32x4*)(lds + n * 528 + ch * 16);
        *(u32x4*)(dst + (size_t)(n0 + n) * Kd + k0 + ch * 16) = w; }
    __syncthreads();
}
struct RmId { __device__ int operator()(int n) const { return n; } };
struct RmWin { __device__ int operator()(int n) const { return (n >= 512 && n < 1152) ? ((n & ~63) | rope_perm(n & 63)) : n; } };

__device__ __forceinline__ void prologue_phase(const Fr& F) {
    const int tid = F.tid, G = F.G, bid = F.bid;
    const float PI2 = 6.283185307179586f;
    const size_t gtid = (size_t)bid * 512 + tid, gsz = (size_t)G * 512;
    { float* rope = WSP(float, WS_ROPE);
      for (size_t i = gtid; i < 2048; i += gsz) { const int pos = (int)(i >> 4), f = (int)(i & 15); const float inv = powf(10000.0f, -(float)f / 16.0f); const float a = (float)pos * inv; rope[i] = cosf(a); rope[2048 + i] = sinf(a); } }
    { bf16_t* W1 = WSP(bf16_t, WS_W1);
      for (size_t i = gtid; i < 256 * 128; i += gsz) { const int r = (int)(i >> 7), n1 = (int)(i & 127); float v = 0.f;
          if (r < 128) { const int k1p = r >> 1, part = r & 1;
              if (part == 0) v = cospif((float)((k1p * n1) & 127) / 64.0f);
              else if (k1p == 0) v = (n1 & 1) ? -1.0f : 1.0f;
              else v = -sinpif((float)((k1p * n1) & 127) / 64.0f); }
          W1[i] = f2bf(v); } }
    { bf16_t* MT = WSP(bf16_t, WS_MT);
      for (size_t i = gtid; i < (size_t)64 * 256 * 128; i += gsz) {
          const int kk = (int)(i & 127), r = (int)((i >> 7) & 255), k1p = (int)(i >> 15);
          const int part = kk >> 6, n2 = kk & 63, s = r >> 7, k2 = (r & 127) >> 1, reim = r & 1;
          float v;
          if (k1p == 0) { const int k = 64 * s + 128 * k2; const int mm = (n2 * k) & 8191; const float cm = cospif((float)mm / 4096.0f), sm = sinpif((float)mm / 4096.0f);
              v = (part == s) ? (reim ? -sm : cm) : 0.0f; }
          else { const int k = (s ? 128 - k1p : k1p) + 128 * k2; const int mm = (n2 * k) & 8191; const float cm = cospif((float)mm / 4096.0f), sm = sinpif((float)mm / 4096.0f);
              if (s == 0) v = reim ? (part ? cm : -sm) : (part ? sm : cm);
              else        v = reim ? (part ? -cm : -sm) : (part ? -sm : cm); }
          MT[i] = f2bf(v); } }
    { bf16_t* WC = WSP(bf16_t, WS_WC);
      const float sc = 5.656854249492381f;
      for (size_t i = gtid; i < 512 * 256; i += gsz) { const int n = (int)(i & 255), r = (int)(i >> 8), k = r >> 1, reim = r & 1; const int mm = (k * n) & 255;
          WC[i] = f2bf(sc * (reim ? -sinpif((float)mm / 128.0f) : cospif((float)mm / 128.0f))); } }
    { bf16_t* RWT = WSP(bf16_t, WS_RWT); const float* rw = INP(13);
      for (size_t i = gtid; i < (size_t)DEPTH * 32 * 1024; i += gsz) { const int k = (int)(i & 1023), e = (int)((i >> 10) & 31), l = (int)(i >> 15); RWT[i] = f2bf(rw[((size_t)l * 1024 + k) * 32 + e]); } }
    { bf16_t* H = WSP(bf16_t, WS_H); for (size_t i = gtid; i < 256 * 1024; i += gsz) H[(size_t)TT * 1024 + i] = 0;
      unsigned* H8z = (unsigned*)(WSP(signed char, WS_H8) + (size_t)TT * 1024); for (size_t i = gtid; i < 256 * 256; i += gsz) H8z[i] = 0u; }
    (void)PI2;
    {
        LAS float* sil = (LAS float*)(F.lds + 65536);
        LAS float* red = (LAS float*)(F.lds + 65536 + 20480);
        for (int i = tid; i < 5 * 1024; i += 512) { const int v = i >> 10, k = i & 1023; const float x = (v < 4) ? INP(1)[v * 1024 + k] : INP(3)[k]; sil[i] = x * sigmoidf_(x); }
        __syncthreads();
        float* MOD = WSP(float, WS_MOD);
        for (int u = bid; u < DEPTH * 96; u += G) {
            const int l = u / 96, j0 = (u % 96) * 64;
            const float* aw = INP(4) + (size_t)l * 1024 * 6144 + j0 + F.lane;
            float a0 = 0.f, a1 = 0.f, a2 = 0.f, a3 = 0.f, a4 = 0.f;
            for (int kk = 0; kk < 128; ++kk) { const int k = F.wave * 128 + kk; const float w = aw[(size_t)k * 6144];
                a0 += sil[k] * w; a1 += sil[1024 + k] * w; a2 += sil[2048 + k] * w; a3 += sil[3072 + k] * w; a4 += sil[4096 + k] * w; }
            red[(F.wave * 5 + 0) * 64 + F.lane] = a0; red[(F.wave * 5 + 1) * 64 + F.lane] = a1; red[(F.wave * 5 + 2) * 64 + F.lane] = a2; red[(F.wave * 5 + 3) * 64 + F.lane] = a3; red[(F.wave * 5 + 4) * 64 + F.lane] = a4;
            __syncthreads();
            if (tid < 320) { const int v = tid >> 6, jl = tid & 63; float s = INP(5)[(size_t)l * 6144 + j0 + jl];
#pragma unroll
                for (int w = 0; w < 8; ++w) s += red[(w * 5 + v) * 64 + jl];
                MOD[((size_t)l * 5 + v) * 6144 + j0 + jl] = s; }
            __syncthreads();
        }
    }
    {
        LAS float* tab = (LAS float*)(F.lds + 65536);
        if (tid < 128) { tab[tid] = cospif((float)tid / 64.0f); tab[128 + tid] = sinpif((float)tid / 64.0f); }
        __syncthreads();
        unsigned char* WFO = WSP(unsigned char, WS_WFO);
        for (int u = bid; u < DEPTH * 4 * 2 * 8; u += G) {
            const int dp = u & 7, reim = (u >> 3) & 1, g = (u >> 4) & 3, l = u >> 6;
            const int dc = 2 * dp + (tid >> 8), o4 = (tid & 255) * 4;
            const float* wf = INP(10) + ((size_t)l * 512 + g * 128) * 1024 + o4;
            f32x4 a[8];
#pragma unroll
            for (int q = 0; q < 8; ++q) a[q] = (f32x4){0.f, 0.f, 0.f, 0.f};
#pragma unroll 4
            for (int j = 0; j < 128; ++j) { const f32x4 w = *(const f32x4*)(wf + (size_t)j * 1024);
#pragma unroll
                for (int q = 0; q < 8; ++q) a[q] += w * tab[reim * 128 + ((j * (dc * 8 + q)) & 127)]; }
#pragma unroll
            for (int e = 0; e < 4; ++e) { u32x2 w2; w2.x = pk4_fp8(a[0][e] * 8.0f, a[1][e] * 8.0f, a[2][e] * 8.0f, a[3][e] * 8.0f); w2.y = pk4_fp8(a[4][e] * 8.0f, a[5][e] * 8.0f, a[6][e] * 8.0f, a[7][e] * 8.0f);
                *(u32x2*)(WFO + ((size_t)l * 1024 + o4 + e) * 1024 + g * 256 + reim * 128 + dc * 8) = w2; }
        }
        __syncthreads();
    }
    {
        constexpr int T_GU = DEPTH * 32 * 32, T_DN = DEPTH * 32 * 16, T_WIN = DEPTH * 52, T_WAO = DEPTH * 16, T_WOUT = DEPTH * 16;
#pragma unroll 1
        for (int q = bid; q < T_GU; q += G) { const int le = q >> 5, ns = q & 31;
            strip_convert<0, 8>(F, INP(15) + (size_t)le * 1024 * 2048, 2048, ns * 64, WSP(signed char, WS_WGU) + (size_t)le * 2048 * 1024, 1024, WSP(float, WS_SWGU) + (size_t)le * 2048, RmGu()); }
#pragma unroll 1
        for (int q = bid; q < T_DN; q += G) { const int le = q >> 4, ns = (q >> 1) & 7, kh = q & 1;
            strip128_fp8(F, INP(17) + (size_t)le * 1024 * 1024, 1024, kh * 512, ns * 128, WSP(unsigned char, WS_WDN) + (size_t)le * 1024 * 1024, 1024); }
#pragma unroll 1
        for (int q = bid; q < T_WIN; q += G) { const int l = q / 52, ns = q % 52;
            strip_convert<0, 8>(F, INP(8) + (size_t)l * 1024 * IN_DIM, IN_DIM, ns * 64, WSP(signed char, WS_WIN) + (size_t)l * IN_DIM * 1024, 1024, WSP(float, WS_SWIN) + (size_t)l * IN_DIM, RmWin()); }
#pragma unroll 1
        for (int q = (bid + 208) % G; q < DEPTH * 8; q += G) { const int l = q >> 3, ns = q & 7;
            strip128_fp8(F, INP(11) + (size_t)l * 512 * 1024, 1024, 0, ns * 128, WSP(unsigned char, WS_WAO) + (size_t)l * 1024 * 512, 512); }
#pragma unroll 1
        for (int q = (bid + 144) % G; q < DEPTH * 16; q += G) { const int l = q >> 4, ns = (q >> 1) & 7, kh = q & 1;
            strip128_fp8(F, INP(12) + (size_t)l * 1024 * 1024, 1024, kh * 512, ns * 128, WSP(unsigned char, WS_WOUT) + (size_t)l * 1024 * 1024, 1024); }
    }
}

template <bool WIDE>
__device__ __forceinline__ void moe_combine(const Fr& F, int tok, int lprev, const volatile LAS int* tstart, f32x4 (&m)[4]) {
    const int* slot = WSP(int, WS_SLOT); const float* gate = WSP(float, WS_GATE); const unsigned char* YE = WSP(unsigned char, WS_YE);
#pragma unroll
    for (int j = 0; j < 4; ++j) m[j] = (f32x4){0.f, 0.f, 0.f, 0.f};
    const i32x4 sl4 = *(const i32x4*)(slot + tok * 4); const f32x4 gk4 = *(const f32x4*)(gate + tok * 4);
#pragma unroll
    for (int k = 0; k < 4; ++k) {
        const int sl = sl4[k]; const float gk = gk4[k];
        const int e = sl >> 20, pos = sl & 0xfffff;
        const size_t row = (size_t)256 * tstart[e] + pos;
        i32x4 w4;
        if (WIDE) w4 = *(const i32x4*)(YE + row * 1024 + 16 * F.lane);
        else { const unsigned char* yp = YE + row * 1024 + 4 * F.lane;
#pragma unroll
            for (int j = 0; j < 4; ++j) w4[j] = *(const int*)(yp + 256 * j); }
#pragma unroll
        for (int j = 0; j < 4; ++j) { const int w = w4[j];
            m[j][0] += gk * __builtin_amdgcn_cvt_f32_fp8(w, 0); m[j][1] += gk * __builtin_amdgcn_cvt_f32_fp8(w, 1); m[j][2] += gk * __builtin_amdgcn_cvt_f32_fp8(w, 2); m[j][3] += gk * __builtin_amdgcn_cvt_f32_fp8(w, 3); }
    }
    (void)lprev;
}
__device__ __forceinline__ int fill_tstart(const Fr& F, int l) {
    volatile LAS int* ts = (volatile LAS int*)(F.lds + LDS_MISC + 64);
    volatile LAS unsigned char* r2e = (volatile LAS unsigned char*)(F.lds + LDS_MISC + 1024);
    __syncthreads();
    if (F.tid < 64) {
        const int e = F.tid & 31; const int* cnt = (const int*)(F.ws + WS_CTL + CTL_CNT) + l * 32;
        const int nt_e = (cnt[e] + 255) >> 8; int inc = nt_e;
#pragma unroll
        for (int o = 1; o < 32; o <<= 1) { const int y = __shfl_up(inc, o, 32); if (e >= o) inc += y; }
        const int start = inc - nt_e;
        if (F.tid < 32) { ts[e] = start; if (e == 31) ts[32] = inc;
            for (int rt = start; rt < inc; ++rt) r2e[rt] = (unsigned char)e; }
    }
    __syncthreads();
    return ts[32];
}

__device__ __forceinline__ void norm1_phase(const Fr& F, int l) {
    const volatile LAS int* tstart = (const volatile LAS int*)(F.lds + LDS_MISC + 64);
    if (l > 0) fill_tstart(F, l - 1);
    const float* MOD = WSP(float, WS_MOD);
    const bool fin = (l == DEPTH);
    const int ntok = fin ? TX : TT;
    const bool tmo = fin && (xb_ld((unsigned*)(F.ws + WS_CTL) + XB_TMO) != 0u);
    const float* gvec = fin ? INP(19) : INP(6) + (size_t)l * 1024;
    bf16_t* XW = WSP(bf16_t, WS_XW); bf16_t* CW = WSP(bf16_t, WS_CW); signed char* H8 = WSP(signed char, WS_H8); float* SHv = WSP(float, WS_SH);
    const bool wide = (l > 0) && !fin;
#define N1_COL(j) (wide ? (16 * F.lane + 4 * (j)) : (256 * (j) + 4 * F.lane))
    int vcur = -1; f32x4 g2v[4], mulv[4], addv[4];
    for (int tok = F.bid * 8 + F.wave; tok < ntok; tok += F.G * 8) {
        const bool isx = tok < TX; const int v = isx ? (tok >> 13) : 4;
        if (v != vcur) { vcur = v;
            const float* g2 = MOD + ((size_t)(l > 0 ? l - 1 : 0) * 5 + v) * 6144 + 5 * 1024; const float* md = MOD + ((size_t)(fin ? 0 : l) * 5 + v) * 6144;
#pragma unroll
            for (int j = 0; j < 4; ++j) { const int c = N1_COL(j); g2v[j] = *(const f32x4*)(g2 + c); const f32x4 g = *(const f32x4*)(gvec + c);
                if (fin) { mulv[j] = g; addv[j] = (f32x4){0.f, 0.f, 0.f, 0.f}; } else { mulv[j] = g * (*(const f32x4*)(md + 1024 + c) + 1.0f); addv[j] = *(const f32x4*)(md + c); } } }
        f32x4 x[4];
        if (l == 0) { const float* src = isx ? INP(0) + (size_t)tok * 1024 : INP(2) + (size_t)(tok - TX) * 1024;
#pragma unroll
            for (int j = 0; j < 4; ++j) x[j] = *(const f32x4*)(src + 256 * j + 4 * F.lane);
        } else { const bf16_t* src = isx ? XW + (size_t)tok * 1024 : CW + (size_t)(tok - TX) * 1024; u32x2 xw[4];
            if (wide) { const u32x4 a = *(const u32x4*)(src + 16 * F.lane), bq = *(const u32x4*)(src + 16 * F.lane + 8);
                xw[0] = (u32x2){a.x, a.y}; xw[1] = (u32x2){a.z, a.w}; xw[2] = (u32x2){bq.x, bq.y}; xw[3] = (u32x2){bq.z, bq.w}; }
            else {
#pragma unroll
                for (int j = 0; j < 4; ++j) xw[j] = *(const u32x2*)(src + 256 * j + 4 * F.lane); }
#pragma unroll
            for (int j = 0; j < 4; ++j) x[j] = (f32x4){bf_lo(xw[j].x), bf_hi(xw[j].x), bf_lo(xw[j].y), bf_hi(xw[j].y)};
        }
        if (l > 0) {
            f32x4 mm[4]; if (wide) moe_combine<true>(F, tok, l - 1, tstart, mm); else moe_combine<false>(F, tok, l - 1, tstart, mm);
            bf16_t* dst = isx ? XW + (size_t)tok * 1024 : CW + (size_t)(tok - TX) * 1024;
#pragma unroll
            for (int j = 0; j < 4; ++j) x[j] += g2v[j] * mm[j];
            if (wide) { u32x4 a, bq; a.x = cvt_pk_bf16(x[0][0], x[0][1]); a.y = cvt_pk_bf16(x[0][2], x[0][3]); a.z = cvt_pk_bf16(x[1][0], x[1][1]); a.w = cvt_pk_bf16(x[1][2], x[1][3]);
                bq.x = cvt_pk_bf16(x[2][0], x[2][1]); bq.y = cvt_pk_bf16(x[2][2], x[2][3]); bq.z = cvt_pk_bf16(x[3][0], x[3][1]); bq.w = cvt_pk_bf16(x[3][2], x[3][3]);
                *(u32x4*)(dst + 16 * F.lane) = a; *(u32x4*)(dst + 16 * F.lane + 8) = bq; }
        }
        float ss = 0.f;
#pragma unroll
        for (int j = 0; j < 4; ++j) ss += x[j][0] * x[j][0] + x[j][1] * x[j][1] + x[j][2] * x[j][2] + x[j][3] * x[j][3];
        ss = wave_sum(ss);
        const float rstd = rsqrtf(ss * (1.0f / 1024.0f) + EPS);
        if (fin) {
#pragma unroll
            for (int j = 0; j < 4; ++j) *(f32x4*)(F.out + (size_t)tok * 1024 + 256 * j + 4 * F.lane) = tmo ? (f32x4){__builtin_nanf(""), __builtin_nanf(""), __builtin_nanf(""), __builtin_nanf("")} : x[j] * rstd * mulv[j];
        } else {
            float amax = 0.f;
#pragma unroll
            for (int j = 0; j < 4; ++j) { x[j] = x[j] * rstd * mulv[j] + addv[j];
                amax = fmaxf(amax, fmaxf(fmaxf(fabsf(x[j][0]), fabsf(x[j][1])), fmaxf(fabsf(x[j][2]), fabsf(x[j][3])))); }
            amax = wave_max(amax);
            const float inv = amax > 0.f ? 127.0f / amax : 0.f;
            u32x4 hq;
#pragma unroll
            for (int j = 0; j < 4; ++j) {
                const int q0 = __float2int_rn(x[j][0] * inv), q1 = __float2int_rn(x[j][1] * inv), q2 = __float2int_rn(x[j][2] * inv), q3 = __float2int_rn(x[j][3] * inv);
                hq[j] = (unsigned)(q0 & 255) | ((unsigned)(q1 & 255) << 8) | ((unsigned)(q2 & 255) << 16) | ((unsigned)(q3 & 255) << 24); }
            if (wide) *(u32x4*)(H8 + (size_t)tok * 1024 + 16 * F.lane) = hq;
            else {
#pragma unroll
                for (int j = 0; j < 4; ++j) *(unsigned*)(H8 + (size_t)tok * 1024 + 256 * j + 4 * F.lane) = hq[j]; }
            if (F.lane == 0) SHv[tok] = amax * (1.0f / 127.0f);
        }
    }
#undef N1_COL
}

__device__ __forceinline__ void norm2_router_phase(const Fr& F, int l, bool fake = false) {
    const int ntok = (l == DEPTH - 1) ? TX : TT;
    const float* MOD = WSP(float, WS_MOD); const float* gvec = INP(7) + (size_t)l * 1024;
    const bf16_t* XW = WSP(bf16_t, WS_XW); const bf16_t* CW = WSP(bf16_t, WS_CW);
    const bf16_t* RWT = WSP(bf16_t, WS_RWT) + (size_t)l * 32 * 1024; const float* rb = INP(14) + l * 32;
    int* cntg = (int*)(F.ws + WS_CTL + CTL_CNT) + l * 32; int* list = WSP(int, WS_LIST); int* slot = WSP(int, WS_SLOT); float* gate = WSP(float, WS_GATE);
    LAS unsigned char* hs = F.lds;
    LAS float* part = (LAS float*)(F.lds + 69632);
    LAS float* logit = (LAS float*)(F.lds + 69632 + 36864);
    LAS int* lcnt = (LAS int*)(F.lds + 69632 + 36864 + 4608);
    LAS int* lbase = lcnt + 32;
    LAS float* tsc = (LAS float*)(lbase + 32);
    LAS int* tokE = (LAS int*)(tsc + 32); LAS float* tokG = (LAS float*)(tokE + 128);
    signed char* H8 = WSP(signed char, WS_H8); float* lscg = WSP(float, WS_LSC);
    const int lane = F.lane, w = F.wave, l32 = lane & 31, hh = lane >> 5;
    bf16x8 rwf[8];
#pragma unroll
    for (int s = 0; s < 8; ++s) rwf[s] = *(const bf16x8*)(RWT + (size_t)l32 * 1024 + 128 * w + 16 * s + 8 * hh);
    for (int tl = F.bid; tl < ntok / 32; tl += F.G) {
        const int t0 = tl * 32;
        if (F.tid < 32) lcnt[F.tid] = 0;
        f32x4 mulv[4], addv[4];
        { const int v0 = (t0 < TX) ? (t0 >> 13) : 4; const float* md0 = MOD + ((size_t)l * 5 + v0) * 6144;
#pragma unroll
          for (int j = 0; j < 4; ++j) { const int c = 256 * j + 4 * lane; mulv[j] = *(const f32x4*)(gvec + c) * (*(const f32x4*)(md0 + 4096 + c) + 1.0f); addv[j] = *(const f32x4*)(md0 + 3072 + c); } }
#pragma unroll 1
        for (int q = 0; q < 4; ++q) {
            const int tloc = 4 * w + q, tok = t0 + tloc; const bool isx = tok < TX; const int v = isx ? (tok >> 13) : 4;
            const bf16_t* src = isx ? XW + (size_t)tok * 1024 : CW + (size_t)(tok - TX) * 1024;
            f32x4 x[4]; float ss = 0.f; u32x2 xw[4];
#pragma unroll
            for (int j = 0; j < 4; ++j) xw[j] = *(const u32x2*)(src + 256 * j + 4 * lane);
#pragma unroll
            for (int j = 0; j < 4; ++j) { x[j] = (f32x4){bf_lo(xw[j].x), bf_hi(xw[j].x), bf_lo(xw[j].y), bf_hi(xw[j].y)}; ss += x[j][0] * x[j][0] + x[j][1] * x[j][1] + x[j][2] * x[j][2] + x[j][3] * x[j][3]; }
            ss = wave_sum(ss); const float rstd = rsqrtf(ss * (1.0f / 1024.0f) + EPS); (void)v;
            float amax = 0.f;
#pragma unroll
            for (int j = 0; j < 4; ++j) { const int c = 256 * j + 4 * lane;
                x[j] = x[j] * rstd * mulv[j] + addv[j];
                amax = fmaxf(amax, fmaxf(fmaxf(fabsf(x[j][0]), fabsf(x[j][1])), fmaxf(fabsf(x[j][2]), fabsf(x[j][3]))));
                u32x2 wv; wv.x = cvt_pk_bf16(x[j][0], x[j][1]); wv.y = cvt_pk_bf16(x[j][2], x[j][3]);
                *(LAS u32x2*)(hs + tloc * 2064 + c * 2) = wv; }
            amax = wave_max(amax);
            const float inv = amax > 0.f ? 127.0f / amax : 0.f;
#pragma unroll
            for (int j = 0; j < 4; ++j) { const int c = 256 * j + 4 * lane;
                const int q0 = __float2int_rn(x[j][0] * inv), q1 = __float2int_rn(x[j][1] * inv), q2 = __float2int_rn(x[j][2] * inv), q3 = __float2int_rn(x[j][3] * inv);
                *(unsigned*)(H8 + (size_t)tok * 1024 + c) = (unsigned)(q0 & 255) | ((unsigned)(q1 & 255) << 8) | ((unsigned)(q2 & 255) << 16) | ((unsigned)(q3 & 255) << 24); }
            if (lane == 0) tsc[tloc] = amax * (1.0f / 127.0f);
        }
        __syncthreads();
        {
            f32x16 acc;
#pragma unroll
            for (int e = 0; e < 16; ++e) acc[e] = 0.f;
#pragma unroll
            for (int s = 0; s < 8; ++s) { const int k = 128 * w + 16 * s + 8 * hh;
                const bf16x8 a = *(const LAS bf16x8*)(hs + l32 * 2064 + k * 2);
                acc = __builtin_amdgcn_mfma_f32_32x32x16_bf16(a, rwf[s], acc, 0, 0, 0); }
#pragma unroll
            for (int e = 0; e < 16; ++e) { const int trow = 8 * (e >> 2) + 4 * hh + (e & 3); part[(w * 32 + trow) * 33 + l32] = acc[e]; }
        }
        __syncthreads();
        int es[4], rk[4]; float gs[4];
        {
            const int tr = F.tid >> 4, e0 = (F.tid & 15) * 2;
            float v0 = rb[e0], v1 = rb[e0 + 1];
#pragma unroll
            for (int ww = 0; ww < 8; ++ww) { v0 += part[(ww * 32 + tr) * 33 + e0]; v1 += part[(ww * 32 + tr) * 33 + e0 + 1]; }
            float lv[4];
#pragma unroll
            for (int k = 0; k < 4; ++k) {
                float bv = v0; int bi = e0; if (v1 > bv) { bv = v1; bi = e0 + 1; }
#define N2_ARGMAX_STEP(C) do { const float ov = dpp_f<C>(bv); const int oi = dpp_i<C>(bi); if (ov > bv || (ov == bv && oi < bi)) { bv = ov; bi = oi; } } while (0)
                N2_ARGMAX_STEP(0xB1); N2_ARGMAX_STEP(0x4E); N2_ARGMAX_STEP(0x141); N2_ARGMAX_STEP(0x140);
#undef N2_ARGMAX_STEP
                es[k] = bi; lv[k] = bv;
                if (bi == e0) v0 = -3.0e38f; if (bi == e0 + 1) v1 = -3.0e38f; }
            if (fake) { __syncthreads(); continue; }
            if ((F.tid & 15) == 0) {
                const float mx = lv[0]; float sum = 0.f;
#pragma unroll
                for (int k = 0; k < 4; ++k) { gs[k] = __expf(lv[k] - mx); sum += gs[k]; }
                const float isum = 1.0f / sum;
#pragma unroll
                for (int k = 0; k < 4; ++k) { tokE[tr * 4 + k] = es[k]; tokG[tr * 4 + k] = gs[k] * isum; }
            }
        }
        __syncthreads();
        if (F.tid < 32) {
#pragma unroll
            for (int k = 0; k < 4; ++k) { es[k] = tokE[F.tid * 4 + k]; gs[k] = tokG[F.tid * 4 + k]; rk[k] = __hip_atomic_fetch_add(&lcnt[es[k]], 1, __ATOMIC_RELAXED, __HIP_MEMORY_SCOPE_WORKGROUP); }
        }
        __syncthreads();
        if (F.tid < 32) { const int n = lcnt[F.tid]; lbase[F.tid] = n ? atomicAdd(&cntg[F.tid], n) : 0; }
        __syncthreads();
        if (F.tid < 32) { const int tok = t0 + F.tid;
#pragma unroll
            for (int k = 0; k < 4; ++k) { const int pos = lbase[es[k]] + rk[k]; list[(size_t)es[k] * TT + pos] = tok; lscg[(size_t)es[k] * TT + pos] = tsc[F.tid]; slot[tok * 4 + k] = (es[k] << 20) | pos; gate[tok * 4 + k] = gs[k]; } }
        __syncthreads();
    }
}

template <int OFF> __device__ __forceinline__ s16x4 tr_read(unsigned vb) { s16x4 r; asm volatile("ds_read_b64_tr_b16 %0, %1 offset:%2" : "=&v"(r) : "v"(vb), "i"(OFF) : "memory"); return r; }

__device__ __forceinline__ void attn_phase(const Fr& F, int l, bool with_ctx) {
    LAS unsigned char* lds = F.lds;
    const unsigned ldsb = (unsigned)(uintptr_t)lds;
    const bf16_t* Q = WSP(bf16_t, WS_Q); const bf16_t* Kb = WSP(bf16_t, WS_K); const bf16_t* Vb = WSP(bf16_t, WS_V); unsigned char* AO = WSP(unsigned char, WS_AO);
    const int tid = F.tid, lane = F.lane, w = F.wave, l32 = lane & 31, hh = lane >> 5;
    const int g = w >> 1, rhalf = w & 1;
    const int nunits = 512 + (with_ctx ? 16 : 0);
    const int skey = tid >> 3, sch = tid & 7;
    const unsigned k_st = (unsigned)(skey * 128 + ((sch ^ ((skey >> 1) & 7)) * 16));
    const unsigned v_st = (unsigned)(8192 + skey * 128 + ((((sch >> 1) ^ (((skey >> 1) & 1) << 1)) * 32) + (sch & 1) * 16));
    unsigned vbase[2];
    { const int li = lane & 15, q = li >> 2, p = li & 3, g16 = l32 >> 4; const int key = 4 * hh + q;
#pragma unroll
      for (int db = 0; db < 2; ++db) { const int c32 = 2 * db + g16; vbase[db] = ldsb + 8192u + (unsigned)(key * 128 + ((c32 ^ (((key >> 1) & 1) << 1)) * 32) + 8 * p); } }
    for (int u = F.bid; u < nunits; u += F.G) {
        int b, qb, kvh; bool isctx;
        if (u < 512) { b = u >> 7; qb = (u >> 1) & 63; kvh = u & 1; isctx = false; }
        else { const int uu = u - 512; b = uu >> 2; qb = (uu >> 1) & 1; kvh = uu & 1; isctx = true; }
        const int head = kvh * 4 + g;
        const int qtok0 = isctx ? (TX + b * LC + qb * 128) : (b * SEQ + qb * 128);
        LAS unsigned char* ql = lds + 49152 + w * 8192;
        { u32x4 qv[8];
#pragma unroll
          for (int i = 0; i < 8; ++i) { const int row = i * 8 + (lane >> 3), ch = lane & 7; qv[i] = *(const u32x4*)(Q + (size_t)(qtok0 + rhalf * 64 + row) * 512 + head * 64 + ch * 8); }
#pragma unroll
          for (int i = 0; i < 8; ++i) { const int row = i * 8 + (lane >> 3), ch = lane & 7; *(LAS u32x4*)(ql + row * 128 + ((ch ^ ((row >> 1) & 7)) * 16)) = qv[i]; } }
        const float sink2 = INP(9)[l * 8 + head] * LOG2E;
        const float sk = __builtin_amdgcn_exp2f(sink2 - SOFT_C);
        float l_run[2] = {hh ? 0.f : sk, hh ? 0.f : sk};
        f32x16 O[2][2];
#pragma unroll
        for (int a = 0; a < 2; ++a)
#pragma unroll
            for (int c = 0; c < 2; ++c)
#pragma unroll
                for (int e = 0; e < 16; ++e) O[a][c][e] = 0.f;
#define ATT_TOK0(tt) (((tt) < 6) ? (b * SEQ + (qb - 1) * 128 + 64 * (tt)) : (TX + b * LC + 64 * ((tt) - 6)))
#define ATT_NEXT(tt) ((!isctx && qb == 63 && ((tt) + 1 == 4 || (tt) + 1 == 5)) ? 6 : (tt) + 1)
#define ATT_PV(SLOTB) do { const unsigned vb0 = vbase[0] + (SLOTB), vb1 = vbase[1] + (SLOTB); \
            ATT_PV_STEP(0, 0); ATT_PV_STEP(0, 1); ATT_PV_STEP(1, 0); ATT_PV_STEP(1, 1); } while (0)
#define ATT_PV_STEP(KB, SP) do { \
            const s16x4 a0 = tr_read<((32 * (KB) + 16 * (SP)) * 128)>(vb0), a1 = tr_read<((32 * (KB) + 16 * (SP) + 8) * 128)>(vb0); \
            const s16x4 c0 = tr_read<((32 * (KB) + 16 * (SP)) * 128)>(vb1), c1 = tr_read<((32 * (KB) + 16 * (SP) + 8) * 128)>(vb1); \
            asm volatile("s_waitcnt lgkmcnt(0)" ::: "memory"); __builtin_amdgcn_sched_barrier(0); \
            const bf16x8 vf0 = (bf16x8){a0[0], a0[1], a0[2], a0[3], a1[0], a1[1], a1[2], a1[3]}, vf1 = (bf16x8){c0[0], c0[1], c0[2], c0[3], c1[0], c1[1], c1[2], c1[3]}; \
            O[0][0] = __builtin_amdgcn_mfma_f32_32x32x16_bf16(vf0, pf[KB][SP][0], O[0][0], 0, 0, 0); O[0][1] = __builtin_amdgcn_mfma_f32_32x32x16_bf16(vf0, pf[KB][SP][1], O[0][1], 0, 0, 0); \
            O[1][0] = __builtin_amdgcn_mfma_f32_32x32x16_bf16(vf1, pf[KB][SP][0], O[1][0], 0, 0, 0); O[1][1] = __builtin_amdgcn_mfma_f32_32x32x16_bf16(vf1, pf[KB][SP][1], O[1][1], 0, 0, 0); } while (0)
        const bool late = (w >= 4);
        int t = isctx ? 6 : (qb == 0 ? 2 : 0);
        int tn = ATT_NEXT(t);
        u32x4 kreg, vreg;
        { const int tok0 = ATT_TOK0(t);
          kreg = *(const u32x4*)(Kb + (size_t)(tok0 + skey) * 128 + kvh * 64 + sch * 8); vreg = *(const u32x4*)(Vb + (size_t)(tok0 + skey) * 128 + kvh * 64 + sch * 8); }
        __syncthreads();
        *(LAS u32x4*)(lds + k_st) = kreg; *(LAS u32x4*)(lds + v_st) = vreg;
        if (tn < 10) { const int tok0 = ATT_TOK0(tn);
            kreg = *(const u32x4*)(Kb + (size_t)(tok0 + skey) * 128 + kvh * 64 + sch * 8); vreg = *(const u32x4*)(Vb + (size_t)(tok0 + skey) * 128 + kvh * 64 + sch * 8); }
        __syncthreads();
        int idx = 0, pidx = 0; bool pvpend = false;
        bf16x8 pf[2][2][2];
        for (;;) {
            const bool more = tn < 10;
            const int nidx = (idx == 2) ? 0 : idx + 1;
            int tnn = 10;
            if (more) {
                *(LAS u32x4*)(lds + nidx * 16384 + k_st) = kreg; *(LAS u32x4*)(lds + nidx * 16384 + v_st) = vreg;
                tnn = ATT_NEXT(tn);
                if (tnn < 10) { const int tok0 = ATT_TOK0(tnn);
                    kreg = *(const u32x4*)(Kb + (size_t)(tok0 + skey) * 128 + kvh * 64 + sch * 8); vreg = *(const u32x4*)(Vb + (size_t)(tok0 + skey) * 128 + kvh * 64 + sch * 8); }
            }
            if (late && pvpend) { ATT_PV((unsigned)(pidx * 16384)); pvpend = false; }
            const bool local = (!isctx) && (t < 6);
            const bool skip = local && ((rhalf == 0 && t == 5) || (rhalf == 1 && t == 0));
            const bool needmask = local && ((rhalf == 0 && (t == 0 || t == 4)) || (rhalf == 1 && (t == 1 || t == 5)));
            if (!skip) {
                LAS unsigned char* kl = lds + idx * 16384;
                f32x16 S[2][2];
#pragma unroll
                for (int kb = 0; kb < 2; ++kb)
#pragma unroll
                    for (int qk = 0; qk < 2; ++qk)
#pragma unroll
                        for (int e = 0; e < 16; ++e) S[kb][qk][e] = -SOFT_C;
#pragma unroll
                for (int kb = 0; kb < 2; ++kb)
#pragma unroll
                    for (int s = 0; s < 4; ++s) { const int key = 32 * kb + l32, ch = 2 * s + hh;
                        const bf16x8 kf = *(const LAS bf16x8*)(kl + key * 128 + ((ch ^ ((key >> 1) & 7)) * 16));
#pragma unroll
                        for (int qk = 0; qk < 2; ++qk) { const int qrow = 32 * qk + l32; const bf16x8 qfr = *(const LAS bf16x8*)(ql + qrow * 128 + ((ch ^ ((qrow >> 1) & 7)) * 16));
                            S[kb][qk] = __builtin_amdgcn_mfma_f32_32x32x16_bf16(kf, qfr, S[kb][qk], 0, 0, 0); } }
#pragma unroll
                for (int qk = 0; qk < 2; ++qk) {
                    if (needmask) { const int rq = rhalf * 64 + qk * 32 + l32;
#pragma unroll
                        for (int kb = 0; kb < 2; ++kb)
#pragma unroll
                            for (int e = 0; e < 16; ++e) { const int kk = 64 * t + 32 * kb + 8 * (e >> 2) + 4 * hh + (e & 3); const int rel = kk - 128 - rq; if (rel < -128 || rel > 128) S[kb][qk][e] = -__builtin_inff(); } }
                    float rs = 0.f;
#pragma unroll
                    for (int kb = 0; kb < 2; ++kb)
#pragma unroll
                        for (int e = 0; e < 16; ++e) { const float p = __builtin_amdgcn_exp2f(S[kb][qk][e]); S[kb][qk][e] = p; rs += p; }
                    l_run[qk] += rs;
#pragma unroll
                    for (int kb = 0; kb < 2; ++kb)
#pragma unroll
                        for (int sp = 0; sp < 2; ++sp) { u32x4 pw;
                            pw.x = cvt_pk_bf16(S[kb][qk][8 * sp + 0], S[kb][qk][8 * sp + 1]); pw.y = cvt_pk_bf16(S[kb][qk][8 * sp + 2], S[kb][qk][8 * sp + 3]);
                            pw.z = cvt_pk_bf16(S[kb][qk][8 * sp + 4], S[kb][qk][8 * sp + 5]); pw.w = cvt_pk_bf16(S[kb][qk][8 * sp + 6], S[kb][qk][8 * sp + 7]);
                            pf[kb][sp][qk] = __builtin_bit_cast(bf16x8, pw); }
                }
                if (late) pvpend = true; else ATT_PV((unsigned)(idx * 16384));
            }
            __syncthreads();
            if (!more) break;
            pidx = idx; idx = nidx; t = tn; tn = tnn;
        }
        if (late && pvpend) ATT_PV((unsigned)(idx * 16384));
#undef ATT_PV
#undef ATT_PV_STEP
#undef ATT_TOK0
#undef ATT_NEXT
#pragma unroll
        for (int qk = 0; qk < 2; ++qk) {
            const float lt = l_run[qk] + __shfl_xor(l_run[qk], 32); const float inv = 1.0f / lt;
            const size_t tok = (size_t)(qtok0 + rhalf * 64 + qk * 32 + l32);
#pragma unroll
            for (int db = 0; db < 2; ++db) { const float i16 = inv * 16.0f; unsigned pq[4];
#pragma unroll
                for (int vq = 0; vq < 4; ++vq) pq[vq] = pk4_fp8(clamp8(O[db][qk][4 * vq] * i16), clamp8(O[db][qk][4 * vq + 1] * i16), clamp8(O[db][qk][4 * vq + 2] * i16), clamp8(O[db][qk][4 * vq + 3] * i16));
                const auto r01 = __builtin_amdgcn_permlane32_swap(pq[0], pq[1], false, false), r23 = __builtin_amdgcn_permlane32_swap(pq[2], pq[3], false, false);
                const auto s0 = __builtin_amdgcn_permlane32_swap(r01[0], r23[0], false, false), s1 = __builtin_amdgcn_permlane32_swap(r01[1], r23[1], false, false);
                *(u32x4*)(AO + tok * 512 + head * 64 + 32 * db + 16 * hh) = (u32x4){s0[0], s1[0], s0[1], s1[1]}; }
        }
    }
    __syncthreads();
}

struct Args { const float* in[20]; float* out; unsigned char* ws; int ph_lo, ph_hi; };

constexpr int PH_PER_LAYER = 9;
constexpr int PH_FINAL = 1 + DEPTH * PH_PER_LAYER;
constexpr int PH_COUNT = PH_FINAL + 1;

__global__ void __launch_bounds__(512, 2) fwd_kernel(Args args) {
    extern __shared__ __attribute__((aligned(16))) unsigned char lds_raw[];
    Fr F;
    F.lds = (LAS unsigned char*)lds_raw; F.ws = args.ws; F.out = args.out;
    F.tid = threadIdx.x; F.lane = F.tid & 63; F.wave = __builtin_amdgcn_readfirstlane(F.tid >> 6); F.G = gridDim.x; F.bid = blockIdx.x;
    volatile LAS unsigned* misc = (volatile LAS unsigned*)(F.lds + LDS_MISC);
    if (F.tid < 64) misc[F.tid] = 0u;
    if (F.tid < 20) { const unsigned long long pv = (unsigned long long)args.in[F.tid]; misc[128 + 2 * F.tid] = (unsigned)pv; misc[128 + 2 * F.tid + 1] = (unsigned)(pv >> 32); }
    __syncthreads();
    XcdBarrier bar; bar.bar = (unsigned*)(F.ws + WS_CTL); bar.x = 0; bar.st = misc;
    const bool one = (args.ph_hi - args.ph_lo) > 1;
    if (one) bar = xcd_barrier_post((unsigned*)(F.ws + WS_CTL), misc);
    const int lo = args.ph_lo, hi = args.ph_hi;
#ifdef STOP_PH
#define IN(k) (lo <= (k) && (k) < hi && ((k) < STOP_PH || (k) == PH_FINAL))
#else
#define IN(k) (lo <= (k) && (k) < hi)
#endif
#ifndef DUP_PH
#define DUP_PH -1
#endif
#define NREP(b) ((DUP_PH == (b)) ? 2 : 1)
#define SEAM(k) do { if (lo <= (k) + 1 && (k) + 1 < hi) xcd_barrier(bar); } while (0)

#ifndef PHM
#define PHM 0xFFFF
#endif
#define PHON(b) ((PHM >> (b)) & 1)
    if (PHON(0) && IN(0)) { for (int rep = 0; rep < NREP(0); ++rep) { LAUNDER(F); prologue_phase(F); SEAM(0); } }

#pragma unroll 1
    for (int l = 0; l < NLAYERS_RUN; ++l) {
        const int pb = 1 + l * PH_PER_LAYER;
        const bool lastl = (l == DEPTH - 1);
        if (PHON(1) && IN(pb + 0)) { LAUNDER(F); norm1_phase(F, l); SEAM(pb + 0); }
        if (PHON(2) && IN(pb + 1)) for (int rep = 0; rep < NREP(2); ++rep) { LAUNDER(F);
            { InProjProb<0> P; P.H = WSP(signed char, WS_H8); P.W = WSP(signed char, WS_WIN) + (size_t)l * IN_DIM * 1024; P.sH = WSP(float, WS_SH); P.sW = WSP(float, WS_SWIN) + (size_t)l * IN_DIM;
              P.FT = WSP(bf16_t, WS_FT); P.FCT = WSP(bf16_t, WS_FCT); P.Q = WSP(bf16_t, WS_Q); P.Kb = WSP(bf16_t, WS_K); P.Vb = WSP(bf16_t, WS_V); P.GF = WSP(bf16_t, WS_GF); P.GA = WSP(bf16_t, WS_GA);
              P.rope = (const LAS float*)(F.lds + LDS_ROPE);
              { const float* rg = WSP(float, WS_ROPE); LAS float* rl = (LAS float*)(F.lds + LDS_ROPE); for (int i = F.tid; i < 4096; i += 512) rl[i] = rg[i]; __syncthreads(); }
              P.nM = lastl ? 128 : 132; P.n_nat = P.nM * 11; P.n_fx = 256; P.n_fc = lastl ? 0 : 8; P.n_extra = lastl ? 4 : 0; P.G = F.G; P.c = F.bid;
              g8::gemm_run(F.lds, P); }
            { InProjProb<1> P; P.H = WSP(signed char, WS_H8); P.W = WSP(signed char, WS_WIN) + (size_t)l * IN_DIM * 1024; P.sH = WSP(float, WS_SH); P.sW = WSP(float, WS_SWIN) + (size_t)l * IN_DIM;
              P.FT = WSP(bf16_t, WS_FT); P.FCT = WSP(bf16_t, WS_FCT); P.Q = nullptr; P.Kb = nullptr; P.Vb = nullptr; P.GF = nullptr; P.GA = nullptr; P.rope = nullptr;
              P.nM = 0; P.n_nat = 0; P.n_fx = 256; P.n_fc = lastl ? 0 : 8; P.n_extra = 0; P.G = F.G; P.c = (F.bid + 84) % F.G;
              g8::gemm_run(F.lds, P); }
            SEAM(pb + 1);
        }
        if (PHON(3) && IN(pb + 2)) for (int rep = 0; rep < NREP(3); ++rep) { LAUNDER(F);
#ifndef NO_ATTN
            attn_phase(F, l, !lastl);
#endif
#ifndef NO_FFT1
            Fft1Prob P; P.W1 = WSP(bf16_t, WS_W1); P.FT = WSP(bf16_t, WS_FT); P.WC = WSP(bf16_t, WS_WC); P.FCT = WSP(bf16_t, WS_FCT); P.T1 = WSP(bf16_t, WS_T1); P.XS = WSP(unsigned char, WS_XS);
            P.n0 = 512; P.n1 = lastl ? 0 : 16; P.G = F.G; P.c = (F.bid + 128) % F.G;
            g8::gemm_run(F.lds, P);
#endif
            SEAM(pb + 2);
        }
        if (PHON(4) && IN(pb + 3)) for (int rep = 0; rep < NREP(4); ++rep) { LAUNDER(F);
            const int nctx = lastl ? 0 : 16;
            { Fft2Prob P; P.MT = WSP(bf16_t, WS_MT); P.T1 = WSP(bf16_t, WS_T1); P.XS = WSP(unsigned char, WS_XS); P.G = F.G - nctx; P.c = F.bid - nctx;
              g8::gemm_run(F.lds, P); }
            if (nctx) { Merge1Prob P; P.XS = WSP(unsigned char, WS_XS); P.AO = WSP(unsigned char, WS_AO); P.WFO = WSP(unsigned char, WS_WFO) + (size_t)l * 1024 * 1024; P.WAO = WSP(unsigned char, WS_WAO) + (size_t)l * 1024 * 512;
              P.GF = WSP(unsigned char, WS_GF); P.GA = WSP(unsigned char, WS_GA); P.Y8 = WSP(unsigned char, WS_YB); P.nM = 4; P.pm0 = 128; P.G = 16; P.c = (F.bid < 16) ? F.bid : -1;
              g8::gemm_run(F.lds, P); }
            SEAM(pb + 3);
        }
        if (PHON(5) && IN(pb + 4)) for (int rep = 0; rep < NREP(5); ++rep) { LAUNDER(F);
            { Merge1Prob P; P.XS = WSP(unsigned char, WS_XS); P.AO = WSP(unsigned char, WS_AO); P.WFO = WSP(unsigned char, WS_WFO) + (size_t)l * 1024 * 1024; P.WAO = WSP(unsigned char, WS_WAO) + (size_t)l * 1024 * 512;
              P.GF = WSP(unsigned char, WS_GF); P.GA = WSP(unsigned char, WS_GA); P.Y8 = WSP(unsigned char, WS_YB); P.nM = 128; P.pm0 = 0; P.G = F.G; P.c = F.bid;
              g8::gemm_run(F.lds, P); }
            SEAM(pb + 4);
        }
        if (PHON(6) && IN(pb + 5)) { LAUNDER(F);
            MergeProb<2> P; P.A = WSP(unsigned char, WS_YB); P.W = WSP(unsigned char, WS_WOUT) + (size_t)l * 1024 * 1024; P.lda = 1024; P.GATE = nullptr; P.T = nullptr; P.Y8 = nullptr;
            P.xin = INP(0); P.cin = INP(2); P.XWb = WSP(bf16_t, WS_XW); P.CWb = WSP(bf16_t, WS_CW); P.in32 = (l == 0);
            P.g1x = WSP(float, WS_MOD) + (size_t)l * 5 * 6144 + 2 * 1024; P.g1c = WSP(float, WS_MOD) + ((size_t)l * 5 + 4) * 6144 + 2 * 1024; P.nM = lastl ? 128 : 132; P.G = F.G; P.c = F.bid;
            g8::gemm_run(F.lds, P); SEAM(pb + 5);
        }
        if (PHON(7) && IN(pb + 6)) for (int rep = 0; rep < NREP(7); ++rep) { LAUNDER(F); norm2_router_phase(F, l, rep + 1 < NREP(7)); SEAM(pb + 6); }
        if (PHON(8) && IN(pb + 7)) for (int rep = 0; rep < NREP(8); ++rep) { LAUNDER(F);
            MoeGuProb P; P.R = fill_tstart(F, l);
            P.H8 = WSP(signed char, WS_H8); P.W8 = WSP(signed char, WS_WGU) + (size_t)l * 32 * 2048 * 1024; P.sW = WSP(float, WS_SWGU) + (size_t)l * 32 * 2048; P.lsc = WSP(float, WS_LSC);
            P.bgu = INP(16) + (size_t)l * 32 * 2048; P.ACT = WSP(unsigned char, WS_ACT);
            P.list = WSP(int, WS_LIST); P.cnt = (const int*)(F.ws + WS_CTL + CTL_CNT) + l * 32; P.tstart = (const volatile LAS int*)(F.lds + LDS_MISC + 64); P.G = F.G; P.c = F.bid;
            g8::gemm_run(F.lds, P); SEAM(pb + 7);
        }
        if (PHON(9) && IN(pb + 8)) for (int rep = 0; rep < NREP(9); ++rep) { LAUNDER(F);
            MoeDnProb P; P.R = fill_tstart(F, l);
            P.ACT = WSP(unsigned char, WS_ACT); P.W = WSP(unsigned char, WS_WDN) + (size_t)l * 32 * 1024 * 1024; P.bdn = INP(18) + (size_t)l * 32 * 1024; P.YE = WSP(unsigned char, WS_YE);
            P.tstart = (const volatile LAS int*)(F.lds + LDS_MISC + 64); P.G = F.G; P.c = F.bid;
            g8::gemm_run(F.lds, P, ((F.bid >> 3) & 3) * STG_DN); SEAM(pb + 8);
        }
    }
#ifdef STOP_PH
    if (IN(PH_FINAL)) { LAUNDER(F);
        const size_t n = (size_t)TX * 1024;
        for (size_t i = (size_t)F.bid * 512 + F.tid; i < n; i += (size_t)F.G * 512) {
            F.out[i] = DUMP_EXPR(i);
        } }
#else
    if (PHON(10) && IN(PH_FINAL)) for (int rep = 0; rep < NREP(10); ++rep) { LAUNDER(F); norm1_phase(F, DEPTH); if (rep + 1 < NREP(10)) xcd_barrier(bar); }
#endif
#undef IN
#undef SEAM
}

extern "C" void kernel_launch(void* const* d_in, const int* in_sizes, int n_in, void* d_out, int out_size, void* d_ws, size_t ws_size, hipStream_t stream) {
    static int grid = 0;
    if (grid == 0) {
        if (n_in != 20 || ws_size < WS_END) { fprintf(stderr, "kernel_launch: bad arguments (n_in %d, ws %zu < %zu)\n", n_in, ws_size, (size_t)WS_END); grid = -1; return; }
        int dev = 0, cus = 0, per_cu = 0;
        if (hipGetDevice(&dev) != hipSuccess || hipDeviceGetAttribute(&cus, hipDeviceAttributeMultiprocessorCount, dev) != hipSuccess) { grid = -1; return; }
        if (hipFuncSetAttribute((const void*)fwd_kernel, hipFuncAttributeMaxDynamicSharedMemorySize, LDS_BYTES) != hipSuccess) { fprintf(stderr, "kernel_launch: hipFuncSetAttribute failed\n"); grid = -1; return; }
        if (hipOccupancyMaxActiveBlocksPerMultiprocessor(&per_cu, (const void*)fwd_kernel, 512, LDS_BYTES) != hipSuccess || per_cu < 1) { fprintf(stderr, "kernel_launch: occupancy query says %d\n", per_cu); }
        (void)hipGetLastError();
        grid = cus;
    }
    if (grid < 0) return;
    (void)hipMemsetAsync((char*)d_ws + WS_CTL, 0, CTL_BYTES, stream);
    Args a{};
    for (int i = 0; i < 20; ++i) a.in[i] = (const float*)d_in[i];
    a.out = (float*)d_out; a.ws = (unsigned char*)d_ws;
#if N_LAUNCH_MODE == 1
    a.ph_lo = 0; a.ph_hi = PH_COUNT;
    hipLaunchKernelGGL(fwd_kernel, dim3(grid), dim3(512), LDS_BYTES, stream, a);
#else
    for (int p = 0; p < PH_COUNT; ++p) { a.ph_lo = p; a.ph_hi = p + 1; hipLaunchKernelGGL(fwd_kernel, dim3(grid), dim3(512), LDS_BYTES, stream, a); }
#endif
    (void)in_sizes; (void)out_size;
}
```
